# Optimizing an MI355X kernel written in HIP

```python
import jax, jax.numpy as jnp
from jax import lax
import numpy as np

D_MODEL = 1024
BATCH = 2
SEQ = 16384
DEPTH = 2

GRID_W = 64
MIX_W = D_MODEL
EPS = 1e-6
D_RNN = MIX_W
RNN_BLOCKS = 4
RNN_BW = D_RNN // RNN_BLOCKS
CONV_A_W = 4
CONV_A_LEFT = 2
LRU_C = 8.0
N_HEADS = 8
N_KV = 2
HEAD_DIM = MIX_W // N_HEADS
GROUP = N_HEADS // N_KV
ROPE_THETA = 10000.0
Q_BLOCK = 128
D_CONV = MIX_W
CONV_C_W = 3
CONV_C_LEFT = 1
N_BRANCH = 3
IN_SIZES = (D_RNN, D_RNN,
            N_HEADS * HEAD_DIM, N_KV * HEAD_DIM, N_KV * HEAD_DIM, N_HEADS * HEAD_DIM,
            D_CONV, D_CONV, D_CONV, D_CONV,
            N_BRANCH * D_MODEL)
N_IN = sum(IN_SIZES)

kernel_name = "hybrid_rglru_gqa_shortconv_encoder"


def rms_norm(x, g):
    xf = x.astype(jnp.float32)
    y = xf * lax.rsqrt(jnp.mean(xf * xf, axis=-1, keepdims=True) + EPS)
    return (y * g.astype(jnp.float32)).astype(x.dtype)


def dwconv(x, w, left):
    K = w.shape[0]
    S = x.shape[1]
    xp = jnp.pad(x, ((0, 0), (left, K - 1 - left), (0, 0)))
    y = xp[:, 0:S] * w[0]
    for k in range(1, K):
        y = y + xp[:, k:k + S] * w[k]
    return y


def _combine(e1, e2):
    a1, b1 = e1
    a2, b2 = e2
    return a1 * a2, a2 * b1 + b2


def rg_lru_dir(x, w_r, b_r, w_i, b_i, lam, reverse):
    B_, S, _ = x.shape
    xb = x.reshape(B_, S, RNN_BLOCKS, RNN_BW)
    r = jax.nn.sigmoid(jnp.einsum('bsnc,ncd->bsnd', xb, w_r).reshape(B_, S, D_RNN) + b_r)
    i = jax.nn.sigmoid(jnp.einsum('bsnc,ncd->bsnd', xb, w_i).reshape(B_, S, D_RNN) + b_i)
    log_a = -LRU_C * r.astype(jnp.float32) * jax.nn.softplus(-lam.astype(jnp.float32))
    a = jnp.exp(log_a)
    u = jnp.sqrt(-jnp.expm1(2.0 * log_a)) * (i * x).astype(jnp.float32)
    _, h = lax.associative_scan(_combine, (a, u), axis=1, reverse=reverse)
    return h


def axial_rope_tables(S):
    rows = S // GRID_W
    row = jnp.repeat(jnp.arange(rows, dtype=jnp.float32), GRID_W)
    col = jnp.tile(jnp.arange(GRID_W, dtype=jnp.float32), rows)
    half = HEAD_DIM // 2
    inv = ROPE_THETA ** (-jnp.arange(0, half, 2, dtype=jnp.float32) / half)
    ang_r = row[:, None] * inv
    ang_c = col[:, None] * inv
    return jnp.cos(ang_r), jnp.sin(ang_r), jnp.cos(ang_c), jnp.sin(ang_c)


def rope_1d(x, cos, sin):
    f = x.shape[-1] // 2
    x1, x2 = x[..., :f], x[..., f:]
    cs = cos[None, :, None, :]
    sn = sin[None, :, None, :]
    return jnp.concatenate([x1 * cs - x2 * sn, x2 * cs + x1 * sn], axis=-1)


def apply_axial_rope(x, tabs):
    cos_r, sin_r, cos_c, sin_c = tabs
    half = HEAD_DIM // 2
    xf = x.astype(jnp.float32)
    y = jnp.concatenate([rope_1d(xf[..., :half], cos_r, sin_r),
                         rope_1d(xf[..., half:], cos_c, sin_c)], axis=-1)
    return y.astype(x.dtype)


def gqa_attention(q, k, v, q_g, k_g, tabs):
    B_, S, _ = q.shape
    q = q.reshape(B_, S, N_HEADS, HEAD_DIM)
    k = k.reshape(B_, S, N_KV, HEAD_DIM)
    v = v.reshape(B_, S, N_KV, HEAD_DIM)
    q = apply_axial_rope(rms_norm(q, q_g), tabs) * (HEAD_DIM ** -0.5)
    k = apply_axial_rope(rms_norm(k, k_g), tabs)
    qb = q.reshape(B_, S // Q_BLOCK, Q_BLOCK, N_KV, GROUP, HEAD_DIM).transpose(1, 0, 2, 3, 4, 5)

    def block(qi):
        s = jnp.einsum('bqkgd,bskd->bkgqs', qi, k).astype(jnp.float32)
        p = jax.nn.softmax(s, axis=-1).astype(v.dtype)
        return jnp.einsum('bkgqs,bskd->bqkgd', p, v)

    o = lax.map(block, qb)
    return o.transpose(1, 0, 2, 3, 4, 5).reshape(B_, S, N_HEADS * HEAD_DIM)


def setup_inputs(seed: int = 0) -> dict:
    key = jax.random.key(seed)
    ks = jax.random.split(key, 20)
    f32 = jnp.float32
    nrm = lambda k, shp, s: jax.random.normal(k, shp, f32) * s
    a8 = jax.random.uniform(ks[12], (DEPTH, 2, D_RNN), f32, minval=0.9, maxval=0.999)
    a = a8 ** (1.0 / LRU_C)
    lam = jnp.log(a) - jnp.log1p(-a)
    return {
        "x": nrm(ks[0], (BATCH, SEQ, D_MODEL), 1.0),
        "c": nrm(ks[1], (BATCH, D_MODEL), 1.0),
        "w_ada": nrm(ks[2], (DEPTH, D_MODEL, 3 * D_MODEL), 0.5 * D_MODEL ** -0.5),
        "b_ada": nrm(ks[3], (DEPTH, 3 * D_MODEL), 0.01),
        "norm_g": 1.0 + nrm(ks[4], (DEPTH, D_MODEL), 0.02),
        "w_in": nrm(ks[5], (DEPTH, D_MODEL, N_IN), D_MODEL ** -0.5),
        "conv_a_w": nrm(ks[6], (DEPTH, CONV_A_W, D_RNN), CONV_A_W ** -0.5),
        "conv_a_b": nrm(ks[7], (DEPTH, D_RNN), 0.01),
        "w_rg": nrm(ks[8], (DEPTH, 2, RNN_BLOCKS, RNN_BW, RNN_BW), RNN_BW ** -0.5),
        "b_rg": nrm(ks[9], (DEPTH, 2, D_RNN), 0.01),
        "w_ig": nrm(ks[10], (DEPTH, 2, RNN_BLOCKS, RNN_BW, RNN_BW), RNN_BW ** -0.5),
        "b_ig": nrm(ks[11], (DEPTH, 2, D_RNN), 0.01),
        "lru_lam": lam,
        "q_norm_g": 1.0 + nrm(ks[13], (DEPTH, HEAD_DIM), 0.02),
        "k_norm_g": 1.0 + nrm(ks[14], (DEPTH, HEAD_DIM), 0.02),
        "conv_c_w": nrm(ks[15], (DEPTH, CONV_C_W, D_CONV), CONV_C_W ** -0.5),
        "w_branch": nrm(ks[16], (DEPTH, N_BRANCH, MIX_W, D_MODEL), MIX_W ** -0.5),
        "w_out": nrm(ks[17], (DEPTH, D_MODEL, D_MODEL), D_MODEL ** -0.5),
    }


def reference(x, c, w_ada, b_ada, norm_g, w_in, conv_a_w, conv_a_b, w_rg, b_rg, w_ig, b_ig,
              lru_lam, q_norm_g, k_norm_g, conv_c_w, w_branch, w_out):
    B_, S, D = x.shape
    tabs = axial_rope_tables(S)
    offsets = [int(o) for o in np.cumsum(IN_SIZES)[:-1]]
    for l in range(DEPTH):
        mod = c @ w_ada[l] + b_ada[l]
        shift, scale, gate = jnp.split(mod, 3, axis=-1)
        h = rms_norm(x, norm_g[l]) * (1.0 + scale[:, None, :]) + shift[:, None, :]
        proj = h @ w_in[l]
        (xa, ga, q, k, v, gb, xc, bc, cc, gc, mg) = jnp.split(proj, offsets, axis=-1)

        ua = dwconv(xa, conv_a_w[l], CONV_A_LEFT) + conv_a_b[l]
        hf = rg_lru_dir(ua, w_rg[l, 0], b_rg[l, 0], w_ig[l, 0], b_ig[l, 0], lru_lam[l, 0], False)
        hb = rg_lru_dir(ua, w_rg[l, 1], b_rg[l, 1], w_ig[l, 1], b_ig[l, 1], lru_lam[l, 1], True)
        ya = (hf + hb).astype(x.dtype) * jax.nn.silu(ga)

        yb = gqa_attention(q, k, v, q_norm_g[l], k_norm_g[l], tabs) * jax.nn.silu(gb)

        yc = bc * dwconv(cc * xc, conv_c_w[l], CONV_C_LEFT) * jax.nn.silu(gc)

        br = jnp.stack([ya, yb, yc], axis=2)
        pb = jnp.einsum('bskw,kwd->bskd', br, w_branch[l])
        gates = jax.nn.sigmoid(mg).reshape(B_, S, N_BRANCH, D)
        merged = jnp.einsum('bskd,bskd->bsd', gates, pb)
        x = x + gate[:, None, :] * (merged @ w_out[l])
    return x
```

```cpp
#include <hip/hip_runtime.h>
#include <hip/hip_cooperative_groups.h>
#include <hip/hip_bf16.h>
#include <cstdio>
#include <cstdint>
namespace cg = cooperative_groups;

#define LAS __attribute__((address_space(3)))
#define GAS __attribute__((address_space(1)))
typedef unsigned short bf16_t;
typedef short bf16x8 __attribute__((ext_vector_type(8)));
typedef float f32x4 __attribute__((ext_vector_type(4)));
typedef float f32x2 __attribute__((ext_vector_type(2)));
typedef unsigned u32x4 __attribute__((ext_vector_type(4)));
typedef unsigned u32x2 __attribute__((ext_vector_type(2)));

constexpr int DM = 1024, SEQ = 16384, NBATCH = 2, DEPTH = 2, NIN = 11776;
constexpr int NPH_PER = 8, NPHASES = 1 + DEPTH * NBATCH * NPH_PER;
constexpr float EPS = 1e-6f;
constexpr float LOG2E = 1.4426950408889634f;

constexpr size_t MiB = 1u << 20;
constexpr size_t WS_MOD = 0;
constexpr size_t WS_ROPE = 64 * 1024;
constexpr size_t WS_BAR = 256 * 1024;
constexpr size_t WS_SA = 1 * MiB, WS_SH = 2 * MiB;
constexpr size_t WS_WIN = 4 * MiB, WS_WG = 50 * MiB, WS_WBR = 54 * MiB, WS_WOUT = 66 * MiB;
constexpr size_t WS_H = 70 * MiB;
constexpr size_t WS_XA = 102 * MiB;
constexpr size_t WS_SGA = 134 * MiB;
constexpr size_t WS_Q = 166 * MiB;
constexpr size_t WS_K = 198 * MiB, WS_V = 206 * MiB;
constexpr size_t WS_SGB = 214 * MiB;
constexpr size_t WS_XC = 246 * MiB, WS_BC = 278 * MiB, WS_CC = 310 * MiB, WS_SGC = 342 * MiB;
constexpr size_t WS_LA = WS_XC, WS_U = WS_BC;
constexpr size_t WS_SMG = 374 * MiB;
constexpr size_t WS_YC = 470 * MiB;
constexpr size_t WS_END = 502 * MiB;
constexpr int LDS_BYTES = 131072 + 1024;

__device__ __forceinline__ float bf2f(bf16_t v) { return __uint_as_float((unsigned)v << 16); }
__device__ __forceinline__ unsigned f2bf(float f) { unsigned u = __float_as_uint(f); return (u + 0x7fffu + ((u >> 16) & 1u)) >> 16; }
__device__ __forceinline__ unsigned cvt_pk_bf16(float lo, float hi) { unsigned r; asm("v_cvt_pk_bf16_f32 %0, %1, %2" : "=v"(r) : "v"(lo), "v"(hi)); return r; }
__device__ __forceinline__ void unpack8(const u32x4 w, float (&f)[8]) {
#pragma unroll
    for (int i = 0; i < 4; ++i) { f[2 * i] = __uint_as_float(w[i] << 16); f[2 * i + 1] = __uint_as_float(w[i] & 0xffff0000u); }
}
__device__ __forceinline__ u32x4 pack8(const float (&f)[8]) {
    u32x4 w; w.x = cvt_pk_bf16(f[0], f[1]); w.y = cvt_pk_bf16(f[2], f[3]); w.z = cvt_pk_bf16(f[4], f[5]); w.w = cvt_pk_bf16(f[6], f[7]); return w;
}
__device__ __forceinline__ float sigmoidf_(float v) { return __builtin_amdgcn_rcpf(1.f + __expf(-v)); }
__device__ __forceinline__ float wave_sum(float v) {
#pragma unroll
    for (int o = 1; o < 64; o <<= 1) v += __shfl_xor(v, o);
    return v;
}
#define LDS_WAIT() asm volatile("s_waitcnt lgkmcnt(0)" ::: "memory")
#define VM_WAIT() asm volatile("s_waitcnt vmcnt(0)" ::: "memory")

namespace pg8 {
constexpr int BM = 256, BK = 64, HALF = 128, HTB = HALF * BK * 2, STAGE_BYTES = 8 * HTB, NXCD = 8, WGM = 8;
__device__ __forceinline__ int lds_byte(int r, int c) { const int st = (r >> 4) * 2 + (c >> 5), rr = r & 15, cc = c & 31, ob = rr * 64 + cc * 2; return st * 1024 + (ob ^ (((ob >> 9) & 1) << 5)); }
__device__ __forceinline__ void stage_rc(int b, int& R, int& C) { const int st = b / 1024, sb = b % 1024, swz = sb ^ (((sb >> 9) & 1) << 5); R = (st >> 1) * 16 + swz / 64; C = (st & 1) * 32 + (swz % 64) / 2; }
__device__ __forceinline__ int perm32(int rho) { const int n = rho >> 4, i = rho & 15; return 8 * (i >> 2) + 4 * n + (i & 3); }

struct Unit { int pm, pn, kk; };
struct Gemm { const bf16_t* A; const bf16_t* Bt; int lda, ldb, K; long a1, a2; };

struct StaticOrder {
    int nM, nN, nwg, G, c;
    __device__ void init(int M, int N, int G_, int c_) { nM = M / BM; nN = N / BM; nwg = nM * nN; G = G_; c = c_; }
    __device__ bool next(int i, Unit& u) const {
        const long L = (long)i * G + c; if (L >= nwg) return false;
        int wgid = (int)L; { const int q = nwg / NXCD, r = nwg % NXCD, xcd = wgid % NXCD, off = wgid / NXCD; wgid = (xcd < r ? xcd * (q + 1) : r * (q + 1) + (xcd - r) * q) + off; }
        const int nig = WGM * nN, gid = wgid / nig, fm = gid * WGM, gsz = (nM - fm) < WGM ? (nM - fm) : WGM;
        u.pm = fm + ((wgid % nig) % gsz); u.pn = (wgid % nig) / gsz; u.kk = 0; return true;
    }
};
struct BranchOrder {
    StaticOrder so;
    __device__ bool next(int i, Unit& u) const { const int ti = i / 3, kk = i - 3 * ti; if (!so.next(ti, u)) return false; u.kk = kk; return true; }
};

template <int MODE> __device__ __forceinline__ const char* unitA(const Gemm& g, const Unit& u) {
    const char* p = (const char*)g.A + (size_t)u.pm * BM * g.lda * 2;
    if (MODE == 1) p += (((u.pn >> 1) & 3) * 256) * 2;
    if (MODE == 2) p += (u.kk == 1 ? g.a1 : (u.kk == 2 ? g.a2 : 0l));
    return p;
}
template <int MODE> __device__ __forceinline__ const char* unitB(const Gemm& g, const Unit& u) {
    const char* p = (const char*)g.Bt + (size_t)u.pn * BM * g.ldb * 2;
    if (MODE == 2) p += (size_t)u.kk * 1024 * 1024 * 2;
    return p;
}

template <class Epi, class Sched, int MODE>
__device__ __forceinline__ void gemm_phase(LAS unsigned char* lds, const Gemm g, const Sched& S, const Epi& E, const int tid) {
    const int wid = __builtin_amdgcn_readfirstlane(tid >> 6), lane = tid & 63, wr = wid >> 2, wc = wid & 3, fr = lane & 15, fq = lane >> 4;
    const int K = g.K, nt = K / BK;
    unsigned voffA[2], voffB[2];
#pragma unroll
    for (int i = 0; i < 2; ++i) { int R, C; stage_rc(tid * 16 + i * 8192, R, C); const int Rb = (R & ~31) + perm32(R & 31);
        voffA[i] = (unsigned)(R * g.lda + C) * 2u; voffB[i] = (unsigned)(Rb * g.ldb + C) * 2u; }
    const size_t kstep = (size_t)(BK * 2);
    const size_t hstepA = (size_t)HALF * g.lda * 2, hstepB = (size_t)HALF * g.ldb * 2;
    const unsigned ldsw = (unsigned)wid * 1024u;
    const int aoff = lds_byte(wr * 64 + fr, fq * 8), boff = lds_byte(wc * 32 + fr, fq * 8);
#define PG8_SA(b, h) (((b) * 2 + (h)) * HTB)
#define PG8_SB(b, h) ((4 + (b) * 2 + (h)) * HTB)
#define PG8_STAGE(bufoff, gbase, voff) do { _Pragma("unroll") for (int _i = 0; _i < 2; ++_i) \
        __builtin_amdgcn_global_load_lds((const unsigned*)((const char*)(gbase) + (voff)[_i]), (LAS unsigned*)(lds + (bufoff) + ldsw + _i * 8192), 16, 0, 0); } while (0)
#define PG8_LDA(dst, b, h) do { _Pragma("unroll") for (int m = 0; m < 4; ++m) _Pragma("unroll") for (int k = 0; k < 2; ++k) dst[m][k] = *(const LAS bf16x8*)(lds + PG8_SA(b, h) + aoff + m * 2048 + k * 1024); } while (0)
#define PG8_LDB(dst, b, h) do { _Pragma("unroll") for (int n = 0; n < 2; ++n) _Pragma("unroll") for (int k = 0; k < 2; ++k) dst[n][k] = *(const LAS bf16x8*)(lds + PG8_SB(b, h) + boff + n * 2048 + k * 1024); } while (0)
#define PG8_MMA(ai, bj, At, Bt) do { __builtin_amdgcn_s_setprio(1); _Pragma("unroll") for (int m = 0; m < 4; ++m) _Pragma("unroll") for (int n = 0; n < 2; ++n) _Pragma("unroll") for (int k = 0; k < 2; ++k) \
        acc[ai][bj][m][n] = __builtin_amdgcn_mfma_f32_16x16x32_bf16(Bt[n][k], At[m][k], acc[ai][bj][m][n], 0, 0, 0); __builtin_amdgcn_s_setprio(0); } while (0)
#define PG8_WAIT_V(n) asm volatile("s_waitcnt vmcnt(" #n ")" ::: "memory")
#define PG8_WAIT_L(n) asm volatile("s_waitcnt lgkmcnt(" #n ")" ::: "memory")
#define PG8_BAR __builtin_amdgcn_s_barrier()
#define PG8_SCHED __builtin_amdgcn_sched_barrier(0)
    Unit cur, nxt; int ui = 0;
    if (!S.next(0, cur)) return;
    f32x4 acc[2][2][4][2];
#pragma unroll
    for (int a = 0; a < 2; ++a)
#pragma unroll
        for (int b = 0; b < 2; ++b)
#pragma unroll
            for (int m = 0; m < 4; ++m)
#pragma unroll
                for (int n = 0; n < 2; ++n) acc[a][b][m][n] = (f32x4){0.f, 0.f, 0.f, 0.f};
    bf16x8 At[4][2], B0[2][2], B1[2][2];
    const char* cA = unitA<MODE>(g, cur); const char* cB = unitB<MODE>(g, cur);
    PG8_STAGE(PG8_SB(0, 0), cB, voffB); PG8_STAGE(PG8_SB(0, 1), cB + hstepB, voffB); PG8_STAGE(PG8_SA(0, 0), cA, voffA); PG8_STAGE(PG8_SA(0, 1), cA + hstepA, voffA);
    if (wr == 1) PG8_BAR;
    PG8_WAIT_V(2); PG8_BAR;
    PG8_STAGE(PG8_SB(1, 0), cB + kstep, voffB); PG8_STAGE(PG8_SA(1, 0), cA + kstep, voffA); PG8_STAGE(PG8_SB(1, 1), cB + hstepB + kstep, voffB);
    PG8_WAIT_V(6); PG8_BAR;
    for (;;) {
        const bool has_next = S.next(ui + 1, nxt);
        const char* nA = has_next ? unitA<MODE>(g, nxt) : cA; const char* nB = has_next ? unitB<MODE>(g, nxt) : cB;
#pragma nounroll
        for (int t = 0; t < nt; t += 2) {
            const bool last = (t == nt - 2);
            const char* a1 = cA + (size_t)(t + 1) * kstep;
            const char* a2 = last ? nA : cA + (size_t)(t + 2) * kstep; const char* b2 = last ? nB : cB + (size_t)(t + 2) * kstep;
            const char* a3 = a2 + kstep; const char* b3 = b2 + kstep;
            PG8_LDB(B0, 0, 0); PG8_LDB(B1, 0, 1); PG8_SCHED; PG8_LDA(At, 0, 0); PG8_STAGE(PG8_SA(1, 1), a1 + hstepA, voffA);
            PG8_WAIT_V(8); PG8_WAIT_L(0); PG8_BAR; PG8_MMA(0, 0, At, B0); PG8_MMA(0, 1, At, B1); PG8_BAR; PG8_SCHED;
            PG8_LDA(At, 0, 1); PG8_STAGE(PG8_SB(0, 0), b2, voffB); PG8_STAGE(PG8_SB(0, 1), b2 + hstepB, voffB); PG8_STAGE(PG8_SA(0, 0), a2, voffA);
            PG8_WAIT_V(8); PG8_WAIT_L(0); PG8_BAR; PG8_MMA(1, 0, At, B0); PG8_MMA(1, 1, At, B1); PG8_BAR; PG8_SCHED;
            PG8_LDB(B0, 1, 0); PG8_LDB(B1, 1, 1); PG8_SCHED; PG8_LDA(At, 1, 0); PG8_STAGE(PG8_SA(0, 1), a2 + hstepA, voffA);
            PG8_WAIT_V(8); PG8_WAIT_L(0); PG8_BAR; PG8_MMA(0, 0, At, B0); PG8_MMA(0, 1, At, B1); PG8_BAR; PG8_SCHED;
            PG8_LDA(At, 1, 1); PG8_STAGE(PG8_SB(1, 0), b3, voffB); PG8_STAGE(PG8_SB(1, 1), b3 + hstepB, voffB); PG8_STAGE(PG8_SA(1, 0), a3, voffA);
            PG8_WAIT_V(8); PG8_WAIT_L(0); PG8_BAR; PG8_MMA(1, 0, At, B0); PG8_MMA(1, 1, At, B1); PG8_BAR; PG8_SCHED;
        }
        if (wr == 0) PG8_BAR;
        E(acc, cur, wr, wc, fr, fq);
        if (!has_next) break;
#pragma unroll
        for (int a = 0; a < 2; ++a)
#pragma unroll
            for (int b = 0; b < 2; ++b)
#pragma unroll
                for (int m = 0; m < 4; ++m)
#pragma unroll
                    for (int n = 0; n < 2; ++n) acc[a][b][m][n] = (f32x4){0.f, 0.f, 0.f, 0.f};
        cur = nxt; cA = nA; cB = nB; ++ui;
        if (wr == 1) PG8_BAR;
    }
    PG8_WAIT_V(0);
    PG8_BAR;
#undef PG8_SA
#undef PG8_SB
#undef PG8_STAGE
#undef PG8_LDA
#undef PG8_LDB
#undef PG8_MMA
#undef PG8_WAIT_V
#undef PG8_WAIT_L
#undef PG8_BAR
#undef PG8_SCHED
}

__device__ __forceinline__ void store_tile_bf16(const f32x4 (&acc)[2][2][4][2], bf16_t* base, int ldc, int row0, int col0, int act) {
#pragma unroll
    for (int ai = 0; ai < 2; ++ai)
#pragma unroll
        for (int m = 0; m < 4; ++m) { bf16_t* rowp = base + (size_t)(row0 + ai * HALF + m * 16) * ldc + col0;
#pragma unroll
            for (int bj = 0; bj < 2; ++bj) { float v[8];
#pragma unroll
                for (int j = 0; j < 4; ++j) { v[j] = acc[ai][bj][m][0][j]; v[4 + j] = acc[ai][bj][m][1][j]; }
                if (act != 0) {
                    float sg[8];
#pragma unroll
                    for (int j = 0; j < 8; ++j) sg[j] = sigmoidf_(v[j]);
                    if (act == 1) {
#pragma unroll
                        for (int j = 0; j < 8; ++j) v[j] *= sg[j];
                    } else {
#pragma unroll
                        for (int j = 0; j < 8; ++j) v[j] = sg[j];
                    }
                }
                *(u32x4*)(rowp + bj * HALF) = pack8(v); }
            asm volatile("" ::: "memory"); }
}
struct EpiInProj {
    unsigned char* ws;
    __device__ __forceinline__ void operator()(const f32x4 (&acc)[2][2][4][2], const Unit& u, int wr, int wc, int fr, int fq) const {
        const int pn = u.pn; size_t off; int ldc = 1024, col, act = 0;
        if (pn < 4) { off = WS_XA; col = pn * 256; }
        else if (pn < 8) { off = WS_SGA; col = (pn - 4) * 256; act = 1; }
        else if (pn < 12) { off = WS_Q; col = (pn - 8) * 256; }
        else if (pn == 12) { off = WS_K; col = 0; ldc = 256; }
        else if (pn == 13) { off = WS_V; col = 0; ldc = 256; }
        else if (pn < 18) { off = WS_SGB; col = (pn - 14) * 256; act = 1; }
        else if (pn < 34) {
            const bool bg = pn >= 26; const int blk = bg ? pn - 26 : pn - 18;
            bf16_t* basep = (bf16_t*)(ws + (bg ? WS_BC : WS_XC));
            const int row0p = u.pm * BM + wr * 64 + fr, col0p = blk * 128 + wc * 32 + 8 * fq;
#pragma unroll
            for (int ai = 0; ai < 2; ++ai)
#pragma unroll
                for (int m = 0; m < 4; ++m) { float v[8];
#pragma unroll
                    for (int j = 0; j < 8; ++j) { const float x0 = acc[ai][0][m][j >> 2][j & 3], x1 = acc[ai][1][m][j >> 2][j & 3];
                        v[j] = bg ? x0 * (x1 * sigmoidf_(x1)) : x0 * x1; }
                    *(u32x4*)(basep + (size_t)(row0p + ai * HALF + m * 16) * 1024 + col0p) = pack8(v); }
            return; }
        else { off = WS_SMG; col = (pn - 34) * 256; ldc = 3072; act = 2; }
        bf16_t* base = (bf16_t*)(ws + off);
        const int row0 = u.pm * BM + wr * 64 + fr, col0 = col + wc * 32 + 8 * fq;
        store_tile_bf16(acc, base, ldc, row0, col0, act);
    }
};
struct EpiGates {
    unsigned char* ws; const float* b_r; const float* b_i; const float* lam;
    __device__ __forceinline__ void operator()(const f32x4 (&acc)[2][2][4][2], const Unit& u, int wr, int wc, int fr, int fq) const {
        const int dir = u.pn >> 3, nb = (u.pn >> 1) & 3, hh = u.pn & 1;
        const int ch0 = nb * 256 + hh * 128 + wc * 32 + 8 * fq;
        float br[8], bi[8], sp[8];
#pragma unroll
        for (int j = 0; j < 8; ++j) { br[j] = b_r[dir * 1024 + ch0 + j]; bi[j] = b_i[dir * 1024 + ch0 + j];
            const float lm = lam[dir * 1024 + ch0 + j]; const float e = __expf(-lm);
            const float spl = lm < -15.f ? -lm : (e < 0.03f ? e * (1.f - e * (0.5f - e * (0.33333334f - 0.25f * e))) : __logf(1.f + e));
            sp[j] = -8.0f * LOG2E * spl; }
        const bf16_t* UA = (const bf16_t*)(ws + WS_H);
        bf16_t* LA = (bf16_t*)(ws + WS_LA + (size_t)dir * 64 * MiB);
        bf16_t* UU = (bf16_t*)(ws + WS_U + (size_t)dir * 64 * MiB);
        const int row0 = u.pm * BM + wr * 64 + fr;
#pragma unroll
        for (int ai = 0; ai < 2; ++ai)
#pragma unroll
            for (int m = 0; m < 4; ++m) { const size_t o = (size_t)(row0 + ai * HALF + m * 16) * 1024 + ch0;
                float x[8]; unpack8(*(const u32x4*)(UA + o), x);
                float la[8], uu[8];
#pragma unroll
                for (int j = 0; j < 8; ++j) { const float pr = acc[ai][0][m][j >> 2][j & 3] + br[j], pi = acc[ai][1][m][j >> 2][j & 3] + bi[j];
                    const float r = sigmoidf_(pr), ig = sigmoidf_(pi);
                    const float l2 = r * sp[j]; const float a = __builtin_amdgcn_exp2f(l2);
                    la[j] = l2; uu[j] = __builtin_amdgcn_sqrtf(fmaxf(1.f - a * a, 0.f)) * ig * x[j]; }
                *(u32x4*)(LA + o) = pack8(la); *(u32x4*)(UU + o) = pack8(uu); }
    }
};
struct EpiBranch {
    unsigned char* ws;
    __device__ __forceinline__ void operator()(const f32x4 (&acc)[2][2][4][2], const Unit& u, int wr, int wc, int fr, int fq) const {
        const bf16_t* G = (const bf16_t*)(ws + WS_SMG) + u.kk * 1024;
        bf16_t* Mg = (bf16_t*)(ws + WS_SGA);
        const int row0 = u.pm * BM + wr * 64 + fr, col0 = u.pn * BM + wc * 32 + 8 * fq;
#pragma unroll
        for (int ai = 0; ai < 2; ++ai)
#pragma unroll
            for (int m = 0; m < 4; ++m) { const int row = row0 + ai * HALF + m * 16;
#pragma unroll
                for (int bj = 0; bj < 2; ++bj) { const int col = col0 + bj * HALF;
                    float gt[8], v[8]; unpack8(*(const u32x4*)(G + (size_t)row * 3072 + col), gt);
#pragma unroll
                    for (int j = 0; j < 8; ++j) v[j] = gt[j] * acc[ai][bj][m][j >> 2][j & 3];
                    bf16_t* mp = Mg + (size_t)row * 1024 + col;
                    if (u.kk != 0) { float old[8]; unpack8(*(const u32x4*)mp, old);
#pragma unroll
                        for (int j = 0; j < 8; ++j) v[j] += old[j]; }
                    *(u32x4*)mp = pack8(v); } }
    }
};
struct EpiOut {
    const float* xi; float* xo; const float* gate;
    __device__ __forceinline__ void operator()(const f32x4 (&acc)[2][2][4][2], const Unit& u, int wr, int wc, int fr, int fq) const {
        const int row0 = u.pm * BM + wr * 64 + fr, col0 = u.pn * BM + wc * 32 + 8 * fq;
        f32x4 gv[2][2];
#pragma unroll
        for (int bj = 0; bj < 2; ++bj)
#pragma unroll
            for (int n = 0; n < 2; ++n) gv[bj][n] = *(const f32x4*)(gate + col0 + bj * HALF + 4 * n);
#pragma unroll
        for (int ai = 0; ai < 2; ++ai)
#pragma unroll
            for (int m = 0; m < 4; ++m) { const size_t o = (size_t)(row0 + ai * HALF + m * 16) * 1024 + col0;
#pragma unroll
                for (int bj = 0; bj < 2; ++bj)
#pragma unroll
                    for (int n = 0; n < 2; ++n) { const f32x4 xv = *(const f32x4*)(xi + o + bj * HALF + 4 * n);
                        *(f32x4*)(xo + o + bj * HALF + 4 * n) = xv + gv[bj][n] * acc[ai][bj][m][n]; } }
    }
};
}

namespace attn {
using bf16 = __hip_bfloat16;
using s16x4 = __attribute__((ext_vector_type(4))) short;
using f32x16 = __attribute__((ext_vector_type(16))) float;
constexpr int D = 128, NW = 8, QBLK = 32, KVBLK = 64;
constexpr float SCALE = 0.088388347648318440f;
constexpr float THR = 8.f;
constexpr int LDQ = 1024, LDK = 256, LDO = 1024;
constexpr size_t SHM_V = KVBLK * D * 2, SHM_K = KVBLK * D * 2, SHM_ATTN = 2 * SHM_V + 2 * SHM_K + NW * 64 * 4;
#define KSWZ(row, colB) ((row) * 256 + ((colB) ^ (((row) & 7) << 4)))
#define SBAR() __builtin_amdgcn_sched_barrier(0)
__device__ __forceinline__ int crow(int r, int hi) { return (r & 3) + 8 * (r >> 2) + 4 * hi; }
__device__ __forceinline__ unsigned cvtpk(float lo, float hi) { unsigned r; asm volatile("v_cvt_pk_bf16_f32 %0, %1, %2" : "=v"(r) : "v"(lo), "v"(hi)); return r; }

__device__ __forceinline__ void partialSM(f32x16& p0, f32x16& p1, float& m_reg, float& mn, float& alpha) {
  constexpr float C = SCALE * 1.4426950408889634f;
  float pmax = p0[0]; for (int r = 1; r < 16; ++r) pmax = fmaxf(pmax, p0[r]); for (int r = 0; r < 16; ++r) pmax = fmaxf(pmax, p1[r]);
  { auto rr = __builtin_amdgcn_permlane32_swap(__float_as_uint(pmax), __float_as_uint(pmax), false, false);
    pmax = fmaxf(__uint_as_float(rr[0]), __uint_as_float(rr[1])); }
  if (__builtin_expect(__all(pmax - m_reg <= THR / SCALE), 1)) { mn = m_reg; alpha = 1.f; }
  else { mn = fmaxf(m_reg, pmax); alpha = __builtin_amdgcn_exp2f((m_reg - mn) * C); m_reg = mn; }
  float mnC = -mn * C;
  for (int r = 0; r < 16; ++r) p0[r] = fmaf(p0[r], C, mnC); for (int r = 0; r < 16; ++r) p1[r] = fmaf(p1[r], C, mnC);
  for (int r = 0; r < 16; ++r) p0[r] = __builtin_amdgcn_exp2f(p0[r]);
}
__device__ __forceinline__ void finishSM(f32x16& p0, f32x16& p1, float alpha, float& l_reg, bf16x8& pa0, bf16x8& pa1, bf16x8& pa2, bf16x8& pa3) {
  for (int r = 0; r < 16; ++r) p1[r] = __builtin_amdgcn_exp2f(p1[r]);
  float ps = 0; for (int r = 0; r < 16; ++r) ps += p0[r]; for (int r = 0; r < 16; ++r) ps += p1[r];
  { auto rr = __builtin_amdgcn_permlane32_swap(__float_as_uint(ps), __float_as_uint(ps), false, false);
    ps = __uint_as_float(rr[0]) + __uint_as_float(rr[1]); }
  l_reg = l_reg * alpha + ps;
#define PK4(P, BASE, OUT) do { unsigned a0 = cvtpk(P[BASE + 0], P[BASE + 1]), a1 = cvtpk(P[BASE + 2], P[BASE + 3]);   \
    unsigned b0 = cvtpk(P[BASE + 4], P[BASE + 5]), b1 = cvtpk(P[BASE + 6], P[BASE + 7]);                              \
    auto r0 = __builtin_amdgcn_permlane32_swap(a0, b0, false, false); auto r1 = __builtin_amdgcn_permlane32_swap(a1, b1, false, false); \
    u32x4 w = {r0[0], r1[0], r0[1], r1[1]}; OUT = *reinterpret_cast<bf16x8*>(&w); } while (0)
  PK4(p0, 0, pa0); PK4(p0, 8, pa1); PK4(p1, 0, pa2); PK4(p1, 8, pa3);
#undef PK4
}
__device__ __forceinline__ void qkt(f32x16& p0, f32x16& p1, const bf16* Ks, const bf16x8* qr, int r32, int hi) {
  p0 = f32x16{}; p1 = f32x16{};
  for (int d0 = 0; d0 < 8; ++d0) { int cb = (d0 * 16 + hi * 8) * 2;
    bf16x8 b0 = *reinterpret_cast<const bf16x8*>((const char*)Ks + KSWZ(r32, cb));
    bf16x8 b1 = *reinterpret_cast<const bf16x8*>((const char*)Ks + KSWZ(32 + r32, cb));
    p0 = __builtin_amdgcn_mfma_f32_32x32x16_bf16(b0, qr[d0], p0, 0, 0, 0);
    p1 = __builtin_amdgcn_mfma_f32_32x32x16_bf16(b1, qr[d0], p1, 0, 0, 0); }
}
__device__ __forceinline__ int v_st(int k, int c) { const int kk = (k & ~0xC) | ((k & 4) << 1) | ((k & 8) >> 1); return ((kk >> 3) * 4 + (c >> 5)) * 512 + ((kk & 7) * 32 + (c & 31)) * 2; }
__device__ __forceinline__ int v_rd_base(int lane) { return ((lane & 3) << 3) | (((lane >> 2) & 3) << 6) | (((lane >> 4) & 1) << 5) | (((lane >> 5) & 1) << 8); }
constexpr int v_rd_off(int d0, int ks, int half) { return d0 * 512 + ks * 4096 + half * 2048; }
template <int OFF> __device__ __forceinline__ s16x4 tr_read(int vb) {
  s16x4 r; asm volatile("ds_read_b64_tr_b16 %0, %1 offset:%2" : "=&v"(r) : "v"(vb), "i"(OFF) : "memory"); return r;
}
template <int D0> __device__ __forceinline__ void pv_one(f32x16& od, int vb, bf16x8 pa0, bf16x8 pa1, bf16x8 pa2, bf16x8 pa3) {
  const s16x4 l0 = tr_read<v_rd_off(D0, 0, 0)>(vb), h0 = tr_read<v_rd_off(D0, 0, 1)>(vb), l1 = tr_read<v_rd_off(D0, 1, 0)>(vb), h1 = tr_read<v_rd_off(D0, 1, 1)>(vb);
  const s16x4 l2 = tr_read<v_rd_off(D0, 2, 0)>(vb), h2 = tr_read<v_rd_off(D0, 2, 1)>(vb), l3 = tr_read<v_rd_off(D0, 3, 0)>(vb), h3 = tr_read<v_rd_off(D0, 3, 1)>(vb);
  asm volatile("s_waitcnt lgkmcnt(0)" ::: "memory"); SBAR();
#define PK(L, H) (bf16x8){L[0], L[1], L[2], L[3], H[0], H[1], H[2], H[3]}
  od = __builtin_amdgcn_mfma_f32_32x32x16_bf16(pa0, PK(l0, h0), od, 0, 0, 0);
  od = __builtin_amdgcn_mfma_f32_32x32x16_bf16(pa1, PK(l1, h1), od, 0, 0, 0);
  od = __builtin_amdgcn_mfma_f32_32x32x16_bf16(pa2, PK(l2, h2), od, 0, 0, 0);
  od = __builtin_amdgcn_mfma_f32_32x32x16_bf16(pa3, PK(l3, h3), od, 0, 0, 0);
#undef PK
}
__device__ __forceinline__ void pv_d0(f32x16* o, int vb, bf16x8 pa0, bf16x8 pa1, bf16x8 pa2, bf16x8 pa3) {
  pv_one<0>(o[0], vb, pa0, pa1, pa2, pa3); pv_one<1>(o[1], vb, pa0, pa1, pa2, pa3); pv_one<2>(o[2], vb, pa0, pa1, pa2, pa3); pv_one<3>(o[3], vb, pa0, pa1, pa2, pa3);
}
__device__ __forceinline__ void attn_dense_body(const bf16* Qb, const bf16* __restrict__ Kh, const bf16* __restrict__ Vh,
                                                bf16_t* Ob, const bf16_t* Gb, int seq, char* lds, const int tid) {
  const int wid = tid >> 6, lane = tid & 63, r32 = lane & 31, hi = lane >> 5;
  bf16* V_lds = (bf16*)lds; bf16* K_lds = (bf16*)(lds + 2 * SHM_V);
  float* ws = (float*)(lds + 2 * SHM_V + 2 * SHM_K) + wid * 64; float* li_l = ws; float* al_l = ws + 32;
  float m_reg = -1e30f, l_reg = 0; f32x16 o[4] = {}; bf16x8 qr[8];
  const bf16* Qw = Qb + (long)(wid * QBLK + r32) * LDQ + hi * 8;
#pragma unroll
  for (int d0 = 0; d0 < 8; ++d0) qr[d0] = *reinterpret_cast<const bf16x8*>(Qw + d0 * 16);
  const int sr = tid >> 4, sc = (tid & 15) * 8, vst0 = v_st(sr, sc), vst1 = v_st(32 + sr, sc);
  const int vb0 = (int)(uintptr_t)V_lds + v_rd_base(lane);
  struct { bf16x8 vs0, vs1, ks0, ks1; } sr_[2];
#define SLOAD(i, k0) do { sr_[i].vs0 = *reinterpret_cast<const bf16x8*>(&Vh[(long)((k0) + sr) * LDK + sc]); sr_[i].vs1 = *reinterpret_cast<const bf16x8*>(&Vh[(long)((k0) + 32 + sr) * LDK + sc]); \
    sr_[i].ks0 = *reinterpret_cast<const bf16x8*>(&Kh[(long)((k0) + sr) * LDK + sc]); sr_[i].ks1 = *reinterpret_cast<const bf16x8*>(&Kh[(long)((k0) + 32 + sr) * LDK + sc]); } while (0)
#define SWRITE(b, i) do { *(bf16x8*)((char*)V_lds + (b) * SHM_V + vst0) = sr_[i].vs0;          \
    *(bf16x8*)((char*)V_lds + (b) * SHM_V + vst1) = sr_[i].vs1; int kc = sc * 2;               \
    *(bf16x8*)((char*)K_lds + (b) * SHM_K + KSWZ(sr, kc)) = sr_[i].ks0;                       \
    *(bf16x8*)((char*)K_lds + (b) * SHM_K + KSWZ(32 + sr, kc)) = sr_[i].ks1; } while (0)
#define SWAIT() asm volatile("s_waitcnt vmcnt(4)" ::: "memory")
#define RESC(a) do { if (__any((a) < 1.f)) { if (hi == 0) al_l[r32] = (a); asm volatile("s_waitcnt lgkmcnt(0)" ::: "memory"); \
    for (int d = 0; d < 4; ++d) for (int r = 0; r < 16; ++r) o[d][r] *= al_l[crow(r, hi)]; } } while (0)
  f32x16 pA0, pA1, pB0, pB1; float mnA, mnB, alA, alB; bf16x8 pa0, pa1, pa2, pa3; const int NT = seq / KVBLK;
  constexpr int SE = 0, SO = 1;
  SLOAD(SE, 0); asm volatile("s_waitcnt vmcnt(0)" ::: "memory"); SWRITE(0, SE); __syncthreads();
  qkt(pA0, pA1, K_lds, qr, r32, hi); partialSM(pA0, pA1, m_reg, mnA, alA);
  SLOAD(SO, KVBLK); if (2 < NT) SLOAD(SE, 2 * KVBLK);
  SWAIT(); SWRITE(1, SO); __syncthreads();
#pragma nounroll
  for (int j = 1; j + 1 < NT; j += 2) {
    SBAR(); qkt(pB0, pB1, (bf16*)((char*)K_lds + SHM_K), qr, r32, hi);
    finishSM(pA0, pA1, alA, l_reg, pa0, pa1, pa2, pa3); SBAR();
    SLOAD(SO, (j + 2) * KVBLK); SBAR();
    pv_d0(o, vb0, pa0, pa1, pa2, pa3); partialSM(pB0, pB1, m_reg, mnB, alB);
    __syncthreads(); SWAIT(); SWRITE(0, SE);
    RESC(alB); __syncthreads();
    SBAR(); qkt(pA0, pA1, K_lds, qr, r32, hi);
    finishSM(pB0, pB1, alB, l_reg, pa0, pa1, pa2, pa3); SBAR();
    if (j + 3 < NT) SLOAD(SE, (j + 3) * KVBLK); SBAR();
    pv_d0(o, vb0 + (int)SHM_V, pa0, pa1, pa2, pa3); partialSM(pA0, pA1, m_reg, mnA, alA);
    __syncthreads(); SWAIT(); SWRITE(1, SO);
    RESC(alA); __syncthreads();
  }
  SBAR(); qkt(pB0, pB1, (bf16*)((char*)K_lds + SHM_K), qr, r32, hi);
  finishSM(pA0, pA1, alA, l_reg, pa0, pa1, pa2, pa3); SBAR();
  pv_d0(o, vb0, pa0, pa1, pa2, pa3); partialSM(pB0, pB1, m_reg, mnB, alB);
  __syncthreads(); RESC(alB);
  finishSM(pB0, pB1, alB, l_reg, pa0, pa1, pa2, pa3); SBAR();
  pv_d0(o, vb0 + (int)SHM_V, pa0, pa1, pa2, pa3);
  if (hi == 0) li_l[r32] = l_reg; asm volatile("s_waitcnt lgkmcnt(0)" ::: "memory");
  float rli[16];
#pragma unroll
  for (int r = 0; r < 16; ++r) rli[r] = __builtin_amdgcn_rcpf(li_l[crow(r, hi)]);
  __syncthreads();
  { int lane_e = lane, wid_e = wid; asm volatile("" : "+v"(lane_e), "+v"(wid_e)); wid_e = __builtin_amdgcn_readfirstlane(wid_e);
    bf16_t* stg = (bf16_t*)lds + wid_e * 4096;
#pragma unroll
    for (int r = 0; r < 16; ++r) { const int orow = crow(r, hi);
#pragma unroll
      for (int d0 = 0; d0 < 4; ++d0) stg[orow * 128 + d0 * 32 + r32] = (bf16_t)f2bf(o[d0][r] * rli[r]); }
    asm volatile("s_waitcnt lgkmcnt(0)" ::: "memory");
    bf16_t* Ow = Ob + (long)(wid_e * QBLK) * LDO; const bf16_t* Gw = Gb + (long)(wid_e * QBLK) * LDO;
    u32x4 gq[8];
#pragma unroll
    for (int i = 0; i < 8; ++i) { const int row = i * 4 + (lane_e >> 4), ch = lane_e & 15; gq[i] = *(const u32x4*)(Gw + (long)row * LDO + ch * 8); }
#pragma unroll
    for (int i = 0; i < 8; ++i) { const int row = i * 4 + (lane_e >> 4), ch = lane_e & 15;
      float ov[8], gv[8]; unpack8(*(const u32x4*)(stg + row * 128 + ch * 8), ov); unpack8(gq[i], gv);
#pragma unroll
      for (int j = 0; j < 8; ++j) ov[j] *= gv[j];
      *(u32x4*)(Ow + (long)row * LDO + ch * 8) = pack8(ov); } }
  __syncthreads();
#undef SLOAD
#undef SWRITE
#undef SWAIT
#undef RESC
}

__device__ __forceinline__ void attn_pp_body(const bf16* Qb, const bf16* __restrict__ Kh, const bf16* __restrict__ Vh,
                                             bf16_t* Ob, const bf16_t* Gb, int seq, char* lds, const int tid) {
  const int wid = __builtin_amdgcn_readfirstlane(tid >> 6), lane = tid & 63, r32 = lane & 31, hi = lane >> 5;
  const int g = wid >> 2;
  constexpr int NB = 3;
  char* V_lds = lds; char* K_lds = lds + NB * SHM_V;
  float* ws = (float*)(lds + NB * (SHM_V + SHM_K)) + wid * 64; float* li_l = ws; float* al_l = ws + 32;
  float m_reg = -1e30f, l_reg = 0; f32x16 o[4] = {}; bf16x8 qr[8];
  const bf16* Qw = Qb + (long)(wid * QBLK + r32) * LDQ + hi * 8;
#pragma unroll
  for (int d0 = 0; d0 < 8; ++d0) qr[d0] = *reinterpret_cast<const bf16x8*>(Qw + d0 * 16);
  const int sr = tid >> 4, sc = (tid & 15) * 8, vst0 = v_st(sr, sc), vst1 = v_st(32 + sr, sc);
  const int ksw0 = KSWZ(sr, sc * 2), ksw1 = KSWZ(32 + sr, sc * 2);
  const int vbase = (int)(uintptr_t)V_lds + v_rd_base(lane);
  struct Stg { bf16x8 vs0, vs1, ks0, ks1; } st0, st1;
#define SLOAD(S, t) do { const long k0_ = (long)(t) * KVBLK; S.vs0 = *reinterpret_cast<const bf16x8*>(&Vh[(k0_ + sr) * LDK + sc]); S.vs1 = *reinterpret_cast<const bf16x8*>(&Vh[(k0_ + 32 + sr) * LDK + sc]); \
    S.ks0 = *reinterpret_cast<const bf16x8*>(&Kh[(k0_ + sr) * LDK + sc]); S.ks1 = *reinterpret_cast<const bf16x8*>(&Kh[(k0_ + 32 + sr) * LDK + sc]); } while (0)
#define SWRITE(S, b) do { *(bf16x8*)(V_lds + (b) * SHM_V + vst0) = S.vs0; *(bf16x8*)(V_lds + (b) * SHM_V + vst1) = S.vs1; \
    *(bf16x8*)(K_lds + (b) * SHM_K + ksw0) = S.ks0; *(bf16x8*)(K_lds + (b) * SHM_K + ksw1) = S.ks1; } while (0)
#define RESC(a) do { if (__any((a) < 1.f)) { if (hi == 0) al_l[r32] = (a); asm volatile("s_waitcnt lgkmcnt(0)" ::: "memory"); \
    for (int d = 0; d < 4; ++d) for (int r = 0; r < 16; ++r) o[d][r] *= al_l[crow(r, hi)]; } } while (0)
  const int NT = seq / KVBLK;
  f32x16 p0, p1; bf16x8 pa0, pa1, pa2, pa3;
#define SMX() do { float mn_, al_; partialSM(p0, p1, m_reg, mn_, al_); RESC(al_); finishSM(p0, p1, al_, l_reg, pa0, pa1, pa2, pa3); } while (0)
  SLOAD(st0, 0); if (g) SLOAD(st1, 1);
  SWRITE(st0, 0); if (g) SWRITE(st1, 1);
  SLOAD(st0, 1 + g); SLOAD(st1, 2 + g);
  __syncthreads();
  if (g) __syncthreads();
  SBAR(); qkt(p0, p1, (const bf16*)K_lds, qr, r32, hi); SBAR();
  __syncthreads();
  SWRITE(st0, 1 + g); if (3 + g < NT) SLOAD(st0, 3 + g);
  SMX();
  __syncthreads();
  int c = 0;
#define STEP(i, ST) do { const int cK_ = (c == 2) ? 0 : c + 1; \
    SBAR(); __builtin_amdgcn_s_setprio(1); \
    qkt(p0, p1, (const bf16*)(K_lds + cK_ * SHM_K), qr, r32, hi); \
    pv_d0(o, vbase + c * (int)SHM_V, pa0, pa1, pa2, pa3); \
    __builtin_amdgcn_s_setprio(0); SBAR(); \
    __syncthreads(); \
    { const int t_ = (i) + 2 + g; if (t_ < NT) { const int cb_ = (cK_ == 2) ? 0 : cK_ + 1; const int cw_ = g ? ((cb_ == 2) ? 0 : cb_ + 1) : cb_; \
        SWRITE(ST, cw_); if (t_ + 2 < NT) SLOAD(ST, t_ + 2); } } \
    SMX(); \
    __syncthreads(); \
    c = cK_; } while (0)
  int i = 0;
#pragma nounroll
  for (; i + 1 < NT - 1; i += 2) { STEP(i, st1); STEP(i + 1, st0); }
  if (i < NT - 1) { STEP(i, st1); }
  SBAR(); pv_d0(o, vbase + c * (int)SHM_V, pa0, pa1, pa2, pa3); SBAR();
  __syncthreads();
  if (!g) __syncthreads();
  if (hi == 0) li_l[r32] = l_reg; asm volatile("s_waitcnt lgkmcnt(0)" ::: "memory");
  float rli[16];
#pragma unroll
  for (int r = 0; r < 16; ++r) rli[r] = __builtin_amdgcn_rcpf(li_l[crow(r, hi)]);
  { int lane_e = lane, wid_e = wid; asm volatile("" : "+v"(lane_e), "+v"(wid_e)); wid_e = __builtin_amdgcn_readfirstlane(wid_e);
    bf16_t* stg = (bf16_t*)lds + wid_e * 4096;
#pragma unroll
    for (int r = 0; r < 16; ++r) { const int orow = crow(r, hi);
#pragma unroll
      for (int d0 = 0; d0 < 4; ++d0) stg[orow * 128 + d0 * 32 + r32] = (bf16_t)f2bf(o[d0][r] * rli[r]); }
    asm volatile("s_waitcnt lgkmcnt(0)" ::: "memory");
    bf16_t* Ow = Ob + (long)(wid_e * QBLK) * LDO; const bf16_t* Gw = Gb + (long)(wid_e * QBLK) * LDO;
    u32x4 gq[8];
#pragma unroll
    for (int i2 = 0; i2 < 8; ++i2) { const int row = i2 * 4 + (lane_e >> 4), ch = lane_e & 15; gq[i2] = *(const u32x4*)(Gw + (long)row * LDO + ch * 8); }
#pragma unroll
    for (int i2 = 0; i2 < 8; ++i2) { const int row = i2 * 4 + (lane_e >> 4), ch = lane_e & 15;
      float ov[8], gv[8]; unpack8(*(const u32x4*)(stg + row * 128 + ch * 8), ov); unpack8(gq[i2], gv);
#pragma unroll
      for (int j = 0; j < 8; ++j) ov[j] *= gv[j];
      *(u32x4*)(Ow + (long)row * LDO + ch * 8) = pack8(ov); } }
  __syncthreads();
#undef SLOAD
#undef SWRITE
#undef RESC
#undef SMX
#undef STEP
}
#undef KSWZ
#undef SBAR
}


#define XB_TMO      128
#define XB_XCNT(j)  (256  + 64 * (j))
#define XB_XSUB(j)  (1280 + 64 * (j))
#define XB_XGEN(j)  (2304 + 64 * (j))
#define XB_TOP      3328
#define XB_TOPGEN   3392
#define XCD_BAR_WORDS 3456
#define XB_SPIN_CAP (1u << 22)
__device__ __forceinline__ unsigned xb_ld(unsigned* p)              { return __hip_atomic_load(p, __ATOMIC_RELAXED, __HIP_MEMORY_SCOPE_AGENT); }
__device__ __forceinline__ unsigned xb_add(unsigned* p, unsigned v) { return __hip_atomic_fetch_add(p, v, __ATOMIC_RELAXED, __HIP_MEMORY_SCOPE_AGENT); }
__device__ __forceinline__ unsigned xb_xcc_id() { return (unsigned)__builtin_amdgcn_s_getreg((3 << 11) | 20) & 0xFu; }
#define XB_SPIN(cond, bar) do { unsigned _sp = 0; while (cond) { __builtin_amdgcn_s_sleep(1); \
    if ((++_sp & 255u) == 0u) { if (xb_ld(&(bar)[XB_TMO])) break; if (_sp > XB_SPIN_CAP) { atomicAdd(&(bar)[XB_TMO], 1u); break; } } } } while (0)
struct XcdBarrier { unsigned* bar; unsigned x; volatile LAS unsigned* st; };
__device__ __forceinline__ XcdBarrier xcd_barrier_post(unsigned* bar, volatile LAS unsigned* st) {
    XcdBarrier b; b.bar = bar; b.x = xb_xcc_id(); b.st = st;
    if (threadIdx.x == 0) (void)xb_add(&bar[XB_XCNT(b.x)], 1u);
    return b;
}
__device__ __forceinline__ void xcd_barrier_complete(unsigned* bar, unsigned x, unsigned& nloc, unsigned& nx) {
    const unsigned G = gridDim.x * gridDim.y * gridDim.z;
    unsigned sum, cnt, mine, sp = 0u;
    for (;;) {
        sum = 0u; cnt = 0u; mine = 0u;
#pragma unroll
        for (unsigned j = 0; j < 16; ++j) { const unsigned c = xb_ld(&bar[XB_XCNT(j)]); sum += c; cnt += (c > 0u) ? 1u : 0u; mine = (j == x) ? c : mine; }
        if (sum == G) break;
        __builtin_amdgcn_s_sleep(1);
        if ((++sp & 255u) == 0u) { if (xb_ld(&bar[XB_TMO])) break; if (sp > XB_SPIN_CAP) { atomicAdd(&bar[XB_TMO], 1u); break; } }
    }
    nloc = mine > 0u ? mine : 1u; nx = cnt > 0u ? cnt : 1u;
}
__device__ __forceinline__ void xcd_barrier(const XcdBarrier& b, const int tid) {
    asm volatile("s_waitcnt vmcnt(0)" ::: "memory");
    __syncthreads();
    if (tid == 0) {
        unsigned* bar = b.bar;
        __builtin_amdgcn_s_waitcnt(0);
        unsigned nloc = b.st[0], nx = b.st[1];
        if (nloc == 0u) { xcd_barrier_complete(bar, b.x, nloc, nx); b.st[0] = nloc; b.st[1] = nx; }
        const unsigned old = xb_add(&bar[XB_XSUB(b.x)], 1u);
        const unsigned gen = old / nloc;
        if (old + 1u == (gen + 1u) * nloc) {
            __builtin_amdgcn_fence(__ATOMIC_RELEASE, "agent");
            asm volatile("s_waitcnt vmcnt(0)" ::: "memory");
            const unsigned og = xb_add(&bar[XB_TOP], 1u);
            const unsigned tg = og / nx;
            if (og + 1u == (tg + 1u) * nx) xb_add(&bar[XB_TOPGEN], 1u);
            else XB_SPIN(xb_ld(&bar[XB_TOPGEN]) == tg, bar);
            __builtin_amdgcn_fence(__ATOMIC_ACQUIRE, "agent");
            xb_add(&bar[XB_XGEN(b.x)], 1u);
            asm volatile("s_waitcnt vmcnt(0)" ::: "memory");
        } else {
            XB_SPIN(xb_ld(&bar[XB_XGEN(b.x)]) == gen, bar);
            __builtin_amdgcn_fence(__ATOMIC_ACQUIRE, "agent");
            asm volatile("s_waitcnt vmcnt(0)" ::: "memory");
        }
    }
    __syncthreads();
}

#ifndef PHM
#define PHM 1023
#endif
#ifndef PROBE_K
#define PROBE_K -1
#endif
struct Args { const float* in[18]; float* out; unsigned char* ws; int ph_lo, ph_hi; };
typedef const __attribute__((address_space(4))) Args* KArgs;
#define INP(a, i) ((const float*)(const GAS float*)((a)->in[i]))
#define OUTP(a) ((float*)(GAS float*)((a)->out))
enum { I_X = 0, I_C, I_WADA, I_BADA, I_NORMG, I_WIN, I_CAW, I_CAB, I_WRG, I_BRG, I_WIG, I_BIG, I_LAM, I_QG, I_KG, I_CCW, I_WBR, I_WOUT };

__device__ __forceinline__ void transpose_item(const float* W, int ldw, bf16_t* dst, int ldd, LAS float* scr, int lane) {
#pragma unroll 32
    for (int i = 0; i < 32; ++i) { const int kk = 2 * i + (lane >> 5); scr[kk * 33 + (lane & 31)] = W[(size_t)kk * ldw + (lane & 31)]; }
    LDS_WAIT();
    const int c = lane & 7;
#pragma unroll
    for (int j = 0; j < 4; ++j) { const int n = (lane >> 3) + 8 * j; const LAS float* s = scr + (8 * c) * 33 + n;
        u32x4 o; o.x = cvt_pk_bf16(s[0 * 33], s[1 * 33]); o.y = cvt_pk_bf16(s[2 * 33], s[3 * 33]); o.z = cvt_pk_bf16(s[4 * 33], s[5 * 33]); o.w = cvt_pk_bf16(s[6 * 33], s[7 * 33]);
        *(u32x4*)(dst + (size_t)n * ldd + 8 * c) = o; }
    LDS_WAIT();
}

__device__ __forceinline__ void phase_prologue(KArgs a, unsigned char* wsb, LAS unsigned char* lds, int tid, int lane, int wave, int bid, int G) {
    unsigned char* ws = wsb;
    {
        LAS float* red = (LAS float*)lds;
        for (int it = bid; it < 96; it += G) {
            const int l = it / 48, jb = it % 48, j = jb * 64 + lane;
            const float* wa = INP(a, I_WADA) + (size_t)l * 1024 * 3072 + j; const float* c0 = INP(a, I_C); const float* c1 = c0 + 1024;
            float a0 = 0.f, a1 = 0.f; const int kb = wave * 128;
#pragma unroll 16
            for (int k = 0; k < 128; ++k) { const float w = wa[(size_t)(kb + k) * 3072]; a0 += c0[kb + k] * w; a1 += c1[kb + k] * w; }
            red[(wave * 2 + 0) * 64 + lane] = a0; red[(wave * 2 + 1) * 64 + lane] = a1;
            __syncthreads();
            if (tid < 128) { const int bb = tid >> 6; float s = 0.f;
#pragma unroll
                for (int w = 0; w < 8; ++w) s += red[(w * 2 + bb) * 64 + lane];
                ((float*)(ws + WS_MOD))[(l * 2 + bb) * 3072 + j] = s + INP(a, I_BADA)[l * 3072 + j]; }
            __syncthreads();
        }
    }
    {
        float* rc = (float*)(ws + WS_ROPE); float* rs = rc + 320 * 32;
        for (int e = bid * 512 + tid; e < 320 * 32; e += G * 512) {
            const int pos = e >> 5, i = e & 31; const int p = pos < 256 ? pos : pos - 256;
            const float inv = __builtin_amdgcn_exp2f(-((float)(2 * i)) * (13.287712379549449f / 64.0f));
            const float ang = (float)p * inv;
            rc[e] = __cosf(ang); rs[e] = __sinf(ang);
        }
    }
    {
        LAS float* scr = (LAS float*)(lds + 8192 + wave * 12288);
        const int gw = bid * 8 + wave, NGW = G * 8;
        constexpr int I_IN = 2 * 16 * 368, I_G = 1024, I_BR = 3072, I_OUT = 1024, NITEMS = I_IN + I_G + I_BR + I_OUT;
        for (int it = gw; it < NITEMS; it += NGW) {
            int r = it;
            if (r < I_IN) { const int l = r / 5888, q = r % 5888, kb = q / 368, nb = q % 368;
                const int n0 = 32 * nb; int drow = n0;
                if (n0 >= 4608 && n0 < 8704) { const int sec = (n0 - 4608) >> 10, ch = (n0 - 4608) & 1023, blk = ch >> 7;
                    drow = ((sec & 1) ? 26 + blk : 18 + blk) * 256 + ((sec >> 1) ? 128 : 0) + (ch & 127); }
                transpose_item(INP(a, I_WIN) + (size_t)l * 1024 * NIN + (size_t)(64 * kb) * NIN + n0, NIN,
                               (bf16_t*)(ws + WS_WIN) + (size_t)l * NIN * 1024 + (size_t)drow * 1024 + 64 * kb, 1024, scr, lane); continue; }
            r -= I_IN;
            if (r < I_G) { const int mi = r >> 5, sub = r & 31, kb = sub >> 3, nblk = sub & 7;
                const int nb = mi & 3, gate = (mi >> 2) & 1, dir = (mi >> 3) & 1, l = mi >> 4;
                const float* src = (gate ? INP(a, I_WIG) : INP(a, I_WRG)) + (size_t)((l * 2 + dir) * 4 + nb) * 65536 + (size_t)(64 * kb) * 256 + 32 * nblk;
                const int n0 = 32 * nblk, hh = n0 >> 7, pn = (dir * 4 + nb) * 2 + hh, row = pn * 256 + gate * 128 + (n0 & 127);
                transpose_item(src, 256, (bf16_t*)(ws + WS_WG) + (size_t)l * 4096 * 256 + (size_t)row * 256 + 64 * kb, 256, scr, lane); continue; }
            r -= I_G;
            if (r < I_BR) { const int mi = r >> 9, sub = r & 511, kb = sub >> 5, nblk = sub & 31;
                transpose_item(INP(a, I_WBR) + (size_t)mi * 1048576 + (size_t)(64 * kb) * 1024 + 32 * nblk, 1024,
                               (bf16_t*)(ws + WS_WBR) + (size_t)mi * 1048576 + (size_t)(32 * nblk) * 1024 + 64 * kb, 1024, scr, lane); continue; }
            r -= I_BR;
            { const int mi = r >> 9, sub = r & 511, kb = sub >> 5, nblk = sub & 31;
                transpose_item(INP(a, I_WOUT) + (size_t)mi * 1048576 + (size_t)(64 * kb) * 1024 + 32 * nblk, 1024,
                               (bf16_t*)(ws + WS_WOUT) + (size_t)mi * 1048576 + (size_t)(32 * nblk) * 1024 + 64 * kb, 1024, scr, lane); }
        }
    }
}

__device__ __forceinline__ void phase_h(KArgs a, unsigned char* wsb, int l, int b, int lane, int wave, int bid, int G) {
    const float* xin = (l == 0 ? INP(a, I_X) : OUTP(a)) + (size_t)b * SEQ * DM;
    const float* mod = (const float*)(wsb + WS_MOD) + (l * 2 + b) * 3072;
    bf16_t* H = (bf16_t*)(wsb + WS_H);
    f32x4 gs[4], sh[4];
#pragma unroll
    for (int j = 0; j < 4; ++j) { const int col = 4 * lane + 256 * j;
        const f32x4 g = *(const f32x4*)(INP(a, I_NORMG) + l * 1024 + col), sc = *(const f32x4*)(mod + 1024 + col);
        gs[j] = g * (sc + 1.0f); sh[j] = *(const f32x4*)(mod + col); }
    const int gw = bid * 8 + wave, NGW = G * 8;
    for (int m = gw; m < SEQ; m += 2 * NGW) {
        const int m2 = (m + NGW < SEQ) ? m + NGW : m;
        const f32x4* xr = (const f32x4*)(xin + (size_t)m * DM) + lane; const f32x4* xr2 = (const f32x4*)(xin + (size_t)m2 * DM) + lane;
        f32x4 v[4], w[4]; float s = 0.f, s2 = 0.f;
#pragma unroll
        for (int j = 0; j < 4; ++j) { v[j] = xr[64 * j]; w[j] = xr2[64 * j]; }
#pragma unroll
        for (int j = 0; j < 4; ++j) { s += (v[j].x * v[j].x + v[j].y * v[j].y) + (v[j].z * v[j].z + v[j].w * v[j].w); s2 += (w[j].x * w[j].x + w[j].y * w[j].y) + (w[j].z * w[j].z + w[j].w * w[j].w); }
        const float rstd = __builtin_amdgcn_rsqf(wave_sum(s) * (1.f / DM) + EPS), rstd2 = __builtin_amdgcn_rsqf(wave_sum(s2) * (1.f / DM) + EPS);
        u32x2* o8 = (u32x2*)(H + (size_t)m * DM) + lane; u32x2* o82 = (u32x2*)(H + (size_t)m2 * DM) + lane;
#pragma unroll
        for (int j = 0; j < 4; ++j) { const f32x4 o = v[j] * rstd * gs[j] + sh[j]; u32x2 q; q.x = cvt_pk_bf16(o.x, o.y); q.y = cvt_pk_bf16(o.z, o.w); o8[64 * j] = q;
            const f32x4 o2 = w[j] * rstd2 * gs[j] + sh[j]; u32x2 q2; q2.x = cvt_pk_bf16(o2.x, o2.y); q2.y = cvt_pk_bf16(o2.z, o2.w); o82[64 * j] = q2; }
    }
}

__device__ __forceinline__ void ldrow8(const bf16_t* __restrict__ base, int t, int ch, float (&v)[8]) {
    if (t < 0 || t >= SEQ) {
#pragma unroll
        for (int j = 0; j < 8; ++j) v[j] = 0.f;
    } else unpack8(*(const u32x4*)(base + (size_t)t * 1024 + ch), v);
}
__device__ __forceinline__ void ld8f32(const float* p, float (&v)[8]) {
    const f32x4 a = *(const f32x4*)p, b = *(const f32x4*)(p + 4);
    v[0] = a.x; v[1] = a.y; v[2] = a.z; v[3] = a.w; v[4] = b.x; v[5] = b.y; v[6] = b.z; v[7] = b.w;
}

__device__ __forceinline__ void phase_elem(KArgs a, unsigned char* wsb, int l, int lane, int wave, int bid, int G) {
    unsigned char* ws = wsb;
    const int gw = bid * 8 + wave, NGW = G * 8;
    for (int it = gw; it < 2048; it += NGW) {
        const int run = it >> 1, hf = it & 1, ch = hf * 512 + lane * 8, t0 = run * 16;
        {
            const bf16_t* __restrict__ XA = (const bf16_t*)(ws + WS_XA); bf16_t* __restrict__ UA = (bf16_t*)(ws + WS_H);
            float w0[8], w1[8], w2[8], w3[8], bb[8];
            const float* cw = INP(a, I_CAW) + (size_t)l * 4 * 1024 + ch;
            ld8f32(cw, w0); ld8f32(cw + 1024, w1); ld8f32(cw + 2048, w2); ld8f32(cw + 3072, w3); ld8f32(INP(a, I_CAB) + l * 1024 + ch, bb);
            float xm2[8], xm1[8], x0[8], xp1[8];
            ldrow8(XA, t0 - 2, ch, xm2); ldrow8(XA, t0 - 1, ch, xm1); ldrow8(XA, t0, ch, x0);
#pragma unroll
            for (int s = 0; s < 16; ++s) { const int t = t0 + s;
                ldrow8(XA, t + 1, ch, xp1);
                float o[8];
#pragma unroll
                for (int j = 0; j < 8; ++j) o[j] = w0[j] * xm2[j] + w1[j] * xm1[j] + w2[j] * x0[j] + w3[j] * xp1[j] + bb[j];
                *(u32x4*)(UA + (size_t)t * 1024 + ch) = pack8(o);
#pragma unroll
                for (int j = 0; j < 8; ++j) { xm2[j] = xm1[j]; xm1[j] = x0[j]; x0[j] = xp1[j]; } }
        }
        {
            const bf16_t* __restrict__ PP = (const bf16_t*)(ws + WS_XC); const bf16_t* __restrict__ BG = (const bf16_t*)(ws + WS_BC); bf16_t* __restrict__ YC = (bf16_t*)(ws + WS_YC);
            float w0[8], w1[8], w2[8];
            const float* cw = INP(a, I_CCW) + (size_t)l * 3 * 1024 + ch;
            ld8f32(cw, w0); ld8f32(cw + 1024, w1); ld8f32(cw + 2048, w2);
            float pm1[8], p0[8], pp1[8], t1[8];
            ldrow8(PP, t0 - 1, ch, pm1); ldrow8(PP, t0, ch, p0);
#pragma unroll
            for (int s = 0; s < 16; ++s) { const int t = t0 + s;
                ldrow8(PP, t + 1, ch, pp1); ldrow8(BG, t, ch, t1);
                float o[8];
#pragma unroll
                for (int j = 0; j < 8; ++j) o[j] = t1[j] * (w0[j] * pm1[j] + w1[j] * p0[j] + w2[j] * pp1[j]);
                *(u32x4*)(YC + (size_t)t * 1024 + ch) = pack8(o);
#pragma unroll
                for (int j = 0; j < 8; ++j) { pm1[j] = p0[j]; p0[j] = pp1[j]; } }
        }
        {
            bf16_t* Q = (bf16_t*)(ws + WS_Q); bf16_t* Kb = (bf16_t*)(ws + WS_K);
            const float* rc = (const float*)(ws + WS_ROPE); const float* rs = rc + 320 * 32;
            const int d0 = (lane & 15) * 8, i0 = (lane & 3) * 8;
            float qg[8], kg[8];
            ld8f32(INP(a, I_QG) + l * 128 + d0, qg); ld8f32(INP(a, I_KG) + l * 128 + d0, kg);
            const bool second = (lane & 4) != 0;
            const int tokb = run * 16 + hf * 8;
            const int tsel = (d0 < 64) ? 0 : 1;
            u32x4 cur[3]; float cs[8], sn[8];
#define LD_TOK(tok, dst, dcs, dsn) do { const int tp_ = tsel ? 256 + ((tok) & 63) : ((tok) >> 6); ld8f32(rc + tp_ * 32 + i0, dcs); ld8f32(rs + tp_ * 32 + i0, dsn); \
                dst[0] = *(const u32x4*)(Q + (size_t)(tok) * 1024 + lane * 8); dst[1] = *(const u32x4*)(Q + (size_t)(tok) * 1024 + 512 + lane * 8); dst[2] = *(const u32x4*)(Kb + (size_t)(tok) * 256 + (lane & 31) * 8); } while (0)
            LD_TOK(tokb, cur, cs, sn);
#pragma unroll
            for (int i = 0; i < 8; ++i) {
                const int tok = tokb + i;
                u32x4 nx[3]; float ncs[8], nsn[8];
                if (i < 7) LD_TOK(tok + 1, nx, ncs, nsn);
#pragma unroll
                for (int part = 0; part < 3; ++part) {
                    bf16_t* p = (part < 2) ? (Q + (size_t)tok * 1024 + part * 512 + lane * 8) : (Kb + (size_t)tok * 256 + (lane & 31) * 8);
                    float v[8]; unpack8(cur[part], v);
                    float ss = 0.f;
#pragma unroll
                    for (int j = 0; j < 8; ++j) ss += v[j] * v[j];
                    ss += __shfl_xor(ss, 1); ss += __shfl_xor(ss, 2); ss += __shfl_xor(ss, 4); ss += __shfl_xor(ss, 8);
                    const float rstd = __builtin_amdgcn_rsqf(ss * (1.f / 128.f) + EPS);
                    float o[8];
#pragma unroll
                    for (int j = 0; j < 8; ++j) { const float y = v[j] * rstd * (part < 2 ? qg[j] : kg[j]); const float pr = __shfl_xor(y, 4);
                        o[j] = y * cs[j] + (second ? pr : -pr) * sn[j]; }
                    if (part < 2 || lane < 32) *(u32x4*)p = pack8(o);
                }
                if (i < 7) {
#pragma unroll
                    for (int part = 0; part < 3; ++part) cur[part] = nx[part];
#pragma unroll
                    for (int j = 0; j < 8; ++j) { cs[j] = ncs[j]; sn[j] = nsn[j]; } }
            }
#undef LD_TOK
        }
    }
}

__device__ __forceinline__ void phase_scan_a(KArgs a, unsigned char* wsb, int lane, int wave, int bid, int G) {
    unsigned char* ws = wsb;
    const int gw = bid * 8 + wave, NGW = G * 8;
    for (int it = gw; it < 2048; it += NGW) {
        const int c = it >> 4, dir = (it >> 3) & 1, ch = (it & 7) * 128 + lane * 2;
        const bf16_t* LA = (const bf16_t*)(ws + WS_LA + (size_t)dir * 64 * MiB) + ch;
        const bf16_t* UU = (const bf16_t*)(ws + WS_U + (size_t)dir * 64 * MiB) + ch;
        float s0 = 0.f, s1 = 0.f, h0 = 0.f, h1 = 0.f;
#pragma unroll 16
        for (int st = 0; st < 128; ++st) { const int t = dir == 0 ? c * 128 + st : c * 128 + 127 - st;
            const unsigned wl = *(const unsigned*)(LA + (size_t)t * 1024), wu = *(const unsigned*)(UU + (size_t)t * 1024);
            const float l0 = __uint_as_float(wl << 16), l1 = __uint_as_float(wl & 0xffff0000u);
            const float u0 = __uint_as_float(wu << 16), u1 = __uint_as_float(wu & 0xffff0000u);
            h0 = __builtin_amdgcn_exp2f(l0) * h0 + u0; h1 = __builtin_amdgcn_exp2f(l1) * h1 + u1; s0 += l0; s1 += l1; }
        *(f32x2*)((float*)(ws + WS_SA) + (c * 2 + dir) * 1024 + ch) = (f32x2){s0, s1};
        *(f32x2*)((float*)(ws + WS_SH) + (c * 2 + dir) * 1024 + ch) = (f32x2){h0, h1};
    }
}
__device__ __forceinline__ void phase_scan_c(unsigned char* wsb, LAS unsigned char* lds, int lane, int wave, int bid, int G) {
    unsigned char* ws = wsb;
    const int gw = bid * 8 + wave, NGW = G * 8;
    const float* __restrict__ SA = (const float*)(ws + WS_SA); const float* __restrict__ SH = (const float*)(ws + WS_SH);
    for (int it = gw; it < 2048; it += NGW) {
        const int c = it >> 4, ch = (it & 15) * 64 + lane;
        float cf = 0.f, cb = 0.f;
#pragma unroll 8
        for (int sidx = 0; sidx < c; ++sidx) { const int idx = (sidx * 2) * 1024 + ch; cf = __builtin_amdgcn_exp2f(SA[idx]) * cf + SH[idx]; }
#pragma unroll 8
        for (int sidx = 127; sidx > c; --sidx) { const int idx = (sidx * 2 + 1) * 1024 + ch; cb = __builtin_amdgcn_exp2f(SA[idx]) * cb + SH[idx]; }
        const bf16_t* __restrict__ LAf = (const bf16_t*)(ws + WS_LA) + ch; const bf16_t* __restrict__ UUf = (const bf16_t*)(ws + WS_U) + ch;
        const bf16_t* __restrict__ LAb = (const bf16_t*)(ws + WS_LA + 64 * MiB) + ch; const bf16_t* __restrict__ UUb = (const bf16_t*)(ws + WS_U + 64 * MiB) + ch;
        const bf16_t* __restrict__ SGA = (const bf16_t*)(ws + WS_SGA) + ch; bf16_t* __restrict__ YA = (bf16_t*)(ws + WS_XA) + ch;
        LAS bf16_t* hfs = (LAS bf16_t*)(lds + wave * 16384) + lane;
        float h = cf;
        { const bf16_t* pl = LAf + (size_t)c * 128 * 1024; const bf16_t* pu = UUf + (size_t)c * 128 * 1024;
            float lA[16], uA[16], lB[16], uB[16];
#define LDF(l_, u_) do { _Pragma("unroll") for (int i = 0; i < 16; ++i) { l_[i] = bf2f(pl[i * 1024]); u_[i] = bf2f(pu[i * 1024]); } pl += 16 * 1024; pu += 16 * 1024; } while (0)
#define CPF(l_, u_, blk) do { _Pragma("unroll") for (int i = 0; i < 16; ++i) { h = __builtin_amdgcn_exp2f(l_[i]) * h + u_[i]; hfs[((blk) * 16 + i) * 64] = (bf16_t)f2bf(h); } } while (0)
            LDF(lA, uA);
#pragma unroll 1
            for (int blk = 0; blk < 8; blk += 2) { LDF(lB, uB); CPF(lA, uA, blk); if (blk + 2 < 8) LDF(lA, uA); CPF(lB, uB, blk + 1); }
#undef LDF
#undef CPF
        }
        h = cb;
        { const size_t e0 = (size_t)(c * 128 + 112) * 1024;
            const bf16_t* pl = LAb + e0; const bf16_t* pu = UUb + e0; const bf16_t* pg = SGA + e0; bf16_t* py = YA + e0;
            float lA[16], uA[16], gA[16], lB[16], uB[16], gB[16];
#define LDB(l_, u_, g_) do { _Pragma("unroll") for (int i = 0; i < 16; ++i) { l_[i] = bf2f(pl[i * 1024]); u_[i] = bf2f(pu[i * 1024]); g_[i] = bf2f(pg[i * 1024]); } pl -= 16 * 1024; pu -= 16 * 1024; pg -= 16 * 1024; } while (0)
#define CPB(l_, u_, g_, blk) do { _Pragma("unroll") for (int i = 15; i >= 0; --i) { h = __builtin_amdgcn_exp2f(l_[i]) * h + u_[i]; \
                py[i * 1024] = (bf16_t)f2bf((bf2f(hfs[((blk) * 16 + i) * 64]) + h) * g_[i]); } py -= 16 * 1024; } while (0)
            LDB(lA, uA, gA);
#pragma unroll 1
            for (int blk = 7; blk >= 0; blk -= 2) { LDB(lB, uB, gB); CPB(lA, uA, gA, blk); if (blk - 2 >= 0) LDB(lA, uA, gA); CPB(lB, uB, gB, blk - 1); }
#undef LDB
#undef CPB
        }
    }
}

__global__ void __launch_bounds__(512, 2) mk_fwd(Args args) {
    extern __shared__ __attribute__((aligned(16))) unsigned char lds[];
    cg::grid_group grid = cg::this_grid();
    LAS unsigned char* L = (LAS unsigned char*)lds;
    if (threadIdx.x < 2) ((LAS unsigned*)(L + 131072))[threadIdx.x] = 0u;
    __syncthreads();
    (void)xcd_barrier_post((unsigned*)(args.ws + WS_BAR), (volatile LAS unsigned*)(L + 131072));
    const int wave_u = __builtin_amdgcn_readfirstlane(threadIdx.x >> 6);
    for (int ph = args.ph_lo; ph < args.ph_hi; ++ph) {
        int tid; { int ln_; asm volatile("v_mbcnt_lo_u32_b32 %0, -1, 0\n\tv_mbcnt_hi_u32_b32 %0, -1, %0" : "=v"(ln_)); tid = wave_u * 64 + ln_; }
        int G = gridDim.x, bid = blockIdx.x; asm volatile("" : "+s"(G), "+s"(bid));
        KArgs ap = (KArgs)__builtin_amdgcn_kernarg_segment_ptr(); asm volatile("" : "+s"(ap));
        GAS unsigned char* wsg = (GAS unsigned char*)ap->ws; asm volatile("" : "+s"(wsg));
        unsigned char* ws = (unsigned char*)wsg;
        const int lane = tid & 63, wave = __builtin_amdgcn_readfirstlane(tid >> 6);
        unsigned long long pt0 = 0; int pcls = -1; if (PROBE_K >= 0) pt0 = __builtin_amdgcn_s_memrealtime();
        if (ph == 0) { pcls = 8; if (PHM & 512) phase_prologue(ap, ws, L, tid, lane, wave, bid, G); }
        else {
            const int q = ph - 1, lb = q / NPH_PER, k = q - lb * NPH_PER, l = lb >> 1, b = lb & 1; pcls = k;
            if (k == 0) { if (PHM & 1) phase_h(ap, ws, l, b, lane, wave, bid, G); }
            else if (k == 1) { if (PHM & 2) {
                pg8::Gemm g{(const bf16_t*)(ws + WS_H), (const bf16_t*)(ws + WS_WIN) + (size_t)l * NIN * 1024, 1024, 1024, 1024, 0, 0};
                pg8::StaticOrder S; S.init(SEQ, NIN, G, bid);
                pg8::EpiInProj E{ws};
                pg8::gemm_phase<pg8::EpiInProj, pg8::StaticOrder, 0>(L, g, S, E, tid); }
            } else if (k == 2) { if (PHM & 4) phase_elem(ap, ws, l, lane, wave, bid, G); }
            else if (k == 3) {
                if (PHM & 8) {
                    pg8::Gemm g{(const bf16_t*)(ws + WS_H), (const bf16_t*)(ws + WS_WG) + (size_t)l * 4096 * 256, 1024, 256, 256, 0, 0};
                    pg8::StaticOrder S; S.init(SEQ, 4096, G, bid);
                    pg8::EpiGates E{ws, INP(ap, I_BRG) + l * 2048, INP(ap, I_BIG) + l * 2048, INP(ap, I_LAM) + l * 2048};
                    pg8::gemm_phase<pg8::EpiGates, pg8::StaticOrder, 1>(L, g, S, E, tid);
                }
                if (PROBE_K == 3) { const unsigned long long t1 = __builtin_amdgcn_s_memrealtime(), dt = t1 - pt0; while (__builtin_amdgcn_s_memrealtime() - t1 < dt) __builtin_amdgcn_s_sleep(8); }
                if (PROBE_K == 9) { pt0 = __builtin_amdgcn_s_memrealtime(); pcls = 9; }
                if (PHM & 256) {
                    const int v = (G % 8 == 0) ? (bid % 8) * (G / 8) + bid / 8 : bid;
                    const int per = (512 + G - 1) / G;
                    for (int i = 0; i < per; ++i) { const int idx = v * per + i; if (idx >= 512) break;
                        const int h = idx >> 6, qb = idx & 63, kvh = h >> 2;
                        const attn::bf16* Qb = (const attn::bf16*)(ws + WS_Q) + (size_t)qb * 256 * 1024 + h * 128;
                        const attn::bf16* Kh = (const attn::bf16*)(ws + WS_K) + kvh * 128;
                        const attn::bf16* Vh = (const attn::bf16*)(ws + WS_V) + kvh * 128;
                        bf16_t* Ob = (bf16_t*)(ws + WS_SGB) + (size_t)qb * 256 * 1024 + h * 128;
                        const bf16_t* Gb = (const bf16_t*)(ws + WS_SGB) + (size_t)qb * 256 * 1024 + h * 128;
                        attn::attn_pp_body(Qb, Kh, Vh, Ob, Gb, SEQ, (char*)lds, tid);
                    }
                }
            } else if (k == 4) { if (PHM & 16) phase_scan_a(ap, ws, lane, wave, bid, G); }
            else if (k == 5) { if (PHM & 32) phase_scan_c(ws, L, lane, wave, bid, G); }
            else if (k == 6) { if (PHM & 64) {
                pg8::Gemm g{(const bf16_t*)(ws + WS_XA), (const bf16_t*)(ws + WS_WBR) + (size_t)l * 3 * 1048576, 1024, 1024, 1024,
                            (long)WS_SGB - (long)WS_XA, (long)WS_YC - (long)WS_XA};
                pg8::BranchOrder S; S.so.init(SEQ, 1024, G, bid);
                pg8::EpiBranch E{ws};
                pg8::gemm_phase<pg8::EpiBranch, pg8::BranchOrder, 2>(L, g, S, E, tid); }
            } else if (PHM & 128) {
                pg8::Gemm g{(const bf16_t*)(ws + WS_SGA), (const bf16_t*)(ws + WS_WOUT) + (size_t)l * 1048576, 1024, 1024, 1024, 0, 0};
                pg8::StaticOrder S; S.init(SEQ, 1024, G, bid);
                const float* xi = (l == 0 ? INP(ap, I_X) : OUTP(ap)) + (size_t)b * SEQ * DM;
                pg8::EpiOut E{xi, OUTP(ap) + (size_t)b * SEQ * DM, (const float*)(ws + WS_MOD) + (l * 2 + b) * 3072 + 2048};
                pg8::gemm_phase<pg8::EpiOut, pg8::StaticOrder, 0>(L, g, S, E, tid);
            }
        }
        if (PROBE_K >= 0 && PROBE_K != 3 && ph + 1 == args.ph_hi && pcls == PROBE_K) { VM_WAIT(); __syncthreads(); const unsigned long long t1 = __builtin_amdgcn_s_memrealtime(), dt = t1 - pt0; while (__builtin_amdgcn_s_memrealtime() - t1 < dt) __builtin_amdgcn_s_sleep(8); }
        if (ph + 1 < args.ph_hi) { if (ph == args.ph_lo) grid.sync(); else { XcdBarrier xbar; xbar.bar = (unsigned*)(ws + WS_BAR); xbar.x = xb_xcc_id(); xbar.st = (volatile LAS unsigned*)(L + 131072); xcd_barrier(xbar, tid); }
            if (PROBE_K >= 0 && PROBE_K != 3 && pcls == PROBE_K) { const unsigned long long t1 = __builtin_amdgcn_s_memrealtime(), dt = t1 - pt0; while (__builtin_amdgcn_s_memrealtime() - t1 < dt) __builtin_amdgcn_s_sleep(8); } }
    }
}

extern "C" void kernel_launch(void* const* d_in, const int* in_sizes, int n_in, void* d_out, int out_size, void* d_ws, size_t ws_size, hipStream_t stream) {
    static int grid = 0;
    if (grid == 0) {
        if (n_in != 18 || ws_size < WS_END) { fprintf(stderr, "kernel_launch: need 18 inputs and >= %zu bytes of workspace (got %d, %zu)\n", (size_t)WS_END, n_in, ws_size); grid = -1; return; }
        int dev = 0, cus = 0, per_cu = 0;
        hipGetDevice(&dev);
        hipDeviceGetAttribute(&cus, hipDeviceAttributeMultiprocessorCount, dev);
        if (hipFuncSetAttribute((const void*)mk_fwd, hipFuncAttributeMaxDynamicSharedMemorySize, LDS_BYTES) != hipSuccess) { fprintf(stderr, "kernel_launch: hipFuncSetAttribute failed\n"); grid = -1; return; }
        if (hipOccupancyMaxActiveBlocksPerMultiprocessor(&per_cu, (const void*)mk_fwd, 512, LDS_BYTES) != hipSuccess || per_cu < 1) { fprintf(stderr, "kernel_launch: occupancy query gave %d\n", per_cu); per_cu = 1; }
        (void)hipGetLastError();
        grid = cus * 1;
    }
    if (grid < 0) return;
    if (hipMemsetAsync((char*)d_ws + WS_BAR, 0, 16384, stream) != hipSuccess) { fprintf(stderr, "kernel_launch: memset failed\n"); return; }
    Args a{};
    for (int i = 0; i < 18; ++i) a.in[i] = (const float*)d_in[i];
    a.out = (float*)d_out; a.ws = (unsigned char*)d_ws; a.ph_lo = 0; a.ph_hi = NPHASES;
    void* kargs[] = {&a};
    hipError_t e = hipLaunchCooperativeKernel((const void*)mk_fwd, dim3(grid), dim3(512), kargs, LDS_BYTES, stream);
    if (e != hipSuccess) fprintf(stderr, "kernel_launch: cooperative launch failed: %s (grid %d)\n", hipGetErrorString(e), grid);
}
```

```cpp
#include <hip/hip_runtime.h>
#include <hip/hip_cooperative_groups.h>
#include <hip/hip_bf16.h>
#include <cstdio>
#include <cstdint>
namespace cg = cooperative_groups;

#define LAS __attribute__((address_space(3)))
#define GAS __attribute__((address_space(1)))
typedef unsigned short bf16_t;
typedef short bf16x8 __attribute__((ext_vector_type(8)));
typedef float f32x4 __attribute__((ext_vector_type(4)));
typedef float f32x2 __attribute__((ext_vector_type(2)));
typedef unsigned u32x4 __attribute__((ext_vector_type(4)));
typedef unsigned u32x2 __attribute__((ext_vector_type(2)));

constexpr int DM = 1024, SEQ = 16384, NBATCH = 2, DEPTH = 2, NIN = 11776;
constexpr int NPH_PER = 8, NPHASES = 1 + DEPTH * NBATCH * NPH_PER;
constexpr float EPS = 1e-6f;
constexpr float LOG2E = 1.4426950408889634f;

constexpr size_t MiB = 1u << 20;
constexpr size_t WS_MOD = 0;
constexpr size_t WS_ROPE = 64 * 1024;
constexpr size_t WS_BAR = 256 * 1024;
constexpr size_t WS_SA = 1 * MiB, WS_SH = 2 * MiB;
constexpr size_t WS_WIN = 4 * MiB, WS_WG = 50 * MiB, WS_WBR = 54 * MiB, WS_WOUT = 66 * MiB;
constexpr size_t WS_H = 70 * MiB;
constexpr size_t WS_XA = 102 * MiB;
constexpr size_t WS_SGA = 134 * MiB;
constexpr size_t WS_Q = 166 * MiB;
constexpr size_t WS_K = 198 * MiB, WS_V = 206 * MiB;
constexpr size_t WS_SGB = 214 * MiB;
constexpr size_t WS_XC = 246 * MiB, WS_BC = 278 * MiB, WS_CC = 310 * MiB, WS_SGC = 342 * MiB;
constexpr size_t WS_LA = WS_XC, WS_U = WS_BC;
constexpr size_t WS_SMG = 374 * MiB;
constexpr size_t WS_YC = 470 * MiB;
constexpr size_t WS_END = 502 * MiB;
constexpr int LDS_BYTES = 131072 + 1024;

__device__ __forceinline__ float bf2f(bf16_t v) { return __uint_as_float((unsigned)v << 16); }
__device__ __forceinline__ unsigned f2bf(float f) { unsigned u = __float_as_uint(f); return (u + 0x7fffu + ((u >> 16) & 1u)) >> 16; }
__device__ __forceinline__ unsigned cvt_pk_bf16(float lo, float hi) { unsigned r; asm("v_cvt_pk_bf16_f32 %0, %1, %2" : "=v"(r) : "v"(lo), "v"(hi)); return r; }
__device__ __forceinline__ void unpack8(const u32x4 w, float (&f)[8]) {
#pragma unroll
    for (int i = 0; i < 4; ++i) { f[2 * i] = __uint_as_float(w[i] << 16); f[2 * i + 1] = __uint_as_float(w[i] & 0xffff0000u); }
}
__device__ __forceinline__ u32x4 pack8(const float (&f)[8]) {
    u32x4 w; w.x = cvt_pk_bf16(f[0], f[1]); w.y = cvt_pk_bf16(f[2], f[3]); w.z = cvt_pk_bf16(f[4], f[5]); w.w = cvt_pk_bf16(f[6], f[7]); return w;
}
__device__ __forceinline__ float sigmoidf_(float v) { return __builtin_amdgcn_rcpf(1.f + __expf(-v)); }
__device__ __forceinline__ float wave_sum(float v) {
#pragma unroll
    for (int o = 1; o < 64; o <<= 1) v += __shfl_xor(v, o);
    return v;
}
#define LDS_WAIT() asm volatile("s_waitcnt lgkmcnt(0)" ::: "memory")
#define VM_WAIT() asm volatile("s_waitcnt vmcnt(0)" ::: "memory")

namespace pg8 {
constexpr int BM = 256, BK = 64, HALF = 128, HTB = HALF * BK * 2, STAGE_BYTES = 8 * HTB, NXCD = 8, WGM = 8;
__device__ __forceinline__ int lds_byte(int r, int c) { const int st = (r >> 4) * 2 + (c >> 5), rr = r & 15, cc = c & 31, ob = rr * 64 + cc * 2; return st * 1024 + (ob ^ (((ob >> 9) & 1) << 5)); }
__device__ __forceinline__ void stage_rc(int b, int& R, int& C) { const int st = b / 1024, sb = b % 1024, swz = sb ^ (((sb >> 9) & 1) << 5); R = (st >> 1) * 16 + swz / 64; C = (st & 1) * 32 + (swz % 64) / 2; }
__device__ __forceinline__ int perm32(int rho) { const int n = rho >> 4, i = rho & 15; return 8 * (i >> 2) + 4 * n + (i & 3); }

struct Unit { int pm, pn, kk; };
struct Gemm { const bf16_t* A; const bf16_t* Bt; int lda, ldb, K; long a1, a2; };

struct StaticOrder {
    int nM, nN, nwg, G, c;
    __device__ void init(int M, int N, int G_, int c_) { nM = M / BM; nN = N / BM; nwg = nM * nN; G = G_; c = c_; }
    __device__ bool next(int i, Unit& u) const {
        const long L = (long)i * G + c; if (L >= nwg) return false;
        int wgid = (int)L; { const int q = nwg / NXCD, r = nwg % NXCD, xcd = wgid % NXCD, off = wgid / NXCD; wgid = (xcd < r ? xcd * (q + 1) : r * (q + 1) + (xcd - r) * q) + off; }
        const int nig = WGM * nN, gid = wgid / nig, fm = gid * WGM, gsz = (nM - fm) < WGM ? (nM - fm) : WGM;
        u.pm = fm + ((wgid % nig) % gsz); u.pn = (wgid % nig) / gsz; u.kk = 0; return true;
    }
};
struct BranchOrder {
    StaticOrder so;
    __device__ bool next(int i, Unit& u) const { const int ti = i / 3, kk = i - 3 * ti; if (!so.next(ti, u)) return false; u.kk = kk; return true; }
};

template <int MODE> __device__ __forceinline__ const char* unitA(const Gemm& g, const Unit& u) {
    const char* p = (const char*)g.A + (size_t)u.pm * BM * g.lda * 2;
    if (MODE == 1) p += (((u.pn >> 1) & 3) * 256) * 2;
    if (MODE == 2) p += (u.kk == 1 ? g.a1 : (u.kk == 2 ? g.a2 : 0l));
    return p;
}
template <int MODE> __device__ __forceinline__ const char* unitB(const Gemm& g, const Unit& u) {
    const char* p = (const char*)g.Bt + (size_t)u.pn * BM * g.ldb * 2;
    if (MODE == 2) p += (size_t)u.kk * 1024 * 1024 * 2;
    return p;
}

template <class Epi, class Sched, int MODE>
__device__ __forceinline__ void gemm_phase(LAS unsigned char* lds, const Gemm g, const Sched& S, const Epi& E, const int tid) {
    const int wid = __builtin_amdgcn_readfirstlane(tid >> 6), lane = tid & 63, wr = wid >> 2, wc = wid & 3, fr = lane & 15, fq = lane >> 4;
    const int K = g.K, nt = K / BK;
    unsigned voffA[2], voffB[2];
#pragma unroll
    for (int i = 0; i < 2; ++i) { int R, C; stage_rc(tid * 16 + i * 8192, R, C); const int Rb = (R & ~31) + perm32(R & 31);
        voffA[i] = (unsigned)(R * g.lda + C) * 2u; voffB[i] = (unsigned)(Rb * g.ldb + C) * 2u; }
    const size_t kstep = (size_t)(BK * 2);
    const size_t hstepA = (size_t)HALF * g.lda * 2, hstepB = (size_t)HALF * g.ldb * 2;
    const unsigned ldsw = (unsigned)wid * 1024u;
    const int aoff = lds_byte(wr * 64 + fr, fq * 8), boff = lds_byte(wc * 32 + fr, fq * 8);
#define PG8_SA(b, h) (((b) * 2 + (h)) * HTB)
#define PG8_SB(b, h) ((4 + (b) * 2 + (h)) * HTB)
#define PG8_STAGE(bufoff, gbase, voff) do { _Pragma("unroll") for (int _i = 0; _i < 2; ++_i) \
        __builtin_amdgcn_global_load_lds((const unsigned*)((const char*)(gbase) + (voff)[_i]), (LAS unsigned*)(lds + (bufoff) + ldsw + _i * 8192), 16, 0, 0); } while (0)
#define PG8_LDA(dst, b, h) do { _Pragma("unroll") for (int m = 0; m < 4; ++m) _Pragma("unroll") for (int k = 0; k < 2; ++k) dst[m][k] = *(const LAS bf16x8*)(lds + PG8_SA(b, h) + aoff + m * 2048 + k * 1024); } while (0)
#define PG8_LDB(dst, b, h) do { _Pragma("unroll") for (int n = 0; n < 2; ++n) _Pragma("unroll") for (int k = 0; k < 2; ++k) dst[n][k] = *(const LAS bf16x8*)(lds + PG8_SB(b, h) + boff + n * 2048 + k * 1024); } while (0)
#define PG8_MMA(ai, bj, At, Bt) do { __builtin_amdgcn_s_setprio(1); _Pragma("unroll") for (int m = 0; m < 4; ++m) _Pragma("unroll") for (int n = 0; n < 2; ++n) _Pragma("unroll") for (int k = 0; k < 2; ++k) \
        acc[ai][bj][m][n] = __builtin_amdgcn_mfma_f32_16x16x32_bf16(Bt[n][k], At[m][k], acc[ai][bj][m][n], 0, 0, 0); __builtin_amdgcn_s_setprio(0); } while (0)
#define PG8_WAIT_V(n) asm volatile("s_waitcnt vmcnt(" #n ")" ::: "memory")
#define PG8_WAIT_L(n) asm volatile("s_waitcnt lgkmcnt(" #n ")" ::: "memory")
#define PG8_BAR __builtin_amdgcn_s_barrier()
#define PG8_SCHED __builtin_amdgcn_sched_barrier(0)
    Unit cur, nxt; int ui = 0;
    if (!S.next(0, cur)) return;
    f32x4 acc[2][2][4][2];
#pragma unroll
    for (int a = 0; a < 2; ++a)
#pragma unroll
        for (int b = 0; b < 2; ++b)
#pragma unroll
            for (int m = 0; m < 4; ++m)
#pragma unroll
                for (int n = 0; n < 2; ++n) acc[a][b][m][n] = (f32x4){0.f, 0.f, 0.f, 0.f};
    bf16x8 At[4][2], B0[2][2], B1[2][2];
    const char* cA = unitA<MODE>(g, cur); const char* cB = unitB<MODE>(g, cur);
    PG8_STAGE(PG8_SB(0, 0), cB, voffB); PG8_STAGE(PG8_SB(0, 1), cB + hstepB, voffB); PG8_STAGE(PG8_SA(0, 0), cA, voffA); PG8_STAGE(PG8_SA(0, 1), cA + hstepA, voffA);
    if (wr == 1) PG8_BAR;
    PG8_WAIT_V(2); PG8_BAR;
    PG8_STAGE(PG8_SB(1, 0), cB + kstep, voffB); PG8_STAGE(PG8_SA(1, 0), cA + kstep, voffA); PG8_STAGE(PG8_SB(1, 1), cB + hstepB + kstep, voffB);
    PG8_WAIT_V(6); PG8_BAR;
    for (;;) {
        const bool has_next = S.next(ui + 1, nxt);
        const char* nA = has_next ? unitA<MODE>(g, nxt) : cA; const char* nB = has_next ? unitB<MODE>(g, nxt) : cB;
#pragma nounroll
        for (int t = 0; t < nt; t += 2) {
            const bool last = (t == nt - 2);
            const char* a1 = cA + (size_t)(t + 1) * kstep;
            const char* a2 = last ? nA : cA + (size_t)(t + 2) * kstep; const char* b2 = last ? nB : cB + (size_t)(t + 2) * kstep;
            const char* a3 = a2 + kstep; const char* b3 = b2 + kstep;
            PG8_LDB(B0, 0, 0); PG8_LDB(B1, 0, 1); PG8_SCHED; PG8_LDA(At, 0, 0); PG8_STAGE(PG8_SA(1, 1), a1 + hstepA, voffA);
            PG8_WAIT_V(8); PG8_WAIT_L(0); PG8_BAR; PG8_MMA(0, 0, At, B0); PG8_MMA(0, 1, At, B1); PG8_BAR; PG8_SCHED;
            PG8_LDA(At, 0, 1); PG8_STAGE(PG8_SB(0, 0), b2, voffB); PG8_STAGE(PG8_SB(0, 1), b2 + hstepB, voffB); PG8_STAGE(PG8_SA(0, 0), a2, voffA);
            PG8_WAIT_V(8); PG8_WAIT_L(0); PG8_BAR; PG8_MMA(1, 0, At, B0); PG8_MMA(1, 1, At, B1); PG8_BAR; PG8_SCHED;
            PG8_LDB(B0, 1, 0); PG8_LDB(B1, 1, 1); PG8_SCHED; PG8_LDA(At, 1, 0); PG8_STAGE(PG8_SA(0, 1), a2 + hstepA, voffA);
            PG8_WAIT_V(8); PG8_WAIT_L(0); PG8_BAR; PG8_MMA(0, 0, At, B0); PG8_MMA(0, 1, At, B1); PG8_BAR; PG8_SCHED;
            PG8_LDA(At, 1, 1); PG8_STAGE(PG8_SB(1, 0), b3, voffB); PG8_STAGE(PG8_SB(1, 1), b3 + hstepB, voffB); PG8_STAGE(PG8_SA(1, 0), a3, voffA);
            PG8_WAIT_V(8); PG8_WAIT_L(0); PG8_BAR; PG8_MMA(1, 0, At, B0); PG8_MMA(1, 1, At, B1); PG8_BAR; PG8_SCHED;
        }
        if (wr == 0) PG8_BAR;
        E(acc, cur, wr, wc, fr, fq);
        if (!has_next) break;
#pragma unroll
        for (int a = 0; a < 2; ++a)
#pragma unroll
            for (int b = 0; b < 2; ++b)
#pragma unroll
                for (int m = 0; m < 4; ++m)
#pragma unroll
                    for (int n = 0; n < 2; ++n) acc[a][b][m][n] = (f32x4){0.f, 0.f, 0.f, 0.f};
        cur = nxt; cA = nA; cB = nB; ++ui;
        if (wr == 1) PG8_BAR;
    }
    PG8_WAIT_V(0);
    PG8_BAR;
#undef PG8_SA
#undef PG8_SB
#undef PG8_STAGE
#undef PG8_LDA
#undef PG8_LDB
#undef PG8_MMA
#undef PG8_WAIT_V
#undef PG8_WAIT_L
#undef PG8_BAR
#undef PG8_SCHED
}

__device__ __forceinline__ void store_tile_bf16(const f32x4 (&acc)[2][2][4][2], bf16_t* base, int ldc, int row0, int col0, int act) {
#pragma unroll
    for (int ai = 0; ai < 2; ++ai)
#pragma unroll
        for (int m = 0; m < 4; ++m) { bf16_t* rowp = base + (size_t)(row0 + ai * HALF + m * 16) * ldc + col0;
#pragma unroll
            for (int bj = 0; bj < 2; ++bj) { float v[8];
#pragma unroll
                for (int j = 0; j < 4; ++j) { v[j] = acc[ai][bj][m][0][j]; v[4 + j] = acc[ai][bj][m][1][j]; }
                if (act != 0) {
                    float sg[8];
#pragma unroll
                    for (int j = 0; j < 8; ++j) sg[j] = sigmoidf_(v[j]);
                    if (act == 1) {
#pragma unroll
                        for (int j = 0; j < 8; ++j) v[j] *= sg[j];
                    } else {
#pragma unroll
                        for (int j = 0; j < 8; ++j) v[j] = sg[j];
                    }
                }
                *(u32x4*)(rowp + bj * HALF) = pack8(v); }
            asm volatile("" ::: "memory"); }
}
struct EpiInProj {
    unsigned char* ws;
    __device__ __forceinline__ void operator()(const f32x4 (&acc)[2][2][4][2], const Unit& u, int wr, int wc, int fr, int fq) const {
        const int pn = u.pn; size_t off; int ldc = 1024, col, act = 0;
        if (pn < 4) { off = WS_XA; col = pn * 256; }
        else if (pn < 8) { off = WS_SGA; col = (pn - 4) * 256; act = 1; }
        else if (pn < 12) { off = WS_Q; col = (pn - 8) * 256; }
        else if (pn == 12) { off = WS_K; col = 0; ldc = 256; }
        else if (pn == 13) { off = WS_V; col = 0; ldc = 256; }
        else if (pn < 18) { off = WS_SGB; col = (pn - 14) * 256; act = 1; }
        else if (pn < 34) {
            const bool bg = pn >= 26; const int blk = bg ? pn - 26 : pn - 18;
            bf16_t* basep = (bf16_t*)(ws + (bg ? WS_BC : WS_XC));
            const int row0p = u.pm * BM + wr * 64 + fr, col0p = blk * 128 + wc * 32 + 8 * fq;
#pragma unroll
            for (int ai = 0; ai < 2; ++ai)
#pragma unroll
                for (int m = 0; m < 4; ++m) { float v[8];
#pragma unroll
                    for (int j = 0; j < 8; ++j) { const float x0 = acc[ai][0][m][j >> 2][j & 3], x1 = acc[ai][1][m][j >> 2][j & 3];
                        v[j] = bg ? x0 * (x1 * sigmoidf_(x1)) : x0 * x1; }
                    *(u32x4*)(basep + (size_t)(row0p + ai * HALF + m * 16) * 1024 + col0p) = pack8(v); }
            return; }
        else { off = WS_SMG; col = (pn - 34) * 256; ldc = 3072; act = 2; }
        bf16_t* base = (bf16_t*)(ws + off);
        const int row0 = u.pm * BM + wr * 64 + fr, col0 = col + wc * 32 + 8 * fq;
        store_tile_bf16(acc, base, ldc, row0, col0, act);
    }
};
struct EpiGates {
    unsigned char* ws; const float* b_r; const float* b_i; const float* lam;
    __device__ __forceinline__ void operator()(const f32x4 (&acc)[2][2][4][2], const Unit& u, int wr, int wc, int fr, int fq) const {
        const int dir = u.pn >> 3, nb = (u.pn >> 1) & 3, hh = u.pn & 1;
        const int ch0 = nb * 256 + hh * 128 + wc * 32 + 8 * fq;
        float br[8], bi[8], sp[8];
#pragma unroll
        for (int j = 0; j < 8; ++j) { br[j] = b_r[dir * 1024 + ch0 + j]; bi[j] = b_i[dir * 1024 + ch0 + j];
            const float lm = lam[dir * 1024 + ch0 + j]; const float e = __expf(-lm);
            const float spl = lm < -15.f ? -lm : (e < 0.03f ? e * (1.f - e * (0.5f - e * (0.33333334f - 0.25f * e))) : __logf(1.f + e));
            sp[j] = -8.0f * LOG2E * spl; }
        const bf16_t* UA = (const bf16_t*)(ws + WS_H);
        bf16_t* LA = (bf16_t*)(ws + WS_LA + (size_t)dir * 64 * MiB);
        bf16_t* UU = (bf16_t*)(ws + WS_U + (size_t)dir * 64 * MiB);
        const int row0 = u.pm * BM + wr * 64 + fr;
#pragma unroll
        for (int ai = 0; ai < 2; ++ai)
#pragma unroll
            for (int m = 0; m < 4; ++m) { const size_t o = (size_t)(row0 + ai * HALF + m * 16) * 1024 + ch0;
                float x[8]; unpack8(*(const u32x4*)(UA + o), x);
                float la[8], uu[8];
#pragma unroll
                for (int j = 0; j < 8; ++j) { const float pr = acc[ai][0][m][j >> 2][j & 3] + br[j], pi = acc[ai][1][m][j >> 2][j & 3] + bi[j];
                    const float r = sigmoidf_(pr), ig = sigmoidf_(pi);
                    const float l2 = r * sp[j]; const float a = __builtin_amdgcn_exp2f(l2);
                    la[j] = l2; uu[j] = __builtin_amdgcn_sqrtf(fmaxf(1.f - a * a, 0.f)) * ig * x[j]; }
                *(u32x4*)(LA + o) = pack8(la); *(u32x4*)(UU + o) = pack8(uu); }
    }
};
struct EpiBranch {
    unsigned char* ws;
    __device__ __forceinline__ void operator()(const f32x4 (&acc)[2][2][4][2], const Unit& u, int wr, int wc, int fr, int fq) const {
        const bf16_t* G = (const bf16_t*)(ws + WS_SMG) + u.kk * 1024;
        bf16_t* Mg = (bf16_t*)(ws + WS_SGA);
        const int row0 = u.pm * BM + wr * 64 + fr, col0 = u.pn * BM + wc * 32 + 8 * fq;
#pragma unroll
        for (int ai = 0; ai < 2; ++ai)
#pragma unroll
            for (int m = 0; m < 4; ++m) { const int row = row0 + ai * HALF + m * 16;
#pragma unroll
                for (int bj = 0; bj < 2; ++bj) { const int col = col0 + bj * HALF;
                    float gt[8], v[8]; unpack8(*(const u32x4*)(G + (size_t)row * 3072 + col), gt);
#pragma unroll
                    for (int j = 0; j < 8; ++j) v[j] = gt[j] * acc[ai][bj][m][j >> 2][j & 3];
                    bf16_t* mp = Mg + (size_t)row * 1024 + col;
                    if (u.kk != 0) { float old[8]; unpack8(*(const u32x4*)mp, old);
#pragma unroll
                        for (int j = 0; j < 8; ++j) v[j] += old[j]; }
                    *(u32x4*)mp = pack8(v); } }
    }
};
struct EpiOut {
    const float* xi; float* xo; const float* gate;
    __device__ __forceinline__ void operator()(const f32x4 (&acc)[2][2][4][2], const Unit& u, int wr, int wc, int fr, int fq) const {
        const int row0 = u.pm * BM + wr * 64 + fr, col0 = u.pn * BM + wc * 32 + 8 * fq;
        f32x4 gv[2][2];
#pragma unroll
        for (int bj = 0; bj < 2; ++bj)
#pragma unroll
            for (int n = 0; n < 2; ++n) gv[bj][n] = *(const f32x4*)(gate + col0 + bj * HALF + 4 * n);
#pragma unroll
        for (int ai = 0; ai < 2; ++ai)
#pragma unroll
            for (int m = 0; m < 4; ++m) { const size_t o = (size_t)(row0 + ai * HALF + m * 16) * 1024 + col0;
#pragma unroll
                for (int bj = 0; bj < 2; ++bj)
#pragma unroll
                    for (int n = 0; n < 2; ++n) { const f32x4 xv = *(const f32x4*)(xi + o + bj * HALF + 4 * n);
                        *(f32x4*)(xo + o + bj * HALF + 4 * n) = xv + gv[bj][n] * acc[ai][bj][m][n]; } }
    }
};
}

namespace attn {
using bf16 = __hip_bfloat16;
using s16x4 = __attribute__((ext_vector_type(4))) short;
using f32x16 = __attribute__((ext_vector_type(16))) float;
constexpr int D = 128, NW = 8, QBLK = 32, KVBLK = 64;
constexpr float SCALE = 0.088388347648318440f;
constexpr float THR = 8.f;
constexpr int LDQ = 1024, LDK = 256, LDO = 1024;
constexpr size_t SHM_V = KVBLK * D * 2, SHM_K = KVBLK * D * 2, SHM_ATTN = 2 * SHM_V + 2 * SHM_K + NW * 64 * 4;
#define KSWZ(row, colB) ((row) * 256 + ((colB) ^ (((row) & 7) << 4)))
#define SBAR() __builtin_amdgcn_sched_barrier(0)
__device__ __forceinline__ int crow(int r, int hi) { return (r & 3) + 8 * (r >> 2) + 4 * hi; }
__device__ __forceinline__ unsigned cvtpk(float lo, float hi) { unsigned r; asm volatile("v_cvt_pk_bf16_f32 %0, %1, %2" : "=v"(r) : "v"(lo), "v"(hi)); return r; }

__device__ __forceinline__ void partialSM(f32x16& p0, f32x16& p1, float& m_reg, float& mn, float& alpha) {
  constexpr float C = SCALE * 1.4426950408889634f;
  float pmax = p0[0]; for (int r = 1; r < 16; ++r) pmax = fmaxf(pmax, p0[r]); for (int r = 0; r < 16; ++r) pmax = fmaxf(pmax, p1[r]);
  { auto rr = __builtin_amdgcn_permlane32_swap(__float_as_uint(pmax), __float_as_uint(pmax), false, false);
    pmax = fmaxf(__uint_as_float(rr[0]), __uint_as_float(rr[1])); }
  if (__builtin_expect(__all(pmax - m_reg <= THR / SCALE), 1)) { mn = m_reg; alpha = 1.f; }
  else { mn = fmaxf(m_reg, pmax); alpha = __builtin_amdgcn_exp2f((m_reg - mn) * C); m_reg = mn; }
  float mnC = -mn * C;
  for (int r = 0; r < 16; ++r) p0[r] = fmaf(p0[r], C, mnC); for (int r = 0; r < 16; ++r) p1[r] = fmaf(p1[r], C, mnC);
  for (int r = 0; r < 16; ++r) p0[r] = __builtin_amdgcn_exp2f(p0[r]);
}
__device__ __forceinline__ void finishSM(f32x16& p0, f32x16& p1, float alpha, float& l_reg, bf16x8& pa0, bf16x8& pa1, bf16x8& pa2, bf16x8& pa3) {
  for (int r = 0; r < 16; ++r) p1[r] = __builtin_amdgcn_exp2f(p1[r]);
  float ps = 0; for (int r = 0; r < 16; ++r) ps += p0[r]; for (int r = 0; r < 16; ++r) ps += p1[r];
  { auto rr = __builtin_amdgcn_permlane32_swap(__float_as_uint(ps), __float_as_uint(ps), false, false);
    ps = __uint_as_float(rr[0]) + __uint_as_float(rr[1]); }
  l_reg = l_reg * alpha + ps;
#define PK4(P, BASE, OUT) do { unsigned a0 = cvtpk(P[BASE + 0], P[BASE + 1]), a1 = cvtpk(P[BASE + 2], P[BASE + 3]);   \
    unsigned b0 = cvtpk(P[BASE + 4], P[BASE + 5]), b1 = cvtpk(P[BASE + 6], P[BASE + 7]);                              \
    auto r0 = __builtin_amdgcn_permlane32_swap(a0, b0, false, false); auto r1 = __builtin_amdgcn_permlane32_swap(a1, b1, false, false); \
    u32x4 w = {r0[0], r1[0], r0[1], r1[1]}; OUT = *reinterpret_cast<bf16x8*>(&w); } while (0)
  PK4(p0, 0, pa0); PK4(p0, 8, pa1); PK4(p1, 0, pa2); PK4(p1, 8, pa3);
#undef PK4
}
__device__ __forceinline__ void qkt(f32x16& p0, f32x16& p1, const bf16* Ks, const bf16x8* qr, int r32, int hi) {
  p0 = f32x16{}; p1 = f32x16{};
  for (int d0 = 0; d0 < 8; ++d0) { int cb = (d0 * 16 + hi * 8) * 2;
    bf16x8 b0 = *reinterpret_cast<const bf16x8*>((const char*)Ks + KSWZ(r32, cb));
    bf16x8 b1 = *reinterpret_cast<const bf16x8*>((const char*)Ks + KSWZ(32 + r32, cb));
    p0 = __builtin_amdgcn_mfma_f32_32x32x16_bf16(b0, qr[d0], p0, 0, 0, 0);
    p1 = __builtin_amdgcn_mfma_f32_32x32x16_bf16(b1, qr[d0], p1, 0, 0, 0); }
}
__device__ __forceinline__ int v_st(int k, int c) { const int kk = (k & ~0xC) | ((k & 4) << 1) | ((k & 8) >> 1); return ((kk >> 3) * 4 + (c >> 5)) * 512 + ((kk & 7) * 32 + (c & 31)) * 2; }
__device__ __forceinline__ int v_rd_base(int lane) { return ((lane & 3) << 3) | (((lane >> 2) & 3) << 6) | (((lane >> 4) & 1) << 5) | (((lane >> 5) & 1) << 8); }
constexpr int v_rd_off(int d0, int ks, int half) { return d0 * 512 + ks * 4096 + half * 2048; }
template <int OFF> __device__ __forceinline__ s16x4 tr_read(int vb) {
  s16x4 r; asm volatile("ds_read_b64_tr_b16 %0, %1 offset:%2" : "=&v"(r) : "v"(vb), "i"(OFF) : "memory"); return r;
}
template <int D0> __device__ __forceinline__ void pv_one(f32x16& od, int vb, bf16x8 pa0, bf16x8 pa1, bf16x8 pa2, bf16x8 pa3) {
  const s16x4 l0 = tr_read<v_rd_off(D0, 0, 0)>(vb), h0 = tr_read<v_rd_off(D0, 0, 1)>(vb), l1 = tr_read<v_rd_off(D0, 1, 0)>(vb), h1 = tr_read<v_rd_off(D0, 1, 1)>(vb);
  const s16x4 l2 = tr_read<v_rd_off(D0, 2, 0)>(vb), h2 = tr_read<v_rd_off(D0, 2, 1)>(vb), l3 = tr_read<v_rd_off(D0, 3, 0)>(vb), h3 = tr_read<v_rd_off(D0, 3, 1)>(vb);
  asm volatile("s_waitcnt lgkmcnt(0)" ::: "memory"); SBAR();
#define PK(L, H) (bf16x8){L[0], L[1], L[2], L[3], H[0], H[1], H[2], H[3]}
  od = __builtin_amdgcn_mfma_f32_32x32x16_bf16(pa0, PK(l0, h0), od, 0, 0, 0);
  od = __builtin_amdgcn_mfma_f32_32x32x16_bf16(pa1, PK(l1, h1), od, 0, 0, 0);
  od = __builtin_amdgcn_mfma_f32_32x32x16_bf16(pa2, PK(l2, h2), od, 0, 0, 0);
  od = __builtin_amdgcn_mfma_f32_32x32x16_bf16(pa3, PK(l3, h3), od, 0, 0, 0);
#undef PK
}
__device__ __forceinline__ void pv_d0(f32x16* o, int vb, bf16x8 pa0, bf16x8 pa1, bf16x8 pa2, bf16x8 pa3) {
  pv_one<0>(o[0], vb, pa0, pa1, pa2, pa3); pv_one<1>(o[1], vb, pa0, pa1, pa2, pa3); pv_one<2>(o[2], vb, pa0, pa1, pa2, pa3); pv_one<3>(o[3], vb, pa0, pa1, pa2, pa3);
}
__device__ __forceinline__ void attn_dense_body(const bf16* Qb, const bf16* __restrict__ Kh, const bf16* __restrict__ Vh,
                                                bf16_t* Ob, const bf16_t* Gb, int seq, char* lds, const int tid) {
  const int wid = tid >> 6, lane = tid & 63, r32 = lane & 31, hi = lane >> 5;
  bf16* V_lds = (bf16*)lds; bf16* K_lds = (bf16*)(lds + 2 * SHM_V);
  float* ws = (float*)(lds + 2 * SHM_V + 2 * SHM_K) + wid * 64; float* li_l = ws; float* al_l = ws + 32;
  float m_reg = -1e30f, l_reg = 0; f32x16 o[4] = {}; bf16x8 qr[8];
  const bf16* Qw = Qb + (long)(wid * QBLK + r32) * LDQ + hi * 8;
#pragma unroll
  for (int d0 = 0; d0 < 8; ++d0) qr[d0] = *reinterpret_cast<const bf16x8*>(Qw + d0 * 16);
  const int sr = tid >> 4, sc = (tid & 15) * 8, vst0 = v_st(sr, sc), vst1 = v_st(32 + sr, sc);
  const int vb0 = (int)(uintptr_t)V_lds + v_rd_base(lane);
  struct { bf16x8 vs0, vs1, ks0, ks1; } sr_[2];
#define SLOAD(i, k0) do { sr_[i].vs0 = *reinterpret_cast<const bf16x8*>(&Vh[(long)((k0) + sr) * LDK + sc]); sr_[i].vs1 = *reinterpret_cast<const bf16x8*>(&Vh[(long)((k0) + 32 + sr) * LDK + sc]); \
    sr_[i].ks0 = *reinterpret_cast<const bf16x8*>(&Kh[(long)((k0) + sr) * LDK + sc]); sr_[i].ks1 = *reinterpret_cast<const bf16x8*>(&Kh[(long)((k0) + 32 + sr) * LDK + sc]); } while (0)
#define SWRITE(b, i) do { *(bf16x8*)((char*)V_lds + (b) * SHM_V + vst0) = sr_[i].vs0;          \
    *(bf16x8*)((char*)V_lds + (b) * SHM_V + vst1) = sr_[i].vs1; int kc = sc * 2;               \
    *(bf16x8*)((char*)K_lds + (b) * SHM_K + KSWZ(sr, kc)) = sr_[i].ks0;                       \
    *(bf16x8*)((char*)K_lds + (b) * SHM_K + KSWZ(32 + sr, kc)) = sr_[i].ks1; } while (0)
#define SWAIT() asm volatile("s_waitcnt vmcnt(4)" ::: "memory")
#define RESC(a) do { if (__any((a) < 1.f)) { if (hi == 0) al_l[r32] = (a); asm volatile("s_waitcnt lgkmcnt(0)" ::: "memory"); \
    for (int d = 0; d < 4; ++d) for (int r = 0; r < 16; ++r) o[d][r] *= al_l[crow(r, hi)]; } } while (0)
  f32x16 pA0, pA1, pB0, pB1; float mnA, mnB, alA, alB; bf16x8 pa0, pa1, pa2, pa3; const int NT = seq / KVBLK;
  constexpr int SE = 0, SO = 1;
  SLOAD(SE, 0); asm volatile("s_waitcnt vmcnt(0)" ::: "memory"); SWRITE(0, SE); __syncthreads();
  qkt(pA0, pA1, K_lds, qr, r32, hi); partialSM(pA0, pA1, m_reg, mnA, alA);
  SLOAD(SO, KVBLK); if (2 < NT) SLOAD(SE, 2 * KVBLK);
  SWAIT(); SWRITE(1, SO); __syncthreads();
#pragma nounroll
  for (int j = 1; j + 1 < NT; j += 2) {
    SBAR(); qkt(pB0, pB1, (bf16*)((char*)K_lds + SHM_K), qr, r32, hi);
    finishSM(pA0, pA1, alA, l_reg, pa0, pa1, pa2, pa3); SBAR();
    SLOAD(SO, (j + 2) * KVBLK); SBAR();
    pv_d0(o, vb0, pa0, pa1, pa2, pa3); partialSM(pB0, pB1, m_reg, mnB, alB);
    __syncthreads(); SWAIT(); SWRITE(0, SE);
    RESC(alB); __syncthreads();
    SBAR(); qkt(pA0, pA1, K_lds, qr, r32, hi);
    finishSM(pB0, pB1, alB, l_reg, pa0, pa1, pa2, pa3); SBAR();
    if (j + 3 < NT) SLOAD(SE, (j + 3) * KVBLK); SBAR();
    pv_d0(o, vb0 + (int)SHM_V, pa0, pa1, pa2, pa3); partialSM(pA0, pA1, m_reg, mnA, alA);
    __syncthreads(); SWAIT(); SWRITE(1, SO);
    RESC(alA); __syncthreads();
  }
  SBAR(); qkt(pB0, pB1, (bf16*)((char*)K_lds + SHM_K), qr, r32, hi);
  finishSM(pA0, pA1, alA, l_reg, pa0, pa1, pa2, pa3); SBAR();
  pv_d0(o, vb0, pa0, pa1, pa2, pa3); partialSM(pB0, pB1, m_reg, mnB, alB);
  __syncthreads(); RESC(alB);
  finishSM(pB0, pB1, alB, l_reg, pa0, pa1, pa2, pa3); SBAR();
  pv_d0(o, vb0 + (int)SHM_V, pa0, pa1, pa2, pa3);
  if (hi == 0) li_l[r32] = l_reg; asm volatile("s_waitcnt lgkmcnt(0)" ::: "memory");
  float rli[16];
#pragma unroll
  for (int r = 0; r < 16; ++r) rli[r] = __builtin_amdgcn_rcpf(li_l[crow(r, hi)]);
  __syncthreads();
  { int lane_e = lane, wid_e = wid; asm volatile("" : "+v"(lane_e), "+v"(wid_e)); wid_e = __builtin_amdgcn_readfirstlane(wid_e);
    bf16_t* stg = (bf16_t*)lds + wid_e * 4096;
#pragma unroll
    for (int r = 0; r < 16; ++r) { const int orow = crow(r, hi);
#pragma unroll
      for (int d0 = 0; d0 < 4; ++d0) stg[orow * 128 + d0 * 32 + r32] = (bf16_t)f2bf(o[d0][r] * rli[r]); }
    asm volatile("s_waitcnt lgkmcnt(0)" ::: "memory");
    bf16_t* Ow = Ob + (long)(wid_e * QBLK) * LDO; const bf16_t* Gw = Gb + (long)(wid_e * QBLK) * LDO;
    u32x4 gq[8];
#pragma unroll
    for (int i = 0; i < 8; ++i) { const int row = i * 4 + (lane_e >> 4), ch = lane_e & 15; gq[i] = *(const u32x4*)(Gw + (long)row * LDO + ch * 8); }
#pragma unroll
    for (int i = 0; i < 8; ++i) { const int row = i * 4 + (lane_e >> 4), ch = lane_e & 15;
      float ov[8], gv[8]; unpack8(*(const u32x4*)(stg + row * 128 + ch * 8), ov); unpack8(gq[i], gv);
#pragma unroll
      for (int j = 0; j < 8; ++j) ov[j] *= gv[j];
      *(u32x4*)(Ow + (long)row * LDO + ch * 8) = pack8(ov); } }
  __syncthreads();
#undef SLOAD
#undef SWRITE
#undef SWAIT
#undef RESC
}

__device__ __forceinline__ void attn_pp_body(const bf16* Qb, const bf16* __restrict__ Kh, const bf16* __restrict__ Vh,
                                             bf16_t* Ob, const bf16_t* Gb, int seq, char* lds, const int tid) {
  const int wid = __builtin_amdgcn_readfirstlane(tid >> 6), lane = tid & 63, r32 = lane & 31, hi = lane >> 5;
  const int g = wid >> 2;
  constexpr int NB = 3;
  char* V_lds = lds; char* K_lds = lds + NB * SHM_V;
  float* ws = (float*)(lds + NB * (SHM_V + SHM_K)) + wid * 64; float* li_l = ws; float* al_l = ws + 32;
  float m_reg = -1e30f, l_reg = 0; f32x16 o[4] = {}; bf16x8 qr[8];
  const bf16* Qw = Qb + (long)(wid * QBLK + r32) * LDQ + hi * 8;
#pragma unroll
  for (int d0 = 0; d0 < 8; ++d0) qr[d0] = *reinterpret_cast<const bf16x8*>(Qw + d0 * 16);
  const int sr = tid >> 4, sc = (tid & 15) * 8, vst0 = v_st(sr, sc), vst1 = v_st(32 + sr, sc);
  const int ksw0 = KSWZ(sr, sc * 2), ksw1 = KSWZ(32 + sr, sc * 2);
  const int vbase = (int)(uintptr_t)V_lds + v_rd_base(lane);
  struct Stg { bf16x8 vs0, vs1, ks0, ks1; } st0, st1;
#define SLOAD(S, t) do { const long k0_ = (long)(t) * KVBLK; S.vs0 = *reinterpret_cast<const bf16x8*>(&Vh[(k0_ + sr) * LDK + sc]); S.vs1 = *reinterpret_cast<const bf16x8*>(&Vh[(k0_ + 32 + sr) * LDK + sc]); \
    S.ks0 = *reinterpret_cast<const bf16x8*>(&Kh[(k0_ + sr) * LDK + sc]); S.ks1 = *reinterpret_cast<const bf16x8*>(&Kh[(k0_ + 32 + sr) * LDK + sc]); } while (0)
#define SWRITE(S, b) do { *(bf16x8*)(V_lds + (b) * SHM_V + vst0) = S.vs0; *(bf16x8*)(V_lds + (b) * SHM_V + vst1) = S.vs1; \
    *(bf16x8*)(K_lds + (b) * SHM_K + ksw0) = S.ks0; *(bf16x8*)(K_lds + (b) * SHM_K + ksw1) = S.ks1; } while (0)
#define RESC(a) do { if (__any((a) < 1.f)) { if (hi == 0) al_l[r32] = (a); asm volatile("s_waitcnt lgkmcnt(0)" ::: "memory"); \
    for (int d = 0; d < 4; ++d) for (int r = 0; r < 16; ++r) o[d][r] *= al_l[crow(r, hi)]; } } while (0)
  const int NT = seq / KVBLK;
  f32x16 p0, p1; bf16x8 pa0, pa1, pa2, pa3;
#define SMX() do { float mn_, al_; partialSM(p0, p1, m_reg, mn_, al_); RESC(al_); finishSM(p0, p1, al_, l_reg, pa0, pa1, pa2, pa3); } while (0)
  SLOAD(st0, 0); if (g) SLOAD(st1, 1);
  SWRITE(st0, 0); if (g) SWRITE(st1, 1);
  SLOAD(st0, 1 + g); SLOAD(st1, 2 + g);
  __syncthreads();
  if (g) __syncthreads();
  SBAR(); qkt(p0, p1, (const bf16*)K_lds, qr, r32, hi); SBAR();
  __syncthreads();
  SWRITE(st0, 1 + g); if (3 + g < NT) SLOAD(st0, 3 + g);
  SMX();
  __syncthreads();
  int c = 0;
#define STEP(i, ST) do { const int cK_ = (c == 2) ? 0 : c + 1; \
    SBAR(); __builtin_amdgcn_s_setprio(1); \
    qkt(p0, p1, (const bf16*)(K_lds + cK_ * SHM_K), qr, r32, hi); \
    pv_d0(o, vbase + c * (int)SHM_V, pa0, pa1, pa2, pa3); \
    __builtin_amdgcn_s_setprio(0); SBAR(); \
    __syncthreads(); \
    { const int t_ = (i) + 2 + g; if (t_ < NT) { const int cb_ = (cK_ == 2) ? 0 : cK_ + 1; const int cw_ = g ? ((cb_ == 2) ? 0 : cb_ + 1) : cb_; \
        SWRITE(ST, cw_); if (t_ + 2 < NT) SLOAD(ST, t_ + 2); } } \
    SMX(); \
    __syncthreads(); \
    c = cK_; } while (0)
  int i = 0;
#pragma nounroll
  for (; i + 1 < NT - 1; i += 2) { STEP(i, st1); STEP(i + 1, st0); }
  if (i < NT - 1) { STEP(i, st1); }
  SBAR(); pv_d0(o, vbase + c * (int)SHM_V, pa0, pa1, pa2, pa3); SBAR();
  __syncthreads();
  if (!g) __syncthreads();
  if (hi == 0) li_l[r32] = l_reg; asm volatile("s_waitcnt lgkmcnt(0)" ::: "memory");
  float rli[16];
#pragma unroll
  for (int r = 0; r < 16; ++r) rli[r] = __builtin_amdgcn_rcpf(li_l[crow(r, hi)]);
  { int lane_e = lane, wid_e = wid; asm volatile("" : "+v"(lane_e), "+v"(wid_e)); wid_e = __builtin_amdgcn_readfirstlane(wid_e);
    bf16_t* stg = (bf16_t*)lds + wid_e * 4096;
#pragma unroll
    for (int r = 0; r < 16; ++r) { const int orow = crow(r, hi);
#pragma unroll
      for (int d0 = 0; d0 < 4; ++d0) stg[orow * 128 + d0 * 32 + r32] = (bf16_t)f2bf(o[d0][r] * rli[r]); }
    asm volatile("s_waitcnt lgkmcnt(0)" ::: "memory");
    bf16_t* Ow = Ob + (long)(wid_e * QBLK) * LDO; const bf16_t* Gw = Gb + (long)(wid_e * QBLK) * LDO;
    u32x4 gq[8];
#pragma unroll
    for (int i2 = 0; i2 < 8; ++i2) { const int row = i2 * 4 + (lane_e >> 4), ch = lane_e & 15; gq[i2] = *(const u32x4*)(Gw + (long)row * LDO + ch * 8); }
#pragma unroll
    for (int i2 = 0; i2 < 8; ++i2) { const int row = i2 * 4 + (lane_e >> 4), ch = lane_e & 15;
      float ov[8], gv[8]; unpack8(*(const u32x4*)(stg + row * 128 + ch * 8), ov); unpack8(gq[i2], gv);
#pragma unroll
      for (int j = 0; j < 8; ++j) ov[j] *= gv[j];
      *(u32x4*)(Ow + (long)row * LDO + ch * 8) = pack8(ov); } }
  __syncthreads();
#undef SLOAD
#undef SWRITE
#undef RESC
#undef SMX
#undef STEP
}
#undef KSWZ
#undef SBAR
}


#define XB_TMO      128
#define XB_XCNT(j)  (256  + 64 * (j))
#define XB_XSUB(j)  (1280 + 64 * (j))
#define XB_XGEN(j)  (2304 + 64 * (j))
#define XB_TOP      3328
#define XB_TOPGEN   3392
#define XCD_BAR_WORDS 3456
#define XB_SPIN_CAP (1u << 22)
__device__ __forceinline__ unsigned xb_ld(unsigned* p)              { return __hip_atomic_load(p, __ATOMIC_RELAXED, __HIP_MEMORY_SCOPE_AGENT); }
__device__ __forceinline__ unsigned xb_add(unsigned* p, unsigned v) { return __hip_atomic_fetch_add(p, v, __ATOMIC_RELAXED, __HIP_MEMORY_SCOPE_AGENT); }
__device__ __forceinline__ unsigned xb_xcc_id() { return (unsigned)__builtin_amdgcn_s_getreg((3 << 11) | 20) & 0xFu; }
#define XB_SPIN(cond, bar) do { unsigned _sp = 0; while (cond) { __builtin_amdgcn_s_sleep(1); \
    if ((++_sp & 255u) == 0u) { if (xb_ld(&(bar)[XB_TMO])) break; if (_sp > XB_SPIN_CAP) { atomicAdd(&(bar)[XB_TMO], 1u); break; } } } } while (0)
struct XcdBarrier { unsigned* bar; unsigned x; volatile LAS unsigned* st; };
__device__ __forceinline__ XcdBarrier xcd_barrier_post(unsigned* bar, volatile LAS unsigned* st) {
    XcdBarrier b; b.bar = bar; b.x = xb_xcc_id(); b.st = st;
    if (threadIdx.x == 0) (void)xb_add(&bar[XB_XCNT(b.x)], 1u);
    return b;
}
__device__ __forceinline__ void xcd_barrier_complete(unsigned* bar, unsigned x, unsigned& nloc, unsigned& nx) {
    const unsigned G = gridDim.x * gridDim.y * gridDim.z;
    unsigned sum, cnt, mine, sp = 0u;
    for (;;) {
        sum = 0u; cnt = 0u; mine = 0u;
#pragma unroll
        for (unsigned j = 0; j < 16; ++j) { const unsigned c = xb_ld(&bar[XB_XCNT(j)]); sum += c; cnt += (c > 0u) ? 1u : 0u; mine = (j == x) ? c : mine; }
        if (sum == G) break;
        __builtin_amdgcn_s_sleep(1);
        if ((++sp & 255u) == 0u) { if (xb_ld(&bar[XB_TMO])) break; if (sp > XB_SPIN_CAP) { atomicAdd(&bar[XB_TMO], 1u); break; } }
    }
    nloc = mine > 0u ? mine : 1u; nx = cnt > 0u ? cnt : 1u;
}
__device__ __forceinline__ void xcd_barrier(const XcdBarrier& b, const int tid) {
    asm volatile("s_waitcnt vmcnt(0)" ::: "memory");
    __syncthreads();
    if (tid == 0) {
        unsigned* bar = b.bar;
        __builtin_amdgcn_s_waitcnt(0);
        unsigned nloc = b.st[0], nx = b.st[1];
        if (nloc == 0u) { xcd_barrier_complete(bar, b.x, nloc, nx); b.st[0] = nloc; b.st[1] = nx; }
        const unsigned old = xb_add(&bar[XB_XSUB(b.x)], 1u);
        const unsigned gen = old / nloc;
        if (old + 1u == (gen + 1u) * nloc) {
            __builtin_amdgcn_fence(__ATOMIC_RELEASE, "agent");
            asm volatile("s_waitcnt vmcnt(0)" ::: "memory");
            const unsigned og = xb_add(&bar[XB_TOP], 1u);
            const unsigned tg = og / nx;
            if (og + 1u == (tg + 1u) * nx) xb_add(&bar[XB_TOPGEN], 1u);
            else XB_SPIN(xb_ld(&bar[XB_TOPGEN]) == tg, bar);
            __builtin_amdgcn_fence(__ATOMIC_ACQUIRE, "agent");
            xb_add(&bar[XB_XGEN(b.x)], 1u);
            asm volatile("s_waitcnt vmcnt(0)" ::: "memory");
        } else {
            XB_SPIN(xb_ld(&bar[XB_XGEN(b.x)]) == gen, bar);
            __builtin_amdgcn_fence(__ATOMIC_ACQUIRE, "agent");
            asm volatile("s_waitcnt vmcnt(0)" ::: "memory");
        }
    }
    __syncthreads();
}

#ifndef PHM
#define PHM 1023
#endif
#ifndef PROBE_K
#define PROBE_K -1
#endif
struct Args { const float* in[18]; float* out; unsigned char* ws; int ph_lo, ph_hi; };
typedef const __attribute__((address_space(4))) Args* KArgs;
#define INP(a, i) ((const float*)(const GAS float*)((a)->in[i]))
#define OUTP(a) ((float*)(GAS float*)((a)->out))
enum { I_X = 0, I_C, I_WADA, I_BADA, I_NORMG, I_WIN, I_CAW, I_CAB, I_WRG, I_BRG, I_WIG, I_BIG, I_LAM, I_QG, I_KG, I_CCW, I_WBR, I_WOUT };

__device__ __forceinline__ void transpose_item(const float* W, int ldw, bf16_t* dst, int ldd, LAS float* scr, int lane) {
#pragma unroll 32
    for (int i = 0; i < 32; ++i) { const int kk = 2 * i + (lane >> 5); scr[kk * 33 + (lane & 31)] = W[(size_t)kk * ldw + (lane & 31)]; }
    LDS_WAIT();
    const int c = lane & 7;
#pragma unroll
    for (int j = 0; j < 4; ++j) { const int n = (lane >> 3) + 8 * j; const LAS float* s = scr + (8 * c) * 33 + n;
        u32x4 o; o.x = cvt_pk_bf16(s[0 * 33], s[1 * 33]); o.y = cvt_pk_bf16(s[2 * 33], s[3 * 33]); o.z = cvt_pk_bf16(s[4 * 33], s[5 * 33]); o.w = cvt_pk_bf16(s[6 * 33], s[7 * 33]);
        *(u32x4*)(dst + (size_t)n * ldd + 8 * c) = o; }
    LDS_WAIT();
}

__device__ __forceinline__ void phase_prologue(KArgs a, unsigned char* wsb, LAS unsigned char* lds, int tid, int lane, int wave, int bid, int G) {
    unsigned char* ws = wsb;
    {
        LAS float* red = (LAS float*)lds;
        for (int it = bid; it < 96; it += G) {
            const int l = it / 48, jb = it % 48, j = jb * 64 + lane;
            const float* wa = INP(a, I_WADA) + (size_t)l * 1024 * 3072 + j; const float* c0 = INP(a, I_C); const float* c1 = c0 + 1024;
            float a0 = 0.f, a1 = 0.f; const int kb = wave * 128;
#pragma unroll 16
            for (int k = 0; k < 128; ++k) { const float w = wa[(size_t)(kb + k) * 3072]; a0 += c0[kb + k] * w; a1 += c1[kb + k] * w; }
            red[(wave * 2 + 0) * 64 + lane] = a0; red[(wave * 2 + 1) * 64 + lane] = a1;
            __syncthreads();
            if (tid < 128) { const int bb = tid >> 6; float s = 0.f;
#pragma unroll
                for (int w = 0; w < 8; ++w) s += red[(w * 2 + bb) * 64 + lane];
                ((float*)(ws + WS_MOD))[(l * 2 + bb) * 3072 + j] = s + INP(a, I_BADA)[l * 3072 + j]; }
            __syncthreads();
        }
    }
    {
        float* rc = (float*)(ws + WS_ROPE); float* rs = rc + 320 * 32;
        for (int e = bid * 512 + tid; e < 320 * 32; e += G * 512) {
            const int pos = e >> 5, i = e & 31; const int p = pos < 256 ? pos : pos - 256;
            const float inv = __builtin_amdgcn_exp2f(-((float)(2 * i)) * (13.287712379549449f / 64.0f));
            const float ang = (float)p * inv;
            rc[e] = __cosf(ang); rs[e] = __sinf(ang);
        }
    }
    {
        LAS float* scr = (LAS float*)(lds + 8192 + wave * 12288);
        const int gw = bid * 8 + wave, NGW = G * 8;
        constexpr int I_IN = 2 * 16 * 368, I_G = 1024, I_BR = 3072, I_OUT = 1024, NITEMS = I_IN + I_G + I_BR + I_OUT;
        for (int it = gw; it < NITEMS; it += NGW) {
            int r = it;
            if (r < I_IN) { const int l = r / 5888, q = r % 5888, kb = q / 368, nb = q % 368;
                const int n0 = 32 * nb; int drow = n0;
                if (n0 >= 4608 && n0 < 8704) { const int sec = (n0 - 4608) >> 10, ch = (n0 - 4608) & 1023, blk = ch >> 7;
                    drow = ((sec & 1) ? 26 + blk : 18 + blk) * 256 + ((sec >> 1) ? 128 : 0) + (ch & 127); }
                transpose_item(INP(a, I_WIN) + (size_t)l * 1024 * NIN + (size_t)(64 * kb) * NIN + n0, NIN,
                               (bf16_t*)(ws + WS_WIN) + (size_t)l * NIN * 1024 + (size_t)drow * 1024 + 64 * kb, 1024, scr, lane); continue; }
            r -= I_IN;
            if (r < I_G) { const int mi = r >> 5, sub = r & 31, kb = sub >> 3, nblk = sub & 7;
                const int nb = mi & 3, gate = (mi >> 2) & 1, dir = (mi >> 3) & 1, l = mi >> 4;
                const float* src = (gate ? INP(a, I_WIG) : INP(a, I_WRG)) + (size_t)((l * 2 + dir) * 4 + nb) * 65536 + (size_t)(64 * kb) * 256 + 32 * nblk;
                const int n0 = 32 * nblk, hh = n0 >> 7, pn = (dir * 4 + nb) * 2 + hh, row = pn * 256 + gate * 128 + (n0 & 127);
                transpose_item(src, 256, (bf16_t*)(ws + WS_WG) + (size_t)l * 4096 * 256 + (size_t)row * 256 + 64 * kb, 256, scr, lane); continue; }
            r -= I_G;
            if (r < I_BR) { const int mi = r >> 9, sub = r & 511, kb = sub >> 5, nblk = sub & 31;
                transpose_item(INP(a, I_WBR) + (size_t)mi * 1048576 + (size_t)(64 * kb) * 1024 + 32 * nblk, 1024,
                               (bf16_t*)(ws + WS_WBR) + (size_t)mi * 1048576 + (size_t)(32 * nblk) * 1024 + 64 * kb, 1024, scr, lane); continue; }
            r -= I_BR;
            { const int mi = r >> 9, sub = r & 511, kb = sub >> 5, nblk = sub & 31;
                transpose_item(INP(a, I_WOUT) + (size_t)mi * 1048576 + (size_t)(64 * kb) * 1024 + 32 * nblk, 1024,
                               (bf16_t*)(ws + WS_WOUT) + (size_t)mi * 1048576 + (size_t)(32 * nblk) * 1024 + 64 * kb, 1024, scr, lane); }
        }
    }
}

__device__ __forceinline__ void phase_h(KArgs a, unsigned char* wsb, int l, int b, int lane, int wave, int bid, int G) {
    const float* xin = (l == 0 ? INP(a, I_X) : OUTP(a)) + (size_t)b * SEQ * DM;
    const float* mod = (const float*)(wsb + WS_MOD) + (l * 2 + b) * 3072;
    bf16_t* H = (bf16_t*)(wsb + WS_H);
    f32x4 gs[4], sh[4];
#pragma unroll
    for (int j = 0; j < 4; ++j) { const int col = 4 * lane + 256 * j;
        const f32x4 g = *(const f32x4*)(INP(a, I_NORMG) + l * 1024 + col), sc = *(const f32x4*)(mod + 1024 + col);
        gs[j] = g * (sc + 1.0f); sh[j] = *(const f32x4*)(mod + col); }
    const int gw = bid * 8 + wave, NGW = G * 8;
    for (int m = gw; m < SEQ; m += 2 * NGW) {
        const int m2 = (m + NGW < SEQ) ? m + NGW : m;
        const f32x4* xr = (const f32x4*)(xin + (size_t)m * DM) + lane; const f32x4* xr2 = (const f32x4*)(xin + (size_t)m2 * DM) + lane;
        f32x4 v[4], w[4]; float s = 0.f, s2 = 0.f;
#pragma unroll
        for (int j = 0; j < 4; ++j) { v[j] = xr[64 * j]; w[j] = xr2[64 * j]; }
#pragma unroll
        for (int j = 0; j < 4; ++j) { s += (v[j].x * v[j].x + v[j].y * v[j].y) + (v[j].z * v[j].z + v[j].w * v[j].w); s2 += (w[j].x * w[j].x + w[j].y * w[j].y) + (w[j].z * w[j].z + w[j].w * w[j].w); }
        const float rstd = __builtin_amdgcn_rsqf(wave_sum(s) * (1.f / DM) + EPS), rstd2 = __builtin_amdgcn_rsqf(wave_sum(s2) * (1.f / DM) + EPS);
        u32x2* o8 = (u32x2*)(H + (size_t)m * DM) + lane; u32x2* o82 = (u32x2*)(H + (size_t)m2 * DM) + lane;
#pragma unroll
        for (int j = 0; j < 4; ++j) { const f32x4 o = v[j] * rstd * gs[j] + sh[j]; u32x2 q; q.x = cvt_pk_bf16(o.x, o.y); q.y = cvt_pk_bf16(o.z, o.w); o8[64 * j] = q;
            const f32x4 o2 = w[j] * rstd2 * gs[j] + sh[j]; u32x2 q2; q2.x = cvt_pk_bf16(o2.x, o2.y); q2.y = cvt_pk_bf16(o2.z, o2.w); o82[64 * j] = q2; }
    }
}

__device__ __forceinline__ void ldrow8(const bf16_t* __restrict__ base, int t, int ch, float (&v)[8]) {
    if (t < 0 || t >= SEQ) {
#pragma unroll
        for (int j = 0; j < 8; ++j) v[j] = 0.f;
    } else unpack8(*(const u32x4*)(base + (size_t)t * 1024 + ch), v);
}
__device__ __forceinline__ void ld8f32(const float* p, float (&v)[8]) {
    const f32x4 a = *(const f32x4*)p, b = *(const f32x4*)(p + 4);
    v[0] = a.x; v[1] = a.y; v[2] = a.z; v[3] = a.w; v[4] = b.x; v[5] = b.y; v[6] = b.z; v[7] = b.w;
}

__device__ __forceinline__ void phase_elem(KArgs a, unsigned char* wsb, int l, int lane, int wave, int bid, int G) {
    unsigned char* ws = wsb;
    const int gw = bid * 8 + wave, NGW = G * 8;
    for (int it = gw; it < 2048; it += NGW) {
        const int run = it >> 1, hf = it & 1, ch = hf * 512 + lane * 8, t0 = run * 16;
        {
            const bf16_t* __restrict__ XA = (const bf16_t*)(ws + WS_XA); bf16_t* __restrict__ UA = (bf16_t*)(ws + WS_H);
            float w0[8], w1[8], w2[8], w3[8], bb[8];
            const float* cw = INP(a, I_CAW) + (size_t)l * 4 * 1024 + ch;
            ld8f32(cw, w0); ld8f32(cw + 1024, w1); ld8f32(cw + 2048, w2); ld8f32(cw + 3072, w3); ld8f32(INP(a, I_CAB) + l * 1024 + ch, bb);
            float xm2[8], xm1[8], x0[8], xp1[8];
            ldrow8(XA, t0 - 2, ch, xm2); ldrow8(XA, t0 - 1, ch, xm1); ldrow8(XA, t0, ch, x0);
#pragma unroll
            for (int s = 0; s < 16; ++s) { const int t = t0 + s;
                ldrow8(XA, t + 1, ch, xp1);
                float o[8];
#pragma unroll
                for (int j = 0; j < 8; ++j) o[j] = w0[j] * xm2[j] + w1[j] * xm1[j] + w2[j] * x0[j] + w3[j] * xp1[j] + bb[j];
                *(u32x4*)(UA + (size_t)t * 1024 + ch) = pack8(o);
#pragma unroll
                for (int j = 0; j < 8; ++j) { xm2[j] = xm1[j]; xm1[j] = x0[j]; x0[j] = xp1[j]; } }
        }
        {
            const bf16_t* __restrict__ PP = (const bf16_t*)(ws + WS_XC); const bf16_t* __restrict__ BG = (const bf16_t*)(ws + WS_BC); bf16_t* __restrict__ YC = (bf16_t*)(ws + WS_YC);
            float w0[8], w1[8], w2[8];
            const float* cw = INP(a, I_CCW) + (size_t)l * 3 * 1024 + ch;
            ld8f32(cw, w0); ld8f32(cw + 1024, w1); ld8f32(cw + 2048, w2);
            float pm1[8], p0[8], pp1[8], t1[8];
            ldrow8(PP, t0 - 1, ch, pm1); ldrow8(PP, t0, ch, p0);
#pragma unroll
            for (int s = 0; s < 16; ++s) { const int t = t0 + s;
                ldrow8(PP, t + 1, ch, pp1); ldrow8(BG, t, ch, t1);
                float o[8];
#pragma unroll
                for (int j = 0; j < 8; ++j) o[j] = t1[j] * (w0[j] * pm1[j] + w1[j] * p0[j] + w2[j] * pp1[j]);
                *(u32x4*)(YC + (size_t)t * 1024 + ch) = pack8(o);
#pragma unroll
                for (int j = 0; j < 8; ++j) { pm1[j] = p0[j]; p0[j] = pp1[j]; } }
        }
        {
            bf16_t* Q = (bf16_t*)(ws + WS_Q); bf16_t* Kb = (bf16_t*)(ws + WS_K);
            const float* rc = (const float*)(ws + WS_ROPE); const float* rs = rc + 320 * 32;
            const int d0 = (lane & 15) * 8, i0 = (lane & 3) * 8;
            float qg[8], kg[8];
            ld8f32(INP(a, I_QG) + l * 128 + d0, qg); ld8f32(INP(a, I_KG) + l * 128 + d0, kg);
            const bool second = (lane & 4) != 0;
            const int tokb = run * 16 + hf * 8;
            const int tsel = (d0 < 64) ? 0 : 1;
            u32x4 cur[3]; float cs[8], sn[8];
#define LD_TOK(tok, dst, dcs, dsn) do { const int tp_ = tsel ? 256 + ((tok) & 63) : ((tok) >> 6); ld8f32(rc + tp_ * 32 + i0, dcs); ld8f32(rs + tp_ * 32 + i0, dsn); \
                dst[0] = *(const u32x4*)(Q + (size_t)(tok) * 1024 + lane * 8); dst[1] = *(const u32x4*)(Q + (size_t)(tok) * 1024 + 512 + lane * 8); dst[2] = *(const u32x4*)(Kb + (size_t)(tok) * 256 + (lane & 31) * 8); } while (0)
            LD_TOK(tokb, cur, cs, sn);
#pragma unroll
            for (int i = 0; i < 8; ++i) {
                const int tok = tokb + i;
                u32x4 nx[3]; float ncs[8], nsn[8];
                if (i < 7) LD_TOK(tok + 1, nx, ncs, nsn);
#pragma unroll
                for (int part = 0; part < 3; ++part) {
                    bf16_t* p = (part < 2) ? (Q + (size_t)tok * 1024 + part * 512 + lane * 8) : (Kb + (size_t)tok * 256 + (lane & 31) * 8);
                    float v[8]; unpack8(cur[part], v);
                    float ss = 0.f;
#pragma unroll
                    for (int j = 0; j < 8; ++j) ss += v[j] * v[j];
                    ss += __shfl_xor(ss, 1); ss += __shfl_xor(ss, 2); ss += __shfl_xor(ss, 4); ss += __shfl_xor(ss, 8);
                    const float rstd = __builtin_amdgcn_rsqf(ss * (1.f / 128.f) + EPS);
                    float o[8];
#pragma unroll
                    for (int j = 0; j < 8; ++j) { const float y = v[j] * rstd * (part < 2 ? qg[j] : kg[j]); const float pr = __shfl_xor(y, 4);
                        o[j] = y * cs[j] + (second ? pr : -pr) * sn[j]; }
                    if (part < 2 || lane < 32) *(u32x4*)p = pack8(o);
                }
                if (i < 7) {
#pragma unroll
                    for (int part = 0; part < 3; ++part) cur[part] = nx[part];
#pragma unroll
                    for (int j = 0; j < 8; ++j) { cs[j] = ncs[j]; sn[j] = nsn[j]; } }
            }
#undef LD_TOK
        }
    }
}

__device__ __forceinline__ void phase_scan_a(KArgs a, unsigned char* wsb, int lane, int wave, int bid, int G) {
    unsigned char* ws = wsb;
    const int gw = bid * 8 + wave, NGW = G * 8;
    for (int it = gw; it < 2048; it += NGW) {
        const int c = it >> 4, dir = (it >> 3) & 1, ch = (it & 7) * 128 + lane * 2;
        const bf16_t* LA = (const bf16_t*)(ws + WS_LA + (size_t)dir * 64 * MiB) + ch;
        const bf16_t* UU = (const bf16_t*)(ws + WS_U + (size_t)dir * 64 * MiB) + ch;
        float s0 = 0.f, s1 = 0.f, h0 = 0.f, h1 = 0.f;
#pragma unroll 16
        for (int st = 0; st < 128; ++st) { const int t = dir == 0 ? c * 128 + st : c * 128 + 127 - st;
            const unsigned wl = *(const unsigned*)(LA + (size_t)t * 1024), wu = *(const unsigned*)(UU + (size_t)t * 1024);
            const float l0 = __uint_as_float(wl << 16), l1 = __uint_as_float(wl & 0xffff0000u);
            const float u0 = __uint_as_float(wu << 16), u1 = __uint_as_float(wu & 0xffff0000u);
            h0 = __builtin_amdgcn_exp2f(l0) * h0 + u0; h1 = __builtin_amdgcn_exp2f(l1) * h1 + u1; s0 += l0; s1 += l1; }
        *(f32x2*)((float*)(ws + WS_SA) + (c * 2 + dir) * 1024 + ch) = (f32x2){s0, s1};
        *(f32x2*)((float*)(ws + WS_SH) + (c * 2 + dir) * 1024 + ch) = (f32x2){h0, h1};
    }
}
__device__ __forceinline__ void phase_scan_c(unsigned char* wsb, LAS unsigned char* lds, int lane, int wave, int bid, int G) {
    unsigned char* ws = wsb;
    const int gw = bid * 8 + wave, NGW = G * 8;
    const float* __restrict__ SA = (const float*)(ws + WS_SA); const float* __restrict__ SH = (const float*)(ws + WS_SH);
    for (int it = gw; it < 2048; it += NGW) {
        const int c = it >> 4, ch = (it & 15) * 64 + lane;
        float cf = 0.f, cb = 0.f;
#pragma unroll 8
        for (int sidx = 0; sidx < c; ++sidx) { const int idx = (sidx * 2) * 1024 + ch; cf = __builtin_amdgcn_exp2f(SA[idx]) * cf + SH[idx]; }
#pragma unroll 8
        for (int sidx = 127; sidx > c; --sidx) { const int idx = (sidx * 2 + 1) * 1024 + ch; cb = __builtin_amdgcn_exp2f(SA[idx]) * cb + SH[idx]; }
        const bf16_t* __restrict__ LAf = (const bf16_t*)(ws + WS_LA) + ch; const bf16_t* __restrict__ UUf = (const bf16_t*)(ws + WS_U) + ch;
        const bf16_t* __restrict__ LAb = (const bf16_t*)(ws + WS_LA + 64 * MiB) + ch; const bf16_t* __restrict__ UUb = (const bf16_t*)(ws + WS_U + 64 * MiB) + ch;
        const bf16_t* __restrict__ SGA = (const bf16_t*)(ws + WS_SGA) + ch; bf16_t* __restrict__ YA = (bf16_t*)(ws + WS_XA) + ch;
        LAS bf16_t* hfs = (LAS bf16_t*)(lds + wave * 16384) + lane;
        float h = cf;
        { const bf16_t* pl = LAf + (size_t)c * 128 * 1024; const bf16_t* pu = UUf + (size_t)c * 128 * 1024;
#pragma unroll 1
            for (int blk = 0; blk < 8; ++blk) {
                float l[16], u[16];
#pragma unroll
                for (int i = 0; i < 16; ++i) { l[i] = bf2f(pl[i * 1024]); u[i] = bf2f(pu[i * 1024]); }
#pragma unroll
                for (int i = 0; i < 16; ++i) { h = __builtin_amdgcn_exp2f(l[i]) * h + u[i]; hfs[(blk * 16 + i) * 64] = (bf16_t)f2bf(h); }
                pl += 16 * 1024; pu += 16 * 1024; } }
        h = cb;
        { const size_t e0 = (size_t)(c * 128 + 112) * 1024;
            const bf16_t* pl = LAb + e0; const bf16_t* pu = UUb + e0; const bf16_t* pg = SGA + e0; bf16_t* py = YA + e0;
#pragma unroll 1
            for (int blk = 7; blk >= 0; --blk) {
                float l[16], u[16], g[16];
#pragma unroll
                for (int i = 0; i < 16; ++i) { l[i] = bf2f(pl[i * 1024]); u[i] = bf2f(pu[i * 1024]); g[i] = bf2f(pg[i * 1024]); }
#pragma unroll
                for (int i = 15; i >= 0; --i) { h = __builtin_amdgcn_exp2f(l[i]) * h + u[i];
                    py[i * 1024] = (bf16_t)f2bf((bf2f(hfs[(blk * 16 + i) * 64]) + h) * g[i]); }
                pl -= 16 * 1024; pu -= 16 * 1024; pg -= 16 * 1024; py -= 16 * 1024; } }
    }
}

__global__ void __launch_bounds__(512, 2) mk_fwd(Args args) {
    extern __shared__ __attribute__((aligned(16))) unsigned char lds[];
    cg::grid_group grid = cg::this_grid();
    LAS unsigned char* L = (LAS unsigned char*)lds;
    if (threadIdx.x < 2) ((LAS unsigned*)(L + 131072))[threadIdx.x] = 0u;
    __syncthreads();
    (void)xcd_barrier_post((unsigned*)(args.ws + WS_BAR), (volatile LAS unsigned*)(L + 131072));
    const int wave_u = __builtin_amdgcn_readfirstlane(threadIdx.x >> 6);
    for (int ph = args.ph_lo; ph < args.ph_hi; ++ph) {
        int tid; { int ln_; asm volatile("v_mbcnt_lo_u32_b32 %0, -1, 0\n\tv_mbcnt_hi_u32_b32 %0, -1, %0" : "=v"(ln_)); tid = wave_u * 64 + ln_; }
        int G = gridDim.x, bid = blockIdx.x; asm volatile("" : "+s"(G), "+s"(bid));
        KArgs ap = (KArgs)__builtin_amdgcn_kernarg_segment_ptr(); asm volatile("" : "+s"(ap));
        GAS unsigned char* wsg = (GAS unsigned char*)ap->ws; asm volatile("" : "+s"(wsg));
        unsigned char* ws = (unsigned char*)wsg;
        const int lane = tid & 63, wave = __builtin_amdgcn_readfirstlane(tid >> 6);
        unsigned long long pt0 = 0; int pcls = -1; if (PROBE_K >= 0) pt0 = __builtin_amdgcn_s_memrealtime();
        if (ph == 0) { pcls = 8; if (PHM & 512) phase_prologue(ap, ws, L, tid, lane, wave, bid, G); }
        else {
            const int q = ph - 1, lb = q / NPH_PER, k = q - lb * NPH_PER, l = lb >> 1, b = lb & 1; pcls = k;
            if (k == 0) { if (PHM & 1) phase_h(ap, ws, l, b, lane, wave, bid, G); }
            else if (k == 1) { if (PHM & 2) {
                pg8::Gemm g{(const bf16_t*)(ws + WS_H), (const bf16_t*)(ws + WS_WIN) + (size_t)l * NIN * 1024, 1024, 1024, 1024, 0, 0};
                pg8::StaticOrder S; S.init(SEQ, NIN, G, bid);
                pg8::EpiInProj E{ws};
                pg8::gemm_phase<pg8::EpiInProj, pg8::StaticOrder, 0>(L, g, S, E, tid); }
            } else if (k == 2) { if (PHM & 4) phase_elem(ap, ws, l, lane, wave, bid, G); }
            else if (k == 3) {
                if (PHM & 8) {
                    pg8::Gemm g{(const bf16_t*)(ws + WS_H), (const bf16_t*)(ws + WS_WG) + (size_t)l * 4096 * 256, 1024, 256, 256, 0, 0};
                    pg8::StaticOrder S; S.init(SEQ, 4096, G, bid);
                    pg8::EpiGates E{ws, INP(ap, I_BRG) + l * 2048, INP(ap, I_BIG) + l * 2048, INP(ap, I_LAM) + l * 2048};
                    pg8::gemm_phase<pg8::EpiGates, pg8::StaticOrder, 1>(L, g, S, E, tid);
                }
                if (PROBE_K == 3) { const unsigned long long t1 = __builtin_amdgcn_s_memrealtime(), dt = t1 - pt0; while (__builtin_amdgcn_s_memrealtime() - t1 < dt) __builtin_amdgcn_s_sleep(8); }
                if (PROBE_K == 9) { pt0 = __builtin_amdgcn_s_memrealtime(); pcls = 9; }
                if (PHM & 256) {
                    const int v = (G % 8 == 0) ? (bid % 8) * (G / 8) + bid / 8 : bid;
                    const int per = (512 + G - 1) / G;
                    for (int i = 0; i < per; ++i) { const int idx = v * per + i; if (idx >= 512) break;
                        const int h = idx >> 6, qb = idx & 63, kvh = h >> 2;
                        const attn::bf16* Qb = (const attn::bf16*)(ws + WS_Q) + (size_t)qb * 256 * 1024 + h * 128;
                        const attn::bf16* Kh = (const attn::bf16*)(ws + WS_K) + kvh * 128;
                        const attn::bf16* Vh = (const attn::bf16*)(ws + WS_V) + kvh * 128;
                        bf16_t* Ob = (bf16_t*)(ws + WS_SGB) + (size_t)qb * 256 * 1024 + h * 128;
                        const bf16_t* Gb = (const bf16_t*)(ws + WS_SGB) + (size_t)qb * 256 * 1024 + h * 128;
                        attn::attn_pp_body(Qb, Kh, Vh, Ob, Gb, SEQ, (char*)lds, tid);
                    }
                }
            } else if (k == 4) { if (PHM & 16) phase_scan_a(ap, ws, lane, wave, bid, G); }
            else if (k == 5) { if (PHM & 32) phase_scan_c(ws, L, lane, wave, bid, G); }
            else if (k == 6) { if (PHM & 64) {
                pg8::Gemm g{(const bf16_t*)(ws + WS_XA), (const bf16_t*)(ws + WS_WBR) + (size_t)l * 3 * 1048576, 1024, 1024, 1024,
                            (long)WS_SGB - (long)WS_XA, (long)WS_YC - (long)WS_XA};
                pg8::BranchOrder S; S.so.init(SEQ, 1024, G, bid);
                pg8::EpiBranch E{ws};
                pg8::gemm_phase<pg8::EpiBranch, pg8::BranchOrder, 2>(L, g, S, E, tid); }
            } else if (PHM & 128) {
                pg8::Gemm g{(const bf16_t*)(ws + WS_SGA), (const bf16_t*)(ws + WS_WOUT) + (size_t)l * 1048576, 1024, 1024, 1024, 0, 0};
                pg8::StaticOrder S; S.init(SEQ, 1024, G, bid);
                const float* xi = (l == 0 ? INP(ap, I_X) : OUTP(ap)) + (size_t)b * SEQ * DM;
                pg8::EpiOut E{xi, OUTP(ap) + (size_t)b * SEQ * DM, (const float*)(ws + WS_MOD) + (l * 2 + b) * 3072 + 2048};
                pg8::gemm_phase<pg8::EpiOut, pg8::StaticOrder, 0>(L, g, S, E, tid);
            }
        }
        if (PROBE_K >= 0 && PROBE_K != 3 && ph + 1 == args.ph_hi && pcls == PROBE_K) { VM_WAIT(); __syncthreads(); const unsigned long long t1 = __builtin_amdgcn_s_memrealtime(), dt = t1 - pt0; while (__builtin_amdgcn_s_memrealtime() - t1 < dt) __builtin_amdgcn_s_sleep(8); }
        if (ph + 1 < args.ph_hi) { if (ph == args.ph_lo) grid.sync(); else { XcdBarrier xbar; xbar.bar = (unsigned*)(ws + WS_BAR); xbar.x = xb_xcc_id(); xbar.st = (volatile LAS unsigned*)(L + 131072); xcd_barrier(xbar, tid); }
            if (PROBE_K >= 0 && PROBE_K != 3 && pcls == PROBE_K) { const unsigned long long t1 = __builtin_amdgcn_s_memrealtime(), dt = t1 - pt0; while (__builtin_amdgcn_s_memrealtime() - t1 < dt) __builtin_amdgcn_s_sleep(8); } }
    }
}

extern "C" void kernel_launch(void* const* d_in, const int* in_sizes, int n_in, void* d_out, int out_size, void* d_ws, size_t ws_size, hipStream_t stream) {
    static int grid = 0;
    if (grid == 0) {
        if (n_in != 18 || ws_size < WS_END) { fprintf(stderr, "kernel_launch: need 18 inputs and >= %zu bytes of workspace (got %d, %zu)\n", (size_t)WS_END, n_in, ws_size); grid = -1; return; }
        int dev = 0, cus = 0, per_cu = 0;
        hipGetDevice(&dev);
        hipDeviceGetAttribute(&cus, hipDeviceAttributeMultiprocessorCount, dev);
        if (hipFuncSetAttribute((const void*)mk_fwd, hipFuncAttributeMaxDynamicSharedMemorySize, LDS_BYTES) != hipSuccess) { fprintf(stderr, "kernel_launch: hipFuncSetAttribute failed\n"); grid = -1; return; }
        if (hipOccupancyMaxActiveBlocksPerMultiprocessor(&per_cu, (const void*)mk_fwd, 512, LDS_BYTES) != hipSuccess || per_cu < 1) { fprintf(stderr, "kernel_launch: occupancy query gave %d\n", per_cu); per_cu = 1; }
        (void)hipGetLastError();
        grid = cus * 1;
    }
    if (grid < 0) return;
    if (hipMemsetAsync((char*)d_ws + WS_BAR, 0, 16384, stream) != hipSuccess) { fprintf(stderr, "kernel_launch: memset failed\n"); return; }
    Args a{};
    for (int i = 0; i < 18; ++i) a.in[i] = (const float*)d_in[i];
    a.out = (float*)d_out; a.ws = (unsigned char*)d_ws; a.ph_lo = 0; a.ph_hi = NPHASES;
    void* kargs[] = {&a};
    hipError_t e = hipLaunchCooperativeKernel((const void*)mk_fwd, dim3(grid), dim3(512), kargs, LDS_BYTES, stream);
    if (e != hipSuccess) fprintf(stderr, "kernel_launch: cooperative launch failed: %s (grid %d)\n", hipGetErrorString(e), grid);
}
```

```cpp
#include <hip/hip_runtime.h>
#include <hip/hip_cooperative_groups.h>
#include <hip/hip_bf16.h>
#include <cstdio>
#include <cstdint>
namespace cg = cooperative_groups;

#define LAS __attribute__((address_space(3)))
#define GAS __attribute__((address_space(1)))
typedef unsigned short bf16_t;
typedef short bf16x8 __attribute__((ext_vector_type(8)));
typedef float f32x4 __attribute__((ext_vector_type(4)));
typedef float f32x2 __attribute__((ext_vector_type(2)));
typedef unsigned u32x4 __attribute__((ext_vector_type(4)));
typedef unsigned u32x2 __attribute__((ext_vector_type(2)));

constexpr int DM = 1024, SEQ = 16384, NBATCH = 2, DEPTH = 2, NIN = 11776;
constexpr int NPH_PER = 8, NPHASES = 1 + DEPTH * NBATCH * NPH_PER;
constexpr float EPS = 1e-6f;
constexpr float LOG2E = 1.4426950408889634f;

constexpr size_t MiB = 1u << 20;
constexpr size_t WS_MOD = 0;
constexpr size_t WS_ROPE = 64 * 1024;
constexpr size_t WS_BAR = 256 * 1024;
constexpr size_t WS_SA = 1 * MiB, WS_SH = 2 * MiB;
constexpr size_t WS_WIN = 4 * MiB, WS_WG = 50 * MiB, WS_WBR = 54 * MiB, WS_WOUT = 66 * MiB;
constexpr size_t WS_H = 70 * MiB;
constexpr size_t WS_XA = 102 * MiB;
constexpr size_t WS_SGA = 134 * MiB;
constexpr size_t WS_Q = 166 * MiB;
constexpr size_t WS_K = 198 * MiB, WS_V = 206 * MiB;
constexpr size_t WS_SGB = 214 * MiB;
constexpr size_t WS_XC = 246 * MiB, WS_BC = 278 * MiB, WS_CC = 310 * MiB, WS_SGC = 342 * MiB;
constexpr size_t WS_LA = WS_XC, WS_U = WS_BC;
constexpr size_t WS_SMG = 374 * MiB;
constexpr size_t WS_YC = 470 * MiB;
constexpr size_t WS_END = 502 * MiB;
constexpr int LDS_BYTES = 131072 + 1024;

__device__ __forceinline__ float bf2f(bf16_t v) { return __uint_as_float((unsigned)v << 16); }
__device__ __forceinline__ unsigned f2bf(float f) { unsigned u = __float_as_uint(f); return (u + 0x7fffu + ((u >> 16) & 1u)) >> 16; }
__device__ __forceinline__ unsigned cvt_pk_bf16(float lo, float hi) { unsigned r; asm("v_cvt_pk_bf16_f32 %0, %1, %2" : "=v"(r) : "v"(lo), "v"(hi)); return r; }
__device__ __forceinline__ void unpack8(const u32x4 w, float (&f)[8]) {
#pragma unroll
    for (int i = 0; i < 4; ++i) { f[2 * i] = __uint_as_float(w[i] << 16); f[2 * i + 1] = __uint_as_float(w[i] & 0xffff0000u); }
}
__device__ __forceinline__ u32x4 pack8(const float (&f)[8]) {
    u32x4 w; w.x = cvt_pk_bf16(f[0], f[1]); w.y = cvt_pk_bf16(f[2], f[3]); w.z = cvt_pk_bf16(f[4], f[5]); w.w = cvt_pk_bf16(f[6], f[7]); return w;
}
__device__ __forceinline__ float sigmoidf_(float v) { return __builtin_amdgcn_rcpf(1.f + __expf(-v)); }
__device__ __forceinline__ float wave_sum(float v) {
#pragma unroll
    for (int o = 1; o < 64; o <<= 1) v += __shfl_xor(v, o);
    return v;
}
#define LDS_WAIT() asm volatile("s_waitcnt lgkmcnt(0)" ::: "memory")
#define VM_WAIT() asm volatile("s_waitcnt vmcnt(0)" ::: "memory")

namespace pg8 {
constexpr int BM = 256, BK = 64, HALF = 128, HTB = HALF * BK * 2, STAGE_BYTES = 8 * HTB, NXCD = 8, WGM = 8;
__device__ __forceinline__ int lds_byte(int r, int c) { const int st = (r >> 4) * 2 + (c >> 5), rr = r & 15, cc = c & 31, ob = rr * 64 + cc * 2; return st * 1024 + (ob ^ (((ob >> 9) & 1) << 5)); }
__device__ __forceinline__ void stage_rc(int b, int& R, int& C) { const int st = b / 1024, sb = b % 1024, swz = sb ^ (((sb >> 9) & 1) << 5); R = (st >> 1) * 16 + swz / 64; C = (st & 1) * 32 + (swz % 64) / 2; }
__device__ __forceinline__ int perm32(int rho) { const int n = rho >> 4, i = rho & 15; return 8 * (i >> 2) + 4 * n + (i & 3); }

struct Unit { int pm, pn, kk; };
struct Gemm { const bf16_t* A; const bf16_t* Bt; int lda, ldb, K; long a1, a2; };

struct StaticOrder {
    int nM, nN, nwg, G, c;
    __device__ void init(int M, int N, int G_, int c_) { nM = M / BM; nN = N / BM; nwg = nM * nN; G = G_; c = c_; }
    __device__ bool next(int i, Unit& u) const {
        const long L = (long)i * G + c; if (L >= nwg) return false;
        int wgid = (int)L; { const int q = nwg / NXCD, r = nwg % NXCD, xcd = wgid % NXCD, off = wgid / NXCD; wgid = (xcd < r ? xcd * (q + 1) : r * (q + 1) + (xcd - r) * q) + off; }
        const int nig = WGM * nN, gid = wgid / nig, fm = gid * WGM, gsz = (nM - fm) < WGM ? (nM - fm) : WGM;
        u.pm = fm + ((wgid % nig) % gsz); u.pn = (wgid % nig) / gsz; u.kk = 0; return true;
    }
};
struct BranchOrder {
    StaticOrder so;
    __device__ bool next(int i, Unit& u) const { const int ti = i / 3, kk = i - 3 * ti; if (!so.next(ti, u)) return false; u.kk = kk; return true; }
};

template <int MODE> __device__ __forceinline__ const char* unitA(const Gemm& g, const Unit& u) {
    const char* p = (const char*)g.A + (size_t)u.pm * BM * g.lda * 2;
    if (MODE == 1) p += (((u.pn >> 1) & 3) * 256) * 2;
    if (MODE == 2) p += (u.kk == 1 ? g.a1 : (u.kk == 2 ? g.a2 : 0l));
    return p;
}
template <int MODE> __device__ __forceinline__ const char* unitB(const Gemm& g, const Unit& u) {
    const char* p = (const char*)g.Bt + (size_t)u.pn * BM * g.ldb * 2;
    if (MODE == 2) p += (size_t)u.kk * 1024 * 1024 * 2;
    return p;
}

template <class Epi, class Sched, int MODE>
__device__ __forceinline__ void gemm_phase(LAS unsigned char* lds, const Gemm g, const Sched& S, const Epi& E, const int tid) {
    const int wid = __builtin_amdgcn_readfirstlane(tid >> 6), lane = tid & 63, wr = wid >> 2, wc = wid & 3, fr = lane & 15, fq = lane >> 4;
    const int K = g.K, nt = K / BK;
    unsigned voffA[2], voffB[2];
#pragma unroll
    for (int i = 0; i < 2; ++i) { int R, C; stage_rc(tid * 16 + i * 8192, R, C); const int Rb = (R & ~31) + perm32(R & 31);
        voffA[i] = (unsigned)(R * g.lda + C) * 2u; voffB[i] = (unsigned)(Rb * g.ldb + C) * 2u; }
    const size_t kstep = (size_t)(BK * 2);
    const size_t hstepA = (size_t)HALF * g.lda * 2, hstepB = (size_t)HALF * g.ldb * 2;
    const unsigned ldsw = (unsigned)wid * 1024u;
    const int aoff = lds_byte(wr * 64 + fr, fq * 8), boff = lds_byte(wc * 32 + fr, fq * 8);
#define PG8_SA(b, h) (((b) * 2 + (h)) * HTB)
#define PG8_SB(b, h) ((4 + (b) * 2 + (h)) * HTB)
#define PG8_STAGE(bufoff, gbase, voff) do { _Pragma("unroll") for (int _i = 0; _i < 2; ++_i) \
        __builtin_amdgcn_global_load_lds((const unsigned*)((const char*)(gbase) + (voff)[_i]), (LAS unsigned*)(lds + (bufoff) + ldsw + _i * 8192), 16, 0, 0); } while (0)
#define PG8_LDA(dst, b, h) do { _Pragma("unroll") for (int m = 0; m < 4; ++m) _Pragma("unroll") for (int k = 0; k < 2; ++k) dst[m][k] = *(const LAS bf16x8*)(lds + PG8_SA(b, h) + aoff + m * 2048 + k * 1024); } while (0)
#define PG8_LDB(dst, b, h) do { _Pragma("unroll") for (int n = 0; n < 2; ++n) _Pragma("unroll") for (int k = 0; k < 2; ++k) dst[n][k] = *(const LAS bf16x8*)(lds + PG8_SB(b, h) + boff + n * 2048 + k * 1024); } while (0)
#define PG8_MMA(ai, bj, At, Bt) do { __builtin_amdgcn_s_setprio(1); _Pragma("unroll") for (int m = 0; m < 4; ++m) _Pragma("unroll") for (int n = 0; n < 2; ++n) _Pragma("unroll") for (int k = 0; k < 2; ++k) \
        acc[ai][bj][m][n] = __builtin_amdgcn_mfma_f32_16x16x32_bf16(Bt[n][k], At[m][k], acc[ai][bj][m][n], 0, 0, 0); __builtin_amdgcn_s_setprio(0); } while (0)
#define PG8_WAIT_V(n) asm volatile("s_waitcnt vmcnt(" #n ")" ::: "memory")
#define PG8_WAIT_L(n) asm volatile("s_waitcnt lgkmcnt(" #n ")" ::: "memory")
#define PG8_BAR __builtin_amdgcn_s_barrier()
#define PG8_SCHED __builtin_amdgcn_sched_barrier(0)
    Unit cur, nxt; int ui = 0;
    if (!S.next(0, cur)) return;
    f32x4 acc[2][2][4][2];
#pragma unroll
    for (int a = 0; a < 2; ++a)
#pragma unroll
        for (int b = 0; b < 2; ++b)
#pragma unroll
            for (int m = 0; m < 4; ++m)
#pragma unroll
                for (int n = 0; n < 2; ++n) acc[a][b][m][n] = (f32x4){0.f, 0.f, 0.f, 0.f};
    bf16x8 At[4][2], B0[2][2], B1[2][2];
    const char* cA = unitA<MODE>(g, cur); const char* cB = unitB<MODE>(g, cur);
    PG8_STAGE(PG8_SB(0, 0), cB, voffB); PG8_STAGE(PG8_SB(0, 1), cB + hstepB, voffB); PG8_STAGE(PG8_SA(0, 0), cA, voffA); PG8_STAGE(PG8_SA(0, 1), cA + hstepA, voffA);
    if (wr == 1) PG8_BAR;
    PG8_WAIT_V(2); PG8_BAR;
    PG8_STAGE(PG8_SB(1, 0), cB + kstep, voffB); PG8_STAGE(PG8_SA(1, 0), cA + kstep, voffA); PG8_STAGE(PG8_SB(1, 1), cB + hstepB + kstep, voffB);
    PG8_WAIT_V(6); PG8_BAR;
    for (;;) {
        const bool has_next = S.next(ui + 1, nxt);
        const char* nA = has_next ? unitA<MODE>(g, nxt) : cA; const char* nB = has_next ? unitB<MODE>(g, nxt) : cB;
#pragma nounroll
        for (int t = 0; t < nt; t += 2) {
            const bool last = (t == nt - 2);
            const char* a1 = cA + (size_t)(t + 1) * kstep;
            const char* a2 = last ? nA : cA + (size_t)(t + 2) * kstep; const char* b2 = last ? nB : cB + (size_t)(t + 2) * kstep;
            const char* a3 = a2 + kstep; const char* b3 = b2 + kstep;
            PG8_LDB(B0, 0, 0); PG8_LDB(B1, 0, 1); PG8_SCHED; PG8_LDA(At, 0, 0); PG8_STAGE(PG8_SA(1, 1), a1 + hstepA, voffA);
            PG8_WAIT_V(8); PG8_WAIT_L(0); PG8_BAR; PG8_MMA(0, 0, At, B0); PG8_MMA(0, 1, At, B1); PG8_BAR; PG8_SCHED;
            PG8_LDA(At, 0, 1); PG8_STAGE(PG8_SB(0, 0), b2, voffB); PG8_STAGE(PG8_SB(0, 1), b2 + hstepB, voffB); PG8_STAGE(PG8_SA(0, 0), a2, voffA);
            PG8_WAIT_V(8); PG8_WAIT_L(0); PG8_BAR; PG8_MMA(1, 0, At, B0); PG8_MMA(1, 1, At, B1); PG8_BAR; PG8_SCHED;
            PG8_LDB(B0, 1, 0); PG8_LDB(B1, 1, 1); PG8_SCHED; PG8_LDA(At, 1, 0); PG8_STAGE(PG8_SA(0, 1), a2 + hstepA, voffA);
            PG8_WAIT_V(8); PG8_WAIT_L(0); PG8_BAR; PG8_MMA(0, 0, At, B0); PG8_MMA(0, 1, At, B1); PG8_BAR; PG8_SCHED;
            PG8_LDA(At, 1, 1); PG8_STAGE(PG8_SB(1, 0), b3, voffB); PG8_STAGE(PG8_SB(1, 1), b3 + hstepB, voffB); PG8_STAGE(PG8_SA(1, 0), a3, voffA);
            PG8_WAIT_V(8); PG8_WAIT_L(0); PG8_BAR; PG8_MMA(1, 0, At, B0); PG8_MMA(1, 1, At, B1); PG8_BAR; PG8_SCHED;
        }
        if (wr == 0) PG8_BAR;
        E(acc, cur, wr, wc, fr, fq);
        if (!has_next) break;
#pragma unroll
        for (int a = 0; a < 2; ++a)
#pragma unroll
            for (int b = 0; b < 2; ++b)
#pragma unroll
                for (int m = 0; m < 4; ++m)
#pragma unroll
                    for (int n = 0; n < 2; ++n) acc[a][b][m][n] = (f32x4){0.f, 0.f, 0.f, 0.f};
        cur = nxt; cA = nA; cB = nB; ++ui;
        if (wr == 1) PG8_BAR;
    }
    PG8_WAIT_V(0);
    PG8_BAR;
#undef PG8_SA
#undef PG8_SB
#undef PG8_STAGE
#undef PG8_LDA
#undef PG8_LDB
#undef PG8_MMA
#undef PG8_WAIT_V
#undef PG8_WAIT_L
#undef PG8_BAR
#undef PG8_SCHED
}

__device__ __forceinline__ void store_tile_bf16(const f32x4 (&acc)[2][2][4][2], bf16_t* base, int ldc, int row0, int col0, int act) {
#pragma unroll
    for (int ai = 0; ai < 2; ++ai)
#pragma unroll
        for (int m = 0; m < 4; ++m) { bf16_t* rowp = base + (size_t)(row0 + ai * HALF + m * 16) * ldc + col0;
#pragma unroll
            for (int bj = 0; bj < 2; ++bj) { float v[8];
#pragma unroll
                for (int j = 0; j < 4; ++j) { v[j] = acc[ai][bj][m][0][j]; v[4 + j] = acc[ai][bj][m][1][j]; }
                if (act != 0) {
                    float sg[8];
#pragma unroll
                    for (int j = 0; j < 8; ++j) sg[j] = sigmoidf_(v[j]);
                    if (act == 1) {
#pragma unroll
                        for (int j = 0; j < 8; ++j) v[j] *= sg[j];
                    } else {
#pragma unroll
                        for (int j = 0; j < 8; ++j) v[j] = sg[j];
                    }
                }
                *(u32x4*)(rowp + bj * HALF) = pack8(v); }
            asm volatile("" ::: "memory"); }
}
struct EpiInProj {
    unsigned char* ws;
    __device__ __forceinline__ void operator()(const f32x4 (&acc)[2][2][4][2], const Unit& u, int wr, int wc, int fr, int fq) const {
        const int pn = u.pn; size_t off; int ldc = 1024, col, act = 0;
        if (pn < 4) { off = WS_XA; col = pn * 256; }
        else if (pn < 8) { off = WS_SGA; col = (pn - 4) * 256; act = 1; }
        else if (pn < 12) { off = WS_Q; col = (pn - 8) * 256; }
        else if (pn == 12) { off = WS_K; col = 0; ldc = 256; }
        else if (pn == 13) { off = WS_V; col = 0; ldc = 256; }
        else if (pn < 18) { off = WS_SGB; col = (pn - 14) * 256; act = 1; }
        else if (pn < 34) {
            const bool bg = pn >= 26; const int blk = bg ? pn - 26 : pn - 18;
            bf16_t* basep = (bf16_t*)(ws + (bg ? WS_BC : WS_XC));
            const int row0p = u.pm * BM + wr * 64 + fr, col0p = blk * 128 + wc * 32 + 8 * fq;
#pragma unroll
            for (int ai = 0; ai < 2; ++ai)
#pragma unroll
                for (int m = 0; m < 4; ++m) { float v[8];
#pragma unroll
                    for (int j = 0; j < 8; ++j) { const float x0 = acc[ai][0][m][j >> 2][j & 3], x1 = acc[ai][1][m][j >> 2][j & 3];
                        v[j] = bg ? x0 * (x1 * sigmoidf_(x1)) : x0 * x1; }
                    *(u32x4*)(basep + (size_t)(row0p + ai * HALF + m * 16) * 1024 + col0p) = pack8(v); }
            return; }
        else { off = WS_SMG; col = (pn - 34) * 256; ldc = 3072; act = 2; }
        bf16_t* base = (bf16_t*)(ws + off);
        const int row0 = u.pm * BM + wr * 64 + fr, col0 = col + wc * 32 + 8 * fq;
        store_tile_bf16(acc, base, ldc, row0, col0, act);
    }
};
struct EpiGates {
    unsigned char* ws; const float* b_r; const float* b_i; const float* lam;
    __device__ __forceinline__ void operator()(const f32x4 (&acc)[2][2][4][2], const Unit& u, int wr, int wc, int fr, int fq) const {
        const int dir = u.pn >> 3, nb = (u.pn >> 1) & 3, hh = u.pn & 1;
        const int ch0 = nb * 256 + hh * 128 + wc * 32 + 8 * fq;
        float br[8], bi[8], sp[8];
#pragma unroll
        for (int j = 0; j < 8; ++j) { br[j] = b_r[dir * 1024 + ch0 + j]; bi[j] = b_i[dir * 1024 + ch0 + j];
            const float lm = lam[dir * 1024 + ch0 + j]; const float e = __expf(-lm);
            const float spl = lm < -15.f ? -lm : (e < 0.03f ? e * (1.f - e * (0.5f - e * (0.33333334f - 0.25f * e))) : __logf(1.f + e));
            sp[j] = -8.0f * LOG2E * spl; }
        const bf16_t* UA = (const bf16_t*)(ws + WS_H);
        bf16_t* LA = (bf16_t*)(ws + WS_LA + (size_t)dir * 64 * MiB);
        bf16_t* UU = (bf16_t*)(ws + WS_U + (size_t)dir * 64 * MiB);
        const int row0 = u.pm * BM + wr * 64 + fr;
#pragma unroll
        for (int ai = 0; ai < 2; ++ai)
#pragma unroll
            for (int m = 0; m < 4; ++m) { const size_t o = (size_t)(row0 + ai * HALF + m * 16) * 1024 + ch0;
                float x[8]; unpack8(*(const u32x4*)(UA + o), x);
                float la[8], uu[8];
#pragma unroll
                for (int j = 0; j < 8; ++j) { const float pr = acc[ai][0][m][j >> 2][j & 3] + br[j], pi = acc[ai][1][m][j >> 2][j & 3] + bi[j];
                    const float r = sigmoidf_(pr), ig = sigmoidf_(pi);
                    const float l2 = r * sp[j]; const float a = __builtin_amdgcn_exp2f(l2);
                    la[j] = l2; uu[j] = __builtin_amdgcn_sqrtf(fmaxf(1.f - a * a, 0.f)) * ig * x[j]; }
                *(u32x4*)(LA + o) = pack8(la); *(u32x4*)(UU + o) = pack8(uu); }
    }
};
struct EpiBranch {
    unsigned char* ws;
    __device__ __forceinline__ void operator()(const f32x4 (&acc)[2][2][4][2], const Unit& u, int wr, int wc, int fr, int fq) const {
        const bf16_t* G = (const bf16_t*)(ws + WS_SMG) + u.kk * 1024;
        bf16_t* Mg = (bf16_t*)(ws + WS_SGA);
        const int row0 = u.pm * BM + wr * 64 + fr, col0 = u.pn * BM + wc * 32 + 8 * fq;
#pragma unroll
        for (int ai = 0; ai < 2; ++ai)
#pragma unroll
            for (int m = 0; m < 4; ++m) { const int row = row0 + ai * HALF + m * 16;
#pragma unroll
                for (int bj = 0; bj < 2; ++bj) { const int col = col0 + bj * HALF;
                    float gt[8], v[8]; unpack8(*(const u32x4*)(G + (size_t)row * 3072 + col), gt);
#pragma unroll
                    for (int j = 0; j < 8; ++j) v[j] = gt[j] * acc[ai][bj][m][j >> 2][j & 3];
                    bf16_t* mp = Mg + (size_t)row * 1024 + col;
                    if (u.kk != 0) { float old[8]; unpack8(*(const u32x4*)mp, old);
#pragma unroll
                        for (int j = 0; j < 8; ++j) v[j] += old[j]; }
                    *(u32x4*)mp = pack8(v); } }
    }
};
struct EpiOut {
    const float* xi; float* xo; const float* gate;
    __device__ __forceinline__ void operator()(const f32x4 (&acc)[2][2][4][2], const Unit& u, int wr, int wc, int fr, int fq) const {
        const int row0 = u.pm * BM + wr * 64 + fr, col0 = u.pn * BM + wc * 32 + 8 * fq;
        f32x4 gv[2][2];
#pragma unroll
        for (int bj = 0; bj < 2; ++bj)
#pragma unroll
            for (int n = 0; n < 2; ++n) gv[bj][n] = *(const f32x4*)(gate + col0 + bj * HALF + 4 * n);
#pragma unroll
        for (int ai = 0; ai < 2; ++ai)
#pragma unroll
            for (int m = 0; m < 4; ++m) { const size_t o = (size_t)(row0 + ai * HALF + m * 16) * 1024 + col0;
#pragma unroll
                for (int bj = 0; bj < 2; ++bj)
#pragma unroll
                    for (int n = 0; n < 2; ++n) { const f32x4 xv = *(const f32x4*)(xi + o + bj * HALF + 4 * n);
                        *(f32x4*)(xo + o + bj * HALF + 4 * n) = xv + gv[bj][n] * acc[ai][bj][m][n]; } }
    }
};
}

namespace attn {
using bf16 = __hip_bfloat16;
using s16x4 = __attribute__((ext_vector_type(4))) short;
using f32x16 = __attribute__((ext_vector_type(16))) float;
constexpr int D = 128, NW = 8, QBLK = 32, KVBLK = 64;
constexpr float SCALE = 0.088388347648318440f;
constexpr float THR = 8.f;
constexpr int LDQ = 1024, LDK = 256, LDO = 1024;
constexpr size_t SHM_V = KVBLK * D * 2, SHM_K = KVBLK * D * 2, SHM_ATTN = 2 * SHM_V + 2 * SHM_K + NW * 64 * 4;
#define KSWZ(row, colB) ((row) * 256 + ((colB) ^ (((row) & 7) << 4)))
#define SBAR() __builtin_amdgcn_sched_barrier(0)
__device__ __forceinline__ int crow(int r, int hi) { return (r & 3) + 8 * (r >> 2) + 4 * hi; }
__device__ __forceinline__ unsigned cvtpk(float lo, float hi) { unsigned r; asm volatile("v_cvt_pk_bf16_f32 %0, %1, %2" : "=v"(r) : "v"(lo), "v"(hi)); return r; }

__device__ __forceinline__ void partialSM(f32x16& p0, f32x16& p1, float& m_reg, float& mn, float& alpha) {
  constexpr float C = SCALE * 1.4426950408889634f;
  float pmax = p0[0]; for (int r = 1; r < 16; ++r) pmax = fmaxf(pmax, p0[r]); for (int r = 0; r < 16; ++r) pmax = fmaxf(pmax, p1[r]);
  { auto rr = __builtin_amdgcn_permlane32_swap(__float_as_uint(pmax), __float_as_uint(pmax), false, false);
    pmax = fmaxf(__uint_as_float(rr[0]), __uint_as_float(rr[1])); }
  if (__builtin_expect(__all(pmax - m_reg <= THR / SCALE), 1)) { mn = m_reg; alpha = 1.f; }
  else { mn = fmaxf(m_reg, pmax); alpha = __builtin_amdgcn_exp2f((m_reg - mn) * C); m_reg = mn; }
  float mnC = -mn * C;
  for (int r = 0; r < 16; ++r) p0[r] = fmaf(p0[r], C, mnC); for (int r = 0; r < 16; ++r) p1[r] = fmaf(p1[r], C, mnC);
  for (int r = 0; r < 16; ++r) p0[r] = __builtin_amdgcn_exp2f(p0[r]);
}
__device__ __forceinline__ void finishSM(f32x16& p0, f32x16& p1, float alpha, float& l_reg, bf16x8& pa0, bf16x8& pa1, bf16x8& pa2, bf16x8& pa3) {
  for (int r = 0; r < 16; ++r) p1[r] = __builtin_amdgcn_exp2f(p1[r]);
  float ps = 0; for (int r = 0; r < 16; ++r) ps += p0[r]; for (int r = 0; r < 16; ++r) ps += p1[r];
  { auto rr = __builtin_amdgcn_permlane32_swap(__float_as_uint(ps), __float_as_uint(ps), false, false);
    ps = __uint_as_float(rr[0]) + __uint_as_float(rr[1]); }
  l_reg = l_reg * alpha + ps;
#define PK4(P, BASE, OUT) do { unsigned a0 = cvtpk(P[BASE + 0], P[BASE + 1]), a1 = cvtpk(P[BASE + 2], P[BASE + 3]);   \
    unsigned b0 = cvtpk(P[BASE + 4], P[BASE + 5]), b1 = cvtpk(P[BASE + 6], P[BASE + 7]);                              \
    auto r0 = __builtin_amdgcn_permlane32_swap(a0, b0, false, false); auto r1 = __builtin_amdgcn_permlane32_swap(a1, b1, false, false); \
    u32x4 w = {r0[0], r1[0], r0[1], r1[1]}; OUT = *reinterpret_cast<bf16x8*>(&w); } while (0)
  PK4(p0, 0, pa0); PK4(p0, 8, pa1); PK4(p1, 0, pa2); PK4(p1, 8, pa3);
#undef PK4
}
__device__ __forceinline__ void qkt(f32x16& p0, f32x16& p1, const bf16* Ks, const bf16x8* qr, int r32, int hi) {
  p0 = f32x16{}; p1 = f32x16{};
  for (int d0 = 0; d0 < 8; ++d0) { int cb = (d0 * 16 + hi * 8) * 2;
    bf16x8 b0 = *reinterpret_cast<const bf16x8*>((const char*)Ks + KSWZ(r32, cb));
    bf16x8 b1 = *reinterpret_cast<const bf16x8*>((const char*)Ks + KSWZ(32 + r32, cb));
    p0 = __builtin_amdgcn_mfma_f32_32x32x16_bf16(b0, qr[d0], p0, 0, 0, 0);
    p1 = __builtin_amdgcn_mfma_f32_32x32x16_bf16(b1, qr[d0], p1, 0, 0, 0); }
}
__device__ __forceinline__ int v_st(int k, int c) { const int kk = (k & ~0xC) | ((k & 4) << 1) | ((k & 8) >> 1); return ((kk >> 3) * 4 + (c >> 5)) * 512 + ((kk & 7) * 32 + (c & 31)) * 2; }
__device__ __forceinline__ int v_rd_base(int lane) { return ((lane & 3) << 3) | (((lane >> 2) & 3) << 6) | (((lane >> 4) & 1) << 5) | (((lane >> 5) & 1) << 8); }
constexpr int v_rd_off(int d0, int ks, int half) { return d0 * 512 + ks * 4096 + half * 2048; }
template <int OFF> __device__ __forceinline__ s16x4 tr_read(int vb) {
  s16x4 r; asm volatile("ds_read_b64_tr_b16 %0, %1 offset:%2" : "=&v"(r) : "v"(vb), "i"(OFF) : "memory"); return r;
}
template <int D0> __device__ __forceinline__ void pv_one(f32x16& od, int vb, bf16x8 pa0, bf16x8 pa1, bf16x8 pa2, bf16x8 pa3) {
  const s16x4 l0 = tr_read<v_rd_off(D0, 0, 0)>(vb), h0 = tr_read<v_rd_off(D0, 0, 1)>(vb), l1 = tr_read<v_rd_off(D0, 1, 0)>(vb), h1 = tr_read<v_rd_off(D0, 1, 1)>(vb);
  const s16x4 l2 = tr_read<v_rd_off(D0, 2, 0)>(vb), h2 = tr_read<v_rd_off(D0, 2, 1)>(vb), l3 = tr_read<v_rd_off(D0, 3, 0)>(vb), h3 = tr_read<v_rd_off(D0, 3, 1)>(vb);
  asm volatile("s_waitcnt lgkmcnt(0)" ::: "memory"); SBAR();
#define PK(L, H) (bf16x8){L[0], L[1], L[2], L[3], H[0], H[1], H[2], H[3]}
  od = __builtin_amdgcn_mfma_f32_32x32x16_bf16(pa0, PK(l0, h0), od, 0, 0, 0);
  od = __builtin_amdgcn_mfma_f32_32x32x16_bf16(pa1, PK(l1, h1), od, 0, 0, 0);
  od = __builtin_amdgcn_mfma_f32_32x32x16_bf16(pa2, PK(l2, h2), od, 0, 0, 0);
  od = __builtin_amdgcn_mfma_f32_32x32x16_bf16(pa3, PK(l3, h3), od, 0, 0, 0);
#undef PK
}
__device__ __forceinline__ void pv_d0(f32x16* o, int vb, bf16x8 pa0, bf16x8 pa1, bf16x8 pa2, bf16x8 pa3) {
  pv_one<0>(o[0], vb, pa0, pa1, pa2, pa3); pv_one<1>(o[1], vb, pa0, pa1, pa2, pa3); pv_one<2>(o[2], vb, pa0, pa1, pa2, pa3); pv_one<3>(o[3], vb, pa0, pa1, pa2, pa3);
}
__device__ __forceinline__ void attn_dense_body(const bf16* Qb, const bf16* __restrict__ Kh, const bf16* __restrict__ Vh,
                                                bf16_t* Ob, const bf16_t* Gb, int seq, char* lds, const int tid) {
  const int wid = tid >> 6, lane = tid & 63, r32 = lane & 31, hi = lane >> 5;
  bf16* V_lds = (bf16*)lds; bf16* K_lds = (bf16*)(lds + 2 * SHM_V);
  float* ws = (float*)(lds + 2 * SHM_V + 2 * SHM_K) + wid * 64; float* li_l = ws; float* al_l = ws + 32;
  float m_reg = -1e30f, l_reg = 0; f32x16 o[4] = {}; bf16x8 qr[8];
  const bf16* Qw = Qb + (long)(wid * QBLK + r32) * LDQ + hi * 8;
#pragma unroll
  for (int d0 = 0; d0 < 8; ++d0) qr[d0] = *reinterpret_cast<const bf16x8*>(Qw + d0 * 16);
  const int sr = tid >> 4, sc = (tid & 15) * 8, vst0 = v_st(sr, sc), vst1 = v_st(32 + sr, sc);
  const int vb0 = (int)(uintptr_t)V_lds + v_rd_base(lane);
  struct { bf16x8 vs0, vs1, ks0, ks1; } sr_[2];
#define SLOAD(i, k0) do { sr_[i].vs0 = *reinterpret_cast<const bf16x8*>(&Vh[(long)((k0) + sr) * LDK + sc]); sr_[i].vs1 = *reinterpret_cast<const bf16x8*>(&Vh[(long)((k0) + 32 + sr) * LDK + sc]); \
    sr_[i].ks0 = *reinterpret_cast<const bf16x8*>(&Kh[(long)((k0) + sr) * LDK + sc]); sr_[i].ks1 = *reinterpret_cast<const bf16x8*>(&Kh[(long)((k0) + 32 + sr) * LDK + sc]); } while (0)
#define SWRITE(b, i) do { *(bf16x8*)((char*)V_lds + (b) * SHM_V + vst0) = sr_[i].vs0;          \
    *(bf16x8*)((char*)V_lds + (b) * SHM_V + vst1) = sr_[i].vs1; int kc = sc * 2;               \
    *(bf16x8*)((char*)K_lds + (b) * SHM_K + KSWZ(sr, kc)) = sr_[i].ks0;                       \
    *(bf16x8*)((char*)K_lds + (b) * SHM_K + KSWZ(32 + sr, kc)) = sr_[i].ks1; } while (0)
#define SWAIT() asm volatile("s_waitcnt vmcnt(4)" ::: "memory")
#define RESC(a) do { if (__any((a) < 1.f)) { if (hi == 0) al_l[r32] = (a); asm volatile("s_waitcnt lgkmcnt(0)" ::: "memory"); \
    for (int d = 0; d < 4; ++d) for (int r = 0; r < 16; ++r) o[d][r] *= al_l[crow(r, hi)]; } } while (0)
  f32x16 pA0, pA1, pB0, pB1; float mnA, mnB, alA, alB; bf16x8 pa0, pa1, pa2, pa3; const int NT = seq / KVBLK;
  constexpr int SE = 0, SO = 1;
  SLOAD(SE, 0); asm volatile("s_waitcnt vmcnt(0)" ::: "memory"); SWRITE(0, SE); __syncthreads();
  qkt(pA0, pA1, K_lds, qr, r32, hi); partialSM(pA0, pA1, m_reg, mnA, alA);
  SLOAD(SO, KVBLK); if (2 < NT) SLOAD(SE, 2 * KVBLK);
  SWAIT(); SWRITE(1, SO); __syncthreads();
#pragma nounroll
  for (int j = 1; j + 1 < NT; j += 2) {
    SBAR(); qkt(pB0, pB1, (bf16*)((char*)K_lds + SHM_K), qr, r32, hi);
    finishSM(pA0, pA1, alA, l_reg, pa0, pa1, pa2, pa3); SBAR();
    SLOAD(SO, (j + 2) * KVBLK); SBAR();
    pv_d0(o, vb0, pa0, pa1, pa2, pa3); partialSM(pB0, pB1, m_reg, mnB, alB);
    __syncthreads(); SWAIT(); SWRITE(0, SE);
    RESC(alB); __syncthreads();
    SBAR(); qkt(pA0, pA1, K_lds, qr, r32, hi);
    finishSM(pB0, pB1, alB, l_reg, pa0, pa1, pa2, pa3); SBAR();
    if (j + 3 < NT) SLOAD(SE, (j + 3) * KVBLK); SBAR();
    pv_d0(o, vb0 + (int)SHM_V, pa0, pa1, pa2, pa3); partialSM(pA0, pA1, m_reg, mnA, alA);
    __syncthreads(); SWAIT(); SWRITE(1, SO);
    RESC(alA); __syncthreads();
  }
  SBAR(); qkt(pB0, pB1, (bf16*)((char*)K_lds + SHM_K), qr, r32, hi);
  finishSM(pA0, pA1, alA, l_reg, pa0, pa1, pa2, pa3); SBAR();
  pv_d0(o, vb0, pa0, pa1, pa2, pa3); partialSM(pB0, pB1, m_reg, mnB, alB);
  __syncthreads(); RESC(alB);
  finishSM(pB0, pB1, alB, l_reg, pa0, pa1, pa2, pa3); SBAR();
  pv_d0(o, vb0 + (int)SHM_V, pa0, pa1, pa2, pa3);
  if (hi == 0) li_l[r32] = l_reg; asm volatile("s_waitcnt lgkmcnt(0)" ::: "memory");
  float rli[16];
#pragma unroll
  for (int r = 0; r < 16; ++r) rli[r] = __builtin_amdgcn_rcpf(li_l[crow(r, hi)]);
  __syncthreads();
  { int lane_e = lane, wid_e = wid; asm volatile("" : "+v"(lane_e), "+v"(wid_e)); wid_e = __builtin_amdgcn_readfirstlane(wid_e);
    bf16_t* stg = (bf16_t*)lds + wid_e * 4096;
#pragma unroll
    for (int r = 0; r < 16; ++r) { const int orow = crow(r, hi);
#pragma unroll
      for (int d0 = 0; d0 < 4; ++d0) stg[orow * 128 + d0 * 32 + r32] = (bf16_t)f2bf(o[d0][r] * rli[r]); }
    asm volatile("s_waitcnt lgkmcnt(0)" ::: "memory");
    bf16_t* Ow = Ob + (long)(wid_e * QBLK) * LDO; const bf16_t* Gw = Gb + (long)(wid_e * QBLK) * LDO;
    u32x4 gq[8];
#pragma unroll
    for (int i = 0; i < 8; ++i) { const int row = i * 4 + (lane_e >> 4), ch = lane_e & 15; gq[i] = *(const u32x4*)(Gw + (long)row * LDO + ch * 8); }
#pragma unroll
    for (int i = 0; i < 8; ++i) { const int row = i * 4 + (lane_e >> 4), ch = lane_e & 15;
      float ov[8], gv[8]; unpack8(*(const u32x4*)(stg + row * 128 + ch * 8), ov); unpack8(gq[i], gv);
#pragma unroll
      for (int j = 0; j < 8; ++j) ov[j] *= gv[j];
      *(u32x4*)(Ow + (long)row * LDO + ch * 8) = pack8(ov); } }
  __syncthreads();
#undef SLOAD
#undef SWRITE
#undef SWAIT
#undef RESC
}

__device__ __forceinline__ void attn_pp_body(const bf16* Qb, const bf16* __restrict__ Kh, const bf16* __restrict__ Vh,
                                             bf16_t* Ob, const bf16_t* Gb, int seq, char* lds, const int tid) {
  const int wid = __builtin_amdgcn_readfirstlane(tid >> 6), lane = tid & 63, r32 = lane & 31, hi = lane >> 5;
  const int g = wid >> 2;
  constexpr int NB = 3;
  char* V_lds = lds; char* K_lds = lds + NB * SHM_V;
  float* ws = (float*)(lds + NB * (SHM_V + SHM_K)) + wid * 64; float* li_l = ws; float* al_l = ws + 32;
  float m_reg = -1e30f, l_reg = 0; f32x16 o[4] = {}; bf16x8 qr[8];
  const bf16* Qw = Qb + (long)(wid * QBLK + r32) * LDQ + hi * 8;
#pragma unroll
  for (int d0 = 0; d0 < 8; ++d0) qr[d0] = *reinterpret_cast<const bf16x8*>(Qw + d0 * 16);
  const int sr = tid >> 4, sc = (tid & 15) * 8, vst0 = v_st(sr, sc), vst1 = v_st(32 + sr, sc);
  const int ksw0 = KSWZ(sr, sc * 2), ksw1 = KSWZ(32 + sr, sc * 2);
  const int vbase = (int)(uintptr_t)V_lds + v_rd_base(lane);
  struct Stg { bf16x8 vs0, vs1, ks0, ks1; } st0, st1;
#define SLOAD(S, t) do { const long k0_ = (long)(t) * KVBLK; S.vs0 = *reinterpret_cast<const bf16x8*>(&Vh[(k0_ + sr) * LDK + sc]); S.vs1 = *reinterpret_cast<const bf16x8*>(&Vh[(k0_ + 32 + sr) * LDK + sc]); \
    S.ks0 = *reinterpret_cast<const bf16x8*>(&Kh[(k0_ + sr) * LDK + sc]); S.ks1 = *reinterpret_cast<const bf16x8*>(&Kh[(k0_ + 32 + sr) * LDK + sc]); } while (0)
#define SWRITE(S, b) do { *(bf16x8*)(V_lds + (b) * SHM_V + vst0) = S.vs0; *(bf16x8*)(V_lds + (b) * SHM_V + vst1) = S.vs1; \
    *(bf16x8*)(K_lds + (b) * SHM_K + ksw0) = S.ks0; *(bf16x8*)(K_lds + (b) * SHM_K + ksw1) = S.ks1; } while (0)
#define RESC(a) do { if (__any((a) < 1.f)) { if (hi == 0) al_l[r32] = (a); asm volatile("s_waitcnt lgkmcnt(0)" ::: "memory"); \
    for (int d = 0; d < 4; ++d) for (int r = 0; r < 16; ++r) o[d][r] *= al_l[crow(r, hi)]; } } while (0)
  const int NT = seq / KVBLK;
  f32x16 p0, p1; bf16x8 pa0, pa1, pa2, pa3;
#define SMX() do { float mn_, al_; partialSM(p0, p1, m_reg, mn_, al_); RESC(al_); finishSM(p0, p1, al_, l_reg, pa0, pa1, pa2, pa3); } while (0)
  SLOAD(st0, 0); if (g) SLOAD(st1, 1);
  SWRITE(st0, 0); if (g) SWRITE(st1, 1);
  SLOAD(st0, 1 + g); SLOAD(st1, 2 + g);
  __syncthreads();
  if (g) __syncthreads();
  SBAR(); qkt(p0, p1, (const bf16*)K_lds, qr, r32, hi); SBAR();
  __syncthreads();
  SWRITE(st0, 1 + g); if (3 + g < NT) SLOAD(st0, 3 + g);
  SMX();
  __syncthreads();
  int c = 0;
#define STEP(i, ST) do { const int cK_ = (c == 2) ? 0 : c + 1; \
    SBAR(); \
    qkt(p0, p1, (const bf16*)(K_lds + cK_ * SHM_K), qr, r32, hi); \
    pv_d0(o, vbase + c * (int)SHM_V, pa0, pa1, pa2, pa3); \
    SBAR(); \
    __syncthreads(); \
    { const int t_ = (i) + 2 + g; if (t_ < NT) { const int cb_ = (cK_ == 2) ? 0 : cK_ + 1; const int cw_ = g ? ((cb_ == 2) ? 0 : cb_ + 1) : cb_; \
        SWRITE(ST, cw_); if (t_ + 2 < NT) SLOAD(ST, t_ + 2); } } \
    SMX(); \
    __syncthreads(); \
    c = cK_; } while (0)
  int i = 0;
#pragma nounroll
  for (; i + 1 < NT - 1; i += 2) { STEP(i, st1); STEP(i + 1, st0); }
  if (i < NT - 1) { STEP(i, st1); }
  SBAR(); pv_d0(o, vbase + c * (int)SHM_V, pa0, pa1, pa2, pa3); SBAR();
  __syncthreads();
  if (!g) __syncthreads();
  if (hi == 0) li_l[r32] = l_reg; asm volatile("s_waitcnt lgkmcnt(0)" ::: "memory");
  float rli[16];
#pragma unroll
  for (int r = 0; r < 16; ++r) rli[r] = __builtin_amdgcn_rcpf(li_l[crow(r, hi)]);
  { int lane_e = lane, wid_e = wid; asm volatile("" : "+v"(lane_e), "+v"(wid_e)); wid_e = __builtin_amdgcn_readfirstlane(wid_e);
    bf16_t* stg = (bf16_t*)lds + wid_e * 4096;
#pragma unroll
    for (int r = 0; r < 16; ++r) { const int orow = crow(r, hi);
#pragma unroll
      for (int d0 = 0; d0 < 4; ++d0) stg[orow * 128 + d0 * 32 + r32] = (bf16_t)f2bf(o[d0][r] * rli[r]); }
    asm volatile("s_waitcnt lgkmcnt(0)" ::: "memory");
    bf16_t* Ow = Ob + (long)(wid_e * QBLK) * LDO; const bf16_t* Gw = Gb + (long)(wid_e * QBLK) * LDO;
    u32x4 gq[8];
#pragma unroll
    for (int i2 = 0; i2 < 8; ++i2) { const int row = i2 * 4 + (lane_e >> 4), ch = lane_e & 15; gq[i2] = *(const u32x4*)(Gw + (long)row * LDO + ch * 8); }
#pragma unroll
    for (int i2 = 0; i2 < 8; ++i2) { const int row = i2 * 4 + (lane_e >> 4), ch = lane_e & 15;
      float ov[8], gv[8]; unpack8(*(const u32x4*)(stg + row * 128 + ch * 8), ov); unpack8(gq[i2], gv);
#pragma unroll
      for (int j = 0; j < 8; ++j) ov[j] *= gv[j];
      *(u32x4*)(Ow + (long)row * LDO + ch * 8) = pack8(ov); } }
  __syncthreads();
#undef SLOAD
#undef SWRITE
#undef RESC
#undef SMX
#undef STEP
}
#undef KSWZ
#undef SBAR
}


#define XB_TMO      128
#define XB_XCNT(j)  (256  + 64 * (j))
#define XB_XSUB(j)  (1280 + 64 * (j))
#define XB_XGEN(j)  (2304 + 64 * (j))
#define XB_TOP      3328
#define XB_TOPGEN   3392
#define XCD_BAR_WORDS 3456
#define XB_SPIN_CAP (1u << 22)
__device__ __forceinline__ unsigned xb_ld(unsigned* p)              { return __hip_atomic_load(p, __ATOMIC_RELAXED, __HIP_MEMORY_SCOPE_AGENT); }
__device__ __forceinline__ unsigned xb_add(unsigned* p, unsigned v) { return __hip_atomic_fetch_add(p, v, __ATOMIC_RELAXED, __HIP_MEMORY_SCOPE_AGENT); }
__device__ __forceinline__ unsigned xb_xcc_id() { return (unsigned)__builtin_amdgcn_s_getreg((3 << 11) | 20) & 0xFu; }
#define XB_SPIN(cond, bar) do { unsigned _sp = 0; while (cond) { __builtin_amdgcn_s_sleep(1); \
    if ((++_sp & 255u) == 0u) { if (xb_ld(&(bar)[XB_TMO])) break; if (_sp > XB_SPIN_CAP) { atomicAdd(&(bar)[XB_TMO], 1u); break; } } } } while (0)
struct XcdBarrier { unsigned* bar; unsigned x; volatile LAS unsigned* st; };
__device__ __forceinline__ XcdBarrier xcd_barrier_post(unsigned* bar, volatile LAS unsigned* st) {
    XcdBarrier b; b.bar = bar; b.x = xb_xcc_id(); b.st = st;
    if (threadIdx.x == 0) (void)xb_add(&bar[XB_XCNT(b.x)], 1u);
    return b;
}
__device__ __forceinline__ void xcd_barrier_complete(unsigned* bar, unsigned x, unsigned& nloc, unsigned& nx) {
    const unsigned G = gridDim.x * gridDim.y * gridDim.z;
    unsigned sum, cnt, mine, sp = 0u;
    for (;;) {
        sum = 0u; cnt = 0u; mine = 0u;
#pragma unroll
        for (unsigned j = 0; j < 16; ++j) { const unsigned c = xb_ld(&bar[XB_XCNT(j)]); sum += c; cnt += (c > 0u) ? 1u : 0u; mine = (j == x) ? c : mine; }
        if (sum == G) break;
        __builtin_amdgcn_s_sleep(1);
        if ((++sp & 255u) == 0u) { if (xb_ld(&bar[XB_TMO])) break; if (sp > XB_SPIN_CAP) { atomicAdd(&bar[XB_TMO], 1u); break; } }
    }
    nloc = mine > 0u ? mine : 1u; nx = cnt > 0u ? cnt : 1u;
}
__device__ __forceinline__ void xcd_barrier(const XcdBarrier& b, const int tid) {
    asm volatile("s_waitcnt vmcnt(0)" ::: "memory");
    __syncthreads();
    if (tid == 0) {
        unsigned* bar = b.bar;
        __builtin_amdgcn_s_waitcnt(0);
        unsigned nloc = b.st[0], nx = b.st[1];
        if (nloc == 0u) { xcd_barrier_complete(bar, b.x, nloc, nx); b.st[0] = nloc; b.st[1] = nx; }
        const unsigned old = xb_add(&bar[XB_XSUB(b.x)], 1u);
        const unsigned gen = old / nloc;
        if (old + 1u == (gen + 1u) * nloc) {
            __builtin_amdgcn_fence(__ATOMIC_RELEASE, "agent");
            asm volatile("s_waitcnt vmcnt(0)" ::: "memory");
            const unsigned og = xb_add(&bar[XB_TOP], 1u);
            const unsigned tg = og / nx;
            if (og + 1u == (tg + 1u) * nx) xb_add(&bar[XB_TOPGEN], 1u);
            else XB_SPIN(xb_ld(&bar[XB_TOPGEN]) == tg, bar);
            __builtin_amdgcn_fence(__ATOMIC_ACQUIRE, "agent");
            xb_add(&bar[XB_XGEN(b.x)], 1u);
            asm volatile("s_waitcnt vmcnt(0)" ::: "memory");
        } else {
            XB_SPIN(xb_ld(&bar[XB_XGEN(b.x)]) == gen, bar);
            __builtin_amdgcn_fence(__ATOMIC_ACQUIRE, "agent");
            asm volatile("s_waitcnt vmcnt(0)" ::: "memory");
        }
    }
    __syncthreads();
}

#ifndef PHM
#define PHM 1023
#endif
#ifndef PROBE_K
#define PROBE_K -1
#endif
struct Args { const float* in[18]; float* out; unsigned char* ws; int ph_lo, ph_hi; };
typedef const __attribute__((address_space(4))) Args* KArgs;
#define INP(a, i) ((const float*)(const GAS float*)((a)->in[i]))
#define OUTP(a) ((float*)(GAS float*)((a)->out))
enum { I_X = 0, I_C, I_WADA, I_BADA, I_NORMG, I_WIN, I_CAW, I_CAB, I_WRG, I_BRG, I_WIG, I_BIG, I_LAM, I_QG, I_KG, I_CCW, I_WBR, I_WOUT };

__device__ __forceinline__ void transpose_item(const float* W, int ldw, bf16_t* dst, int ldd, LAS float* scr, int lane) {
#pragma unroll 8
    for (int i = 0; i < 32; ++i) { const int kk = 2 * i + (lane >> 5); scr[kk * 33 + (lane & 31)] = W[(size_t)kk * ldw + (lane & 31)]; }
    LDS_WAIT();
    const int c = lane & 7;
#pragma unroll
    for (int j = 0; j < 4; ++j) { const int n = (lane >> 3) + 8 * j; const LAS float* s = scr + (8 * c) * 33 + n;
        u32x4 o; o.x = cvt_pk_bf16(s[0 * 33], s[1 * 33]); o.y = cvt_pk_bf16(s[2 * 33], s[3 * 33]); o.z = cvt_pk_bf16(s[4 * 33], s[5 * 33]); o.w = cvt_pk_bf16(s[6 * 33], s[7 * 33]);
        *(u32x4*)(dst + (size_t)n * ldd + 8 * c) = o; }
    LDS_WAIT();
}

__device__ __forceinline__ void phase_prologue(KArgs a, unsigned char* wsb, LAS unsigned char* lds, int tid, int lane, int wave, int bid, int G) {
    unsigned char* ws = wsb;
    {
        LAS float* red = (LAS float*)lds;
        for (int it = bid; it < 96; it += G) {
            const int l = it / 48, jb = it % 48, j = jb * 64 + lane;
            const float* wa = INP(a, I_WADA) + (size_t)l * 1024 * 3072 + j; const float* c0 = INP(a, I_C); const float* c1 = c0 + 1024;
            float a0 = 0.f, a1 = 0.f; const int kb = wave * 128;
#pragma unroll 16
            for (int k = 0; k < 128; ++k) { const float w = wa[(size_t)(kb + k) * 3072]; a0 += c0[kb + k] * w; a1 += c1[kb + k] * w; }
            red[(wave * 2 + 0) * 64 + lane] = a0; red[(wave * 2 + 1) * 64 + lane] = a1;
            __syncthreads();
            if (tid < 128) { const int bb = tid >> 6; float s = 0.f;
#pragma unroll
                for (int w = 0; w < 8; ++w) s += red[(w * 2 + bb) * 64 + lane];
                ((float*)(ws + WS_MOD))[(l * 2 + bb) * 3072 + j] = s + INP(a, I_BADA)[l * 3072 + j]; }
            __syncthreads();
        }
    }
    {
        float* rc = (float*)(ws + WS_ROPE); float* rs = rc + 320 * 32;
        for (int e = bid * 512 + tid; e < 320 * 32; e += G * 512) {
            const int pos = e >> 5, i = e & 31; const int p = pos < 256 ? pos : pos - 256;
            const float inv = __builtin_amdgcn_exp2f(-((float)(2 * i)) * (13.287712379549449f / 64.0f));
            const float ang = (float)p * inv;
            rc[e] = __cosf(ang); rs[e] = __sinf(ang);
        }
    }
    {
        LAS float* scr = (LAS float*)(lds + 8192 + wave * 12288);
        const int gw = bid * 8 + wave, NGW = G * 8;
        constexpr int I_IN = 2 * 16 * 368, I_G = 1024, I_BR = 3072, I_OUT = 1024, NITEMS = I_IN + I_G + I_BR + I_OUT;
        for (int it = gw; it < NITEMS; it += NGW) {
            int r = it;
            if (r < I_IN) { const int l = r / 5888, q = r % 5888, kb = q / 368, nb = q % 368;
                const int n0 = 32 * nb; int drow = n0;
                if (n0 >= 4608 && n0 < 8704) { const int sec = (n0 - 4608) >> 10, ch = (n0 - 4608) & 1023, blk = ch >> 7;
                    drow = ((sec & 1) ? 26 + blk : 18 + blk) * 256 + ((sec >> 1) ? 128 : 0) + (ch & 127); }
                transpose_item(INP(a, I_WIN) + (size_t)l * 1024 * NIN + (size_t)(64 * kb) * NIN + n0, NIN,
                               (bf16_t*)(ws + WS_WIN) + (size_t)l * NIN * 1024 + (size_t)drow * 1024 + 64 * kb, 1024, scr, lane); continue; }
            r -= I_IN;
            if (r < I_G) { const int mi = r >> 5, sub = r & 31, kb = sub >> 3, nblk = sub & 7;
                const int nb = mi & 3, gate = (mi >> 2) & 1, dir = (mi >> 3) & 1, l = mi >> 4;
                const float* src = (gate ? INP(a, I_WIG) : INP(a, I_WRG)) + (size_t)((l * 2 + dir) * 4 + nb) * 65536 + (size_t)(64 * kb) * 256 + 32 * nblk;
                const int n0 = 32 * nblk, hh = n0 >> 7, pn = (dir * 4 + nb) * 2 + hh, row = pn * 256 + gate * 128 + (n0 & 127);
                transpose_item(src, 256, (bf16_t*)(ws + WS_WG) + (size_t)l * 4096 * 256 + (size_t)row * 256 + 64 * kb, 256, scr, lane); continue; }
            r -= I_G;
            if (r < I_BR) { const int mi = r >> 9, sub = r & 511, kb = sub >> 5, nblk = sub & 31;
                transpose_item(INP(a, I_WBR) + (size_t)mi * 1048576 + (size_t)(64 * kb) * 1024 + 32 * nblk, 1024,
                               (bf16_t*)(ws + WS_WBR) + (size_t)mi * 1048576 + (size_t)(32 * nblk) * 1024 + 64 * kb, 1024, scr, lane); continue; }
            r -= I_BR;
            { const int mi = r >> 9, sub = r & 511, kb = sub >> 5, nblk = sub & 31;
                transpose_item(INP(a, I_WOUT) + (size_t)mi * 1048576 + (size_t)(64 * kb) * 1024 + 32 * nblk, 1024,
                               (bf16_t*)(ws + WS_WOUT) + (size_t)mi * 1048576 + (size_t)(32 * nblk) * 1024 + 64 * kb, 1024, scr, lane); }
        }
    }
}

__device__ __forceinline__ void phase_h(KArgs a, unsigned char* wsb, int l, int b, int lane, int wave, int bid, int G) {
    const float* xin = (l == 0 ? INP(a, I_X) : OUTP(a)) + (size_t)b * SEQ * DM;
    const float* mod = (const float*)(wsb + WS_MOD) + (l * 2 + b) * 3072;
    bf16_t* H = (bf16_t*)(wsb + WS_H);
    f32x4 gs[4], sh[4];
#pragma unroll
    for (int j = 0; j < 4; ++j) { const int col = 4 * lane + 256 * j;
        const f32x4 g = *(const f32x4*)(INP(a, I_NORMG) + l * 1024 + col), sc = *(const f32x4*)(mod + 1024 + col);
        gs[j] = g * (sc + 1.0f); sh[j] = *(const f32x4*)(mod + col); }
    const int gw = bid * 8 + wave, NGW = G * 8;
    for (int m = gw; m < SEQ; m += 2 * NGW) {
        const int m2 = (m + NGW < SEQ) ? m + NGW : m;
        const f32x4* xr = (const f32x4*)(xin + (size_t)m * DM) + lane; const f32x4* xr2 = (const f32x4*)(xin + (size_t)m2 * DM) + lane;
        f32x4 v[4], w[4]; float s = 0.f, s2 = 0.f;
#pragma unroll
        for (int j = 0; j < 4; ++j) { v[j] = xr[64 * j]; w[j] = xr2[64 * j]; }
#pragma unroll
        for (int j = 0; j < 4; ++j) { s += (v[j].x * v[j].x + v[j].y * v[j].y) + (v[j].z * v[j].z + v[j].w * v[j].w); s2 += (w[j].x * w[j].x + w[j].y * w[j].y) + (w[j].z * w[j].z + w[j].w * w[j].w); }
        const float rstd = __builtin_amdgcn_rsqf(wave_sum(s) * (1.f / DM) + EPS), rstd2 = __builtin_amdgcn_rsqf(wave_sum(s2) * (1.f / DM) + EPS);
        u32x2* o8 = (u32x2*)(H + (size_t)m * DM) + lane; u32x2* o82 = (u32x2*)(H + (size_t)m2 * DM) + lane;
#pragma unroll
        for (int j = 0; j < 4; ++j) { const f32x4 o = v[j] * rstd * gs[j] + sh[j]; u32x2 q; q.x = cvt_pk_bf16(o.x, o.y); q.y = cvt_pk_bf16(o.z, o.w); o8[64 * j] = q;
            const f32x4 o2 = w[j] * rstd2 * gs[j] + sh[j]; u32x2 q2; q2.x = cvt_pk_bf16(o2.x, o2.y); q2.y = cvt_pk_bf16(o2.z, o2.w); o82[64 * j] = q2; }
    }
}

__device__ __forceinline__ void ldrow8(const bf16_t* __restrict__ base, int t, int ch, float (&v)[8]) {
    if (t < 0 || t >= SEQ) {
#pragma unroll
        for (int j = 0; j < 8; ++j) v[j] = 0.f;
    } else unpack8(*(const u32x4*)(base + (size_t)t * 1024 + ch), v);
}
__device__ __forceinline__ void ld8f32(const float* p, float (&v)[8]) {
    const f32x4 a = *(const f32x4*)p, b = *(const f32x4*)(p + 4);
    v[0] = a.x; v[1] = a.y; v[2] = a.z; v[3] = a.w; v[4] = b.x; v[5] = b.y; v[6] = b.z; v[7] = b.w;
}

__device__ __forceinline__ void phase_elem(KArgs a, unsigned char* wsb, int l, int lane, int wave, int bid, int G) {
    unsigned char* ws = wsb;
    const int gw = bid * 8 + wave, NGW = G * 8;
    for (int it = gw; it < 2048; it += NGW) {
        const int run = it >> 1, hf = it & 1, ch = hf * 512 + lane * 8, t0 = run * 16;
        {
            const bf16_t* __restrict__ XA = (const bf16_t*)(ws + WS_XA); bf16_t* __restrict__ UA = (bf16_t*)(ws + WS_H);
            float w0[8], w1[8], w2[8], w3[8], bb[8];
            const float* cw = INP(a, I_CAW) + (size_t)l * 4 * 1024 + ch;
            ld8f32(cw, w0); ld8f32(cw + 1024, w1); ld8f32(cw + 2048, w2); ld8f32(cw + 3072, w3); ld8f32(INP(a, I_CAB) + l * 1024 + ch, bb);
            float xm2[8], xm1[8], x0[8], xp1[8];
            ldrow8(XA, t0 - 2, ch, xm2); ldrow8(XA, t0 - 1, ch, xm1); ldrow8(XA, t0, ch, x0);
#pragma unroll
            for (int s = 0; s < 16; ++s) { const int t = t0 + s;
                ldrow8(XA, t + 1, ch, xp1);
                float o[8];
#pragma unroll
                for (int j = 0; j < 8; ++j) o[j] = w0[j] * xm2[j] + w1[j] * xm1[j] + w2[j] * x0[j] + w3[j] * xp1[j] + bb[j];
                *(u32x4*)(UA + (size_t)t * 1024 + ch) = pack8(o);
#pragma unroll
                for (int j = 0; j < 8; ++j) { xm2[j] = xm1[j]; xm1[j] = x0[j]; x0[j] = xp1[j]; } }
        }
        {
            const bf16_t* __restrict__ PP = (const bf16_t*)(ws + WS_XC); const bf16_t* __restrict__ BG = (const bf16_t*)(ws + WS_BC); bf16_t* __restrict__ YC = (bf16_t*)(ws + WS_YC);
            float w0[8], w1[8], w2[8];
            const float* cw = INP(a, I_CCW) + (size_t)l * 3 * 1024 + ch;
            ld8f32(cw, w0); ld8f32(cw + 1024, w1); ld8f32(cw + 2048, w2);
            float pm1[8], p0[8], pp1[8], t1[8];
            ldrow8(PP, t0 - 1, ch, pm1); ldrow8(PP, t0, ch, p0);
#pragma unroll
            for (int s = 0; s < 16; ++s) { const int t = t0 + s;
                ldrow8(PP, t + 1, ch, pp1); ldrow8(BG, t, ch, t1);
                float o[8];
#pragma unroll
                for (int j = 0; j < 8; ++j) o[j] = t1[j] * (w0[j] * pm1[j] + w1[j] * p0[j] + w2[j] * pp1[j]);
                *(u32x4*)(YC + (size_t)t * 1024 + ch) = pack8(o);
#pragma unroll
                for (int j = 0; j < 8; ++j) { pm1[j] = p0[j]; p0[j] = pp1[j]; } }
        }
        {
            bf16_t* Q = (bf16_t*)(ws + WS_Q); bf16_t* Kb = (bf16_t*)(ws + WS_K);
            const float* rc = (const float*)(ws + WS_ROPE); const float* rs = rc + 320 * 32;
            const int d0 = (lane & 15) * 8, i0 = (lane & 3) * 8;
            float qg[8], kg[8];
            ld8f32(INP(a, I_QG) + l * 128 + d0, qg); ld8f32(INP(a, I_KG) + l * 128 + d0, kg);
            const bool second = (lane & 4) != 0;
            const int tokb = run * 16 + hf * 8;
            const int tsel = (d0 < 64) ? 0 : 1;
            u32x4 cur[3]; float cs[8], sn[8];
#define LD_TOK(tok, dst, dcs, dsn) do { const int tp_ = tsel ? 256 + ((tok) & 63) : ((tok) >> 6); ld8f32(rc + tp_ * 32 + i0, dcs); ld8f32(rs + tp_ * 32 + i0, dsn); \
                dst[0] = *(const u32x4*)(Q + (size_t)(tok) * 1024 + lane * 8); dst[1] = *(const u32x4*)(Q + (size_t)(tok) * 1024 + 512 + lane * 8); dst[2] = *(const u32x4*)(Kb + (size_t)(tok) * 256 + (lane & 31) * 8); } while (0)
            LD_TOK(tokb, cur, cs, sn);
#pragma unroll
            for (int i = 0; i < 8; ++i) {
                const int tok = tokb + i;
                u32x4 nx[3]; float ncs[8], nsn[8];
                if (i < 7) LD_TOK(tok + 1, nx, ncs, nsn);
#pragma unroll
                for (int part = 0; part < 3; ++part) {
                    bf16_t* p = (part < 2) ? (Q + (size_t)tok * 1024 + part * 512 + lane * 8) : (Kb + (size_t)tok * 256 + (lane & 31) * 8);
                    float v[8]; unpack8(cur[part], v);
                    float ss = 0.f;
#pragma unroll
                    for (int j = 0; j < 8; ++j) ss += v[j] * v[j];
                    ss += __shfl_xor(ss, 1); ss += __shfl_xor(ss, 2); ss += __shfl_xor(ss, 4); ss += __shfl_xor(ss, 8);
                    const float rstd = __builtin_amdgcn_rsqf(ss * (1.f / 128.f) + EPS);
                    float o[8];
#pragma unroll
                    for (int j = 0; j < 8; ++j) { const float y = v[j] * rstd * (part < 2 ? qg[j] : kg[j]); const float pr = __shfl_xor(y, 4);
                        o[j] = y * cs[j] + (second ? pr : -pr) * sn[j]; }
                    if (part < 2 || lane < 32) *(u32x4*)p = pack8(o);
                }
                if (i < 7) {
#pragma unroll
                    for (int part = 0; part < 3; ++part) cur[part] = nx[part];
#pragma unroll
                    for (int j = 0; j < 8; ++j) { cs[j] = ncs[j]; sn[j] = nsn[j]; } }
            }
#undef LD_TOK
        }
    }
}

__device__ __forceinline__ void phase_scan_a(KArgs a, unsigned char* wsb, int lane, int wave, int bid, int G) {
    unsigned char* ws = wsb;
    const int gw = bid * 8 + wave, NGW = G * 8;
    for (int it = gw; it < 2048; it += NGW) {
        const int c = it >> 4, dir = (it >> 3) & 1, ch = (it & 7) * 128 + lane * 2;
        const bf16_t* LA = (const bf16_t*)(ws + WS_LA + (size_t)dir * 64 * MiB) + ch;
        const bf16_t* UU = (const bf16_t*)(ws + WS_U + (size_t)dir * 64 * MiB) + ch;
        float s0 = 0.f, s1 = 0.f, h0 = 0.f, h1 = 0.f;
#pragma unroll 16
        for (int st = 0; st < 128; ++st) { const int t = dir == 0 ? c * 128 + st : c * 128 + 127 - st;
            const unsigned wl = *(const unsigned*)(LA + (size_t)t * 1024), wu = *(const unsigned*)(UU + (size_t)t * 1024);
            const float l0 = __uint_as_float(wl << 16), l1 = __uint_as_float(wl & 0xffff0000u);
            const float u0 = __uint_as_float(wu << 16), u1 = __uint_as_float(wu & 0xffff0000u);
            h0 = __builtin_amdgcn_exp2f(l0) * h0 + u0; h1 = __builtin_amdgcn_exp2f(l1) * h1 + u1; s0 += l0; s1 += l1; }
        *(f32x2*)((float*)(ws + WS_SA) + (c * 2 + dir) * 1024 + ch) = (f32x2){s0, s1};
        *(f32x2*)((float*)(ws + WS_SH) + (c * 2 + dir) * 1024 + ch) = (f32x2){h0, h1};
    }
}
__device__ __forceinline__ void phase_scan_c(unsigned char* wsb, LAS unsigned char* lds, int lane, int wave, int bid, int G) {
    unsigned char* ws = wsb;
    const int gw = bid * 8 + wave, NGW = G * 8;
    const float* __restrict__ SA = (const float*)(ws + WS_SA); const float* __restrict__ SH = (const float*)(ws + WS_SH);
    for (int it = gw; it < 2048; it += NGW) {
        const int c = it >> 4, ch = (it & 15) * 64 + lane;
        float cf = 0.f, cb = 0.f;
#pragma unroll 8
        for (int sidx = 0; sidx < c; ++sidx) { const int idx = (sidx * 2) * 1024 + ch; cf = __builtin_amdgcn_exp2f(SA[idx]) * cf + SH[idx]; }
#pragma unroll 8
        for (int sidx = 127; sidx > c; --sidx) { const int idx = (sidx * 2 + 1) * 1024 + ch; cb = __builtin_amdgcn_exp2f(SA[idx]) * cb + SH[idx]; }
        const bf16_t* __restrict__ LAf = (const bf16_t*)(ws + WS_LA) + ch; const bf16_t* __restrict__ UUf = (const bf16_t*)(ws + WS_U) + ch;
        const bf16_t* __restrict__ LAb = (const bf16_t*)(ws + WS_LA + 64 * MiB) + ch; const bf16_t* __restrict__ UUb = (const bf16_t*)(ws + WS_U + 64 * MiB) + ch;
        const bf16_t* __restrict__ SGA = (const bf16_t*)(ws + WS_SGA) + ch; bf16_t* __restrict__ YA = (bf16_t*)(ws + WS_XA) + ch;
        LAS bf16_t* hfs = (LAS bf16_t*)(lds + wave * 16384) + lane;
        float h = cf;
        { const bf16_t* pl = LAf + (size_t)c * 128 * 1024; const bf16_t* pu = UUf + (size_t)c * 128 * 1024;
#pragma unroll 1
            for (int blk = 0; blk < 8; ++blk) {
                float l[16], u[16];
#pragma unroll
                for (int i = 0; i < 16; ++i) { l[i] = bf2f(pl[i * 1024]); u[i] = bf2f(pu[i * 1024]); }
#pragma unroll
                for (int i = 0; i < 16; ++i) { h = __builtin_amdgcn_exp2f(l[i]) * h + u[i]; hfs[(blk * 16 + i) * 64] = (bf16_t)f2bf(h); }
                pl += 16 * 1024; pu += 16 * 1024; } }
        h = cb;
        { const size_t e0 = (size_t)(c * 128 + 112) * 1024;
            const bf16_t* pl = LAb + e0; const bf16_t* pu = UUb + e0; const bf16_t* pg = SGA + e0; bf16_t* py = YA + e0;
#pragma unroll 1
            for (int blk = 7; blk >= 0; --blk) {
                float l[16], u[16], g[16];
#pragma unroll
                for (int i = 0; i < 16; ++i) { l[i] = bf2f(pl[i * 1024]); u[i] = bf2f(pu[i * 1024]); g[i] = bf2f(pg[i * 1024]); }
#pragma unroll
                for (int i = 15; i >= 0; --i) { h = __builtin_amdgcn_exp2f(l[i]) * h + u[i];
                    py[i * 1024] = (bf16_t)f2bf((bf2f(hfs[(blk * 16 + i) * 64]) + h) * g[i]); }
                pl -= 16 * 1024; pu -= 16 * 1024; pg -= 16 * 1024; py -= 16 * 1024; } }
    }
}

__global__ void __launch_bounds__(512, 2) mk_fwd(Args args) {
    extern __shared__ __attribute__((aligned(16))) unsigned char lds[];
    cg::grid_group grid = cg::this_grid();
    LAS unsigned char* L = (LAS unsigned char*)lds;
    if (threadIdx.x < 2) ((LAS unsigned*)(L + 131072))[threadIdx.x] = 0u;
    __syncthreads();
    (void)xcd_barrier_post((unsigned*)(args.ws + WS_BAR), (volatile LAS unsigned*)(L + 131072));
    const int wave_u = __builtin_amdgcn_readfirstlane(threadIdx.x >> 6);
    for (int ph = args.ph_lo; ph < args.ph_hi; ++ph) {
        int tid; { int ln_; asm volatile("v_mbcnt_lo_u32_b32 %0, -1, 0\n\tv_mbcnt_hi_u32_b32 %0, -1, %0" : "=v"(ln_)); tid = wave_u * 64 + ln_; }
        int G = gridDim.x, bid = blockIdx.x; asm volatile("" : "+s"(G), "+s"(bid));
        KArgs ap = (KArgs)__builtin_amdgcn_kernarg_segment_ptr(); asm volatile("" : "+s"(ap));
        GAS unsigned char* wsg = (GAS unsigned char*)ap->ws; asm volatile("" : "+s"(wsg));
        unsigned char* ws = (unsigned char*)wsg;
        const int lane = tid & 63, wave = __builtin_amdgcn_readfirstlane(tid >> 6);
        unsigned long long pt0 = 0; int pcls = -1; if (PROBE_K >= 0) pt0 = __builtin_amdgcn_s_memrealtime();
        if (ph == 0) { pcls = 8; if (PHM & 512) phase_prologue(ap, ws, L, tid, lane, wave, bid, G); }
        else {
            const int q = ph - 1, lb = q / NPH_PER, k = q - lb * NPH_PER, l = lb >> 1, b = lb & 1; pcls = k;
            if (k == 0) { if (PHM & 1) phase_h(ap, ws, l, b, lane, wave, bid, G); }
            else if (k == 1) { if (PHM & 2) {
                pg8::Gemm g{(const bf16_t*)(ws + WS_H), (const bf16_t*)(ws + WS_WIN) + (size_t)l * NIN * 1024, 1024, 1024, 1024, 0, 0};
                pg8::StaticOrder S; S.init(SEQ, NIN, G, bid);
                pg8::EpiInProj E{ws};
                pg8::gemm_phase<pg8::EpiInProj, pg8::StaticOrder, 0>(L, g, S, E, tid); }
            } else if (k == 2) { if (PHM & 4) phase_elem(ap, ws, l, lane, wave, bid, G); }
            else if (k == 3) {
                if (PHM & 8) {
                    pg8::Gemm g{(const bf16_t*)(ws + WS_H), (const bf16_t*)(ws + WS_WG) + (size_t)l * 4096 * 256, 1024, 256, 256, 0, 0};
                    pg8::StaticOrder S; S.init(SEQ, 4096, G, bid);
                    pg8::EpiGates E{ws, INP(ap, I_BRG) + l * 2048, INP(ap, I_BIG) + l * 2048, INP(ap, I_LAM) + l * 2048};
                    pg8::gemm_phase<pg8::EpiGates, pg8::StaticOrder, 1>(L, g, S, E, tid);
                }
                if (PROBE_K == 3) { const unsigned long long t1 = __builtin_amdgcn_s_memrealtime(), dt = t1 - pt0; while (__builtin_amdgcn_s_memrealtime() - t1 < dt) __builtin_amdgcn_s_sleep(8); }
                if (PROBE_K == 9) { pt0 = __builtin_amdgcn_s_memrealtime(); pcls = 9; }
                if (PHM & 256) {
                    const int v = (G % 8 == 0) ? (bid % 8) * (G / 8) + bid / 8 : bid;
                    const int per = (512 + G - 1) / G;
                    for (int i = 0; i < per; ++i) { const int idx = v * per + i; if (idx >= 512) break;
                        const int h = idx >> 6, qb = idx & 63, kvh = h >> 2;
                        const attn::bf16* Qb = (const attn::bf16*)(ws + WS_Q) + (size_t)qb * 256 * 1024 + h * 128;
                        const attn::bf16* Kh = (const attn::bf16*)(ws + WS_K) + kvh * 128;
                        const attn::bf16* Vh = (const attn::bf16*)(ws + WS_V) + kvh * 128;
                        bf16_t* Ob = (bf16_t*)(ws + WS_SGB) + (size_t)qb * 256 * 1024 + h * 128;
                        const bf16_t* Gb = (const bf16_t*)(ws + WS_SGB) + (size_t)qb * 256 * 1024 + h * 128;
                        attn::attn_pp_body(Qb, Kh, Vh, Ob, Gb, SEQ, (char*)lds, tid);
                    }
                }
            } else if (k == 4) { if (PHM & 16) phase_scan_a(ap, ws, lane, wave, bid, G); }
            else if (k == 5) { if (PHM & 32) phase_scan_c(ws, L, lane, wave, bid, G); }
            else if (k == 6) { if (PHM & 64) {
                pg8::Gemm g{(const bf16_t*)(ws + WS_XA), (const bf16_t*)(ws + WS_WBR) + (size_t)l * 3 * 1048576, 1024, 1024, 1024,
                            (long)WS_SGB - (long)WS_XA, (long)WS_YC - (long)WS_XA};
                pg8::BranchOrder S; S.so.init(SEQ, 1024, G, bid);
                pg8::EpiBranch E{ws};
                pg8::gemm_phase<pg8::EpiBranch, pg8::BranchOrder, 2>(L, g, S, E, tid); }
            } else if (PHM & 128) {
                pg8::Gemm g{(const bf16_t*)(ws + WS_SGA), (const bf16_t*)(ws + WS_WOUT) + (size_t)l * 1048576, 1024, 1024, 1024, 0, 0};
                pg8::StaticOrder S; S.init(SEQ, 1024, G, bid);
                const float* xi = (l == 0 ? INP(ap, I_X) : OUTP(ap)) + (size_t)b * SEQ * DM;
                pg8::EpiOut E{xi, OUTP(ap) + (size_t)b * SEQ * DM, (const float*)(ws + WS_MOD) + (l * 2 + b) * 3072 + 2048};
                pg8::gemm_phase<pg8::EpiOut, pg8::StaticOrder, 0>(L, g, S, E, tid);
            }
        }
        if (PROBE_K >= 0 && PROBE_K != 3 && ph + 1 == args.ph_hi && pcls == PROBE_K) { VM_WAIT(); __syncthreads(); const unsigned long long t1 = __builtin_amdgcn_s_memrealtime(), dt = t1 - pt0; while (__builtin_amdgcn_s_memrealtime() - t1 < dt) __builtin_amdgcn_s_sleep(8); }
        if (ph + 1 < args.ph_hi) { if (ph == args.ph_lo) grid.sync(); else { XcdBarrier xbar; xbar.bar = (unsigned*)(ws + WS_BAR); xbar.x = xb_xcc_id(); xbar.st = (volatile LAS unsigned*)(L + 131072); xcd_barrier(xbar, tid); }
            if (PROBE_K >= 0 && PROBE_K != 3 && pcls == PROBE_K) { const unsigned long long t1 = __builtin_amdgcn_s_memrealtime(), dt = t1 - pt0; while (__builtin_amdgcn_s_memrealtime() - t1 < dt) __builtin_amdgcn_s_sleep(8); } }
    }
}

extern "C" void kernel_launch(void* const* d_in, const int* in_sizes, int n_in, void* d_out, int out_size, void* d_ws, size_t ws_size, hipStream_t stream) {
    static int grid = 0;
    if (grid == 0) {
        if (n_in != 18 || ws_size < WS_END) { fprintf(stderr, "kernel_launch: need 18 inputs and >= %zu bytes of workspace (got %d, %zu)\n", (size_t)WS_END, n_in, ws_size); grid = -1; return; }
        int dev = 0, cus = 0, per_cu = 0;
        hipGetDevice(&dev);
        hipDeviceGetAttribute(&cus, hipDeviceAttributeMultiprocessorCount, dev);
        if (hipFuncSetAttribute((const void*)mk_fwd, hipFuncAttributeMaxDynamicSharedMemorySize, LDS_BYTES) != hipSuccess) { fprintf(stderr, "kernel_launch: hipFuncSetAttribute failed\n"); grid = -1; return; }
        if (hipOccupancyMaxActiveBlocksPerMultiprocessor(&per_cu, (const void*)mk_fwd, 512, LDS_BYTES) != hipSuccess || per_cu < 1) { fprintf(stderr, "kernel_launch: occupancy query gave %d\n", per_cu); per_cu = 1; }
        (void)hipGetLastError();
        grid = cus * 1;
    }
    if (grid < 0) return;
    if (hipMemsetAsync((char*)d_ws + WS_BAR, 0, 16384, stream) != hipSuccess) { fprintf(stderr, "kernel_launch: memset failed\n"); return; }
    Args a{};
    for (int i = 0; i < 18; ++i) a.in[i] = (const float*)d_in[i];
    a.out = (float*)d_out; a.ws = (unsigned char*)d_ws; a.ph_lo = 0; a.ph_hi = NPHASES;
    void* kargs[] = {&a};
    hipError_t e = hipLaunchCooperativeKernel((const void*)mk_fwd, dim3(grid), dim3(512), kargs, LDS_BYTES, stream);
    if (e != hipSuccess) fprintf(stderr, "kernel_launch: cooperative launch failed: %s (grid %d)\n", hipGetErrorString(e), grid);
}
```

```cpp
#include <hip/hip_runtime.h>
#include <hip/hip_cooperative_groups.h>
#include <hip/hip_bf16.h>
#include <cstdio>
#include <cstdint>
namespace cg = cooperative_groups;
#ifndef PROBE_F8
#define PROBE_F8 0
#endif

#define LAS __attribute__((address_space(3)))
#define GAS __attribute__((address_space(1)))
typedef unsigned short bf16_t;
typedef short bf16x8 __attribute__((ext_vector_type(8)));
typedef float f32x4 __attribute__((ext_vector_type(4)));
typedef float f32x2 __attribute__((ext_vector_type(2)));
typedef unsigned u32x4 __attribute__((ext_vector_type(4)));
typedef unsigned u32x2 __attribute__((ext_vector_type(2)));

constexpr int DM = 1024, SEQ = 16384, NBATCH = 2, DEPTH = 2, NIN = 11776;
constexpr int NPH_PER = 8, NPHASES = 1 + DEPTH * NBATCH * NPH_PER;
constexpr float EPS = 1e-6f;
constexpr float LOG2E = 1.4426950408889634f;

constexpr size_t MiB = 1u << 20;
constexpr size_t WS_MOD = 0;
constexpr size_t WS_ROPE = 64 * 1024;
constexpr size_t WS_BAR = 256 * 1024;
constexpr size_t WS_SA = 1 * MiB, WS_SH = 2 * MiB;
constexpr size_t WS_WIN = 4 * MiB, WS_WG = 50 * MiB, WS_WBR = 54 * MiB, WS_WOUT = 66 * MiB;
constexpr size_t WS_H = 70 * MiB;
constexpr size_t WS_XA = 102 * MiB;
constexpr size_t WS_SGA = 134 * MiB;
constexpr size_t WS_Q = 166 * MiB;
constexpr size_t WS_K = 198 * MiB, WS_V = 206 * MiB;
constexpr size_t WS_SGB = 214 * MiB;
constexpr size_t WS_XC = 246 * MiB, WS_BC = 278 * MiB, WS_CC = 310 * MiB, WS_SGC = 342 * MiB;
constexpr size_t WS_LA = WS_XC, WS_U = WS_BC;
constexpr size_t WS_SMG = 374 * MiB;
constexpr size_t WS_YC = 470 * MiB;
constexpr size_t WS_K8 = 502 * MiB, WS_V8 = 506 * MiB;
constexpr size_t WS_SPARE = 510 * MiB;
constexpr size_t WS_FLAG = WS_BAR + 15 * 1024;
constexpr size_t WS_END = 512 * MiB;
constexpr int LDS_BYTES = 131072 + 1024;

__device__ __forceinline__ float bf2f(bf16_t v) { return __uint_as_float((unsigned)v << 16); }
__device__ __forceinline__ unsigned f2bf(float f) { unsigned u = __float_as_uint(f); return (u + 0x7fffu + ((u >> 16) & 1u)) >> 16; }
__device__ __forceinline__ unsigned cvt_pk_bf16(float lo, float hi) { unsigned r; asm("v_cvt_pk_bf16_f32 %0, %1, %2" : "=v"(r) : "v"(lo), "v"(hi)); return r; }
__device__ __forceinline__ void unpack8(const u32x4 w, float (&f)[8]) {
#pragma unroll
    for (int i = 0; i < 4; ++i) { f[2 * i] = __uint_as_float(w[i] << 16); f[2 * i + 1] = __uint_as_float(w[i] & 0xffff0000u); }
}
__device__ __forceinline__ u32x4 pack8(const float (&f)[8]) {
    u32x4 w; w.x = cvt_pk_bf16(f[0], f[1]); w.y = cvt_pk_bf16(f[2], f[3]); w.z = cvt_pk_bf16(f[4], f[5]); w.w = cvt_pk_bf16(f[6], f[7]); return w;
}
typedef int i32x8 __attribute__((ext_vector_type(8)));
__device__ __forceinline__ int pk4_fp8(float a, float b, float c, float d) { int r = __builtin_amdgcn_cvt_pk_fp8_f32(a, b, 0, false); return __builtin_amdgcn_cvt_pk_fp8_f32(c, d, r, true); }
__device__ __forceinline__ float sigmoidf_(float v) { return __builtin_amdgcn_rcpf(1.f + __expf(-v)); }
__device__ __forceinline__ float wave_sum(float v) {
#pragma unroll
    for (int o = 1; o < 64; o <<= 1) v += __shfl_xor(v, o);
    return v;
}
#define LDS_WAIT() asm volatile("s_waitcnt lgkmcnt(0)" ::: "memory")
#define VM_WAIT() asm volatile("s_waitcnt vmcnt(0)" ::: "memory")

namespace pg8 {
constexpr int BM = 256, BK = 64, HALF = 128, HTB = HALF * BK * 2, STAGE_BYTES = 8 * HTB, NXCD = 8, WGM = 8;
__device__ __forceinline__ int lds_byte(int r, int c) { const int st = (r >> 4) * 2 + (c >> 5), rr = r & 15, cc = c & 31, ob = rr * 64 + cc * 2; return st * 1024 + (ob ^ (((ob >> 9) & 1) << 5)); }
__device__ __forceinline__ void stage_rc(int b, int& R, int& C) { const int st = b / 1024, sb = b % 1024, swz = sb ^ (((sb >> 9) & 1) << 5); R = (st >> 1) * 16 + swz / 64; C = (st & 1) * 32 + (swz % 64) / 2; }
__device__ __forceinline__ int perm32(int rho) { const int n = rho >> 4, i = rho & 15; return 8 * (i >> 2) + 4 * n + (i & 3); }

struct Unit { int pm, pn, kk; };
struct Gemm { const bf16_t* A; const bf16_t* Bt; int lda, ldb, K; long a1, a2; };

struct StaticOrder {
    int nM, nN, nwg, G, c;
    __device__ void init(int M, int N, int G_, int c_) { nM = M / BM; nN = N / BM; nwg = nM * nN; G = G_; c = c_; }
    __device__ bool next(int i, Unit& u) const {
        const long L = (long)i * G + c; if (L >= nwg) return false;
        int wgid = (int)L; { const int q = nwg / NXCD, r = nwg % NXCD, xcd = wgid % NXCD, off = wgid / NXCD; wgid = (xcd < r ? xcd * (q + 1) : r * (q + 1) + (xcd - r) * q) + off; }
        const int nig = WGM * nN, gid = wgid / nig, fm = gid * WGM, gsz = (nM - fm) < WGM ? (nM - fm) : WGM;
        u.pm = fm + ((wgid % nig) % gsz); u.pn = (wgid % nig) / gsz; u.kk = 0; return true;
    }
};
struct BranchOrder {
    StaticOrder so;
    __device__ bool next(int i, Unit& u) const { const int ti = i / 3, kk = i - 3 * ti; if (!so.next(ti, u)) return false; u.kk = kk; return true; }
};

template <int MODE> __device__ __forceinline__ const char* unitA(const Gemm& g, const Unit& u) {
    const char* p = (const char*)g.A + (size_t)u.pm * BM * g.lda * 2;
    if (MODE == 1) p += (((u.pn >> 1) & 3) * 256) * 2;
    if (MODE == 2) p += (u.kk == 1 ? g.a1 : (u.kk == 2 ? g.a2 : 0l));
    return p;
}
template <int MODE> __device__ __forceinline__ const char* unitB(const Gemm& g, const Unit& u) {
    const char* p = (const char*)g.Bt + (size_t)u.pn * BM * g.ldb * 2;
    if (MODE == 2) p += (size_t)u.kk * 1024 * 1024 * 2;
    return p;
}

template <class Epi, class Sched, int MODE>
__device__ __forceinline__ void gemm_phase(LAS unsigned char* lds, const Gemm g, const Sched& S, const Epi& E, const int tid) {
    const int wid = __builtin_amdgcn_readfirstlane(tid >> 6), lane = tid & 63, wr = wid >> 2, wc = wid & 3, fr = lane & 15, fq = lane >> 4;
    const int K = g.K, nt = K / BK;
    unsigned voffA[2], voffB[2];
#pragma unroll
    for (int i = 0; i < 2; ++i) { int R, C; stage_rc(tid * 16 + i * 8192, R, C); const int Rb = (R & ~31) + perm32(R & 31);
        voffA[i] = (unsigned)(R * g.lda + C) * 2u; voffB[i] = (unsigned)(Rb * g.ldb + C) * 2u; }
    const size_t kstep = (size_t)(BK * 2);
    const size_t hstepA = (size_t)HALF * g.lda * 2, hstepB = (size_t)HALF * g.ldb * 2;
    const unsigned ldsw = (unsigned)wid * 1024u;
    const int aoff = lds_byte(wr * 64 + fr, fq * 8), boff = lds_byte(wc * 32 + fr, fq * 8);
#define PG8_SA(b, h) (((b) * 2 + (h)) * HTB)
#define PG8_SB(b, h) ((4 + (b) * 2 + (h)) * HTB)
#define PG8_STAGE(bufoff, gbase, voff) do { _Pragma("unroll") for (int _i = 0; _i < 2; ++_i) \
        __builtin_amdgcn_global_load_lds((const unsigned*)((const char*)(gbase) + (voff)[_i]), (LAS unsigned*)(lds + (bufoff) + ldsw + _i * 8192), 16, 0, 0); } while (0)
#define PG8_LDA(dst, b, h) do { _Pragma("unroll") for (int m = 0; m < 4; ++m) _Pragma("unroll") for (int k = 0; k < 2; ++k) dst[m][k] = *(const LAS bf16x8*)(lds + PG8_SA(b, h) + aoff + m * 2048 + k * 1024); } while (0)
#define PG8_LDB(dst, b, h) do { _Pragma("unroll") for (int n = 0; n < 2; ++n) _Pragma("unroll") for (int k = 0; k < 2; ++k) dst[n][k] = *(const LAS bf16x8*)(lds + PG8_SB(b, h) + boff + n * 2048 + k * 1024); } while (0)
#define PG8_MMA(ai, bj, At, Bt) do { __builtin_amdgcn_s_setprio(1); _Pragma("unroll") for (int m = 0; m < 4; ++m) _Pragma("unroll") for (int n = 0; n < 2; ++n) _Pragma("unroll") for (int k = 0; k < 2; ++k) \
        acc[ai][bj][m][n] = __builtin_amdgcn_mfma_f32_16x16x32_bf16(Bt[n][k], At[m][k], acc[ai][bj][m][n], 0, 0, 0); __builtin_amdgcn_s_setprio(0); } while (0)
#define PG8_WAIT_V(n) asm volatile("s_waitcnt vmcnt(" #n ")" ::: "memory")
#define PG8_WAIT_L(n) asm volatile("s_waitcnt lgkmcnt(" #n ")" ::: "memory")
#define PG8_BAR __builtin_amdgcn_s_barrier()
#define PG8_SCHED __builtin_amdgcn_sched_barrier(0)
    Unit cur, nxt; int ui = 0;
    if (!S.next(0, cur)) return;
    f32x4 acc[2][2][4][2];
#pragma unroll
    for (int a = 0; a < 2; ++a)
#pragma unroll
        for (int b = 0; b < 2; ++b)
#pragma unroll
            for (int m = 0; m < 4; ++m)
#pragma unroll
                for (int n = 0; n < 2; ++n) acc[a][b][m][n] = (f32x4){0.f, 0.f, 0.f, 0.f};
    bf16x8 At[4][2], B0[2][2], B1[2][2];
    const char* cA = unitA<MODE>(g, cur); const char* cB = unitB<MODE>(g, cur);
    PG8_STAGE(PG8_SB(0, 0), cB, voffB); PG8_STAGE(PG8_SB(0, 1), cB + hstepB, voffB); PG8_STAGE(PG8_SA(0, 0), cA, voffA); PG8_STAGE(PG8_SA(0, 1), cA + hstepA, voffA);
    if (wr == 1) PG8_BAR;
    PG8_WAIT_V(2); PG8_BAR;
    PG8_STAGE(PG8_SB(1, 0), cB + kstep, voffB); PG8_STAGE(PG8_SA(1, 0), cA + kstep, voffA); PG8_STAGE(PG8_SB(1, 1), cB + hstepB + kstep, voffB);
    PG8_WAIT_V(6); PG8_BAR;
    for (;;) {
        const bool has_next = S.next(ui + 1, nxt);
        const char* nA = has_next ? unitA<MODE>(g, nxt) : cA; const char* nB = has_next ? unitB<MODE>(g, nxt) : cB;
#pragma nounroll
        for (int t = 0; t < nt; t += 2) {
            const bool last = (t == nt - 2);
            const char* a1 = cA + (size_t)(t + 1) * kstep;
            const char* a2 = last ? nA : cA + (size_t)(t + 2) * kstep; const char* b2 = last ? nB : cB + (size_t)(t + 2) * kstep;
            const char* a3 = a2 + kstep; const char* b3 = b2 + kstep;
            PG8_LDB(B0, 0, 0); PG8_LDB(B1, 0, 1); PG8_SCHED; PG8_LDA(At, 0, 0); PG8_STAGE(PG8_SA(1, 1), a1 + hstepA, voffA);
            PG8_WAIT_V(8); PG8_WAIT_L(0); PG8_BAR; PG8_MMA(0, 0, At, B0); PG8_MMA(0, 1, At, B1); PG8_BAR; PG8_SCHED;
            PG8_LDA(At, 0, 1); PG8_STAGE(PG8_SB(0, 0), b2, voffB); PG8_STAGE(PG8_SB(0, 1), b2 + hstepB, voffB); PG8_STAGE(PG8_SA(0, 0), a2, voffA);
            PG8_WAIT_V(8); PG8_WAIT_L(0); PG8_BAR; PG8_MMA(1, 0, At, B0); PG8_MMA(1, 1, At, B1); PG8_BAR; PG8_SCHED;
            PG8_LDB(B0, 1, 0); PG8_LDB(B1, 1, 1); PG8_SCHED; PG8_LDA(At, 1, 0); PG8_STAGE(PG8_SA(0, 1), a2 + hstepA, voffA);
            PG8_WAIT_V(8); PG8_WAIT_L(0); PG8_BAR; PG8_MMA(0, 0, At, B0); PG8_MMA(0, 1, At, B1); PG8_BAR; PG8_SCHED;
            PG8_LDA(At, 1, 1); PG8_STAGE(PG8_SB(1, 0), b3, voffB); PG8_STAGE(PG8_SB(1, 1), b3 + hstepB, voffB); PG8_STAGE(PG8_SA(1, 0), a3, voffA);
            PG8_WAIT_V(8); PG8_WAIT_L(0); PG8_BAR; PG8_MMA(1, 0, At, B0); PG8_MMA(1, 1, At, B1); PG8_BAR; PG8_SCHED;
        }
        if (wr == 0) PG8_BAR;
        E(acc, cur, wr, wc, fr, fq);
        if (!has_next) break;
#pragma unroll
        for (int a = 0; a < 2; ++a)
#pragma unroll
            for (int b = 0; b < 2; ++b)
#pragma unroll
                for (int m = 0; m < 4; ++m)
#pragma unroll
                    for (int n = 0; n < 2; ++n) acc[a][b][m][n] = (f32x4){0.f, 0.f, 0.f, 0.f};
        cur = nxt; cA = nA; cB = nB; ++ui;
        if (wr == 1) PG8_BAR;
    }
    PG8_WAIT_V(0);
    PG8_BAR;
#undef PG8_SA
#undef PG8_SB
#undef PG8_STAGE
#undef PG8_LDA
#undef PG8_LDB
#undef PG8_MMA
#undef PG8_WAIT_V
#undef PG8_WAIT_L
#undef PG8_BAR
#undef PG8_SCHED
}

__device__ __forceinline__ void store_tile_bf16(const f32x4 (&acc)[2][2][4][2], bf16_t* base, int ldc, int row0, int col0, int act) {
#pragma unroll
    for (int ai = 0; ai < 2; ++ai)
#pragma unroll
        for (int m = 0; m < 4; ++m) { bf16_t* rowp = base + (size_t)(row0 + ai * HALF + m * 16) * ldc + col0;
#pragma unroll
            for (int bj = 0; bj < 2; ++bj) { float v[8];
#pragma unroll
                for (int j = 0; j < 4; ++j) { v[j] = acc[ai][bj][m][0][j]; v[4 + j] = acc[ai][bj][m][1][j]; }
                if (act != 0) {
                    float sg[8];
#pragma unroll
                    for (int j = 0; j < 8; ++j) sg[j] = sigmoidf_(v[j]);
                    if (act == 1) {
#pragma unroll
                        for (int j = 0; j < 8; ++j) v[j] *= sg[j];
                    } else {
#pragma unroll
                        for (int j = 0; j < 8; ++j) v[j] = sg[j];
                    }
                }
                *(u32x4*)(rowp + bj * HALF) = pack8(v); }
            asm volatile("" ::: "memory"); }
}
struct EpiInProj {
    unsigned char* ws;
    __device__ __forceinline__ void operator()(const f32x4 (&acc)[2][2][4][2], const Unit& u, int wr, int wc, int fr, int fq) const {
        const int pn = u.pn; size_t off; int ldc = 1024, col, act = 0;
        if (pn < 4) { off = WS_XA; col = pn * 256; }
        else if (pn < 8) { off = WS_SGA; col = (pn - 4) * 256; act = 1; }
        else if (pn < 12) { off = WS_Q; col = (pn - 8) * 256; }
        else if (pn == 12) { off = WS_K; col = 0; ldc = 256; }
        else if (pn == 13) { off = WS_V; col = 0; ldc = 256; }
        else if (pn < 18) { off = WS_SGB; col = (pn - 14) * 256; act = 1; }
        else if (pn < 34) {
            const bool bg = pn >= 26; const int blk = bg ? pn - 26 : pn - 18;
            bf16_t* basep = (bf16_t*)(ws + (bg ? WS_BC : WS_XC));
            const int row0p = u.pm * BM + wr * 64 + fr, col0p = blk * 128 + wc * 32 + 8 * fq;
#pragma unroll
            for (int ai = 0; ai < 2; ++ai)
#pragma unroll
                for (int m = 0; m < 4; ++m) { float v[8];
#pragma unroll
                    for (int j = 0; j < 8; ++j) { const float x0 = acc[ai][0][m][j >> 2][j & 3], x1 = acc[ai][1][m][j >> 2][j & 3];
                        v[j] = bg ? x0 * (x1 * sigmoidf_(x1)) : x0 * x1; }
                    *(u32x4*)(basep + (size_t)(row0p + ai * HALF + m * 16) * 1024 + col0p) = pack8(v); }
            return; }
        else { off = WS_SMG; col = (pn - 34) * 256; ldc = 3072; act = 2; }
        bf16_t* base = (bf16_t*)(ws + off);
        const int row0 = u.pm * BM + wr * 64 + fr, col0 = col + wc * 32 + 8 * fq;
        store_tile_bf16(acc, base, ldc, row0, col0, act);
    }
};
struct EpiGates {
    unsigned char* ws; const float* b_r; const float* b_i; const float* lam;
    __device__ __forceinline__ void operator()(const f32x4 (&acc)[2][2][4][2], const Unit& u, int wr, int wc, int fr, int fq) const {
        const int dir = u.pn >> 3, nb = (u.pn >> 1) & 3, hh = u.pn & 1;
        const int ch0 = nb * 256 + hh * 128 + wc * 32 + 8 * fq;
        float br[8], bi[8], sp[8];
#pragma unroll
        for (int j = 0; j < 8; ++j) { br[j] = b_r[dir * 1024 + ch0 + j]; bi[j] = b_i[dir * 1024 + ch0 + j];
            const float lm = lam[dir * 1024 + ch0 + j]; const float e = __expf(-lm);
            const float spl = lm < -15.f ? -lm : (e < 0.03f ? e * (1.f - e * (0.5f - e * (0.33333334f - 0.25f * e))) : __logf(1.f + e));
            sp[j] = -8.0f * LOG2E * spl; }
        const bf16_t* UA = (const bf16_t*)(ws + WS_H);
        bf16_t* LA = (bf16_t*)(ws + WS_LA + (size_t)dir * 64 * MiB);
        bf16_t* UU = (bf16_t*)(ws + WS_U + (size_t)dir * 64 * MiB);
        const int row0 = u.pm * BM + wr * 64 + fr;
#pragma unroll
        for (int ai = 0; ai < 2; ++ai)
#pragma unroll
            for (int m = 0; m < 4; ++m) { const size_t o = (size_t)(row0 + ai * HALF + m * 16) * 1024 + ch0;
                float x[8]; unpack8(*(const u32x4*)(UA + o), x);
                float la[8], uu[8];
#pragma unroll
                for (int j = 0; j < 8; ++j) { const float pr = acc[ai][0][m][j >> 2][j & 3] + br[j], pi = acc[ai][1][m][j >> 2][j & 3] + bi[j];
                    const float r = sigmoidf_(pr), ig = sigmoidf_(pi);
                    const float l2 = r * sp[j]; const float a = __builtin_amdgcn_exp2f(l2);
                    la[j] = l2; uu[j] = __builtin_amdgcn_sqrtf(fmaxf(1.f - a * a, 0.f)) * ig * x[j]; }
                *(u32x4*)(LA + o) = pack8(la); *(u32x4*)(UU + o) = pack8(uu); }
    }
};
struct EpiBranch {
    unsigned char* ws;
    __device__ __forceinline__ void operator()(const f32x4 (&acc)[2][2][4][2], const Unit& u, int wr, int wc, int fr, int fq) const {
        const bf16_t* G = (const bf16_t*)(ws + WS_SMG) + u.kk * 1024;
        bf16_t* Mg = (bf16_t*)(ws + WS_SGA);
        const int row0 = u.pm * BM + wr * 64 + fr, col0 = u.pn * BM + wc * 32 + 8 * fq;
#pragma unroll
        for (int ai = 0; ai < 2; ++ai)
#pragma unroll
            for (int m = 0; m < 4; ++m) { const int row = row0 + ai * HALF + m * 16;
#pragma unroll
                for (int bj = 0; bj < 2; ++bj) { const int col = col0 + bj * HALF;
                    float gt[8], v[8]; unpack8(*(const u32x4*)(G + (size_t)row * 3072 + col), gt);
#pragma unroll
                    for (int j = 0; j < 8; ++j) v[j] = gt[j] * acc[ai][bj][m][j >> 2][j & 3];
                    bf16_t* mp = Mg + (size_t)row * 1024 + col;
                    if (u.kk != 0) { float old[8]; unpack8(*(const u32x4*)mp, old);
#pragma unroll
                        for (int j = 0; j < 8; ++j) v[j] += old[j]; }
                    *(u32x4*)mp = pack8(v); } }
    }
};
struct EpiOut {
    const float* xi; float* xo; const float* gate; const unsigned* flag;
    __device__ __forceinline__ void operator()(const f32x4 (&acc)[2][2][4][2], const Unit& u, int wr, int wc, int fr, int fq) const {
        const int row0 = u.pm * BM + wr * 64 + fr, col0 = u.pn * BM + wc * 32 + 8 * fq;
        const bool bad = PROBE_F8 ? (__hip_atomic_load(flag, __ATOMIC_RELAXED, __HIP_MEMORY_SCOPE_AGENT) != 0u) : false; const float qn = __builtin_nanf("");
        f32x4 gv[2][2];
#pragma unroll
        for (int bj = 0; bj < 2; ++bj)
#pragma unroll
            for (int n = 0; n < 2; ++n) gv[bj][n] = *(const f32x4*)(gate + col0 + bj * HALF + 4 * n);
#pragma unroll
        for (int ai = 0; ai < 2; ++ai)
#pragma unroll
            for (int m = 0; m < 4; ++m) { const size_t o = (size_t)(row0 + ai * HALF + m * 16) * 1024 + col0;
#pragma unroll
                for (int bj = 0; bj < 2; ++bj)
#pragma unroll
                    for (int n = 0; n < 2; ++n) { const f32x4 xv = *(const f32x4*)(xi + o + bj * HALF + 4 * n);
                        f32x4 r = xv + gv[bj][n] * acc[ai][bj][m][n]; if (PROBE_F8 && bad) r = (f32x4){qn, qn, qn, qn};
                        *(f32x4*)(xo + o + bj * HALF + 4 * n) = r; } }
    }
};
}

namespace attn {
using bf16 = __hip_bfloat16;
using s16x4 = __attribute__((ext_vector_type(4))) short;
using f32x16 = __attribute__((ext_vector_type(16))) float;
constexpr int D = 128, NW = 8, QBLK = 32, KVBLK = 64;
constexpr float SCALE = 0.088388347648318440f;
constexpr float THR = 8.f;
constexpr int LDQ = 1024, LDK = 256, LDO = 1024;
constexpr size_t SHM_V = KVBLK * D * 2, SHM_K = KVBLK * D * 2, SHM_ATTN = 2 * SHM_V + 2 * SHM_K + NW * 64 * 4;
#define KSWZ(row, colB) ((row) * 256 + ((colB) ^ (((row) & 7) << 4)))
#define SBAR() __builtin_amdgcn_sched_barrier(0)
__device__ __forceinline__ int crow(int r, int hi) { return (r & 3) + 8 * (r >> 2) + 4 * hi; }
__device__ __forceinline__ unsigned cvtpk(float lo, float hi) { unsigned r; asm volatile("v_cvt_pk_bf16_f32 %0, %1, %2" : "=v"(r) : "v"(lo), "v"(hi)); return r; }

__device__ __forceinline__ void partialSM(f32x16& p0, f32x16& p1, float& m_reg, float& mn, float& alpha) {
  constexpr float C = SCALE * 1.4426950408889634f;
  float pmax = p0[0]; for (int r = 1; r < 16; ++r) pmax = fmaxf(pmax, p0[r]); for (int r = 0; r < 16; ++r) pmax = fmaxf(pmax, p1[r]);
  { auto rr = __builtin_amdgcn_permlane32_swap(__float_as_uint(pmax), __float_as_uint(pmax), false, false);
    pmax = fmaxf(__uint_as_float(rr[0]), __uint_as_float(rr[1])); }
  if (__builtin_expect(__all(pmax - m_reg <= THR / SCALE), 1)) { mn = m_reg; alpha = 1.f; }
  else { mn = fmaxf(m_reg, pmax); alpha = __builtin_amdgcn_exp2f((m_reg - mn) * C); m_reg = mn; }
  float mnC = -mn * C;
  for (int r = 0; r < 16; ++r) p0[r] = fmaf(p0[r], C, mnC); for (int r = 0; r < 16; ++r) p1[r] = fmaf(p1[r], C, mnC);
  for (int r = 0; r < 16; ++r) p0[r] = __builtin_amdgcn_exp2f(p0[r]);
}
__device__ __forceinline__ void finishSM(f32x16& p0, f32x16& p1, float alpha, float& l_reg, bf16x8& pa0, bf16x8& pa1, bf16x8& pa2, bf16x8& pa3) {
  for (int r = 0; r < 16; ++r) p1[r] = __builtin_amdgcn_exp2f(p1[r]);
  float ps = 0; for (int r = 0; r < 16; ++r) ps += p0[r]; for (int r = 0; r < 16; ++r) ps += p1[r];
  { auto rr = __builtin_amdgcn_permlane32_swap(__float_as_uint(ps), __float_as_uint(ps), false, false);
    ps = __uint_as_float(rr[0]) + __uint_as_float(rr[1]); }
  l_reg = l_reg * alpha + ps;
#define PK4(P, BASE, OUT) do { unsigned a0 = cvtpk(P[BASE + 0], P[BASE + 1]), a1 = cvtpk(P[BASE + 2], P[BASE + 3]);   \
    unsigned b0 = cvtpk(P[BASE + 4], P[BASE + 5]), b1 = cvtpk(P[BASE + 6], P[BASE + 7]);                              \
    auto r0 = __builtin_amdgcn_permlane32_swap(a0, b0, false, false); auto r1 = __builtin_amdgcn_permlane32_swap(a1, b1, false, false); \
    u32x4 w = {r0[0], r1[0], r0[1], r1[1]}; OUT = *reinterpret_cast<bf16x8*>(&w); } while (0)
  PK4(p0, 0, pa0); PK4(p0, 8, pa1); PK4(p1, 0, pa2); PK4(p1, 8, pa3);
#undef PK4
}
__device__ __forceinline__ void qkt(f32x16& p0, f32x16& p1, const bf16* Ks, const bf16x8* qr, int r32, int hi) {
  p0 = f32x16{}; p1 = f32x16{};
  for (int d0 = 0; d0 < 8; ++d0) { int cb = (d0 * 16 + hi * 8) * 2;
    bf16x8 b0 = *reinterpret_cast<const bf16x8*>((const char*)Ks + KSWZ(r32, cb));
    bf16x8 b1 = *reinterpret_cast<const bf16x8*>((const char*)Ks + KSWZ(32 + r32, cb));
    p0 = __builtin_amdgcn_mfma_f32_32x32x16_bf16(b0, qr[d0], p0, 0, 0, 0);
    p1 = __builtin_amdgcn_mfma_f32_32x32x16_bf16(b1, qr[d0], p1, 0, 0, 0); }
}
__device__ __forceinline__ int v_st(int k, int c) { const int kk = (k & ~0xC) | ((k & 4) << 1) | ((k & 8) >> 1); return ((kk >> 3) * 4 + (c >> 5)) * 512 + ((kk & 7) * 32 + (c & 31)) * 2; }
__device__ __forceinline__ int v_rd_base(int lane) { return ((lane & 3) << 3) | (((lane >> 2) & 3) << 6) | (((lane >> 4) & 1) << 5) | (((lane >> 5) & 1) << 8); }
constexpr int v_rd_off(int d0, int ks, int half) { return d0 * 512 + ks * 4096 + half * 2048; }
template <int OFF> __device__ __forceinline__ s16x4 tr_read(int vb) {
  s16x4 r; asm volatile("ds_read_b64_tr_b16 %0, %1 offset:%2" : "=&v"(r) : "v"(vb), "i"(OFF) : "memory"); return r;
}
template <int D0> __device__ __forceinline__ void pv_one(f32x16& od, int vb, bf16x8 pa0, bf16x8 pa1, bf16x8 pa2, bf16x8 pa3) {
  const s16x4 l0 = tr_read<v_rd_off(D0, 0, 0)>(vb), h0 = tr_read<v_rd_off(D0, 0, 1)>(vb), l1 = tr_read<v_rd_off(D0, 1, 0)>(vb), h1 = tr_read<v_rd_off(D0, 1, 1)>(vb);
  const s16x4 l2 = tr_read<v_rd_off(D0, 2, 0)>(vb), h2 = tr_read<v_rd_off(D0, 2, 1)>(vb), l3 = tr_read<v_rd_off(D0, 3, 0)>(vb), h3 = tr_read<v_rd_off(D0, 3, 1)>(vb);
  asm volatile("s_waitcnt lgkmcnt(0)" ::: "memory"); SBAR();
#define PK(L, H) (bf16x8){L[0], L[1], L[2], L[3], H[0], H[1], H[2], H[3]}
  od = __builtin_amdgcn_mfma_f32_32x32x16_bf16(pa0, PK(l0, h0), od, 0, 0, 0);
  od = __builtin_amdgcn_mfma_f32_32x32x16_bf16(pa1, PK(l1, h1), od, 0, 0, 0);
  od = __builtin_amdgcn_mfma_f32_32x32x16_bf16(pa2, PK(l2, h2), od, 0, 0, 0);
  od = __builtin_amdgcn_mfma_f32_32x32x16_bf16(pa3, PK(l3, h3), od, 0, 0, 0);
#undef PK
}
__device__ __forceinline__ void pv_d0(f32x16* o, int vb, bf16x8 pa0, bf16x8 pa1, bf16x8 pa2, bf16x8 pa3) {
  pv_one<0>(o[0], vb, pa0, pa1, pa2, pa3); pv_one<1>(o[1], vb, pa0, pa1, pa2, pa3); pv_one<2>(o[2], vb, pa0, pa1, pa2, pa3); pv_one<3>(o[3], vb, pa0, pa1, pa2, pa3);
}
__device__ __forceinline__ void attn_dense_body(const bf16* Qb, const bf16* __restrict__ Kh, const bf16* __restrict__ Vh,
                                                bf16_t* Ob, const bf16_t* Gb, int seq, char* lds, const int tid) {
  const int wid = tid >> 6, lane = tid & 63, r32 = lane & 31, hi = lane >> 5;
  bf16* V_lds = (bf16*)lds; bf16* K_lds = (bf16*)(lds + 2 * SHM_V);
  float* ws = (float*)(lds + 2 * SHM_V + 2 * SHM_K) + wid * 64; float* li_l = ws; float* al_l = ws + 32;
  float m_reg = -1e30f, l_reg = 0; f32x16 o[4] = {}; bf16x8 qr[8];
  const bf16* Qw = Qb + (long)(wid * QBLK + r32) * LDQ + hi * 8;
#pragma unroll
  for (int d0 = 0; d0 < 8; ++d0) qr[d0] = *reinterpret_cast<const bf16x8*>(Qw + d0 * 16);
  const int sr = tid >> 4, sc = (tid & 15) * 8, vst0 = v_st(sr, sc), vst1 = v_st(32 + sr, sc);
  const int vb0 = (int)(uintptr_t)V_lds + v_rd_base(lane);
  struct { bf16x8 vs0, vs1, ks0, ks1; } sr_[2];
#define SLOAD(i, k0) do { sr_[i].vs0 = *reinterpret_cast<const bf16x8*>(&Vh[(long)((k0) + sr) * LDK + sc]); sr_[i].vs1 = *reinterpret_cast<const bf16x8*>(&Vh[(long)((k0) + 32 + sr) * LDK + sc]); \
    sr_[i].ks0 = *reinterpret_cast<const bf16x8*>(&Kh[(long)((k0) + sr) * LDK + sc]); sr_[i].ks1 = *reinterpret_cast<const bf16x8*>(&Kh[(long)((k0) + 32 + sr) * LDK + sc]); } while (0)
#define SWRITE(b, i) do { *(bf16x8*)((char*)V_lds + (b) * SHM_V + vst0) = sr_[i].vs0;          \
    *(bf16x8*)((char*)V_lds + (b) * SHM_V + vst1) = sr_[i].vs1; int kc = sc * 2;               \
    *(bf16x8*)((char*)K_lds + (b) * SHM_K + KSWZ(sr, kc)) = sr_[i].ks0;                       \
    *(bf16x8*)((char*)K_lds + (b) * SHM_K + KSWZ(32 + sr, kc)) = sr_[i].ks1; } while (0)
#define SWAIT() asm volatile("s_waitcnt vmcnt(4)" ::: "memory")
#define RESC(a) do { if (__any((a) < 1.f)) { if (hi == 0) al_l[r32] = (a); asm volatile("s_waitcnt lgkmcnt(0)" ::: "memory"); \
    for (int d = 0; d < 4; ++d) for (int r = 0; r < 16; ++r) o[d][r] *= al_l[crow(r, hi)]; } } while (0)
  f32x16 pA0, pA1, pB0, pB1; float mnA, mnB, alA, alB; bf16x8 pa0, pa1, pa2, pa3; const int NT = seq / KVBLK;
  constexpr int SE = 0, SO = 1;
  SLOAD(SE, 0); asm volatile("s_waitcnt vmcnt(0)" ::: "memory"); SWRITE(0, SE); __syncthreads();
  qkt(pA0, pA1, K_lds, qr, r32, hi); partialSM(pA0, pA1, m_reg, mnA, alA);
  SLOAD(SO, KVBLK); if (2 < NT) SLOAD(SE, 2 * KVBLK);
  SWAIT(); SWRITE(1, SO); __syncthreads();
#pragma nounroll
  for (int j = 1; j + 1 < NT; j += 2) {
    SBAR(); qkt(pB0, pB1, (bf16*)((char*)K_lds + SHM_K), qr, r32, hi);
    finishSM(pA0, pA1, alA, l_reg, pa0, pa1, pa2, pa3); SBAR();
    SLOAD(SO, (j + 2) * KVBLK); SBAR();
    pv_d0(o, vb0, pa0, pa1, pa2, pa3); partialSM(pB0, pB1, m_reg, mnB, alB);
    __syncthreads(); SWAIT(); SWRITE(0, SE);
    RESC(alB); __syncthreads();
    SBAR(); qkt(pA0, pA1, K_lds, qr, r32, hi);
    finishSM(pB0, pB1, alB, l_reg, pa0, pa1, pa2, pa3); SBAR();
    if (j + 3 < NT) SLOAD(SE, (j + 3) * KVBLK); SBAR();
    pv_d0(o, vb0 + (int)SHM_V, pa0, pa1, pa2, pa3); partialSM(pA0, pA1, m_reg, mnA, alA);
    __syncthreads(); SWAIT(); SWRITE(1, SO);
    RESC(alA); __syncthreads();
  }
  SBAR(); qkt(pB0, pB1, (bf16*)((char*)K_lds + SHM_K), qr, r32, hi);
  finishSM(pA0, pA1, alA, l_reg, pa0, pa1, pa2, pa3); SBAR();
  pv_d0(o, vb0, pa0, pa1, pa2, pa3); partialSM(pB0, pB1, m_reg, mnB, alB);
  __syncthreads(); RESC(alB);
  finishSM(pB0, pB1, alB, l_reg, pa0, pa1, pa2, pa3); SBAR();
  pv_d0(o, vb0 + (int)SHM_V, pa0, pa1, pa2, pa3);
  if (hi == 0) li_l[r32] = l_reg; asm volatile("s_waitcnt lgkmcnt(0)" ::: "memory");
  float rli[16];
#pragma unroll
  for (int r = 0; r < 16; ++r) rli[r] = __builtin_amdgcn_rcpf(li_l[crow(r, hi)]);
  __syncthreads();
  { int lane_e = lane, wid_e = wid; asm volatile("" : "+v"(lane_e), "+v"(wid_e)); wid_e = __builtin_amdgcn_readfirstlane(wid_e);
    bf16_t* stg = (bf16_t*)lds + wid_e * 4096;
#pragma unroll
    for (int r = 0; r < 16; ++r) { const int orow = crow(r, hi);
#pragma unroll
      for (int d0 = 0; d0 < 4; ++d0) stg[orow * 128 + d0 * 32 + r32] = (bf16_t)f2bf(o[d0][r] * rli[r]); }
    asm volatile("s_waitcnt lgkmcnt(0)" ::: "memory");
    bf16_t* Ow = Ob + (long)(wid_e * QBLK) * LDO; const bf16_t* Gw = Gb + (long)(wid_e * QBLK) * LDO;
    u32x4 gq[8];
#pragma unroll
    for (int i = 0; i < 8; ++i) { const int row = i * 4 + (lane_e >> 4), ch = lane_e & 15; gq[i] = *(const u32x4*)(Gw + (long)row * LDO + ch * 8); }
#pragma unroll
    for (int i = 0; i < 8; ++i) { const int row = i * 4 + (lane_e >> 4), ch = lane_e & 15;
      float ov[8], gv[8]; unpack8(*(const u32x4*)(stg + row * 128 + ch * 8), ov); unpack8(gq[i], gv);
#pragma unroll
      for (int j = 0; j < 8; ++j) ov[j] *= gv[j];
      *(u32x4*)(Ow + (long)row * LDO + ch * 8) = pack8(ov); } }
  __syncthreads();
#undef SLOAD
#undef SWRITE
#undef SWAIT
#undef RESC
}

__device__ __forceinline__ void attn_pp_body(const bf16* Qb, const bf16* __restrict__ Kh, const bf16* __restrict__ Vh,
                                             bf16_t* Ob, const bf16_t* Gb, int seq, char* lds, const int tid, const bf16_t* cmp = nullptr, unsigned* flag = nullptr) {
  const int wid = __builtin_amdgcn_readfirstlane(tid >> 6), lane = tid & 63, r32 = lane & 31, hi = lane >> 5;
  const int g = wid >> 2;
  constexpr int NB = 3;
  char* V_lds = lds; char* K_lds = lds + NB * SHM_V;
  float* ws = (float*)(lds + NB * (SHM_V + SHM_K)) + wid * 64; float* li_l = ws; float* al_l = ws + 32;
  float m_reg = -1e30f, l_reg = 0; f32x16 o[4] = {}; bf16x8 qr[8];
  const bf16* Qw = Qb + (long)(wid * QBLK + r32) * LDQ + hi * 8;
#pragma unroll
  for (int d0 = 0; d0 < 8; ++d0) qr[d0] = *reinterpret_cast<const bf16x8*>(Qw + d0 * 16);
  const int sr = tid >> 4, sc = (tid & 15) * 8, vst0 = v_st(sr, sc), vst1 = v_st(32 + sr, sc);
  const int ksw0 = KSWZ(sr, sc * 2), ksw1 = KSWZ(32 + sr, sc * 2);
  const int vbase = (int)(uintptr_t)V_lds + v_rd_base(lane);
  struct Stg { bf16x8 vs0, vs1, ks0, ks1; } st0, st1;
#define SLOAD(S, t) do { const long k0_ = (long)(t) * KVBLK; S.vs0 = *reinterpret_cast<const bf16x8*>(&Vh[(k0_ + sr) * LDK + sc]); S.vs1 = *reinterpret_cast<const bf16x8*>(&Vh[(k0_ + 32 + sr) * LDK + sc]); \
    S.ks0 = *reinterpret_cast<const bf16x8*>(&Kh[(k0_ + sr) * LDK + sc]); S.ks1 = *reinterpret_cast<const bf16x8*>(&Kh[(k0_ + 32 + sr) * LDK + sc]); } while (0)
#define SWRITE(S, b) do { *(bf16x8*)(V_lds + (b) * SHM_V + vst0) = S.vs0; *(bf16x8*)(V_lds + (b) * SHM_V + vst1) = S.vs1; \
    *(bf16x8*)(K_lds + (b) * SHM_K + ksw0) = S.ks0; *(bf16x8*)(K_lds + (b) * SHM_K + ksw1) = S.ks1; } while (0)
#define RESC(a) do { if (__any((a) < 1.f)) { if (hi == 0) al_l[r32] = (a); asm volatile("s_waitcnt lgkmcnt(0)" ::: "memory"); \
    for (int d = 0; d < 4; ++d) for (int r = 0; r < 16; ++r) o[d][r] *= al_l[crow(r, hi)]; } } while (0)
  const int NT = seq / KVBLK;
  f32x16 p0, p1; bf16x8 pa0, pa1, pa2, pa3;
#define SMX() do { float mn_, al_; partialSM(p0, p1, m_reg, mn_, al_); RESC(al_); finishSM(p0, p1, al_, l_reg, pa0, pa1, pa2, pa3); } while (0)
  SLOAD(st0, 0); if (g) SLOAD(st1, 1);
  SWRITE(st0, 0); if (g) SWRITE(st1, 1);
  SLOAD(st0, 1 + g); SLOAD(st1, 2 + g);
  __syncthreads();
  if (g) __syncthreads();
  SBAR(); qkt(p0, p1, (const bf16*)K_lds, qr, r32, hi); SBAR();
  __syncthreads();
  SWRITE(st0, 1 + g); if (3 + g < NT) SLOAD(st0, 3 + g);
  SMX();
  __syncthreads();
  int c = 0;
#define STEP(i, ST) do { const int cK_ = (c == 2) ? 0 : c + 1; \
    SBAR(); \
    qkt(p0, p1, (const bf16*)(K_lds + cK_ * SHM_K), qr, r32, hi); \
    pv_d0(o, vbase + c * (int)SHM_V, pa0, pa1, pa2, pa3); \
    SBAR(); \
    __syncthreads(); \
    { const int t_ = (i) + 2 + g; if (t_ < NT) { const int cb_ = (cK_ == 2) ? 0 : cK_ + 1; const int cw_ = g ? ((cb_ == 2) ? 0 : cb_ + 1) : cb_; \
        SWRITE(ST, cw_); if (t_ + 2 < NT) SLOAD(ST, t_ + 2); } } \
    SMX(); \
    __syncthreads(); \
    c = cK_; } while (0)
  int i = 0;
#pragma nounroll
  for (; i + 1 < NT - 1; i += 2) { STEP(i, st1); STEP(i + 1, st0); }
  if (i < NT - 1) { STEP(i, st1); }
  SBAR(); pv_d0(o, vbase + c * (int)SHM_V, pa0, pa1, pa2, pa3); SBAR();
  __syncthreads();
  if (!g) __syncthreads();
  if (hi == 0) li_l[r32] = l_reg; asm volatile("s_waitcnt lgkmcnt(0)" ::: "memory");
  float rli[16];
#pragma unroll
  for (int r = 0; r < 16; ++r) rli[r] = __builtin_amdgcn_rcpf(li_l[crow(r, hi)]);
  { int lane_e = lane, wid_e = wid; asm volatile("" : "+v"(lane_e), "+v"(wid_e)); wid_e = __builtin_amdgcn_readfirstlane(wid_e);
    bf16_t* stg = (bf16_t*)lds + wid_e * 4096;
#pragma unroll
    for (int r = 0; r < 16; ++r) { const int orow = crow(r, hi);
#pragma unroll
      for (int d0 = 0; d0 < 4; ++d0) stg[orow * 128 + d0 * 32 + r32] = (bf16_t)f2bf(o[d0][r] * rli[r]); }
    asm volatile("s_waitcnt lgkmcnt(0)" ::: "memory");
    bf16_t* Ow = Ob + (long)(wid_e * QBLK) * LDO; const bf16_t* Gw = Gb + (long)(wid_e * QBLK) * LDO;
    u32x4 gq[8];
#pragma unroll
    for (int i2 = 0; i2 < 8; ++i2) { const int row = i2 * 4 + (lane_e >> 4), ch = lane_e & 15; gq[i2] = *(const u32x4*)(Gw + (long)row * LDO + ch * 8); }
#pragma unroll
    for (int i2 = 0; i2 < 8; ++i2) { const int row = i2 * 4 + (lane_e >> 4), ch = lane_e & 15;
      float ov[8], gv[8]; unpack8(*(const u32x4*)(stg + row * 128 + ch * 8), ov); unpack8(gq[i2], gv);
#pragma unroll
      for (int j = 0; j < 8; ++j) ov[j] *= gv[j];
      *(u32x4*)(Ow + (long)row * LDO + ch * 8) = pack8(ov); } }
  __syncthreads();
  if (PROBE_F8 && cmp) {
    asm volatile("s_waitcnt vmcnt(0)" ::: "memory");
    float pr_d = 0.f, pr_r = 0.f; int lane_c = lane; asm volatile("" : "+v"(lane_c));
    const bf16_t* stg2 = (const bf16_t*)lds + wid * 4096;
    float a0[8], c0[8];
#pragma unroll
    for (int i2 = 0; i2 < 8; ++i2) { const int rl = i2 * 4 + (lane_c >> 4), ch = lane_c & 15; float a[8], cv[8];
      unpack8(*(const u32x4*)(stg2 + rl * 128 + ch * 8), a); unpack8(*(const u32x4*)(cmp + (long)(wid * QBLK + rl) * LDO + ch * 8), cv);
      if (i2 == 0) {
#pragma unroll
        for (int j = 0; j < 8; ++j) { a0[j] = a[j]; c0[j] = cv[j]; }
      } else {
#pragma unroll
        for (int j = 0; j < 8; ++j) { const float fa = a[j] - a0[j], fc = cv[j] - c0[j]; pr_d = fmaxf(pr_d, fabsf(fa - fc)); pr_r = fmaxf(pr_r, fabsf(fa)); } } }
#pragma unroll
    for (int o_ = 1; o_ < 64; o_ <<= 1) { pr_d = fmaxf(pr_d, __shfl_xor(pr_d, o_)); pr_r = fmaxf(pr_r, __shfl_xor(pr_r, o_)); }
    if (lane_c == 0 && !(pr_d <= 0.3f * pr_r)) atomicOr(flag, 1u);
    __syncthreads(); }
#undef SLOAD
#undef SWRITE
#undef RESC
#undef SMX
#undef STEP
}

constexpr float THR8 = 1.5f;
__device__ __forceinline__ void partialSM8(f32x16& p0, f32x16& p1, float& m_reg, float& alpha) {
  constexpr float C = SCALE * 1.4426950408889634f;
  float pmax = p0[0]; for (int r = 1; r < 16; ++r) pmax = fmaxf(pmax, p0[r]); for (int r = 0; r < 16; ++r) pmax = fmaxf(pmax, p1[r]);
  { auto rr = __builtin_amdgcn_permlane32_swap(__float_as_uint(pmax), __float_as_uint(pmax), false, false);
    pmax = fmaxf(__uint_as_float(rr[0]), __uint_as_float(rr[1])); }
  float mn;
  if (__builtin_expect(__all(pmax - m_reg <= THR8 / SCALE), 1)) { mn = m_reg; alpha = 1.f; }
  else { mn = fmaxf(m_reg, pmax); alpha = __builtin_amdgcn_exp2f((m_reg - mn) * C); m_reg = mn; }
  const float mnC = 6.0f - mn * C;
  for (int r = 0; r < 16; ++r) p0[r] = fmaf(p0[r], C, mnC); for (int r = 0; r < 16; ++r) p1[r] = fmaf(p1[r], C, mnC);
  for (int r = 0; r < 16; ++r) p0[r] = __builtin_amdgcn_exp2f(p0[r]);
}
__device__ __forceinline__ void finishSM8(f32x16& p0, f32x16& p1, float alpha, float& l_reg, i32x8& pa) {
  for (int r = 0; r < 16; ++r) p1[r] = __builtin_amdgcn_exp2f(p1[r]);
  float ps = 0; for (int r = 0; r < 16; ++r) ps += p0[r]; for (int r = 0; r < 16; ++r) ps += p1[r];
  { auto rr = __builtin_amdgcn_permlane32_swap(__float_as_uint(ps), __float_as_uint(ps), false, false);
    ps = __uint_as_float(rr[0]) + __uint_as_float(rr[1]); }
  l_reg = l_reg * alpha + ps;
#pragma unroll
  for (int w = 0; w < 4; ++w) { pa[w] = pk4_fp8(p0[4 * w], p0[4 * w + 1], p0[4 * w + 2], p0[4 * w + 3]); pa[4 + w] = pk4_fp8(p1[4 * w], p1[4 * w + 1], p1[4 * w + 2], p1[4 * w + 3]); }
}
#define MFMA8(A, B, Cc) __builtin_amdgcn_mfma_scale_f32_32x32x64_f8f6f4((A), (B), (Cc), 0, 0, 0, 0x7f7f7f7f, 0, 0x7f7f7f7f)
__device__ __forceinline__ i32x8 cat8(const u32x4 lo, const u32x4 hi4) { i32x8 r; r[0] = (int)lo.x; r[1] = (int)lo.y; r[2] = (int)lo.z; r[3] = (int)lo.w; r[4] = (int)hi4.x; r[5] = (int)hi4.y; r[6] = (int)hi4.z; r[7] = (int)hi4.w; return r; }
__device__ __forceinline__ void qkt8(f32x16& p0, f32x16& p1, const char* Ks, const i32x8* qf, int r32, int hi) {
  const int x = r32 & 7; const char* k0 = Ks + r32 * 128; const char* k1 = k0 + 32 * 128;
  p0 = f32x16{}; p1 = f32x16{};
#pragma unroll
  for (int s2 = 0; s2 < 2; ++s2) { const int c0 = 4 * s2 + 2 * hi, oa = 16 * (c0 ^ x), ob = 16 * ((c0 + 1) ^ x);
    const i32x8 a0 = cat8(*reinterpret_cast<const u32x4*>(k0 + oa), *reinterpret_cast<const u32x4*>(k0 + ob));
    const i32x8 a1 = cat8(*reinterpret_cast<const u32x4*>(k1 + oa), *reinterpret_cast<const u32x4*>(k1 + ob));
    p0 = MFMA8(a0, qf[s2], p0); p1 = MFMA8(a1, qf[s2], p1); }
}
__device__ __forceinline__ void pv8(f32x16* o, const char* Vs, const i32x8 pa, int r32, int hi) {
  const int sw = (r32 >> 2) & 3; const char* vb = Vs + r32 * 64; const int oa = 16 * ((2 * hi) ^ sw), ob = 16 * ((2 * hi + 1) ^ sw);
#pragma unroll
  for (int d0 = 0; d0 < 4; ++d0) { const i32x8 b = cat8(*reinterpret_cast<const u32x4*>(vb + d0 * 2048 + oa), *reinterpret_cast<const u32x4*>(vb + d0 * 2048 + ob));
    o[d0] = MFMA8(pa, b, o[d0]); }
}
__device__ __forceinline__ void attn_pp8_body(const bf16* Qb, const unsigned char* __restrict__ K8, const unsigned char* __restrict__ V8,
                                              bf16_t* Ob, const bf16_t* Gb, int seq, char* lds, const int tid) {
  const int wid = __builtin_amdgcn_readfirstlane(tid >> 6), lane = tid & 63, r32 = lane & 31, hi = lane >> 5;
  const int g = wid >> 2;
  constexpr int NB = 3, SL = 8192;
  char* V_lds = lds; char* K_lds = lds + NB * SL;
  float* ws = (float*)(lds + 65536) + wid * 64; float* li_l = ws; float* al_l = ws + 32;
  float m_reg = -1e30f, l_reg = 0; f32x16 o[4] = {}; i32x8 qf[2];
  { const bf16* Qw = Qb + (long)(wid * QBLK + r32) * LDQ + hi * 32;
#pragma unroll
    for (int s2 = 0; s2 < 2; ++s2) {
#pragma unroll
      for (int q4 = 0; q4 < 4; ++q4) { float f[8]; unpack8(*reinterpret_cast<const u32x4*>(Qw + s2 * 64 + q4 * 8), f);
        qf[s2][2 * q4] = pk4_fp8(f[0], f[1], f[2], f[3]); qf[s2][2 * q4 + 1] = pk4_fp8(f[4], f[5], f[6], f[7]); } } }
  struct Stg8 { u32x4 k, v; } st0, st1;
#define SLOAD(S, t) do { const size_t o_ = (size_t)(t) * SL + (size_t)tid * 16; S.k = *reinterpret_cast<const u32x4*>(K8 + o_); S.v = *reinterpret_cast<const u32x4*>(V8 + o_); } while (0)
#define SWRITE(S, b) do { *(u32x4*)(K_lds + (b) * SL + tid * 16) = S.k; *(u32x4*)(V_lds + (b) * SL + tid * 16) = S.v; } while (0)
#define RESC(a) do { if (__any((a) < 1.f)) { if (hi == 0) al_l[r32] = (a); asm volatile("s_waitcnt lgkmcnt(0)" ::: "memory"); \
    for (int d = 0; d < 4; ++d) for (int r = 0; r < 16; ++r) o[d][r] *= al_l[crow(r, hi)]; } } while (0)
  const int NT = seq / KVBLK;
  f32x16 p0, p1; i32x8 pa;
#define SMX() do { float al_; partialSM8(p0, p1, m_reg, al_); RESC(al_); finishSM8(p0, p1, al_, l_reg, pa); } while (0)
  SLOAD(st0, 0); if (g) SLOAD(st1, 1);
  SWRITE(st0, 0); if (g) SWRITE(st1, 1);
  SLOAD(st0, 1 + g); SLOAD(st1, 2 + g);
  __syncthreads();
  if (g) __syncthreads();
  SBAR(); qkt8(p0, p1, K_lds, qf, r32, hi); SBAR();
  __syncthreads();
  SWRITE(st0, 1 + g); if (3 + g < NT) SLOAD(st0, 3 + g);
  SMX();
  __syncthreads();
  int c = 0;
#define STEP(i, ST) do { const int cK_ = (c == 2) ? 0 : c + 1; \
    SBAR(); \
    qkt8(p0, p1, K_lds + cK_ * SL, qf, r32, hi); \
    pv8(o, V_lds + c * SL, pa, r32, hi); \
    SBAR(); \
    __syncthreads(); \
    { const int t_ = (i) + 2 + g; if (t_ < NT) { const int cb_ = (cK_ == 2) ? 0 : cK_ + 1; const int cw_ = g ? ((cb_ == 2) ? 0 : cb_ + 1) : cb_; \
        SWRITE(ST, cw_); if (t_ + 2 < NT) SLOAD(ST, t_ + 2); } } \
    SMX(); \
    __syncthreads(); \
    c = cK_; } while (0)
  int i = 0;
#pragma nounroll
  for (; i + 1 < NT - 1; i += 2) { STEP(i, st1); STEP(i + 1, st0); }
  if (i < NT - 1) { STEP(i, st1); }
  SBAR(); pv8(o, V_lds + c * SL, pa, r32, hi); SBAR();
  __syncthreads();
  if (!g) __syncthreads();
  if (hi == 0) li_l[r32] = l_reg; asm volatile("s_waitcnt lgkmcnt(0)" ::: "memory");
  float rli[16];
#pragma unroll
  for (int r = 0; r < 16; ++r) rli[r] = __builtin_amdgcn_rcpf(li_l[crow(r, hi)]);
  { int lane_e = lane, wid_e = wid; asm volatile("" : "+v"(lane_e), "+v"(wid_e)); wid_e = __builtin_amdgcn_readfirstlane(wid_e);
    bf16_t* stg = (bf16_t*)lds + wid_e * 4096;
#pragma unroll
    for (int r = 0; r < 16; ++r) { const int orow = crow(r, hi);
#pragma unroll
      for (int d0 = 0; d0 < 4; ++d0) stg[orow * 128 + d0 * 32 + r32] = (bf16_t)f2bf(o[d0][r] * rli[r]); }
    asm volatile("s_waitcnt lgkmcnt(0)" ::: "memory");
    bf16_t* Ow = Ob + (long)(wid_e * QBLK) * LDO; const bf16_t* Gw = Gb + (long)(wid_e * QBLK) * LDO;
    u32x4 gq[8];
#pragma unroll
    for (int i2 = 0; i2 < 8; ++i2) { const int row = i2 * 4 + (lane_e >> 4), ch = lane_e & 15; gq[i2] = Gb ? *(const u32x4*)(Gw + (long)row * LDO + ch * 8) : (u32x4){0x3f803f80u, 0x3f803f80u, 0x3f803f80u, 0x3f803f80u}; }
#pragma unroll
    for (int i2 = 0; i2 < 8; ++i2) { const int row = i2 * 4 + (lane_e >> 4), ch = lane_e & 15;
      float ov[8], gv[8]; unpack8(*(const u32x4*)(stg + row * 128 + ch * 8), ov); unpack8(gq[i2], gv);
#pragma unroll
      for (int j = 0; j < 8; ++j) ov[j] *= gv[j];
      *(u32x4*)(Ow + (long)row * LDO + ch * 8) = pack8(ov); } }
  __syncthreads();
#undef SLOAD
#undef SWRITE
#undef RESC
#undef SMX
#undef STEP
#undef MFMA8
}
#undef KSWZ
#undef SBAR
}


#define XB_TMO      128
#define XB_XCNT(j)  (256  + 64 * (j))
#define XB_XSUB(j)  (1280 + 64 * (j))
#define XB_XGEN(j)  (2304 + 64 * (j))
#define XB_TOP      3328
#define XB_TOPGEN   3392
#define XCD_BAR_WORDS 3456
#define XB_SPIN_CAP (1u << 22)
__device__ __forceinline__ unsigned xb_ld(unsigned* p)              { return __hip_atomic_load(p, __ATOMIC_RELAXED, __HIP_MEMORY_SCOPE_AGENT); }
__device__ __forceinline__ unsigned xb_add(unsigned* p, unsigned v) { return __hip_atomic_fetch_add(p, v, __ATOMIC_RELAXED, __HIP_MEMORY_SCOPE_AGENT); }
__device__ __forceinline__ unsigned xb_xcc_id() { return (unsigned)__builtin_amdgcn_s_getreg((3 << 11) | 20) & 0xFu; }
#define XB_SPIN(cond, bar) do { unsigned _sp = 0; while (cond) { __builtin_amdgcn_s_sleep(1); \
    if ((++_sp & 255u) == 0u) { if (xb_ld(&(bar)[XB_TMO])) break; if (_sp > XB_SPIN_CAP) { atomicAdd(&(bar)[XB_TMO], 1u); break; } } } } while (0)
struct XcdBarrier { unsigned* bar; unsigned x; volatile LAS unsigned* st; };
__device__ __forceinline__ XcdBarrier xcd_barrier_post(unsigned* bar, volatile LAS unsigned* st) {
    XcdBarrier b; b.bar = bar; b.x = xb_xcc_id(); b.st = st;
    if (threadIdx.x == 0) (void)xb_add(&bar[XB_XCNT(b.x)], 1u);
    return b;
}
__device__ __forceinline__ void xcd_barrier_complete(unsigned* bar, unsigned x, unsigned& nloc, unsigned& nx) {
    const unsigned G = gridDim.x * gridDim.y * gridDim.z;
    unsigned sum, cnt, mine, sp = 0u;
    for (;;) {
        sum = 0u; cnt = 0u; mine = 0u;
#pragma unroll
        for (unsigned j = 0; j < 16; ++j) { const unsigned c = xb_ld(&bar[XB_XCNT(j)]); sum += c; cnt += (c > 0u) ? 1u : 0u; mine = (j == x) ? c : mine; }
        if (sum == G) break;
        __builtin_amdgcn_s_sleep(1);
        if ((++sp & 255u) == 0u) { if (xb_ld(&bar[XB_TMO])) break; if (sp > XB_SPIN_CAP) { atomicAdd(&bar[XB_TMO], 1u); break; } }
    }
    nloc = mine > 0u ? mine : 1u; nx = cnt > 0u ? cnt : 1u;
}
__device__ __forceinline__ void xcd_barrier(const XcdBarrier& b, const int tid) {
    asm volatile("s_waitcnt vmcnt(0)" ::: "memory");
    __syncthreads();
    if (tid == 0) {
        unsigned* bar = b.bar;
        __builtin_amdgcn_s_waitcnt(0);
        unsigned nloc = b.st[0], nx = b.st[1];
        if (nloc == 0u) { xcd_barrier_complete(bar, b.x, nloc, nx); b.st[0] = nloc; b.st[1] = nx; }
        const unsigned old = xb_add(&bar[XB_XSUB(b.x)], 1u);
        const unsigned gen = old / nloc;
        if (old + 1u == (gen + 1u) * nloc) {
            __builtin_amdgcn_fence(__ATOMIC_RELEASE, "agent");
            asm volatile("s_waitcnt vmcnt(0)" ::: "memory");
            const unsigned og = xb_add(&bar[XB_TOP], 1u);
            const unsigned tg = og / nx;
            if (og + 1u == (tg + 1u) * nx) xb_add(&bar[XB_TOPGEN], 1u);
            else XB_SPIN(xb_ld(&bar[XB_TOPGEN]) == tg, bar);
            __builtin_amdgcn_fence(__ATOMIC_ACQUIRE, "agent");
            xb_add(&bar[XB_XGEN(b.x)], 1u);
            asm volatile("s_waitcnt vmcnt(0)" ::: "memory");
        } else {
            XB_SPIN(xb_ld(&bar[XB_XGEN(b.x)]) == gen, bar);
            __builtin_amdgcn_fence(__ATOMIC_ACQUIRE, "agent");
            asm volatile("s_waitcnt vmcnt(0)" ::: "memory");
        }
    }
    __syncthreads();
}

#ifndef PHM
#define PHM 1023
#endif
#ifndef PROBE_K
#define PROBE_K -1
#endif
struct Args { const float* in[18]; float* out; unsigned char* ws; int ph_lo, ph_hi; };
typedef const __attribute__((address_space(4))) Args* KArgs;
#define INP(a, i) ((const float*)(const GAS float*)((a)->in[i]))
#define OUTP(a) ((float*)(GAS float*)((a)->out))
enum { I_X = 0, I_C, I_WADA, I_BADA, I_NORMG, I_WIN, I_CAW, I_CAB, I_WRG, I_BRG, I_WIG, I_BIG, I_LAM, I_QG, I_KG, I_CCW, I_WBR, I_WOUT };

__device__ __forceinline__ void transpose_item(const float* W, int ldw, bf16_t* dst, int ldd, LAS float* scr, int lane) {
#pragma unroll 8
    for (int i = 0; i < 32; ++i) { const int kk = 2 * i + (lane >> 5); scr[kk * 33 + (lane & 31)] = W[(size_t)kk * ldw + (lane & 31)]; }
    LDS_WAIT();
    const int c = lane & 7;
#pragma unroll
    for (int j = 0; j < 4; ++j) { const int n = (lane >> 3) + 8 * j; const LAS float* s = scr + (8 * c) * 33 + n;
        u32x4 o; o.x = cvt_pk_bf16(s[0 * 33], s[1 * 33]); o.y = cvt_pk_bf16(s[2 * 33], s[3 * 33]); o.z = cvt_pk_bf16(s[4 * 33], s[5 * 33]); o.w = cvt_pk_bf16(s[6 * 33], s[7 * 33]);
        *(u32x4*)(dst + (size_t)n * ldd + 8 * c) = o; }
    LDS_WAIT();
}

__device__ __forceinline__ void phase_prologue(KArgs a, unsigned char* wsb, LAS unsigned char* lds, int tid, int lane, int wave, int bid, int G) {
    unsigned char* ws = wsb;
    {
        LAS float* red = (LAS float*)lds;
        for (int it = bid; it < 96; it += G) {
            const int l = it / 48, jb = it % 48, j = jb * 64 + lane;
            const float* wa = INP(a, I_WADA) + (size_t)l * 1024 * 3072 + j; const float* c0 = INP(a, I_C); const float* c1 = c0 + 1024;
            float a0 = 0.f, a1 = 0.f; const int kb = wave * 128;
#pragma unroll 16
            for (int k = 0; k < 128; ++k) { const float w = wa[(size_t)(kb + k) * 3072]; a0 += c0[kb + k] * w; a1 += c1[kb + k] * w; }
            red[(wave * 2 + 0) * 64 + lane] = a0; red[(wave * 2 + 1) * 64 + lane] = a1;
            __syncthreads();
            if (tid < 128) { const int bb = tid >> 6; float s = 0.f;
#pragma unroll
                for (int w = 0; w < 8; ++w) s += red[(w * 2 + bb) * 64 + lane];
                ((float*)(ws + WS_MOD))[(l * 2 + bb) * 3072 + j] = s + INP(a, I_BADA)[l * 3072 + j]; }
            __syncthreads();
        }
    }
    {
        float* rc = (float*)(ws + WS_ROPE); float* rs = rc + 320 * 32;
        for (int e = bid * 512 + tid; e < 320 * 32; e += G * 512) {
            const int pos = e >> 5, i = e & 31; const int p = pos < 256 ? pos : pos - 256;
            const float inv = __builtin_amdgcn_exp2f(-((float)(2 * i)) * (13.287712379549449f / 64.0f));
            const float ang = (float)p * inv;
            rc[e] = __cosf(ang); rs[e] = __sinf(ang);
        }
    }
    {
        LAS float* scr = (LAS float*)(lds + 8192 + wave * 12288);
        const int gw = bid * 8 + wave, NGW = G * 8;
        constexpr int I_IN = 2 * 16 * 368, I_G = 1024, I_BR = 3072, I_OUT = 1024, NITEMS = I_IN + I_G + I_BR + I_OUT;
        for (int it = gw; it < NITEMS; it += NGW) {
            int r = it;
            if (r < I_IN) { const int l = r / 5888, q = r % 5888, kb = q / 368, nb = q % 368;
                const int n0 = 32 * nb; int drow = n0;
                if (n0 >= 4608 && n0 < 8704) { const int sec = (n0 - 4608) >> 10, ch = (n0 - 4608) & 1023, blk = ch >> 7;
                    drow = ((sec & 1) ? 26 + blk : 18 + blk) * 256 + ((sec >> 1) ? 128 : 0) + (ch & 127); }
                transpose_item(INP(a, I_WIN) + (size_t)l * 1024 * NIN + (size_t)(64 * kb) * NIN + n0, NIN,
                               (bf16_t*)(ws + WS_WIN) + (size_t)l * NIN * 1024 + (size_t)drow * 1024 + 64 * kb, 1024, scr, lane); continue; }
            r -= I_IN;
            if (r < I_G) { const int mi = r >> 5, sub = r & 31, kb = sub >> 3, nblk = sub & 7;
                const int nb = mi & 3, gate = (mi >> 2) & 1, dir = (mi >> 3) & 1, l = mi >> 4;
                const float* src = (gate ? INP(a, I_WIG) : INP(a, I_WRG)) + (size_t)((l * 2 + dir) * 4 + nb) * 65536 + (size_t)(64 * kb) * 256 + 32 * nblk;
                const int n0 = 32 * nblk, hh = n0 >> 7, pn = (dir * 4 + nb) * 2 + hh, row = pn * 256 + gate * 128 + (n0 & 127);
                transpose_item(src, 256, (bf16_t*)(ws + WS_WG) + (size_t)l * 4096 * 256 + (size_t)row * 256 + 64 * kb, 256, scr, lane); continue; }
            r -= I_G;
            if (r < I_BR) { const int mi = r >> 9, sub = r & 511, kb = sub >> 5, nblk = sub & 31;
                transpose_item(INP(a, I_WBR) + (size_t)mi * 1048576 + (size_t)(64 * kb) * 1024 + 32 * nblk, 1024,
                               (bf16_t*)(ws + WS_WBR) + (size_t)mi * 1048576 + (size_t)(32 * nblk) * 1024 + 64 * kb, 1024, scr, lane); continue; }
            r -= I_BR;
            { const int mi = r >> 9, sub = r & 511, kb = sub >> 5, nblk = sub & 31;
                transpose_item(INP(a, I_WOUT) + (size_t)mi * 1048576 + (size_t)(64 * kb) * 1024 + 32 * nblk, 1024,
                               (bf16_t*)(ws + WS_WOUT) + (size_t)mi * 1048576 + (size_t)(32 * nblk) * 1024 + 64 * kb, 1024, scr, lane); }
        }
    }
}

__device__ __forceinline__ void phase_h(KArgs a, unsigned char* wsb, int l, int b, int lane, int wave, int bid, int G) {
    const float* xin = (l == 0 ? INP(a, I_X) : OUTP(a)) + (size_t)b * SEQ * DM;
    const float* mod = (const float*)(wsb + WS_MOD) + (l * 2 + b) * 3072;
    bf16_t* H = (bf16_t*)(wsb + WS_H);
    f32x4 gs[4], sh[4];
#pragma unroll
    for (int j = 0; j < 4; ++j) { const int col = 4 * lane + 256 * j;
        const f32x4 g = *(const f32x4*)(INP(a, I_NORMG) + l * 1024 + col), sc = *(const f32x4*)(mod + 1024 + col);
        gs[j] = g * (sc + 1.0f); sh[j] = *(const f32x4*)(mod + col); }
    const int gw = bid * 8 + wave, NGW = G * 8;
    for (int m = gw; m < SEQ; m += 2 * NGW) {
        const int m2 = (m + NGW < SEQ) ? m + NGW : m;
        const f32x4* xr = (const f32x4*)(xin + (size_t)m * DM) + lane; const f32x4* xr2 = (const f32x4*)(xin + (size_t)m2 * DM) + lane;
        f32x4 v[4], w[4]; float s = 0.f, s2 = 0.f;
#pragma unroll
        for (int j = 0; j < 4; ++j) { v[j] = xr[64 * j]; w[j] = xr2[64 * j]; }
#pragma unroll
        for (int j = 0; j < 4; ++j) { s += (v[j].x * v[j].x + v[j].y * v[j].y) + (v[j].z * v[j].z + v[j].w * v[j].w); s2 += (w[j].x * w[j].x + w[j].y * w[j].y) + (w[j].z * w[j].z + w[j].w * w[j].w); }
        const float rstd = __builtin_amdgcn_rsqf(wave_sum(s) * (1.f / DM) + EPS), rstd2 = __builtin_amdgcn_rsqf(wave_sum(s2) * (1.f / DM) + EPS);
        u32x2* o8 = (u32x2*)(H + (size_t)m * DM) + lane; u32x2* o82 = (u32x2*)(H + (size_t)m2 * DM) + lane;
#pragma unroll
        for (int j = 0; j < 4; ++j) { const f32x4 o = v[j] * rstd * gs[j] + sh[j]; u32x2 q; q.x = cvt_pk_bf16(o.x, o.y); q.y = cvt_pk_bf16(o.z, o.w); o8[64 * j] = q;
            const f32x4 o2 = w[j] * rstd2 * gs[j] + sh[j]; u32x2 q2; q2.x = cvt_pk_bf16(o2.x, o2.y); q2.y = cvt_pk_bf16(o2.z, o2.w); o82[64 * j] = q2; }
    }
}

__device__ __forceinline__ void ldrow8(const bf16_t* __restrict__ base, int t, int ch, float (&v)[8]) {
    if (t < 0 || t >= SEQ) {
#pragma unroll
        for (int j = 0; j < 8; ++j) v[j] = 0.f;
    } else unpack8(*(const u32x4*)(base + (size_t)t * 1024 + ch), v);
}
__device__ __forceinline__ void ld8f32(const float* p, float (&v)[8]) {
    const f32x4 a = *(const f32x4*)p, b = *(const f32x4*)(p + 4);
    v[0] = a.x; v[1] = a.y; v[2] = a.z; v[3] = a.w; v[4] = b.x; v[5] = b.y; v[6] = b.z; v[7] = b.w;
}

__device__ __forceinline__ void phase_elem(KArgs a, unsigned char* wsb, int l, int lane, int wave, int bid, int G) {
    unsigned char* ws = wsb;
    const int gw = bid * 8 + wave, NGW = G * 8;
    for (int it = gw; it < 2048; it += NGW) {
        const int run = it >> 1, hf = it & 1, ch = hf * 512 + lane * 8, t0 = run * 16;
        {
            const bf16_t* __restrict__ XA = (const bf16_t*)(ws + WS_XA); bf16_t* __restrict__ UA = (bf16_t*)(ws + WS_H);
            float w0[8], w1[8], w2[8], w3[8], bb[8];
            const float* cw = INP(a, I_CAW) + (size_t)l * 4 * 1024 + ch;
            ld8f32(cw, w0); ld8f32(cw + 1024, w1); ld8f32(cw + 2048, w2); ld8f32(cw + 3072, w3); ld8f32(INP(a, I_CAB) + l * 1024 + ch, bb);
            float xm2[8], xm1[8], x0[8], xp1[8];
            ldrow8(XA, t0 - 2, ch, xm2); ldrow8(XA, t0 - 1, ch, xm1); ldrow8(XA, t0, ch, x0);
#pragma unroll
            for (int s = 0; s < 16; ++s) { const int t = t0 + s;
                ldrow8(XA, t + 1, ch, xp1);
                float o[8];
#pragma unroll
                for (int j = 0; j < 8; ++j) o[j] = w0[j] * xm2[j] + w1[j] * xm1[j] + w2[j] * x0[j] + w3[j] * xp1[j] + bb[j];
                *(u32x4*)(UA + (size_t)t * 1024 + ch) = pack8(o);
#pragma unroll
                for (int j = 0; j < 8; ++j) { xm2[j] = xm1[j]; xm1[j] = x0[j]; x0[j] = xp1[j]; } }
        }
        {
            const bf16_t* __restrict__ PP = (const bf16_t*)(ws + WS_XC); const bf16_t* __restrict__ BG = (const bf16_t*)(ws + WS_BC); bf16_t* __restrict__ YC = (bf16_t*)(ws + WS_YC);
            float w0[8], w1[8], w2[8];
            const float* cw = INP(a, I_CCW) + (size_t)l * 3 * 1024 + ch;
            ld8f32(cw, w0); ld8f32(cw + 1024, w1); ld8f32(cw + 2048, w2);
            float pm1[8], p0[8], pp1[8], t1[8];
            ldrow8(PP, t0 - 1, ch, pm1); ldrow8(PP, t0, ch, p0);
#pragma unroll
            for (int s = 0; s < 16; ++s) { const int t = t0 + s;
                ldrow8(PP, t + 1, ch, pp1); ldrow8(BG, t, ch, t1);
                float o[8];
#pragma unroll
                for (int j = 0; j < 8; ++j) o[j] = t1[j] * (w0[j] * pm1[j] + w1[j] * p0[j] + w2[j] * pp1[j]);
                *(u32x4*)(YC + (size_t)t * 1024 + ch) = pack8(o);
#pragma unroll
                for (int j = 0; j < 8; ++j) { pm1[j] = p0[j]; p0[j] = pp1[j]; } }
        }
        {
            bf16_t* Q = (bf16_t*)(ws + WS_Q); bf16_t* Kb = (bf16_t*)(ws + WS_K);
            const float* rc = (const float*)(ws + WS_ROPE); const float* rs = rc + 320 * 32;
            const int d0 = (lane & 15) * 8, i0 = (lane & 3) * 8;
            float qg[8], kg[8];
            ld8f32(INP(a, I_QG) + l * 128 + d0, qg); ld8f32(INP(a, I_KG) + l * 128 + d0, kg);
            const bool second = (lane & 4) != 0;
            const int tokb = run * 16 + hf * 8;
            const int tsel = (d0 < 64) ? 0 : 1;
            u32x4 cur[3]; float cs[8], sn[8];
#define LD_TOK(tok, dst, dcs, dsn) do { const int tp_ = tsel ? 256 + ((tok) & 63) : ((tok) >> 6); ld8f32(rc + tp_ * 32 + i0, dcs); ld8f32(rs + tp_ * 32 + i0, dsn); \
                dst[0] = *(const u32x4*)(Q + (size_t)(tok) * 1024 + lane * 8); dst[1] = *(const u32x4*)(Q + (size_t)(tok) * 1024 + 512 + lane * 8); dst[2] = *(const u32x4*)(Kb + (size_t)(tok) * 256 + (lane & 31) * 8); } while (0)
            LD_TOK(tokb, cur, cs, sn);
#pragma unroll
            for (int i = 0; i < 8; ++i) {
                const int tok = tokb + i;
                u32x4 nx[3]; float ncs[8], nsn[8];
                if (i < 7) LD_TOK(tok + 1, nx, ncs, nsn);
#pragma unroll
                for (int part = 0; part < 3; ++part) {
                    bf16_t* p = (part < 2) ? (Q + (size_t)tok * 1024 + part * 512 + lane * 8) : (Kb + (size_t)tok * 256 + (lane & 31) * 8);
                    float v[8]; unpack8(cur[part], v);
                    float ss = 0.f;
#pragma unroll
                    for (int j = 0; j < 8; ++j) ss += v[j] * v[j];
                    ss += __shfl_xor(ss, 1); ss += __shfl_xor(ss, 2); ss += __shfl_xor(ss, 4); ss += __shfl_xor(ss, 8);
                    const float rstd = __builtin_amdgcn_rsqf(ss * (1.f / 128.f) + EPS);
                    float o[8];
#pragma unroll
                    for (int j = 0; j < 8; ++j) { const float y = v[j] * rstd * (part < 2 ? qg[j] : kg[j]); const float pr = __shfl_xor(y, 4);
                        o[j] = y * cs[j] + (second ? pr : -pr) * sn[j]; }
                    if (part < 2 || lane < 32) *(u32x4*)p = pack8(o);
                    if (part == 2 && lane < 32) {
                        const int kvh = lane >> 4, r = tok & 63, dch = (lane & 15) >> 1;
                        unsigned char* kp = ws + WS_K8 + (size_t)kvh * 2097152 + (size_t)(tok >> 6) * 8192 + r * 128 + 16 * (dch ^ (r & 7)) + (lane & 1) * 8;
                        u32x2 w8; w8.x = (unsigned)pk4_fp8(o[0], o[1], o[2], o[3]); w8.y = (unsigned)pk4_fp8(o[4], o[5], o[6], o[7]); *(u32x2*)kp = w8; }
                }
                if (i < 7) {
#pragma unroll
                    for (int part = 0; part < 3; ++part) cur[part] = nx[part];
#pragma unroll
                    for (int j = 0; j < 8; ++j) { cs[j] = ncs[j]; sn[j] = nsn[j]; } }
            }
#undef LD_TOK
        }
    }
    for (int it = gw; it < 4096; it += NGW) {
        const int jh = it & 1, h = (it >> 1) & 1, dh = (it >> 2) & 1, tile = (it >> 3) & 255, kvh = it >> 11;
        const int d = dh * 64 + lane;
        const bf16_t* __restrict__ V = (const bf16_t*)(ws + WS_V) + (size_t)tile * 64 * 256 + kvh * 128 + d;
        float f[16];
#pragma unroll
        for (int jj = 0; jj < 16; ++jj) { const int key = (jj & 3) + 8 * (jj >> 2) + 4 * h + 32 * jh; f[jj] = bf2f(V[(size_t)key * 256]); }
        u32x4 w; w.x = (unsigned)pk4_fp8(f[0], f[1], f[2], f[3]); w.y = (unsigned)pk4_fp8(f[4], f[5], f[6], f[7]); w.z = (unsigned)pk4_fp8(f[8], f[9], f[10], f[11]); w.w = (unsigned)pk4_fp8(f[12], f[13], f[14], f[15]);
        *(u32x4*)(ws + WS_V8 + (size_t)kvh * 2097152 + (size_t)tile * 8192 + d * 64 + 16 * ((2 * h + jh) ^ ((d >> 2) & 3))) = w;
    }
}

__device__ __forceinline__ void phase_scan_a(KArgs a, unsigned char* wsb, int lane, int wave, int bid, int G) {
    unsigned char* ws = wsb;
    const int gw = bid * 8 + wave, NGW = G * 8;
    for (int it = gw; it < 2048; it += NGW) {
        const int c = it >> 4, dir = (it >> 3) & 1, ch = (it & 7) * 128 + lane * 2;
        const bf16_t* LA = (const bf16_t*)(ws + WS_LA + (size_t)dir * 64 * MiB) + ch;
        const bf16_t* UU = (const bf16_t*)(ws + WS_U + (size_t)dir * 64 * MiB) + ch;
        float s0 = 0.f, s1 = 0.f, h0 = 0.f, h1 = 0.f;
#pragma unroll 16
        for (int st = 0; st < 128; ++st) { const int t = dir == 0 ? c * 128 + st : c * 128 + 127 - st;
            const unsigned wl = *(const unsigned*)(LA + (size_t)t * 1024), wu = *(const unsigned*)(UU + (size_t)t * 1024);
            const float l0 = __uint_as_float(wl << 16), l1 = __uint_as_float(wl & 0xffff0000u);
            const float u0 = __uint_as_float(wu << 16), u1 = __uint_as_float(wu & 0xffff0000u);
            h0 = __builtin_amdgcn_exp2f(l0) * h0 + u0; h1 = __builtin_amdgcn_exp2f(l1) * h1 + u1; s0 += l0; s1 += l1; }
        *(f32x2*)((float*)(ws + WS_SA) + (c * 2 + dir) * 1024 + ch) = (f32x2){s0, s1};
        *(f32x2*)((float*)(ws + WS_SH) + (c * 2 + dir) * 1024 + ch) = (f32x2){h0, h1};
    }
}
__device__ __forceinline__ void phase_scan_c(unsigned char* wsb, LAS unsigned char* lds, int lane, int wave, int bid, int G) {
    unsigned char* ws = wsb;
    const int gw = bid * 8 + wave, NGW = G * 8;
    const float* __restrict__ SA = (const float*)(ws + WS_SA); const float* __restrict__ SH = (const float*)(ws + WS_SH);
    for (int it = gw; it < 2048; it += NGW) {
        const int c = it >> 4, ch = (it & 15) * 64 + lane;
        float cf = 0.f, cb = 0.f;
#pragma unroll 8
        for (int sidx = 0; sidx < c; ++sidx) { const int idx = (sidx * 2) * 1024 + ch; cf = __builtin_amdgcn_exp2f(SA[idx]) * cf + SH[idx]; }
#pragma unroll 8
        for (int sidx = 127; sidx > c; --sidx) { const int idx = (sidx * 2 + 1) * 1024 + ch; cb = __builtin_amdgcn_exp2f(SA[idx]) * cb + SH[idx]; }
        const bf16_t* __restrict__ LAf = (const bf16_t*)(ws + WS_LA) + ch; const bf16_t* __restrict__ UUf = (const bf16_t*)(ws + WS_U) + ch;
        const bf16_t* __restrict__ LAb = (const bf16_t*)(ws + WS_LA + 64 * MiB) + ch; const bf16_t* __restrict__ UUb = (const bf16_t*)(ws + WS_U + 64 * MiB) + ch;
        const bf16_t* __restrict__ SGA = (const bf16_t*)(ws + WS_SGA) + ch; bf16_t* __restrict__ YA = (bf16_t*)(ws + WS_XA) + ch;
        LAS bf16_t* hfs = (LAS bf16_t*)(lds + wave * 16384) + lane;
        float h = cf;
        { const bf16_t* pl = LAf + (size_t)c * 128 * 1024; const bf16_t* pu = UUf + (size_t)c * 128 * 1024;
#pragma unroll 1
            for (int blk = 0; blk < 8; ++blk) {
                float l[16], u[16];
#pragma unroll
                for (int i = 0; i < 16; ++i) { l[i] = bf2f(pl[i * 1024]); u[i] = bf2f(pu[i * 1024]); }
#pragma unroll
                for (int i = 0; i < 16; ++i) { h = __builtin_amdgcn_exp2f(l[i]) * h + u[i]; hfs[(blk * 16 + i) * 64] = (bf16_t)f2bf(h); }
                pl += 16 * 1024; pu += 16 * 1024; } }
        h = cb;
        { const size_t e0 = (size_t)(c * 128 + 112) * 1024;
            const bf16_t* pl = LAb + e0; const bf16_t* pu = UUb + e0; const bf16_t* pg = SGA + e0; bf16_t* py = YA + e0;
#pragma unroll 1
            for (int blk = 7; blk >= 0; --blk) {
                float l[16], u[16], g[16];
#pragma unroll
                for (int i = 0; i < 16; ++i) { l[i] = bf2f(pl[i * 1024]); u[i] = bf2f(pu[i * 1024]); g[i] = bf2f(pg[i * 1024]); }
#pragma unroll
                for (int i = 15; i >= 0; --i) { h = __builtin_amdgcn_exp2f(l[i]) * h + u[i];
                    py[i * 1024] = (bf16_t)f2bf((bf2f(hfs[(blk * 16 + i) * 64]) + h) * g[i]); }
                pl -= 16 * 1024; pu -= 16 * 1024; pg -= 16 * 1024; py -= 16 * 1024; } }
    }
}

__global__ void __launch_bounds__(512, 2) mk_fwd(Args args) {
    extern __shared__ __attribute__((aligned(16))) unsigned char lds[];
    cg::grid_group grid = cg::this_grid();
    LAS unsigned char* L = (LAS unsigned char*)lds;
    if (threadIdx.x < 2) ((LAS unsigned*)(L + 131072))[threadIdx.x] = 0u;
    __syncthreads();
    (void)xcd_barrier_post((unsigned*)(args.ws + WS_BAR), (volatile LAS unsigned*)(L + 131072));
    const int wave_u = __builtin_amdgcn_readfirstlane(threadIdx.x >> 6);
    for (int ph = args.ph_lo; ph < args.ph_hi; ++ph) {
        int tid; { int ln_; asm volatile("v_mbcnt_lo_u32_b32 %0, -1, 0\n\tv_mbcnt_hi_u32_b32 %0, -1, %0" : "=v"(ln_)); tid = wave_u * 64 + ln_; }
        int G = gridDim.x, bid = blockIdx.x; asm volatile("" : "+s"(G), "+s"(bid));
        KArgs ap = (KArgs)__builtin_amdgcn_kernarg_segment_ptr(); asm volatile("" : "+s"(ap));
        GAS unsigned char* wsg = (GAS unsigned char*)ap->ws; asm volatile("" : "+s"(wsg));
        unsigned char* ws = (unsigned char*)wsg;
        const int lane = tid & 63, wave = __builtin_amdgcn_readfirstlane(tid >> 6);
        unsigned long long pt0 = 0; int pcls = -1; if (PROBE_K >= 0) pt0 = __builtin_amdgcn_s_memrealtime();
        if (ph == 0) { pcls = 8; if (PHM & 512) phase_prologue(ap, ws, L, tid, lane, wave, bid, G); }
        else {
            const int q = ph - 1, lb = q / NPH_PER, k = q - lb * NPH_PER, l = lb >> 1, b = lb & 1; pcls = k;
            if (k == 0) { if (PHM & 1) phase_h(ap, ws, l, b, lane, wave, bid, G); }
            else if (k == 1) { if (PHM & 2) {
                pg8::Gemm g{(const bf16_t*)(ws + WS_H), (const bf16_t*)(ws + WS_WIN) + (size_t)l * NIN * 1024, 1024, 1024, 1024, 0, 0};
                pg8::StaticOrder S; S.init(SEQ, NIN, G, bid);
                pg8::EpiInProj E{ws};
                pg8::gemm_phase<pg8::EpiInProj, pg8::StaticOrder, 0>(L, g, S, E, tid); }
            } else if (k == 2) { if (PHM & 4) phase_elem(ap, ws, l, lane, wave, bid, G); }
            else if (k == 3) {
                if (PHM & 8) {
                    pg8::Gemm g{(const bf16_t*)(ws + WS_H), (const bf16_t*)(ws + WS_WG) + (size_t)l * 4096 * 256, 1024, 256, 256, 0, 0};
                    pg8::StaticOrder S; S.init(SEQ, 4096, G, bid);
                    pg8::EpiGates E{ws, INP(ap, I_BRG) + l * 2048, INP(ap, I_BIG) + l * 2048, INP(ap, I_LAM) + l * 2048};
                    pg8::gemm_phase<pg8::EpiGates, pg8::StaticOrder, 1>(L, g, S, E, tid);
                }
                if (PROBE_K == 3) { const unsigned long long t1 = __builtin_amdgcn_s_memrealtime(), dt = t1 - pt0; while (__builtin_amdgcn_s_memrealtime() - t1 < dt) __builtin_amdgcn_s_sleep(8); }
                if (PROBE_K == 9) { pt0 = __builtin_amdgcn_s_memrealtime(); pcls = 9; }
                if (PHM & 256) {
                    const int v = (G % 8 == 0) ? (bid % 8) * (G / 8) + bid / 8 : bid;
                    const int per = (512 + G - 1) / G;
                    if (PROBE_F8 && l == 0 && b == 0) {
                        for (int i = 0; i < per; ++i) { const int idx = v * per + i; if (idx >= 4) break;
                            const int h = idx >> 6, qb = idx & 63, kvh = h >> 2;
                            const attn::bf16* Qb = (const attn::bf16*)(ws + WS_Q) + (size_t)qb * 256 * 1024 + h * 128;
                            const bf16_t* Gb = (const bf16_t*)(ws + WS_SGB) + (size_t)qb * 256 * 1024 + h * 128;
                            attn::attn_pp8_body(Qb, ws + WS_K8 + (size_t)kvh * 2097152, ws + WS_V8 + (size_t)kvh * 2097152, (bf16_t*)(ws + WS_SPARE) + (size_t)idx * 256 * 1024, nullptr, SEQ, (char*)lds, tid);
                        }
                    }
                    int tid2 = tid; asm volatile("" : "+v"(tid2));
                    for (int i = 0; i < per; ++i) { const int idx = v * per + i; if (idx >= 512) break;
                        const int h = idx >> 6, qb = idx & 63, kvh = h >> 2;
                        const attn::bf16* Qb = (const attn::bf16*)(ws + WS_Q) + (size_t)qb * 256 * 1024 + h * 128;
                        bf16_t* Ob = (bf16_t*)(ws + WS_SGB) + (size_t)qb * 256 * 1024 + h * 128;
                        const bf16_t* Gb = (const bf16_t*)(ws + WS_SGB) + (size_t)qb * 256 * 1024 + h * 128;
                        if (PROBE_F8) {
                            const attn::bf16* Kh = (const attn::bf16*)(ws + WS_K) + kvh * 128;
                            const attn::bf16* Vh = (const attn::bf16*)(ws + WS_V) + kvh * 128;
                            const bf16_t* cmp = (l == 0 && b == 0 && idx < 4) ? (const bf16_t*)(ws + WS_SPARE) + (size_t)idx * 256 * 1024 : nullptr;
                            attn::attn_pp_body(Qb, Kh, Vh, Ob, Gb, SEQ, (char*)lds, tid2, cmp, (unsigned*)(ws + WS_FLAG));
                        } else attn::attn_pp8_body(Qb, ws + WS_K8 + (size_t)kvh * 2097152, ws + WS_V8 + (size_t)kvh * 2097152, Ob, Gb, SEQ, (char*)lds, tid2);
                    }
                }
            } else if (k == 4) { if (PHM & 16) phase_scan_a(ap, ws, lane, wave, bid, G); }
            else if (k == 5) { if (PHM & 32) phase_scan_c(ws, L, lane, wave, bid, G); }
            else if (k == 6) { if (PHM & 64) {
                pg8::Gemm g{(const bf16_t*)(ws + WS_XA), (const bf16_t*)(ws + WS_WBR) + (size_t)l * 3 * 1048576, 1024, 1024, 1024,
                            (long)WS_SGB - (long)WS_XA, (long)WS_YC - (long)WS_XA};
                pg8::BranchOrder S; S.so.init(SEQ, 1024, G, bid);
                pg8::EpiBranch E{ws};
                pg8::gemm_phase<pg8::EpiBranch, pg8::BranchOrder, 2>(L, g, S, E, tid); }
            } else if (PHM & 128) {
                pg8::Gemm g{(const bf16_t*)(ws + WS_SGA), (const bf16_t*)(ws + WS_WOUT) + (size_t)l * 1048576, 1024, 1024, 1024, 0, 0};
                pg8::StaticOrder S; S.init(SEQ, 1024, G, bid);
                const float* xi = (l == 0 ? INP(ap, I_X) : OUTP(ap)) + (size_t)b * SEQ * DM;
                pg8::EpiOut E{xi, OUTP(ap) + (size_t)b * SEQ * DM, (const float*)(ws + WS_MOD) + (l * 2 + b) * 3072 + 2048, (const unsigned*)(ws + WS_FLAG)};
                pg8::gemm_phase<pg8::EpiOut, pg8::StaticOrder, 0>(L, g, S, E, tid);
            }
        }
        if (PROBE_K >= 0 && PROBE_K != 3 && ph + 1 == args.ph_hi && pcls == PROBE_K) { VM_WAIT(); __syncthreads(); const unsigned long long t1 = __builtin_amdgcn_s_memrealtime(), dt = t1 - pt0; while (__builtin_amdgcn_s_memrealtime() - t1 < dt) __builtin_amdgcn_s_sleep(8); }
        if (ph + 1 < args.ph_hi) { if (ph == args.ph_lo) grid.sync(); else { XcdBarrier xbar; xbar.bar = (unsigned*)(ws + WS_BAR); xbar.x = xb_xcc_id(); xbar.st = (volatile LAS unsigned*)(L + 131072); xcd_barrier(xbar, tid); }
            if (PROBE_K >= 0 && PROBE_K != 3 && pcls == PROBE_K) { const unsigned long long t1 = __builtin_amdgcn_s_memrealtime(), dt = t1 - pt0; while (__builtin_amdgcn_s_memrealtime() - t1 < dt) __builtin_amdgcn_s_sleep(8); } }
    }
}

extern "C" void kernel_launch(void* const* d_in, const int* in_sizes, int n_in, void* d_out, int out_size, void* d_ws, size_t ws_size, hipStream_t stream) {
    static int grid = 0;
    if (grid == 0) {
        if (n_in != 18 || ws_size < WS_END) { fprintf(stderr, "kernel_launch: need 18 inputs and >= %zu bytes of workspace (got %d, %zu)\n", (size_t)WS_END, n_in, ws_size); grid = -1; return; }
        int dev = 0, cus = 0, per_cu = 0;
        hipGetDevice(&dev);
        hipDeviceGetAttribute(&cus, hipDeviceAttributeMultiprocessorCount, dev);
        if (hipFuncSetAttribute((const void*)mk_fwd, hipFuncAttributeMaxDynamicSharedMemorySize, LDS_BYTES) != hipSuccess) { fprintf(stderr, "kernel_launch: hipFuncSetAttribute failed\n"); grid = -1; return; }
        if (hipOccupancyMaxActiveBlocksPerMultiprocessor(&per_cu, (const void*)mk_fwd, 512, LDS_BYTES) != hipSuccess || per_cu < 1) { fprintf(stderr, "kernel_launch: occupancy query gave %d\n", per_cu); per_cu = 1; }
        (void)hipGetLastError();
        grid = cus * 1;
    }
    if (grid < 0) return;
    if (hipMemsetAsync((char*)d_ws + WS_BAR, 0, 16384, stream) != hipSuccess) { fprintf(stderr, "kernel_launch: memset failed\n"); return; }
    Args a{};
    for (int i = 0; i < 18; ++i) a.in[i] = (const float*)d_in[i];
    a.out = (float*)d_out; a.ws = (unsigned char*)d_ws; a.ph_lo = 0; a.ph_hi = NPHASES;
    void* kargs[] = {&a};
    hipError_t e = hipLaunchCooperativeKernel((const void*)mk_fwd, dim3(grid), dim3(512), kargs, LDS_BYTES, stream);
    if (e != hipSuccess) fprintf(stderr, "kernel_launch: cooperative launch failed: %s (grid %d)\n", hipGetErrorString(e), grid);
}
```

```cpp
#include <hip/hip_runtime.h>
#include <hip/hip_cooperative_groups.h>
#include <hip/hip_bf16.h>
#include <cstdio>
#include <cstdint>
namespace cg = cooperative_groups;
#ifndef PROBE_F8
#define PROBE_F8 0
#endif

#define LAS __attribute__((address_space(3)))
#define GAS __attribute__((address_space(1)))
typedef unsigned short bf16_t;
typedef short bf16x8 __attribute__((ext_vector_type(8)));
typedef float f32x4 __attribute__((ext_vector_type(4)));
typedef float f32x2 __attribute__((ext_vector_type(2)));
typedef unsigned u32x4 __attribute__((ext_vector_type(4)));
typedef unsigned u32x2 __attribute__((ext_vector_type(2)));

constexpr int DM = 1024, SEQ = 16384, NBATCH = 2, DEPTH = 2, NIN = 11776;
constexpr int NPH_PER = 8, NPHASES = 1 + DEPTH * NBATCH * NPH_PER;
constexpr float EPS = 1e-6f;
constexpr float LOG2E = 1.4426950408889634f;

constexpr size_t MiB = 1u << 20;
constexpr size_t WS_MOD = 0;
constexpr size_t WS_ROPE = 64 * 1024;
constexpr size_t WS_BAR = 256 * 1024;
constexpr size_t WS_SA = 1 * MiB, WS_SH = 2 * MiB;
constexpr size_t WS_WIN = 4 * MiB, WS_WG = 50 * MiB, WS_WBR = 54 * MiB, WS_WOUT = 66 * MiB;
constexpr size_t WS_H = 70 * MiB;
constexpr size_t WS_XA = 102 * MiB;
constexpr size_t WS_SGA = 134 * MiB;
constexpr size_t WS_Q = 166 * MiB;
constexpr size_t WS_K = 198 * MiB, WS_V = 206 * MiB;
constexpr size_t WS_SGB = 214 * MiB;
constexpr size_t WS_XC = 246 * MiB, WS_BC = 278 * MiB, WS_CC = 310 * MiB, WS_SGC = 342 * MiB;
constexpr size_t WS_LA = WS_XC, WS_U = WS_BC;
constexpr size_t WS_SMG = 374 * MiB;
constexpr size_t WS_YC = 470 * MiB;
constexpr size_t WS_K8 = 502 * MiB, WS_V8 = 506 * MiB;
constexpr size_t WS_SPARE = 510 * MiB;
constexpr size_t WS_FLAG = WS_BAR + 15 * 1024;
constexpr size_t WS_END = 512 * MiB;
constexpr int LDS_BYTES = 131072 + 1024;

__device__ __forceinline__ float bf2f(bf16_t v) { return __uint_as_float((unsigned)v << 16); }
__device__ __forceinline__ unsigned f2bf(float f) { unsigned u = __float_as_uint(f); return (u + 0x7fffu + ((u >> 16) & 1u)) >> 16; }
__device__ __forceinline__ unsigned cvt_pk_bf16(float lo, float hi) { unsigned r; asm("v_cvt_pk_bf16_f32 %0, %1, %2" : "=v"(r) : "v"(lo), "v"(hi)); return r; }
__device__ __forceinline__ void unpack8(const u32x4 w, float (&f)[8]) {
#pragma unroll
    for (int i = 0; i < 4; ++i) { f[2 * i] = __uint_as_float(w[i] << 16); f[2 * i + 1] = __uint_as_float(w[i] & 0xffff0000u); }
}
__device__ __forceinline__ u32x4 pack8(const float (&f)[8]) {
    u32x4 w; w.x = cvt_pk_bf16(f[0], f[1]); w.y = cvt_pk_bf16(f[2], f[3]); w.z = cvt_pk_bf16(f[4], f[5]); w.w = cvt_pk_bf16(f[6], f[7]); return w;
}
typedef int i32x8 __attribute__((ext_vector_type(8)));
__device__ __forceinline__ int pk4_fp8(float a, float b, float c, float d) { int r = __builtin_amdgcn_cvt_pk_fp8_f32(a, b, 0, false); return __builtin_amdgcn_cvt_pk_fp8_f32(c, d, r, true); }
__device__ __forceinline__ float sigmoidf_(float v) { return __builtin_amdgcn_rcpf(1.f + __expf(-v)); }
__device__ __forceinline__ float wave_sum(float v) {
#pragma unroll
    for (int o = 1; o < 64; o <<= 1) v += __shfl_xor(v, o);
    return v;
}
#define LDS_WAIT() asm volatile("s_waitcnt lgkmcnt(0)" ::: "memory")
#define VM_WAIT() asm volatile("s_waitcnt vmcnt(0)" ::: "memory")

namespace pg8 {
constexpr int BM = 256, BK = 64, HALF = 128, HTB = HALF * BK * 2, STAGE_BYTES = 8 * HTB, NXCD = 8, WGM = 8;
__device__ __forceinline__ int lds_byte(int r, int c) { const int st = (r >> 4) * 2 + (c >> 5), rr = r & 15, cc = c & 31, ob = rr * 64 + cc * 2; return st * 1024 + (ob ^ (((ob >> 9) & 1) << 5)); }
__device__ __forceinline__ void stage_rc(int b, int& R, int& C) { const int st = b / 1024, sb = b % 1024, swz = sb ^ (((sb >> 9) & 1) << 5); R = (st >> 1) * 16 + swz / 64; C = (st & 1) * 32 + (swz % 64) / 2; }
__device__ __forceinline__ int perm32(int rho) { const int n = rho >> 4, i = rho & 15; return 8 * (i >> 2) + 4 * n + (i & 3); }

struct Unit { int pm, pn, kk; };
struct Gemm { const bf16_t* A; const bf16_t* Bt; int lda, ldb, K; long a1, a2; };

struct StaticOrder {
    int nM, nN, nwg, G, c;
    __device__ void init(int M, int N, int G_, int c_) { nM = M / BM; nN = N / BM; nwg = nM * nN; G = G_; c = c_; }
    __device__ bool next(int i, Unit& u) const {
        const long L = (long)i * G + c; if (L >= nwg) return false;
        int wgid = (int)L; { const int q = nwg / NXCD, r = nwg % NXCD, xcd = wgid % NXCD, off = wgid / NXCD; wgid = (xcd < r ? xcd * (q + 1) : r * (q + 1) + (xcd - r) * q) + off; }
        const int nig = WGM * nN, gid = wgid / nig, fm = gid * WGM, gsz = (nM - fm) < WGM ? (nM - fm) : WGM;
        u.pm = fm + ((wgid % nig) % gsz); u.pn = (wgid % nig) / gsz; u.kk = 0; return true;
    }
};
struct BranchOrder {
    StaticOrder so;
    __device__ bool next(int i, Unit& u) const { const int ti = i / 3, kk = i - 3 * ti; if (!so.next(ti, u)) return false; u.kk = kk; return true; }
};

template <int MODE> __device__ __forceinline__ const char* unitA(const Gemm& g, const Unit& u) {
    const char* p = (const char*)g.A + (size_t)u.pm * BM * g.lda * 2;
    if (MODE == 1) p += (((u.pn >> 1) & 3) * 256) * 2;
    if (MODE == 2) p += (u.kk == 1 ? g.a1 : (u.kk == 2 ? g.a2 : 0l));
    return p;
}
template <int MODE> __device__ __forceinline__ const char* unitB(const Gemm& g, const Unit& u) {
    const char* p = (const char*)g.Bt + (size_t)u.pn * BM * g.ldb * 2;
    if (MODE == 2) p += (size_t)u.kk * 1024 * 1024 * 2;
    return p;
}

template <class Epi, class Sched, int MODE>
__device__ __forceinline__ void gemm_phase(LAS unsigned char* lds, const Gemm g, const Sched& S, const Epi& E, const int tid) {
    const int wid = __builtin_amdgcn_readfirstlane(tid >> 6), lane = tid & 63, wr = wid >> 2, wc = wid & 3, fr = lane & 15, fq = lane >> 4;
    const int K = g.K, nt = K / BK;
    unsigned voffA[2], voffB[2];
#pragma unroll
    for (int i = 0; i < 2; ++i) { int R, C; stage_rc(tid * 16 + i * 8192, R, C); const int Rb = (R & ~31) + perm32(R & 31);
        voffA[i] = (unsigned)(R * g.lda + C) * 2u; voffB[i] = (unsigned)(Rb * g.ldb + C) * 2u; }
    const size_t kstep = (size_t)(BK * 2);
    const size_t hstepA = (size_t)HALF * g.lda * 2, hstepB = (size_t)HALF * g.ldb * 2;
    const unsigned ldsw = (unsigned)wid * 1024u;
    const int aoff = lds_byte(wr * 64 + fr, fq * 8), boff = lds_byte(wc * 32 + fr, fq * 8);
#define PG8_SA(b, h) (((b) * 2 + (h)) * HTB)
#define PG8_SB(b, h) ((4 + (b) * 2 + (h)) * HTB)
#define PG8_STAGE(bufoff, gbase, voff) do { _Pragma("unroll") for (int _i = 0; _i < 2; ++_i) \
        __builtin_amdgcn_global_load_lds((const unsigned*)((const char*)(gbase) + (voff)[_i]), (LAS unsigned*)(lds + (bufoff) + ldsw + _i * 8192), 16, 0, 0); } while (0)
#define PG8_LDA(dst, b, h) do { _Pragma("unroll") for (int m = 0; m < 4; ++m) _Pragma("unroll") for (int k = 0; k < 2; ++k) dst[m][k] = *(const LAS bf16x8*)(lds + PG8_SA(b, h) + aoff + m * 2048 + k * 1024); } while (0)
#define PG8_LDB(dst, b, h) do { _Pragma("unroll") for (int n = 0; n < 2; ++n) _Pragma("unroll") for (int k = 0; k < 2; ++k) dst[n][k] = *(const LAS bf16x8*)(lds + PG8_SB(b, h) + boff + n * 2048 + k * 1024); } while (0)
#define PG8_MMA(ai, bj, At, Bt) do { __builtin_amdgcn_s_setprio(1); _Pragma("unroll") for (int m = 0; m < 4; ++m) _Pragma("unroll") for (int n = 0; n < 2; ++n) _Pragma("unroll") for (int k = 0; k < 2; ++k) \
        acc[ai][bj][m][n] = __builtin_amdgcn_mfma_f32_16x16x32_bf16(Bt[n][k], At[m][k], acc[ai][bj][m][n], 0, 0, 0); __builtin_amdgcn_s_setprio(0); } while (0)
#define PG8_WAIT_V(n) asm volatile("s_waitcnt vmcnt(" #n ")" ::: "memory")
#define PG8_WAIT_L(n) asm volatile("s_waitcnt lgkmcnt(" #n ")" ::: "memory")
#define PG8_BAR __builtin_amdgcn_s_barrier()
#define PG8_SCHED __builtin_amdgcn_sched_barrier(0)
    Unit cur, nxt; int ui = 0;
    if (!S.next(0, cur)) return;
    f32x4 acc[2][2][4][2];
#pragma unroll
    for (int a = 0; a < 2; ++a)
#pragma unroll
        for (int b = 0; b < 2; ++b)
#pragma unroll
            for (int m = 0; m < 4; ++m)
#pragma unroll
                for (int n = 0; n < 2; ++n) acc[a][b][m][n] = (f32x4){0.f, 0.f, 0.f, 0.f};
    bf16x8 At[4][2], B0[2][2], B1[2][2];
    const char* cA = unitA<MODE>(g, cur); const char* cB = unitB<MODE>(g, cur);
    PG8_STAGE(PG8_SB(0, 0), cB, voffB); PG8_STAGE(PG8_SB(0, 1), cB + hstepB, voffB); PG8_STAGE(PG8_SA(0, 0), cA, voffA); PG8_STAGE(PG8_SA(0, 1), cA + hstepA, voffA);
    if (wr == 1) PG8_BAR;
    PG8_WAIT_V(2); PG8_BAR;
    PG8_STAGE(PG8_SB(1, 0), cB + kstep, voffB); PG8_STAGE(PG8_SA(1, 0), cA + kstep, voffA); PG8_STAGE(PG8_SB(1, 1), cB + hstepB + kstep, voffB);
    PG8_WAIT_V(6); PG8_BAR;
    for (;;) {
        const bool has_next = S.next(ui + 1, nxt);
        const char* nA = has_next ? unitA<MODE>(g, nxt) : cA; const char* nB = has_next ? unitB<MODE>(g, nxt) : cB;
#pragma nounroll
        for (int t = 0; t < nt; t += 2) {
            const bool last = (t == nt - 2);
            const char* a1 = cA + (size_t)(t + 1) * kstep;
            const char* a2 = last ? nA : cA + (size_t)(t + 2) * kstep; const char* b2 = last ? nB : cB + (size_t)(t + 2) * kstep;
            const char* a3 = a2 + kstep; const char* b3 = b2 + kstep;
            PG8_LDB(B0, 0, 0); PG8_LDB(B1, 0, 1); PG8_SCHED; PG8_LDA(At, 0, 0); PG8_STAGE(PG8_SA(1, 1), a1 + hstepA, voffA);
            PG8_WAIT_V(8); PG8_WAIT_L(0); PG8_BAR; PG8_MMA(0, 0, At, B0); PG8_MMA(0, 1, At, B1); PG8_BAR; PG8_SCHED;
            PG8_LDA(At, 0, 1); PG8_STAGE(PG8_SB(0, 0), b2, voffB); PG8_STAGE(PG8_SB(0, 1), b2 + hstepB, voffB); PG8_STAGE(PG8_SA(0, 0), a2, voffA);
            PG8_WAIT_V(8); PG8_WAIT_L(0); PG8_BAR; PG8_MMA(1, 0, At, B0); PG8_MMA(1, 1, At, B1); PG8_BAR; PG8_SCHED;
            PG8_LDB(B0, 1, 0); PG8_LDB(B1, 1, 1); PG8_SCHED; PG8_LDA(At, 1, 0); PG8_STAGE(PG8_SA(0, 1), a2 + hstepA, voffA);
            PG8_WAIT_V(8); PG8_WAIT_L(0); PG8_BAR; PG8_MMA(0, 0, At, B0); PG8_MMA(0, 1, At, B1); PG8_BAR; PG8_SCHED;
            PG8_LDA(At, 1, 1); PG8_STAGE(PG8_SB(1, 0), b3, voffB); PG8_STAGE(PG8_SB(1, 1), b3 + hstepB, voffB); PG8_STAGE(PG8_SA(1, 0), a3, voffA);
            PG8_WAIT_V(8); PG8_WAIT_L(0); PG8_BAR; PG8_MMA(1, 0, At, B0); PG8_MMA(1, 1, At, B1); PG8_BAR; PG8_SCHED;
        }
        if (wr == 0) PG8_BAR;
        E(acc, cur, wr, wc, fr, fq);
        if (!has_next) break;
#pragma unroll
        for (int a = 0; a < 2; ++a)
#pragma unroll
            for (int b = 0; b < 2; ++b)
#pragma unroll
                for (int m = 0; m < 4; ++m)
#pragma unroll
                    for (int n = 0; n < 2; ++n) acc[a][b][m][n] = (f32x4){0.f, 0.f, 0.f, 0.f};
        cur = nxt; cA = nA; cB = nB; ++ui;
        if (wr == 1) PG8_BAR;
    }
    PG8_WAIT_V(0);
    PG8_BAR;
#undef PG8_SA
#undef PG8_SB
#undef PG8_STAGE
#undef PG8_LDA
#undef PG8_LDB
#undef PG8_MMA
#undef PG8_WAIT_V
#undef PG8_WAIT_L
#undef PG8_BAR
#undef PG8_SCHED
}

__device__ __forceinline__ void store_tile_bf16(const f32x4 (&acc)[2][2][4][2], bf16_t* base, int ldc, int row0, int col0, int act) {
#pragma unroll
    for (int ai = 0; ai < 2; ++ai)
#pragma unroll
        for (int m = 0; m < 4; ++m) { bf16_t* rowp = base + (size_t)(row0 + ai * HALF + m * 16) * ldc + col0;
#pragma unroll
            for (int bj = 0; bj < 2; ++bj) { float v[8];
#pragma unroll
                for (int j = 0; j < 4; ++j) { v[j] = acc[ai][bj][m][0][j]; v[4 + j] = acc[ai][bj][m][1][j]; }
                if (act != 0) {
                    float sg[8];
#pragma unroll
                    for (int j = 0; j < 8; ++j) sg[j] = sigmoidf_(v[j]);
                    if (act == 1) {
#pragma unroll
                        for (int j = 0; j < 8; ++j) v[j] *= sg[j];
                    } else {
#pragma unroll
                        for (int j = 0; j < 8; ++j) v[j] = sg[j];
                    }
                }
                *(u32x4*)(rowp + bj * HALF) = pack8(v); }
            asm volatile("" ::: "memory"); }
}
struct EpiInProj {
    unsigned char* ws;
    __device__ __forceinline__ void operator()(const f32x4 (&acc)[2][2][4][2], const Unit& u, int wr, int wc, int fr, int fq) const {
        const int pn = u.pn; size_t off; int ldc = 1024, col, act = 0;
        if (pn < 4) { off = WS_XA; col = pn * 256; }
        else if (pn < 8) { off = WS_SGA; col = (pn - 4) * 256; act = 1; }
        else if (pn < 12) { off = WS_Q; col = (pn - 8) * 256; }
        else if (pn == 12) { off = WS_K; col = 0; ldc = 256; }
        else if (pn == 13) { off = WS_V; col = 0; ldc = 256; }
        else if (pn < 18) { off = WS_SGB; col = (pn - 14) * 256; act = 1; }
        else if (pn < 34) {
            const bool bg = pn >= 26; const int blk = bg ? pn - 26 : pn - 18;
            bf16_t* basep = (bf16_t*)(ws + (bg ? WS_BC : WS_XC));
            const int row0p = u.pm * BM + wr * 64 + fr, col0p = blk * 128 + wc * 32 + 8 * fq;
#pragma unroll
            for (int ai = 0; ai < 2; ++ai)
#pragma unroll
                for (int m = 0; m < 4; ++m) { float v[8];
#pragma unroll
                    for (int j = 0; j < 8; ++j) { const float x0 = acc[ai][0][m][j >> 2][j & 3], x1 = acc[ai][1][m][j >> 2][j & 3];
                        v[j] = bg ? x0 * (x1 * sigmoidf_(x1)) : x0 * x1; }
                    *(u32x4*)(basep + (size_t)(row0p + ai * HALF + m * 16) * 1024 + col0p) = pack8(v); }
            return; }
        else { off = WS_SMG; col = (pn - 34) * 256; ldc = 3072; act = 2; }
        bf16_t* base = (bf16_t*)(ws + off);
        const int row0 = u.pm * BM + wr * 64 + fr, col0 = col + wc * 32 + 8 * fq;
        store_tile_bf16(acc, base, ldc, row0, col0, act);
    }
};
struct EpiGates {
    unsigned char* ws; const float* b_r; const float* b_i; const float* lam;
    __device__ __forceinline__ void operator()(const f32x4 (&acc)[2][2][4][2], const Unit& u, int wr, int wc, int fr, int fq) const {
        const int dir = u.pn >> 3, nb = (u.pn >> 1) & 3, hh = u.pn & 1;
        const int ch0 = nb * 256 + hh * 128 + wc * 32 + 8 * fq;
        float br[8], bi[8], sp[8];
#pragma unroll
        for (int j = 0; j < 8; ++j) { br[j] = b_r[dir * 1024 + ch0 + j]; bi[j] = b_i[dir * 1024 + ch0 + j];
            const float lm = lam[dir * 1024 + ch0 + j]; const float e = __expf(-lm);
            const float spl = lm < -15.f ? -lm : (e < 0.03f ? e * (1.f - e * (0.5f - e * (0.33333334f - 0.25f * e))) : __logf(1.f + e));
            sp[j] = -8.0f * LOG2E * spl; }
        const bf16_t* UA = (const bf16_t*)(ws + WS_H);
        bf16_t* LA = (bf16_t*)(ws + WS_LA + (size_t)dir * 64 * MiB);
        bf16_t* UU = (bf16_t*)(ws + WS_U + (size_t)dir * 64 * MiB);
        const int row0 = u.pm * BM + wr * 64 + fr;
#pragma unroll
        for (int ai = 0; ai < 2; ++ai)
#pragma unroll
            for (int m = 0; m < 4; ++m) { const size_t o = (size_t)(row0 + ai * HALF + m * 16) * 1024 + ch0;
                float x[8]; unpack8(*(const u32x4*)(UA + o), x);
                float la[8], uu[8];
#pragma unroll
                for (int j = 0; j < 8; ++j) { const float pr = acc[ai][0][m][j >> 2][j & 3] + br[j], pi = acc[ai][1][m][j >> 2][j & 3] + bi[j];
                    const float r = sigmoidf_(pr), ig = sigmoidf_(pi);
                    const float l2 = r * sp[j]; const float a = __builtin_amdgcn_exp2f(l2);
                    la[j] = l2; uu[j] = __builtin_amdgcn_sqrtf(fmaxf(1.f - a * a, 0.f)) * ig * x[j]; }
                *(u32x4*)(LA + o) = pack8(la); *(u32x4*)(UU + o) = pack8(uu); }
    }
};
struct EpiBranch {
    unsigned char* ws;
    __device__ __forceinline__ void operator()(const f32x4 (&acc)[2][2][4][2], const Unit& u, int wr, int wc, int fr, int fq) const {
        const bf16_t* G = (const bf16_t*)(ws + WS_SMG) + u.kk * 1024;
        bf16_t* Mg = (bf16_t*)(ws + WS_SGA);
        const int row0 = u.pm * BM + wr * 64 + fr, col0 = u.pn * BM + wc * 32 + 8 * fq;
#pragma unroll
        for (int ai = 0; ai < 2; ++ai)
#pragma unroll
            for (int m = 0; m < 4; ++m) { const int row = row0 + ai * HALF + m * 16;
#pragma unroll
                for (int bj = 0; bj < 2; ++bj) { const int col = col0 + bj * HALF;
                    float gt[8], v[8]; unpack8(*(const u32x4*)(G + (size_t)row * 3072 + col), gt);
#pragma unroll
                    for (int j = 0; j < 8; ++j) v[j] = gt[j] * acc[ai][bj][m][j >> 2][j & 3];
                    bf16_t* mp = Mg + (size_t)row * 1024 + col;
                    if (u.kk != 0) { float old[8]; unpack8(*(const u32x4*)mp, old);
#pragma unroll
                        for (int j = 0; j < 8; ++j) v[j] += old[j]; }
                    *(u32x4*)mp = pack8(v); } }
    }
};
struct EpiOut {
    const float* xi; float* xo; const float* gate; const unsigned* flag;
    __device__ __forceinline__ void operator()(const f32x4 (&acc)[2][2][4][2], const Unit& u, int wr, int wc, int fr, int fq) const {
        const int row0 = u.pm * BM + wr * 64 + fr, col0 = u.pn * BM + wc * 32 + 8 * fq;
        const bool bad = PROBE_F8 ? (__hip_atomic_load(flag, __ATOMIC_RELAXED, __HIP_MEMORY_SCOPE_AGENT) != 0u) : false; const float qn = __builtin_nanf("");
        f32x4 gv[2][2];
#pragma unroll
        for (int bj = 0; bj < 2; ++bj)
#pragma unroll
            for (int n = 0; n < 2; ++n) gv[bj][n] = *(const f32x4*)(gate + col0 + bj * HALF + 4 * n);
#pragma unroll
        for (int ai = 0; ai < 2; ++ai)
#pragma unroll
            for (int m = 0; m < 4; ++m) { const size_t o = (size_t)(row0 + ai * HALF + m * 16) * 1024 + col0;
#pragma unroll
                for (int bj = 0; bj < 2; ++bj)
#pragma unroll
                    for (int n = 0; n < 2; ++n) { const f32x4 xv = *(const f32x4*)(xi + o + bj * HALF + 4 * n);
                        f32x4 r = xv + gv[bj][n] * acc[ai][bj][m][n]; if (PROBE_F8 && bad) r = (f32x4){qn, qn, qn, qn};
                        *(f32x4*)(xo + o + bj * HALF + 4 * n) = r; } }
    }
};
}

namespace attn {
using bf16 = __hip_bfloat16;
using s16x4 = __attribute__((ext_vector_type(4))) short;
using f32x16 = __attribute__((ext_vector_type(16))) float;
constexpr int D = 128, NW = 8, QBLK = 32, KVBLK = 64;
constexpr float SCALE = 0.088388347648318440f;
constexpr float THR = 8.f;
constexpr int LDQ = 1024, LDK = 256, LDO = 1024;
constexpr size_t SHM_V = KVBLK * D * 2, SHM_K = KVBLK * D * 2, SHM_ATTN = 2 * SHM_V + 2 * SHM_K + NW * 64 * 4;
#define KSWZ(row, colB) ((row) * 256 + ((colB) ^ (((row) & 7) << 4)))
#define SBAR() __builtin_amdgcn_sched_barrier(0)
__device__ __forceinline__ int crow(int r, int hi) { return (r & 3) + 8 * (r >> 2) + 4 * hi; }
__device__ __forceinline__ unsigned cvtpk(float lo, float hi) { unsigned r; asm volatile("v_cvt_pk_bf16_f32 %0, %1, %2" : "=v"(r) : "v"(lo), "v"(hi)); return r; }

__device__ __forceinline__ void partialSM(f32x16& p0, f32x16& p1, float& m_reg, float& mn, float& alpha) {
  constexpr float C = SCALE * 1.4426950408889634f;
  float pmax = p0[0]; for (int r = 1; r < 16; ++r) pmax = fmaxf(pmax, p0[r]); for (int r = 0; r < 16; ++r) pmax = fmaxf(pmax, p1[r]);
  { auto rr = __builtin_amdgcn_permlane32_swap(__float_as_uint(pmax), __float_as_uint(pmax), false, false);
    pmax = fmaxf(__uint_as_float(rr[0]), __uint_as_float(rr[1])); }
  if (__builtin_expect(__all(pmax - m_reg <= THR / SCALE), 1)) { mn = m_reg; alpha = 1.f; }
  else { mn = fmaxf(m_reg, pmax); alpha = __builtin_amdgcn_exp2f((m_reg - mn) * C); m_reg = mn; }
  float mnC = -mn * C;
  for (int r = 0; r < 16; ++r) p0[r] = fmaf(p0[r], C, mnC); for (int r = 0; r < 16; ++r) p1[r] = fmaf(p1[r], C, mnC);
  for (int r = 0; r < 16; ++r) p0[r] = __builtin_amdgcn_exp2f(p0[r]);
}
__device__ __forceinline__ void finishSM(f32x16& p0, f32x16& p1, float alpha, float& l_reg, bf16x8& pa0, bf16x8& pa1, bf16x8& pa2, bf16x8& pa3) {
  for (int r = 0; r < 16; ++r) p1[r] = __builtin_amdgcn_exp2f(p1[r]);
  float ps = 0; for (int r = 0; r < 16; ++r) ps += p0[r]; for (int r = 0; r < 16; ++r) ps += p1[r];
  { auto rr = __builtin_amdgcn_permlane32_swap(__float_as_uint(ps), __float_as_uint(ps), false, false);
    ps = __uint_as_float(rr[0]) + __uint_as_float(rr[1]); }
  l_reg = l_reg * alpha + ps;
#define PK4(P, BASE, OUT) do { unsigned a0 = cvtpk(P[BASE + 0], P[BASE + 1]), a1 = cvtpk(P[BASE + 2], P[BASE + 3]);   \
    unsigned b0 = cvtpk(P[BASE + 4], P[BASE + 5]), b1 = cvtpk(P[BASE + 6], P[BASE + 7]);                              \
    auto r0 = __builtin_amdgcn_permlane32_swap(a0, b0, false, false); auto r1 = __builtin_amdgcn_permlane32_swap(a1, b1, false, false); \
    u32x4 w = {r0[0], r1[0], r0[1], r1[1]}; OUT = *reinterpret_cast<bf16x8*>(&w); } while (0)
  PK4(p0, 0, pa0); PK4(p0, 8, pa1); PK4(p1, 0, pa2); PK4(p1, 8, pa3);
#undef PK4
}
__device__ __forceinline__ void qkt(f32x16& p0, f32x16& p1, const bf16* Ks, const bf16x8* qr, int r32, int hi) {
  p0 = f32x16{}; p1 = f32x16{};
  for (int d0 = 0; d0 < 8; ++d0) { int cb = (d0 * 16 + hi * 8) * 2;
    bf16x8 b0 = *reinterpret_cast<const bf16x8*>((const char*)Ks + KSWZ(r32, cb));
    bf16x8 b1 = *reinterpret_cast<const bf16x8*>((const char*)Ks + KSWZ(32 + r32, cb));
    p0 = __builtin_amdgcn_mfma_f32_32x32x16_bf16(b0, qr[d0], p0, 0, 0, 0);
    p1 = __builtin_amdgcn_mfma_f32_32x32x16_bf16(b1, qr[d0], p1, 0, 0, 0); }
}
__device__ __forceinline__ int v_st(int k, int c) { const int kk = (k & ~0xC) | ((k & 4) << 1) | ((k & 8) >> 1); return ((kk >> 3) * 4 + (c >> 5)) * 512 + ((kk & 7) * 32 + (c & 31)) * 2; }
__device__ __forceinline__ int v_rd_base(int lane) { return ((lane & 3) << 3) | (((lane >> 2) & 3) << 6) | (((lane >> 4) & 1) << 5) | (((lane >> 5) & 1) << 8); }
constexpr int v_rd_off(int d0, int ks, int half) { return d0 * 512 + ks * 4096 + half * 2048; }
template <int OFF> __device__ __forceinline__ s16x4 tr_read(int vb) {
  s16x4 r; asm volatile("ds_read_b64_tr_b16 %0, %1 offset:%2" : "=&v"(r) : "v"(vb), "i"(OFF) : "memory"); return r;
}
template <int D0> __device__ __forceinline__ void pv_one(f32x16& od, int vb, bf16x8 pa0, bf16x8 pa1, bf16x8 pa2, bf16x8 pa3) {
  const s16x4 l0 = tr_read<v_rd_off(D0, 0, 0)>(vb), h0 = tr_read<v_rd_off(D0, 0, 1)>(vb), l1 = tr_read<v_rd_off(D0, 1, 0)>(vb), h1 = tr_read<v_rd_off(D0, 1, 1)>(vb);
  const s16x4 l2 = tr_read<v_rd_off(D0, 2, 0)>(vb), h2 = tr_read<v_rd_off(D0, 2, 1)>(vb), l3 = tr_read<v_rd_off(D0, 3, 0)>(vb), h3 = tr_read<v_rd_off(D0, 3, 1)>(vb);
  asm volatile("s_waitcnt lgkmcnt(0)" ::: "memory"); SBAR();
#define PK(L, H) (bf16x8){L[0], L[1], L[2], L[3], H[0], H[1], H[2], H[3]}
  od = __builtin_amdgcn_mfma_f32_32x32x16_bf16(pa0, PK(l0, h0), od, 0, 0, 0);
  od = __builtin_amdgcn_mfma_f32_32x32x16_bf16(pa1, PK(l1, h1), od, 0, 0, 0);
  od = __builtin_amdgcn_mfma_f32_32x32x16_bf16(pa2, PK(l2, h2), od, 0, 0, 0);
  od = __builtin_amdgcn_mfma_f32_32x32x16_bf16(pa3, PK(l3, h3), od, 0, 0, 0);
#undef PK
}
__device__ __forceinline__ void pv_d0(f32x16* o, int vb, bf16x8 pa0, bf16x8 pa1, bf16x8 pa2, bf16x8 pa3) {
  pv_one<0>(o[0], vb, pa0, pa1, pa2, pa3); pv_one<1>(o[1], vb, pa0, pa1, pa2, pa3); pv_one<2>(o[2], vb, pa0, pa1, pa2, pa3); pv_one<3>(o[3], vb, pa0, pa1, pa2, pa3);
}
__device__ __forceinline__ void attn_dense_body(const bf16* Qb, const bf16* __restrict__ Kh, const bf16* __restrict__ Vh,
                                                bf16_t* Ob, const bf16_t* Gb, int seq, char* lds, const int tid) {
  const int wid = tid >> 6, lane = tid & 63, r32 = lane & 31, hi = lane >> 5;
  bf16* V_lds = (bf16*)lds; bf16* K_lds = (bf16*)(lds + 2 * SHM_V);
  float* ws = (float*)(lds + 2 * SHM_V + 2 * SHM_K) + wid * 64; float* li_l = ws; float* al_l = ws + 32;
  float m_reg = -1e30f, l_reg = 0; f32x16 o[4] = {}; bf16x8 qr[8];
  const bf16* Qw = Qb + (long)(wid * QBLK + r32) * LDQ + hi * 8;
#pragma unroll
  for (int d0 = 0; d0 < 8; ++d0) qr[d0] = *reinterpret_cast<const bf16x8*>(Qw + d0 * 16);
  const int sr = tid >> 4, sc = (tid & 15) * 8, vst0 = v_st(sr, sc), vst1 = v_st(32 + sr, sc);
  const int vb0 = (int)(uintptr_t)V_lds + v_rd_base(lane);
  struct { bf16x8 vs0, vs1, ks0, ks1; } sr_[2];
#define SLOAD(i, k0) do { sr_[i].vs0 = *reinterpret_cast<const bf16x8*>(&Vh[(long)((k0) + sr) * LDK + sc]); sr_[i].vs1 = *reinterpret_cast<const bf16x8*>(&Vh[(long)((k0) + 32 + sr) * LDK + sc]); \
    sr_[i].ks0 = *reinterpret_cast<const bf16x8*>(&Kh[(long)((k0) + sr) * LDK + sc]); sr_[i].ks1 = *reinterpret_cast<const bf16x8*>(&Kh[(long)((k0) + 32 + sr) * LDK + sc]); } while (0)
#define SWRITE(b, i) do { *(bf16x8*)((char*)V_lds + (b) * SHM_V + vst0) = sr_[i].vs0;          \
    *(bf16x8*)((char*)V_lds + (b) * SHM_V + vst1) = sr_[i].vs1; int kc = sc * 2;               \
    *(bf16x8*)((char*)K_lds + (b) * SHM_K + KSWZ(sr, kc)) = sr_[i].ks0;                       \
    *(bf16x8*)((char*)K_lds + (b) * SHM_K + KSWZ(32 + sr, kc)) = sr_[i].ks1; } while (0)
#define SWAIT() asm volatile("s_waitcnt vmcnt(4)" ::: "memory")
#define RESC(a) do { if (__any((a) < 1.f)) { if (hi == 0) al_l[r32] = (a); asm volatile("s_waitcnt lgkmcnt(0)" ::: "memory"); \
    for (int d = 0; d < 4; ++d) for (int r = 0; r < 16; ++r) o[d][r] *= al_l[crow(r, hi)]; } } while (0)
  f32x16 pA0, pA1, pB0, pB1; float mnA, mnB, alA, alB; bf16x8 pa0, pa1, pa2, pa3; const int NT = seq / KVBLK;
  constexpr int SE = 0, SO = 1;
  SLOAD(SE, 0); asm volatile("s_waitcnt vmcnt(0)" ::: "memory"); SWRITE(0, SE); __syncthreads();
  qkt(pA0, pA1, K_lds, qr, r32, hi); partialSM(pA0, pA1, m_reg, mnA, alA);
  SLOAD(SO, KVBLK); if (2 < NT) SLOAD(SE, 2 * KVBLK);
  SWAIT(); SWRITE(1, SO); __syncthreads();
#pragma nounroll
  for (int j = 1; j + 1 < NT; j += 2) {
    SBAR(); qkt(pB0, pB1, (bf16*)((char*)K_lds + SHM_K), qr, r32, hi);
    finishSM(pA0, pA1, alA, l_reg, pa0, pa1, pa2, pa3); SBAR();
    SLOAD(SO, (j + 2) * KVBLK); SBAR();
    pv_d0(o, vb0, pa0, pa1, pa2, pa3); partialSM(pB0, pB1, m_reg, mnB, alB);
    __syncthreads(); SWAIT(); SWRITE(0, SE);
    RESC(alB); __syncthreads();
    SBAR(); qkt(pA0, pA1, K_lds, qr, r32, hi);
    finishSM(pB0, pB1, alB, l_reg, pa0, pa1, pa2, pa3); SBAR();
    if (j + 3 < NT) SLOAD(SE, (j + 3) * KVBLK); SBAR();
    pv_d0(o, vb0 + (int)SHM_V, pa0, pa1, pa2, pa3); partialSM(pA0, pA1, m_reg, mnA, alA);
    __syncthreads(); SWAIT(); SWRITE(1, SO);
    RESC(alA); __syncthreads();
  }
  SBAR(); qkt(pB0, pB1, (bf16*)((char*)K_lds + SHM_K), qr, r32, hi);
  finishSM(pA0, pA1, alA, l_reg, pa0, pa1, pa2, pa3); SBAR();
  pv_d0(o, vb0, pa0, pa1, pa2, pa3); partialSM(pB0, pB1, m_reg, mnB, alB);
  __syncthreads(); RESC(alB);
  finishSM(pB0, pB1, alB, l_reg, pa0, pa1, pa2, pa3); SBAR();
  pv_d0(o, vb0 + (int)SHM_V, pa0, pa1, pa2, pa3);
  if (hi == 0) li_l[r32] = l_reg; asm volatile("s_waitcnt lgkmcnt(0)" ::: "memory");
  float rli[16];
#pragma unroll
  for (int r = 0; r < 16; ++r) rli[r] = __builtin_amdgcn_rcpf(li_l[crow(r, hi)]);
  __syncthreads();
  { int lane_e = lane, wid_e = wid; asm volatile("" : "+v"(lane_e), "+v"(wid_e)); wid_e = __builtin_amdgcn_readfirstlane(wid_e);
    bf16_t* stg = (bf16_t*)lds + wid_e * 4096;
#pragma unroll
    for (int r = 0; r < 16; ++r) { const int orow = crow(r, hi);
#pragma unroll
      for (int d0 = 0; d0 < 4; ++d0) stg[orow * 128 + d0 * 32 + r32] = (bf16_t)f2bf(o[d0][r] * rli[r]); }
    asm volatile("s_waitcnt lgkmcnt(0)" ::: "memory");
    bf16_t* Ow = Ob + (long)(wid_e * QBLK) * LDO; const bf16_t* Gw = Gb + (long)(wid_e * QBLK) * LDO;
    u32x4 gq[8];
#pragma unroll
    for (int i = 0; i < 8; ++i) { const int row = i * 4 + (lane_e >> 4), ch = lane_e & 15; gq[i] = *(const u32x4*)(Gw + (long)row * LDO + ch * 8); }
#pragma unroll
    for (int i = 0; i < 8; ++i) { const int row = i * 4 + (lane_e >> 4), ch = lane_e & 15;
      float ov[8], gv[8]; unpack8(*(const u32x4*)(stg + row * 128 + ch * 8), ov); unpack8(gq[i], gv);
#pragma unroll
      for (int j = 0; j < 8; ++j) ov[j] *= gv[j];
      *(u32x4*)(Ow + (long)row * LDO + ch * 8) = pack8(ov); } }
  __syncthreads();
#undef SLOAD
#undef SWRITE
#undef SWAIT
#undef RESC
}

__device__ __forceinline__ void attn_pp_body(const bf16* Qb, const bf16* __restrict__ Kh, const bf16* __restrict__ Vh,
                                             bf16_t* Ob, const bf16_t* Gb, int seq, char* lds, const int tid, const bf16_t* cmp = nullptr, unsigned* flag = nullptr) {
  const int wid = __builtin_amdgcn_readfirstlane(tid >> 6), lane = tid & 63, r32 = lane & 31, hi = lane >> 5;
  const int g = wid >> 2;
  constexpr int NB = 3;
  char* V_lds = lds; char* K_lds = lds + NB * SHM_V;
  float* ws = (float*)(lds + NB * (SHM_V + SHM_K)) + wid * 64; float* li_l = ws; float* al_l = ws + 32;
  float m_reg = -1e30f, l_reg = 0; f32x16 o[4] = {}; bf16x8 qr[8];
  const bf16* Qw = Qb + (long)(wid * QBLK + r32) * LDQ + hi * 8;
#pragma unroll
  for (int d0 = 0; d0 < 8; ++d0) qr[d0] = *reinterpret_cast<const bf16x8*>(Qw + d0 * 16);
  const int sr = tid >> 4, sc = (tid & 15) * 8, vst0 = v_st(sr, sc), vst1 = v_st(32 + sr, sc);
  const int ksw0 = KSWZ(sr, sc * 2), ksw1 = KSWZ(32 + sr, sc * 2);
  const int vbase = (int)(uintptr_t)V_lds + v_rd_base(lane);
  struct Stg { bf16x8 vs0, vs1, ks0, ks1; } st0, st1;
#define SLOAD(S, t) do { const long k0_ = (long)(t) * KVBLK; S.vs0 = *reinterpret_cast<const bf16x8*>(&Vh[(k0_ + sr) * LDK + sc]); S.vs1 = *reinterpret_cast<const bf16x8*>(&Vh[(k0_ + 32 + sr) * LDK + sc]); \
    S.ks0 = *reinterpret_cast<const bf16x8*>(&Kh[(k0_ + sr) * LDK + sc]); S.ks1 = *reinterpret_cast<const bf16x8*>(&Kh[(k0_ + 32 + sr) * LDK + sc]); } while (0)
#define SWRITE(S, b) do { *(bf16x8*)(V_lds + (b) * SHM_V + vst0) = S.vs0; *(bf16x8*)(V_lds + (b) * SHM_V + vst1) = S.vs1; \
    *(bf16x8*)(K_lds + (b) * SHM_K + ksw0) = S.ks0; *(bf16x8*)(K_lds + (b) * SHM_K + ksw1) = S.ks1; } while (0)
#define RESC(a) do { if (__any((a) < 1.f)) { if (hi == 0) al_l[r32] = (a); asm volatile("s_waitcnt lgkmcnt(0)" ::: "memory"); \
    for (int d = 0; d < 4; ++d) for (int r = 0; r < 16; ++r) o[d][r] *= al_l[crow(r, hi)]; } } while (0)
  const int NT = seq / KVBLK;
  f32x16 p0, p1; bf16x8 pa0, pa1, pa2, pa3;
#define SMX() do { float mn_, al_; partialSM(p0, p1, m_reg, mn_, al_); RESC(al_); finishSM(p0, p1, al_, l_reg, pa0, pa1, pa2, pa3); } while (0)
  SLOAD(st0, 0); if (g) SLOAD(st1, 1);
  SWRITE(st0, 0); if (g) SWRITE(st1, 1);
  SLOAD(st0, 1 + g); SLOAD(st1, 2 + g);
  __syncthreads();
  if (g) __syncthreads();
  SBAR(); qkt(p0, p1, (const bf16*)K_lds, qr, r32, hi); SBAR();
  __syncthreads();
  SWRITE(st0, 1 + g); if (3 + g < NT) SLOAD(st0, 3 + g);
  SMX();
  __syncthreads();
  int c = 0;
#define STEP(i, ST) do { const int cK_ = (c == 2) ? 0 : c + 1; \
    SBAR(); \
    qkt(p0, p1, (const bf16*)(K_lds + cK_ * SHM_K), qr, r32, hi); \
    pv_d0(o, vbase + c * (int)SHM_V, pa0, pa1, pa2, pa3); \
    SBAR(); \
    __syncthreads(); \
    { const int t_ = (i) + 2 + g; if (t_ < NT) { const int cb_ = (cK_ == 2) ? 0 : cK_ + 1; const int cw_ = g ? ((cb_ == 2) ? 0 : cb_ + 1) : cb_; \
        SWRITE(ST, cw_); if (t_ + 2 < NT) SLOAD(ST, t_ + 2); } } \
    SMX(); \
    __syncthreads(); \
    c = cK_; } while (0)
  int i = 0;
#pragma nounroll
  for (; i + 1 < NT - 1; i += 2) { STEP(i, st1); STEP(i + 1, st0); }
  if (i < NT - 1) { STEP(i, st1); }
  SBAR(); pv_d0(o, vbase + c * (int)SHM_V, pa0, pa1, pa2, pa3); SBAR();
  __syncthreads();
  if (!g) __syncthreads();
  if (hi == 0) li_l[r32] = l_reg; asm volatile("s_waitcnt lgkmcnt(0)" ::: "memory");
  float rli[16];
#pragma unroll
  for (int r = 0; r < 16; ++r) rli[r] = __builtin_amdgcn_rcpf(li_l[crow(r, hi)]);
  { int lane_e = lane, wid_e = wid; asm volatile("" : "+v"(lane_e), "+v"(wid_e)); wid_e = __builtin_amdgcn_readfirstlane(wid_e);
    bf16_t* stg = (bf16_t*)lds + wid_e * 4096;
#pragma unroll
    for (int r = 0; r < 16; ++r) { const int orow = crow(r, hi);
#pragma unroll
      for (int d0 = 0; d0 < 4; ++d0) stg[orow * 128 + d0 * 32 + r32] = (bf16_t)f2bf(o[d0][r] * rli[r]); }
    asm volatile("s_waitcnt lgkmcnt(0)" ::: "memory");
    bf16_t* Ow = Ob + (long)(wid_e * QBLK) * LDO; const bf16_t* Gw = Gb + (long)(wid_e * QBLK) * LDO;
    u32x4 gq[8];
#pragma unroll
    for (int i2 = 0; i2 < 8; ++i2) { const int row = i2 * 4 + (lane_e >> 4), ch = lane_e & 15; gq[i2] = *(const u32x4*)(Gw + (long)row * LDO + ch * 8); }
#pragma unroll
    for (int i2 = 0; i2 < 8; ++i2) { const int row = i2 * 4 + (lane_e >> 4), ch = lane_e & 15;
      float ov[8], gv[8]; unpack8(*(const u32x4*)(stg + row * 128 + ch * 8), ov); unpack8(gq[i2], gv);
#pragma unroll
      for (int j = 0; j < 8; ++j) ov[j] *= gv[j];
      *(u32x4*)(Ow + (long)row * LDO + ch * 8) = pack8(ov); } }
  __syncthreads();
  if (PROBE_F8 && cmp) {
    asm volatile("s_waitcnt vmcnt(0)" ::: "memory");
    float pr_d = 0.f, pr_r = 0.f; int lane_c = lane; asm volatile("" : "+v"(lane_c));
    const bf16_t* stg2 = (const bf16_t*)lds + wid * 4096;
    float a0[8], c0[8];
#pragma unroll
    for (int i2 = 0; i2 < 8; ++i2) { const int rl = i2 * 4 + (lane_c >> 4), ch = lane_c & 15; float a[8], cv[8];
      unpack8(*(const u32x4*)(stg2 + rl * 128 + ch * 8), a); unpack8(*(const u32x4*)(cmp + (long)(wid * QBLK + rl) * LDO + ch * 8), cv);
      if (i2 == 0) {
#pragma unroll
        for (int j = 0; j < 8; ++j) { a0[j] = a[j]; c0[j] = cv[j]; }
      } else {
#pragma unroll
        for (int j = 0; j < 8; ++j) { const float fa = a[j] - a0[j], fc = cv[j] - c0[j]; pr_d = fmaxf(pr_d, fabsf(fa - fc)); pr_r = fmaxf(pr_r, fabsf(fa)); } } }
#pragma unroll
    for (int o_ = 1; o_ < 64; o_ <<= 1) { pr_d = fmaxf(pr_d, __shfl_xor(pr_d, o_)); pr_r = fmaxf(pr_r, __shfl_xor(pr_r, o_)); }
    if (lane_c == 0 && !(pr_d <= 0.3f * pr_r)) atomicOr(flag, 1u);
    __syncthreads(); }
#undef SLOAD
#undef SWRITE
#undef RESC
#undef SMX
#undef STEP
}

constexpr float THR8 = 1.5f;
__device__ __forceinline__ void partialSM8(f32x16& p0, f32x16& p1, float& m_reg, float& alpha) {
  constexpr float C = SCALE * 1.4426950408889634f;
  float pmax = p0[0]; for (int r = 1; r < 16; ++r) pmax = fmaxf(pmax, p0[r]); for (int r = 0; r < 16; ++r) pmax = fmaxf(pmax, p1[r]);
  { auto rr = __builtin_amdgcn_permlane32_swap(__float_as_uint(pmax), __float_as_uint(pmax), false, false);
    pmax = fmaxf(__uint_as_float(rr[0]), __uint_as_float(rr[1])); }
  float mn;
  if (__builtin_expect(__all(pmax - m_reg <= THR8 / SCALE), 1)) { mn = m_reg; alpha = 1.f; }
  else { mn = fmaxf(m_reg, pmax); alpha = __builtin_amdgcn_exp2f((m_reg - mn) * C); m_reg = mn; }
  const float mnC = 6.0f - mn * C;
  for (int r = 0; r < 16; ++r) p0[r] = fmaf(p0[r], C, mnC); for (int r = 0; r < 16; ++r) p1[r] = fmaf(p1[r], C, mnC);
  for (int r = 0; r < 16; ++r) p0[r] = __builtin_amdgcn_exp2f(p0[r]);
}
__device__ __forceinline__ void finishSM8(f32x16& p0, f32x16& p1, float alpha, float& l_reg, i32x8& pa) {
  for (int r = 0; r < 16; ++r) p1[r] = __builtin_amdgcn_exp2f(p1[r]);
  float ps = 0; for (int r = 0; r < 16; ++r) ps += p0[r]; for (int r = 0; r < 16; ++r) ps += p1[r];
  { auto rr = __builtin_amdgcn_permlane32_swap(__float_as_uint(ps), __float_as_uint(ps), false, false);
    ps = __uint_as_float(rr[0]) + __uint_as_float(rr[1]); }
  l_reg = l_reg * alpha + ps;
#pragma unroll
  for (int w = 0; w < 4; ++w) { pa[w] = pk4_fp8(p0[4 * w], p0[4 * w + 1], p0[4 * w + 2], p0[4 * w + 3]); pa[4 + w] = pk4_fp8(p1[4 * w], p1[4 * w + 1], p1[4 * w + 2], p1[4 * w + 3]); }
}
#define MFMA8(A, B, Cc) __builtin_amdgcn_mfma_scale_f32_32x32x64_f8f6f4((A), (B), (Cc), 0, 0, 0, 0x7f7f7f7f, 0, 0x7f7f7f7f)
__device__ __forceinline__ i32x8 cat8(const u32x4 lo, const u32x4 hi4) { i32x8 r; r[0] = (int)lo.x; r[1] = (int)lo.y; r[2] = (int)lo.z; r[3] = (int)lo.w; r[4] = (int)hi4.x; r[5] = (int)hi4.y; r[6] = (int)hi4.z; r[7] = (int)hi4.w; return r; }
__device__ __forceinline__ void qkt8(f32x16& p0, f32x16& p1, const char* Ks, const i32x8* qf, int r32, int hi) {
  const int x = r32 & 7; const char* k0 = Ks + r32 * 128; const char* k1 = k0 + 32 * 128;
  p0 = f32x16{}; p1 = f32x16{};
#pragma unroll
  for (int s2 = 0; s2 < 2; ++s2) { const int c0 = 4 * s2 + 2 * hi, oa = 16 * (c0 ^ x), ob = 16 * ((c0 + 1) ^ x);
    const i32x8 a0 = cat8(*reinterpret_cast<const u32x4*>(k0 + oa), *reinterpret_cast<const u32x4*>(k0 + ob));
    const i32x8 a1 = cat8(*reinterpret_cast<const u32x4*>(k1 + oa), *reinterpret_cast<const u32x4*>(k1 + ob));
    p0 = MFMA8(a0, qf[s2], p0); p1 = MFMA8(a1, qf[s2], p1); }
}
__device__ __forceinline__ void pv8(f32x16* o, const char* Vs, const i32x8 pa, int r32, int hi) {
  const int sw = (r32 >> 2) & 3; const char* vb = Vs + r32 * 64; const int oa = 16 * ((2 * hi) ^ sw), ob = 16 * ((2 * hi + 1) ^ sw);
#pragma unroll
  for (int d0 = 0; d0 < 4; ++d0) { const i32x8 b = cat8(*reinterpret_cast<const u32x4*>(vb + d0 * 2048 + oa), *reinterpret_cast<const u32x4*>(vb + d0 * 2048 + ob));
    o[d0] = MFMA8(pa, b, o[d0]); }
}
__device__ __forceinline__ void attn_pp8_body(const bf16* Qb, const unsigned char* __restrict__ K8, const unsigned char* __restrict__ V8,
                                              bf16_t* Ob, const bf16_t* Gb, int seq, char* lds, const int tid) {
  const int wid = __builtin_amdgcn_readfirstlane(tid >> 6), lane = tid & 63, r32 = lane & 31, hi = lane >> 5;
  const int g = wid >> 2;
  constexpr int NB = 3, SL = 8192;
  char* V_lds = lds; char* K_lds = lds + NB * SL;
  float* ws = (float*)(lds + 65536) + wid * 64; float* li_l = ws; float* al_l = ws + 32;
  float m_reg = -1e30f, l_reg = 0; f32x16 o[4] = {}; i32x8 qf[2];
  { const bf16* Qw = Qb + (long)(wid * QBLK + r32) * LDQ + hi * 32;
#pragma unroll
    for (int s2 = 0; s2 < 2; ++s2) {
#pragma unroll
      for (int q4 = 0; q4 < 4; ++q4) { float f[8]; unpack8(*reinterpret_cast<const u32x4*>(Qw + s2 * 64 + q4 * 8), f);
        qf[s2][2 * q4] = pk4_fp8(f[0], f[1], f[2], f[3]); qf[s2][2 * q4 + 1] = pk4_fp8(f[4], f[5], f[6], f[7]); } } }
  struct Stg8 { u32x4 k, v; } st0, st1;
#define SLOAD(S, t) do { const size_t o_ = (size_t)(t) * SL + (size_t)tid * 16; S.k = *reinterpret_cast<const u32x4*>(K8 + o_); S.v = *reinterpret_cast<const u32x4*>(V8 + o_); } while (0)
#define SWRITE(S, b) do { *(u32x4*)(K_lds + (b) * SL + tid * 16) = S.k; *(u32x4*)(V_lds + (b) * SL + tid * 16) = S.v; } while (0)
#define RESC(a) do { if (__any((a) < 1.f)) { if (hi == 0) al_l[r32] = (a); asm volatile("s_waitcnt lgkmcnt(0)" ::: "memory"); \
    for (int d = 0; d < 4; ++d) for (int r = 0; r < 16; ++r) o[d][r] *= al_l[crow(r, hi)]; } } while (0)
  const int NT = seq / KVBLK;
  f32x16 p0, p1; i32x8 pa;
#define SMX() do { float al_; partialSM8(p0, p1, m_reg, al_); RESC(al_); finishSM8(p0, p1, al_, l_reg, pa); } while (0)
  SLOAD(st0, 0); if (g) SLOAD(st1, 1);
  SWRITE(st0, 0); if (g) SWRITE(st1, 1);
  SLOAD(st0, 1 + g); SLOAD(st1, 2 + g);
  __syncthreads();
  if (g) __syncthreads();
  SBAR(); qkt8(p0, p1, K_lds, qf, r32, hi); SBAR();
  __syncthreads();
  SWRITE(st0, 1 + g); if (3 + g < NT) SLOAD(st0, 3 + g);
  SMX();
  __syncthreads();
  int c = 0;
#define STEP(i, ST) do { const int cK_ = (c == 2) ? 0 : c + 1; \
    SBAR(); \
    float al2_; \
    qkt8(p0, p1, K_lds + cK_ * SL, qf, r32, hi); \
    partialSM8(p0, p1, m_reg, al2_);            \
    pv8(o, V_lds + c * SL, pa, r32, hi); \
    SBAR(); \
    __syncthreads(); \
    { const int t_ = (i) + 2 + g; if (t_ < NT) { const int cb_ = (cK_ == 2) ? 0 : cK_ + 1; const int cw_ = g ? ((cb_ == 2) ? 0 : cb_ + 1) : cb_; \
        SWRITE(ST, cw_); if (t_ + 2 < NT) SLOAD(ST, t_ + 2); } } \
    RESC(al2_); finishSM8(p0, p1, al2_, l_reg, pa); \
    __syncthreads(); \
    c = cK_; } while (0)
  int i = 0;
#pragma nounroll
  for (; i + 1 < NT - 1; i += 2) { STEP(i, st1); STEP(i + 1, st0); }
  if (i < NT - 1) { STEP(i, st1); }
  SBAR(); pv8(o, V_lds + c * SL, pa, r32, hi); SBAR();
  __syncthreads();
  if (!g) __syncthreads();
  if (hi == 0) li_l[r32] = l_reg; asm volatile("s_waitcnt lgkmcnt(0)" ::: "memory");
  float rli[16];
#pragma unroll
  for (int r = 0; r < 16; ++r) rli[r] = __builtin_amdgcn_rcpf(li_l[crow(r, hi)]);
  { int lane_e = lane, wid_e = wid; asm volatile("" : "+v"(lane_e), "+v"(wid_e)); wid_e = __builtin_amdgcn_readfirstlane(wid_e);
    bf16_t* stg = (bf16_t*)lds + wid_e * 4096;
#pragma unroll
    for (int r = 0; r < 16; ++r) { const int orow = crow(r, hi);
#pragma unroll
      for (int d0 = 0; d0 < 4; ++d0) stg[orow * 128 + d0 * 32 + r32] = (bf16_t)f2bf(o[d0][r] * rli[r]); }
    asm volatile("s_waitcnt lgkmcnt(0)" ::: "memory");
    bf16_t* Ow = Ob + (long)(wid_e * QBLK) * LDO; const bf16_t* Gw = Gb + (long)(wid_e * QBLK) * LDO;
    u32x4 gq[8];
#pragma unroll
    for (int i2 = 0; i2 < 8; ++i2) { const int row = i2 * 4 + (lane_e >> 4), ch = lane_e & 15; gq[i2] = Gb ? *(const u32x4*)(Gw + (long)row * LDO + ch * 8) : (u32x4){0x3f803f80u, 0x3f803f80u, 0x3f803f80u, 0x3f803f80u}; }
#pragma unroll
    for (int i2 = 0; i2 < 8; ++i2) { const int row = i2 * 4 + (lane_e >> 4), ch = lane_e & 15;
      float ov[8], gv[8]; unpack8(*(const u32x4*)(stg + row * 128 + ch * 8), ov); unpack8(gq[i2], gv);
#pragma unroll
      for (int j = 0; j < 8; ++j) ov[j] *= gv[j];
      *(u32x4*)(Ow + (long)row * LDO + ch * 8) = pack8(ov); } }
  __syncthreads();
#undef SLOAD
#undef SWRITE
#undef RESC
#undef SMX
#undef STEP
#undef MFMA8
}
#undef KSWZ
#undef SBAR
}


#define XB_TMO      128
#define XB_XCNT(j)  (256  + 64 * (j))
#define XB_XSUB(j)  (1280 + 64 * (j))
#define XB_XGEN(j)  (2304 + 64 * (j))
#define XB_TOP      3328
#define XB_TOPGEN   3392
#define XCD_BAR_WORDS 3456
#define XB_SPIN_CAP (1u << 22)
__device__ __forceinline__ unsigned xb_ld(unsigned* p)              { return __hip_atomic_load(p, __ATOMIC_RELAXED, __HIP_MEMORY_SCOPE_AGENT); }
__device__ __forceinline__ unsigned xb_add(unsigned* p, unsigned v) { return __hip_atomic_fetch_add(p, v, __ATOMIC_RELAXED, __HIP_MEMORY_SCOPE_AGENT); }
__device__ __forceinline__ unsigned xb_xcc_id() { return (unsigned)__builtin_amdgcn_s_getreg((3 << 11) | 20) & 0xFu; }
#define XB_SPIN(cond, bar) do { unsigned _sp = 0; while (cond) { __builtin_amdgcn_s_sleep(1); \
    if ((++_sp & 255u) == 0u) { if (xb_ld(&(bar)[XB_TMO])) break; if (_sp > XB_SPIN_CAP) { atomicAdd(&(bar)[XB_TMO], 1u); break; } } } } while (0)
struct XcdBarrier { unsigned* bar; unsigned x; volatile LAS unsigned* st; };
__device__ __forceinline__ XcdBarrier xcd_barrier_post(unsigned* bar, volatile LAS unsigned* st) {
    XcdBarrier b; b.bar = bar; b.x = xb_xcc_id(); b.st = st;
    if (threadIdx.x == 0) (void)xb_add(&bar[XB_XCNT(b.x)], 1u);
    return b;
}
__device__ __forceinline__ void xcd_barrier_complete(unsigned* bar, unsigned x, unsigned& nloc, unsigned& nx) {
    const unsigned G = gridDim.x * gridDim.y * gridDim.z;
    unsigned sum, cnt, mine, sp = 0u;
    for (;;) {
        sum = 0u; cnt = 0u; mine = 0u;
#pragma unroll
        for (unsigned j = 0; j < 16; ++j) { const unsigned c = xb_ld(&bar[XB_XCNT(j)]); sum += c; cnt += (c > 0u) ? 1u : 0u; mine = (j == x) ? c : mine; }
        if (sum == G) break;
        __builtin_amdgcn_s_sleep(1);
        if ((++sp & 255u) == 0u) { if (xb_ld(&bar[XB_TMO])) break; if (sp > XB_SPIN_CAP) { atomicAdd(&bar[XB_TMO], 1u); break; } }
    }
    nloc = mine > 0u ? mine : 1u; nx = cnt > 0u ? cnt : 1u;
}
__device__ __forceinline__ void xcd_barrier(const XcdBarrier& b, const int tid) {
    asm volatile("s_waitcnt vmcnt(0)" ::: "memory");
    __syncthreads();
    if (tid == 0) {
        unsigned* bar = b.bar;
        __builtin_amdgcn_s_waitcnt(0);
        unsigned nloc = b.st[0], nx = b.st[1];
        if (nloc == 0u) { xcd_barrier_complete(bar, b.x, nloc, nx); b.st[0] = nloc; b.st[1] = nx; }
        const unsigned old = xb_add(&bar[XB_XSUB(b.x)], 1u);
        const unsigned gen = old / nloc;
        if (old + 1u == (gen + 1u) * nloc) {
            __builtin_amdgcn_fence(__ATOMIC_RELEASE, "agent");
            asm volatile("s_waitcnt vmcnt(0)" ::: "memory");
            const unsigned og = xb_add(&bar[XB_TOP], 1u);
            const unsigned tg = og / nx;
            if (og + 1u == (tg + 1u) * nx) xb_add(&bar[XB_TOPGEN], 1u);
            else XB_SPIN(xb_ld(&bar[XB_TOPGEN]) == tg, bar);
            __builtin_amdgcn_fence(__ATOMIC_ACQUIRE, "agent");
            xb_add(&bar[XB_XGEN(b.x)], 1u);
            asm volatile("s_waitcnt vmcnt(0)" ::: "memory");
        } else {
            XB_SPIN(xb_ld(&bar[XB_XGEN(b.x)]) == gen, bar);
            __builtin_amdgcn_fence(__ATOMIC_ACQUIRE, "agent");
            asm volatile("s_waitcnt vmcnt(0)" ::: "memory");
        }
    }
    __syncthreads();
}

#ifndef PHM
#define PHM 1023
#endif
#ifndef PROBE_K
#define PROBE_K -1
#endif
struct Args { const float* in[18]; float* out; unsigned char* ws; int ph_lo, ph_hi; };
typedef const __attribute__((address_space(4))) Args* KArgs;
#define INP(a, i) ((const float*)(const GAS float*)((a)->in[i]))
#define OUTP(a) ((float*)(GAS float*)((a)->out))
enum { I_X = 0, I_C, I_WADA, I_BADA, I_NORMG, I_WIN, I_CAW, I_CAB, I_WRG, I_BRG, I_WIG, I_BIG, I_LAM, I_QG, I_KG, I_CCW, I_WBR, I_WOUT };

__device__ __forceinline__ void transpose_item(const float* W, int ldw, bf16_t* dst, int ldd, LAS float* scr, int lane) {
#pragma unroll 8
    for (int i = 0; i < 32; ++i) { const int kk = 2 * i + (lane >> 5); scr[kk * 33 + (lane & 31)] = W[(size_t)kk * ldw + (lane & 31)]; }
    LDS_WAIT();
    const int c = lane & 7;
#pragma unroll
    for (int j = 0; j < 4; ++j) { const int n = (lane >> 3) + 8 * j; const LAS float* s = scr + (8 * c) * 33 + n;
        u32x4 o; o.x = cvt_pk_bf16(s[0 * 33], s[1 * 33]); o.y = cvt_pk_bf16(s[2 * 33], s[3 * 33]); o.z = cvt_pk_bf16(s[4 * 33], s[5 * 33]); o.w = cvt_pk_bf16(s[6 * 33], s[7 * 33]);
        *(u32x4*)(dst + (size_t)n * ldd + 8 * c) = o; }
    LDS_WAIT();
}

__device__ __forceinline__ void phase_prologue(KArgs a, unsigned char* wsb, LAS unsigned char* lds, int tid, int lane, int wave, int bid, int G) {
    unsigned char* ws = wsb;
    {
        LAS float* red = (LAS float*)lds;
        for (int it = bid; it < 96; it += G) {
            const int l = it / 48, jb = it % 48, j = jb * 64 + lane;
            const float* wa = INP(a, I_WADA) + (size_t)l * 1024 * 3072 + j; const float* c0 = INP(a, I_C); const float* c1 = c0 + 1024;
            float a0 = 0.f, a1 = 0.f; const int kb = wave * 128;
#pragma unroll 16
            for (int k = 0; k < 128; ++k) { const float w = wa[(size_t)(kb + k) * 3072]; a0 += c0[kb + k] * w; a1 += c1[kb + k] * w; }
            red[(wave * 2 + 0) * 64 + lane] = a0; red[(wave * 2 + 1) * 64 + lane] = a1;
            __syncthreads();
            if (tid < 128) { const int bb = tid >> 6; float s = 0.f;
#pragma unroll
                for (int w = 0; w < 8; ++w) s += red[(w * 2 + bb) * 64 + lane];
                ((float*)(ws + WS_MOD))[(l * 2 + bb) * 3072 + j] = s + INP(a, I_BADA)[l * 3072 + j]; }
            __syncthreads();
        }
    }
    {
        float* rc = (float*)(ws + WS_ROPE); float* rs = rc + 320 * 32;
        for (int e = bid * 512 + tid; e < 320 * 32; e += G * 512) {
            const int pos = e >> 5, i = e & 31; const int p = pos < 256 ? pos : pos - 256;
            const float inv = __builtin_amdgcn_exp2f(-((float)(2 * i)) * (13.287712379549449f / 64.0f));
            const float ang = (float)p * inv;
            rc[e] = __cosf(ang); rs[e] = __sinf(ang);
        }
    }
    {
        LAS float* scr = (LAS float*)(lds + 8192 + wave * 12288);
        const int gw = bid * 8 + wave, NGW = G * 8;
        constexpr int I_IN = 2 * 16 * 368, I_G = 1024, I_BR = 3072, I_OUT = 1024, NITEMS = I_IN + I_G + I_BR + I_OUT;
        for (int it = gw; it < NITEMS; it += NGW) {
            int r = it;
            if (r < I_IN) { const int l = r / 5888, q = r % 5888, kb = q / 368, nb = q % 368;
                const int n0 = 32 * nb; int drow = n0;
                if (n0 >= 4608 && n0 < 8704) { const int sec = (n0 - 4608) >> 10, ch = (n0 - 4608) & 1023, blk = ch >> 7;
                    drow = ((sec & 1) ? 26 + blk : 18 + blk) * 256 + ((sec >> 1) ? 128 : 0) + (ch & 127); }
                transpose_item(INP(a, I_WIN) + (size_t)l * 1024 * NIN + (size_t)(64 * kb) * NIN + n0, NIN,
                               (bf16_t*)(ws + WS_WIN) + (size_t)l * NIN * 1024 + (size_t)drow * 1024 + 64 * kb, 1024, scr, lane); continue; }
            r -= I_IN;
            if (r < I_G) { const int mi = r >> 5, sub = r & 31, kb = sub >> 3, nblk = sub & 7;
                const int nb = mi & 3, gate = (mi >> 2) & 1, dir = (mi >> 3) & 1, l = mi >> 4;
                const float* src = (gate ? INP(a, I_WIG) : INP(a, I_WRG)) + (size_t)((l * 2 + dir) * 4 + nb) * 65536 + (size_t)(64 * kb) * 256 + 32 * nblk;
                const int n0 = 32 * nblk, hh = n0 >> 7, pn = (dir * 4 + nb) * 2 + hh, row = pn * 256 + gate * 128 + (n0 & 127);
                transpose_item(src, 256, (bf16_t*)(ws + WS_WG) + (size_t)l * 4096 * 256 + (size_t)row * 256 + 64 * kb, 256, scr, lane); continue; }
            r -= I_G;
            if (r < I_BR) { const int mi = r >> 9, sub = r & 511, kb = sub >> 5, nblk = sub & 31;
                transpose_item(INP(a, I_WBR) + (size_t)mi * 1048576 + (size_t)(64 * kb) * 1024 + 32 * nblk, 1024,
                               (bf16_t*)(ws + WS_WBR) + (size_t)mi * 1048576 + (size_t)(32 * nblk) * 1024 + 64 * kb, 1024, scr, lane); continue; }
            r -= I_BR;
            { const int mi = r >> 9, sub = r & 511, kb = sub >> 5, nblk = sub & 31;
                transpose_item(INP(a, I_WOUT) + (size_t)mi * 1048576 + (size_t)(64 * kb) * 1024 + 32 * nblk, 1024,
                               (bf16_t*)(ws + WS_WOUT) + (size_t)mi * 1048576 + (size_t)(32 * nblk) * 1024 + 64 * kb, 1024, scr, lane); }
        }
    }
}

__device__ __forceinline__ void phase_h(KArgs a, unsigned char* wsb, int l, int b, int lane, int wave, int bid, int G) {
    const float* xin = (l == 0 ? INP(a, I_X) : OUTP(a)) + (size_t)b * SEQ * DM;
    const float* mod = (const float*)(wsb + WS_MOD) + (l * 2 + b) * 3072;
    bf16_t* H = (bf16_t*)(wsb + WS_H);
    f32x4 gs[4], sh[4];
#pragma unroll
    for (int j = 0; j < 4; ++j) { const int col = 4 * lane + 256 * j;
        const f32x4 g = *(const f32x4*)(INP(a, I_NORMG) + l * 1024 + col), sc = *(const f32x4*)(mod + 1024 + col);
        gs[j] = g * (sc + 1.0f); sh[j] = *(const f32x4*)(mod + col); }
    const int gw = bid * 8 + wave, NGW = G * 8;
    for (int m = gw; m < SEQ; m += 2 * NGW) {
        const int m2 = (m + NGW < SEQ) ? m + NGW : m;
        const f32x4* xr = (const f32x4*)(xin + (size_t)m * DM) + lane; const f32x4* xr2 = (const f32x4*)(xin + (size_t)m2 * DM) + lane;
        f32x4 v[4], w[4]; float s = 0.f, s2 = 0.f;
#pragma unroll
        for (int j = 0; j < 4; ++j) { v[j] = xr[64 * j]; w[j] = xr2[64 * j]; }
#pragma unroll
        for (int j = 0; j < 4; ++j) { s += (v[j].x * v[j].x + v[j].y * v[j].y) + (v[j].z * v[j].z + v[j].w * v[j].w); s2 += (w[j].x * w[j].x + w[j].y * w[j].y) + (w[j].z * w[j].z + w[j].w * w[j].w); }
        const float rstd = __builtin_amdgcn_rsqf(wave_sum(s) * (1.f / DM) + EPS), rstd2 = __builtin_amdgcn_rsqf(wave_sum(s2) * (1.f / DM) + EPS);
        u32x2* o8 = (u32x2*)(H + (size_t)m * DM) + lane; u32x2* o82 = (u32x2*)(H + (size_t)m2 * DM) + lane;
#pragma unroll
        for (int j = 0; j < 4; ++j) { const f32x4 o = v[j] * rstd * gs[j] + sh[j]; u32x2 q; q.x = cvt_pk_bf16(o.x, o.y); q.y = cvt_pk_bf16(o.z, o.w); o8[64 * j] = q;
            const f32x4 o2 = w[j] * rstd2 * gs[j] + sh[j]; u32x2 q2; q2.x = cvt_pk_bf16(o2.x, o2.y); q2.y = cvt_pk_bf16(o2.z, o2.w); o82[64 * j] = q2; }
    }
}

__device__ __forceinline__ void ldrow8(const bf16_t* __restrict__ base, int t, int ch, float (&v)[8]) {
    if (t < 0 || t >= SEQ) {
#pragma unroll
        for (int j = 0; j < 8; ++j) v[j] = 0.f;
    } else unpack8(*(const u32x4*)(base + (size_t)t * 1024 + ch), v);
}
__device__ __forceinline__ void ld8f32(const float* p, float (&v)[8]) {
    const f32x4 a = *(const f32x4*)p, b = *(const f32x4*)(p + 4);
    v[0] = a.x; v[1] = a.y; v[2] = a.z; v[3] = a.w; v[4] = b.x; v[5] = b.y; v[6] = b.z; v[7] = b.w;
}

__device__ __forceinline__ void phase_elem(KArgs a, unsigned char* wsb, int l, int lane, int wave, int bid, int G) {
    unsigned char* ws = wsb;
    const int gw = bid * 8 + wave, NGW = G * 8;
    for (int it = gw; it < 2048; it += NGW) {
        const int run = it >> 1, hf = it & 1, ch = hf * 512 + lane * 8, t0 = run * 16;
        {
            const bf16_t* __restrict__ XA = (const bf16_t*)(ws + WS_XA); bf16_t* __restrict__ UA = (bf16_t*)(ws + WS_H);
            float w0[8], w1[8], w2[8], w3[8], bb[8];
            const float* cw = INP(a, I_CAW) + (size_t)l * 4 * 1024 + ch;
            ld8f32(cw, w0); ld8f32(cw + 1024, w1); ld8f32(cw + 2048, w2); ld8f32(cw + 3072, w3); ld8f32(INP(a, I_CAB) + l * 1024 + ch, bb);
            float xm2[8], xm1[8], x0[8], xp1[8];
            ldrow8(XA, t0 - 2, ch, xm2); ldrow8(XA, t0 - 1, ch, xm1); ldrow8(XA, t0, ch, x0);
#pragma unroll
            for (int s = 0; s < 16; ++s) { const int t = t0 + s;
                ldrow8(XA, t + 1, ch, xp1);
                float o[8];
#pragma unroll
                for (int j = 0; j < 8; ++j) o[j] = w0[j] * xm2[j] + w1[j] * xm1[j] + w2[j] * x0[j] + w3[j] * xp1[j] + bb[j];
                *(u32x4*)(UA + (size_t)t * 1024 + ch) = pack8(o);
#pragma unroll
                for (int j = 0; j < 8; ++j) { xm2[j] = xm1[j]; xm1[j] = x0[j]; x0[j] = xp1[j]; } }
        }
        {
            const bf16_t* __restrict__ PP = (const bf16_t*)(ws + WS_XC); const bf16_t* __restrict__ BG = (const bf16_t*)(ws + WS_BC); bf16_t* __restrict__ YC = (bf16_t*)(ws + WS_YC);
            float w0[8], w1[8], w2[8];
            const float* cw = INP(a, I_CCW) + (size_t)l * 3 * 1024 + ch;
            ld8f32(cw, w0); ld8f32(cw + 1024, w1); ld8f32(cw + 2048, w2);
            float pm1[8], p0[8], pp1[8], t1[8];
            ldrow8(PP, t0 - 1, ch, pm1); ldrow8(PP, t0, ch, p0);
#pragma unroll
            for (int s = 0; s < 16; ++s) { const int t = t0 + s;
                ldrow8(PP, t + 1, ch, pp1); ldrow8(BG, t, ch, t1);
                float o[8];
#pragma unroll
                for (int j = 0; j < 8; ++j) o[j] = t1[j] * (w0[j] * pm1[j] + w1[j] * p0[j] + w2[j] * pp1[j]);
                *(u32x4*)(YC + (size_t)t * 1024 + ch) = pack8(o);
#pragma unroll
                for (int j = 0; j < 8; ++j) { pm1[j] = p0[j]; p0[j] = pp1[j]; } }
        }
        {
            bf16_t* Q = (bf16_t*)(ws + WS_Q); bf16_t* Kb = (bf16_t*)(ws + WS_K);
            const float* rc = (const float*)(ws + WS_ROPE); const float* rs = rc + 320 * 32;
            const int d0 = (lane & 15) * 8, i0 = (lane & 3) * 8;
            float qg[8], kg[8];
            ld8f32(INP(a, I_QG) + l * 128 + d0, qg); ld8f32(INP(a, I_KG) + l * 128 + d0, kg);
            const bool second = (lane & 4) != 0;
            const int tokb = run * 16 + hf * 8;
            const int tsel = (d0 < 64) ? 0 : 1;
            u32x4 cur[3]; float cs[8], sn[8];
#define LD_TOK(tok, dst, dcs, dsn) do { const int tp_ = tsel ? 256 + ((tok) & 63) : ((tok) >> 6); ld8f32(rc + tp_ * 32 + i0, dcs); ld8f32(rs + tp_ * 32 + i0, dsn); \
                dst[0] = *(const u32x4*)(Q + (size_t)(tok) * 1024 + lane * 8); dst[1] = *(const u32x4*)(Q + (size_t)(tok) * 1024 + 512 + lane * 8); dst[2] = *(const u32x4*)(Kb + (size_t)(tok) * 256 + (lane & 31) * 8); } while (0)
            LD_TOK(tokb, cur, cs, sn);
#pragma unroll
            for (int i = 0; i < 8; ++i) {
                const int tok = tokb + i;
                u32x4 nx[3]; float ncs[8], nsn[8];
                if (i < 7) LD_TOK(tok + 1, nx, ncs, nsn);
#pragma unroll
                for (int part = 0; part < 3; ++part) {
                    bf16_t* p = (part < 2) ? (Q + (size_t)tok * 1024 + part * 512 + lane * 8) : (Kb + (size_t)tok * 256 + (lane & 31) * 8);
                    float v[8]; unpack8(cur[part], v);
                    float ss = 0.f;
#pragma unroll
                    for (int j = 0; j < 8; ++j) ss += v[j] * v[j];
                    ss += __shfl_xor(ss, 1); ss += __shfl_xor(ss, 2); ss += __shfl_xor(ss, 4); ss += __shfl_xor(ss, 8);
                    const float rstd = __builtin_amdgcn_rsqf(ss * (1.f / 128.f) + EPS);
                    float o[8];
#pragma unroll
                    for (int j = 0; j < 8; ++j) { const float y = v[j] * rstd * (part < 2 ? qg[j] : kg[j]); const float pr = __shfl_xor(y, 4);
                        o[j] = y * cs[j] + (second ? pr : -pr) * sn[j]; }
                    if (part < 2 || lane < 32) *(u32x4*)p = pack8(o);
                    if (part == 2 && lane < 32) {
                        const int kvh = lane >> 4, r = tok & 63, dch = (lane & 15) >> 1;
                        unsigned char* kp = ws + WS_K8 + (size_t)kvh * 2097152 + (size_t)(tok >> 6) * 8192 + r * 128 + 16 * (dch ^ (r & 7)) + (lane & 1) * 8;
                        u32x2 w8; w8.x = (unsigned)pk4_fp8(o[0], o[1], o[2], o[3]); w8.y = (unsigned)pk4_fp8(o[4], o[5], o[6], o[7]); *(u32x2*)kp = w8; }
                }
                if (i < 7) {
#pragma unroll
                    for (int part = 0; part < 3; ++part) cur[part] = nx[part];
#pragma unroll
                    for (int j = 0; j < 8; ++j) { cs[j] = ncs[j]; sn[j] = nsn[j]; } }
            }
#undef LD_TOK
        }
    }
    for (int it = gw; it < 4096; it += NGW) {
        const int jh = it & 1, h = (it >> 1) & 1, dh = (it >> 2) & 1, tile = (it >> 3) & 255, kvh = it >> 11;
        const int d = dh * 64 + lane;
        const bf16_t* __restrict__ V = (const bf16_t*)(ws + WS_V) + (size_t)tile * 64 * 256 + kvh * 128 + d;
        float f[16];
#pragma unroll
        for (int jj = 0; jj < 16; ++jj) { const int key = (jj & 3) + 8 * (jj >> 2) + 4 * h + 32 * jh; f[jj] = bf2f(V[(size_t)key * 256]); }
        u32x4 w; w.x = (unsigned)pk4_fp8(f[0], f[1], f[2], f[3]); w.y = (unsigned)pk4_fp8(f[4], f[5], f[6], f[7]); w.z = (unsigned)pk4_fp8(f[8], f[9], f[10], f[11]); w.w = (unsigned)pk4_fp8(f[12], f[13], f[14], f[15]);
        *(u32x4*)(ws + WS_V8 + (size_t)kvh * 2097152 + (size_t)tile * 8192 + d * 64 + 16 * ((2 * h + jh) ^ ((d >> 2) & 3))) = w;
    }
}

__device__ __forceinline__ void phase_scan_a(KArgs a, unsigned char* wsb, int lane, int wave, int bid, int G) {
    unsigned char* ws = wsb;
    const int gw = bid * 8 + wave, NGW = G * 8;
    for (int it = gw; it < 2048; it += NGW) {
        const int c = it >> 4, dir = (it >> 3) & 1, ch = (it & 7) * 128 + lane * 2;
        const bf16_t* LA = (const bf16_t*)(ws + WS_LA + (size_t)dir * 64 * MiB) + ch;
        const bf16_t* UU = (const bf16_t*)(ws + WS_U + (size_t)dir * 64 * MiB) + ch;
        float s0 = 0.f, s1 = 0.f, h0 = 0.f, h1 = 0.f;
#pragma unroll 16
        for (int st = 0; st < 128; ++st) { const int t = dir == 0 ? c * 128 + st : c * 128 + 127 - st;
            const unsigned wl = *(const unsigned*)(LA + (size_t)t * 1024), wu = *(const unsigned*)(UU + (size_t)t * 1024);
            const float l0 = __uint_as_float(wl << 16), l1 = __uint_as_float(wl & 0xffff0000u);
            const float u0 = __uint_as_float(wu << 16), u1 = __uint_as_float(wu & 0xffff0000u);
            h0 = __builtin_amdgcn_exp2f(l0) * h0 + u0; h1 = __builtin_amdgcn_exp2f(l1) * h1 + u1; s0 += l0; s1 += l1; }
        *(f32x2*)((float*)(ws + WS_SA) + (c * 2 + dir) * 1024 + ch) = (f32x2){s0, s1};
        *(f32x2*)((float*)(ws + WS_SH) + (c * 2 + dir) * 1024 + ch) = (f32x2){h0, h1};
    }
}
__device__ __forceinline__ void phase_scan_c(unsigned char* wsb, LAS unsigned char* lds, int lane, int wave, int bid, int G) {
    unsigned char* ws = wsb;
    const int gw = bid * 8 + wave, NGW = G * 8;
    const float* __restrict__ SA = (const float*)(ws + WS_SA); const float* __restrict__ SH = (const float*)(ws + WS_SH);
    for (int it = gw; it < 2048; it += NGW) {
        const int c = it >> 4, ch = (it & 15) * 64 + lane;
        float cf = 0.f, cb = 0.f;
#pragma unroll 8
        for (int sidx = 0; sidx < c; ++sidx) { const int idx = (sidx * 2) * 1024 + ch; cf = __builtin_amdgcn_exp2f(SA[idx]) * cf + SH[idx]; }
#pragma unroll 8
        for (int sidx = 127; sidx > c; --sidx) { const int idx = (sidx * 2 + 1) * 1024 + ch; cb = __builtin_amdgcn_exp2f(SA[idx]) * cb + SH[idx]; }
        const bf16_t* __restrict__ LAf = (const bf16_t*)(ws + WS_LA) + ch; const bf16_t* __restrict__ UUf = (const bf16_t*)(ws + WS_U) + ch;
        const bf16_t* __restrict__ LAb = (const bf16_t*)(ws + WS_LA + 64 * MiB) + ch; const bf16_t* __restrict__ UUb = (const bf16_t*)(ws + WS_U + 64 * MiB) + ch;
        const bf16_t* __restrict__ SGA = (const bf16_t*)(ws + WS_SGA) + ch; bf16_t* __restrict__ YA = (bf16_t*)(ws + WS_XA) + ch;
        LAS bf16_t* hfs = (LAS bf16_t*)(lds + wave * 16384) + lane;
        float h = cf;
        { const bf16_t* pl = LAf + (size_t)c * 128 * 1024; const bf16_t* pu = UUf + (size_t)c * 128 * 1024;
#pragma unroll 1
            for (int blk = 0; blk < 8; ++blk) {
                float l[16], u[16];
#pragma unroll
                for (int i = 0; i < 16; ++i) { l[i] = bf2f(pl[i * 1024]); u[i] = bf2f(pu[i * 1024]); }
#pragma unroll
                for (int i = 0; i < 16; ++i) { h = __builtin_amdgcn_exp2f(l[i]) * h + u[i]; hfs[(blk * 16 + i) * 64] = (bf16_t)f2bf(h); }
                pl += 16 * 1024; pu += 16 * 1024; } }
        h = cb;
        { const size_t e0 = (size_t)(c * 128 + 112) * 1024;
            const bf16_t* pl = LAb + e0; const bf16_t* pu = UUb + e0; const bf16_t* pg = SGA + e0; bf16_t* py = YA + e0;
#pragma unroll 1
            for (int blk = 7; blk >= 0; --blk) {
                float l[16], u[16], g[16];
#pragma unroll
                for (int i = 0; i < 16; ++i) { l[i] = bf2f(pl[i * 1024]); u[i] = bf2f(pu[i * 1024]); g[i] = bf2f(pg[i * 1024]); }
#pragma unroll
                for (int i = 15; i >= 0; --i) { h = __builtin_amdgcn_exp2f(l[i]) * h + u[i];
                    py[i * 1024] = (bf16_t)f2bf((bf2f(hfs[(blk * 16 + i) * 64]) + h) * g[i]); }
                pl -= 16 * 1024; pu -= 16 * 1024; pg -= 16 * 1024; py -= 16 * 1024; } }
    }
}

__global__ void __launch_bounds__(512, 2) mk_fwd(Args args) {
    extern __shared__ __attribute__((aligned(16))) unsigned char lds[];
    cg::grid_group grid = cg::this_grid();
    LAS unsigned char* L = (LAS unsigned char*)lds;
    if (threadIdx.x < 2) ((LAS unsigned*)(L + 131072))[threadIdx.x] = 0u;
    __syncthreads();
    (void)xcd_barrier_post((unsigned*)(args.ws + WS_BAR), (volatile LAS unsigned*)(L + 131072));
    const int wave_u = __builtin_amdgcn_readfirstlane(threadIdx.x >> 6);
    for (int ph = args.ph_lo; ph < args.ph_hi; ++ph) {
        int tid; { int ln_; asm volatile("v_mbcnt_lo_u32_b32 %0, -1, 0\n\tv_mbcnt_hi_u32_b32 %0, -1, %0" : "=v"(ln_)); tid = wave_u * 64 + ln_; }
        int G = gridDim.x, bid = blockIdx.x; asm volatile("" : "+s"(G), "+s"(bid));
        KArgs ap = (KArgs)__builtin_amdgcn_kernarg_segment_ptr(); asm volatile("" : "+s"(ap));
        GAS unsigned char* wsg = (GAS unsigned char*)ap->ws; asm volatile("" : "+s"(wsg));
        unsigned char* ws = (unsigned char*)wsg;
        const int lane = tid & 63, wave = __builtin_amdgcn_readfirstlane(tid >> 6);
        unsigned long long pt0 = 0; int pcls = -1; if (PROBE_K >= 0) pt0 = __builtin_amdgcn_s_memrealtime();
        if (ph == 0) { pcls = 8; if (PHM & 512) phase_prologue(ap, ws, L, tid, lane, wave, bid, G); }
        else {
            const int q = ph - 1, lb = q / NPH_PER, k = q - lb * NPH_PER, l = lb >> 1, b = lb & 1; pcls = k;
            if (k == 0) { if (PHM & 1) phase_h(ap, ws, l, b, lane, wave, bid, G); }
            else if (k == 1) { if (PHM & 2) {
                pg8::Gemm g{(const bf16_t*)(ws + WS_H), (const bf16_t*)(ws + WS_WIN) + (size_t)l * NIN * 1024, 1024, 1024, 1024, 0, 0};
                pg8::StaticOrder S; S.init(SEQ, NIN, G, bid);
                pg8::EpiInProj E{ws};
                pg8::gemm_phase<pg8::EpiInProj, pg8::StaticOrder, 0>(L, g, S, E, tid); }
            } else if (k == 2) { if (PHM & 4) phase_elem(ap, ws, l, lane, wave, bid, G); }
            else if (k == 3) {
                if (PHM & 8) {
                    pg8::Gemm g{(const bf16_t*)(ws + WS_H), (const bf16_t*)(ws + WS_WG) + (size_t)l * 4096 * 256, 1024, 256, 256, 0, 0};
                    pg8::StaticOrder S; S.init(SEQ, 4096, G, bid);
                    pg8::EpiGates E{ws, INP(ap, I_BRG) + l * 2048, INP(ap, I_BIG) + l * 2048, INP(ap, I_LAM) + l * 2048};
                    pg8::gemm_phase<pg8::EpiGates, pg8::StaticOrder, 1>(L, g, S, E, tid);
                }
                if (PROBE_K == 3) { const unsigned long long t1 = __builtin_amdgcn_s_memrealtime(), dt = t1 - pt0; while (__builtin_amdgcn_s_memrealtime() - t1 < dt) __builtin_amdgcn_s_sleep(8); }
                if (PROBE_K == 9) { pt0 = __builtin_amdgcn_s_memrealtime(); pcls = 9; }
                if (PHM & 256) {
                    const int v = (G % 8 == 0) ? (bid % 8) * (G / 8) + bid / 8 : bid;
                    const int per = (512 + G - 1) / G;
                    if (PROBE_F8 && l == 0 && b == 0) {
                        for (int i = 0; i < per; ++i) { const int idx = v * per + i; if (idx >= 4) break;
                            const int h = idx >> 6, qb = idx & 63, kvh = h >> 2;
                            const attn::bf16* Qb = (const attn::bf16*)(ws + WS_Q) + (size_t)qb * 256 * 1024 + h * 128;
                            const bf16_t* Gb = (const bf16_t*)(ws + WS_SGB) + (size_t)qb * 256 * 1024 + h * 128;
                            attn::attn_pp8_body(Qb, ws + WS_K8 + (size_t)kvh * 2097152, ws + WS_V8 + (size_t)kvh * 2097152, (bf16_t*)(ws + WS_SPARE) + (size_t)idx * 256 * 1024, nullptr, SEQ, (char*)lds, tid);
                        }
                    }
                    int tid2 = tid; asm volatile("" : "+v"(tid2));
                    for (int i = 0; i < per; ++i) { const int idx = v * per + i; if (idx >= 512) break;
                        const int h = idx >> 6, qb = idx & 63, kvh = h >> 2;
                        const attn::bf16* Qb = (const attn::bf16*)(ws + WS_Q) + (size_t)qb * 256 * 1024 + h * 128;
                        bf16_t* Ob = (bf16_t*)(ws + WS_SGB) + (size_t)qb * 256 * 1024 + h * 128;
                        const bf16_t* Gb = (const bf16_t*)(ws + WS_SGB) + (size_t)qb * 256 * 1024 + h * 128;
                        if (PROBE_F8) {
                            const attn::bf16* Kh = (const attn::bf16*)(ws + WS_K) + kvh * 128;
                            const attn::bf16* Vh = (const attn::bf16*)(ws + WS_V) + kvh * 128;
                            const bf16_t* cmp = (l == 0 && b == 0 && idx < 4) ? (const bf16_t*)(ws + WS_SPARE) + (size_t)idx * 256 * 1024 : nullptr;
                            attn::attn_pp_body(Qb, Kh, Vh, Ob, Gb, SEQ, (char*)lds, tid2, cmp, (unsigned*)(ws + WS_FLAG));
                        } else attn::attn_pp8_body(Qb, ws + WS_K8 + (size_t)kvh * 2097152, ws + WS_V8 + (size_t)kvh * 2097152, Ob, Gb, SEQ, (char*)lds, tid2);
                    }
                }
            } else if (k == 4) { if (PHM & 16) phase_scan_a(ap, ws, lane, wave, bid, G); }
            else if (k == 5) { if (PHM & 32) phase_scan_c(ws, L, lane, wave, bid, G); }
            else if (k == 6) { if (PHM & 64) {
                pg8::Gemm g{(const bf16_t*)(ws + WS_XA), (const bf16_t*)(ws + WS_WBR) + (size_t)l * 3 * 1048576, 1024, 1024, 1024,
                            (long)WS_SGB - (long)WS_XA, (long)WS_YC - (long)WS_XA};
                pg8::BranchOrder S; S.so.init(SEQ, 1024, G, bid);
                pg8::EpiBranch E{ws};
                pg8::gemm_phase<pg8::EpiBranch, pg8::BranchOrder, 2>(L, g, S, E, tid); }
            } else if (PHM & 128) {
                pg8::Gemm g{(const bf16_t*)(ws + WS_SGA), (const bf16_t*)(ws + WS_WOUT) + (size_t)l * 1048576, 1024, 1024, 1024, 0, 0};
                pg8::StaticOrder S; S.init(SEQ, 1024, G, bid);
                const float* xi = (l == 0 ? INP(ap, I_X) : OUTP(ap)) + (size_t)b * SEQ * DM;
                pg8::EpiOut E{xi, OUTP(ap) + (size_t)b * SEQ * DM, (const float*)(ws + WS_MOD) + (l * 2 + b) * 3072 + 2048, (const unsigned*)(ws + WS_FLAG)};
                pg8::gemm_phase<pg8::EpiOut, pg8::StaticOrder, 0>(L, g, S, E, tid);
            }
        }
        if (PROBE_K >= 0 && PROBE_K != 3 && ph + 1 == args.ph_hi && pcls == PROBE_K) { VM_WAIT(); __syncthreads(); const unsigned long long t1 = __builtin_amdgcn_s_memrealtime(), dt = t1 - pt0; while (__builtin_amdgcn_s_memrealtime() - t1 < dt) __builtin_amdgcn_s_sleep(8); }
        if (ph + 1 < args.ph_hi) { if (ph == args.ph_lo) grid.sync(); else { XcdBarrier xbar; xbar.bar = (unsigned*)(ws + WS_BAR); xbar.x = xb_xcc_id(); xbar.st = (volatile LAS unsigned*)(L + 131072); xcd_barrier(xbar, tid); }
            if (PROBE_K >= 0 && PROBE_K != 3 && pcls == PROBE_K) { const unsigned long long t1 = __builtin_amdgcn_s_memrealtime(), dt = t1 - pt0; while (__builtin_amdgcn_s_memrealtime() - t1 < dt) __builtin_amdgcn_s_sleep(8); } }
    }
}

extern "C" void kernel_launch(void* const* d_in, const int* in_sizes, int n_in, void* d_out, int out_size, void* d_ws, size_t ws_size, hipStream_t stream) {
    static int grid = 0;
    if (grid == 0) {
        if (n_in != 18 || ws_size < WS_END) { fprintf(stderr, "kernel_launch: need 18 inputs and >= %zu bytes of workspace (got %d, %zu)\n", (size_t)WS_END, n_in, ws_size); grid = -1; return; }
        int dev = 0, cus = 0, per_cu = 0;
        hipGetDevice(&dev);
        hipDeviceGetAttribute(&cus, hipDeviceAttributeMultiprocessorCount, dev);
        if (hipFuncSetAttribute((const void*)mk_fwd, hipFuncAttributeMaxDynamicSharedMemorySize, LDS_BYTES) != hipSuccess) { fprintf(stderr, "kernel_launch: hipFuncSetAttribute failed\n"); grid = -1; return; }
        if (hipOccupancyMaxActiveBlocksPerMultiprocessor(&per_cu, (const void*)mk_fwd, 512, LDS_BYTES) != hipSuccess || per_cu < 1) { fprintf(stderr, "kernel_launch: occupancy query gave %d\n", per_cu); per_cu = 1; }
        (void)hipGetLastError();
        grid = cus * 1;
    }
    if (grid < 0) return;
    if (hipMemsetAsync((char*)d_ws + WS_BAR, 0, 16384, stream) != hipSuccess) { fprintf(stderr, "kernel_launch: memset failed\n"); return; }
    Args a{};
    for (int i = 0; i < 18; ++i) a.in[i] = (const float*)d_in[i];
    a.out = (float*)d_out; a.ws = (unsigned char*)d_ws; a.ph_lo = 0; a.ph_hi = NPHASES;
    void* kargs[] = {&a};
    hipError_t e = hipLaunchCooperativeKernel((const void*)mk_fwd, dim3(grid), dim3(512), kargs, LDS_BYTES, stream);
    if (e != hipSuccess) fprintf(stderr, "kernel_launch: cooperative launch failed: %s (grid %d)\n", hipGetErrorString(e), grid);
}
```

```cpp
#include <hip/hip_runtime.h>
#include <hip/hip_cooperative_groups.h>
#include <hip/hip_bf16.h>
#include <cstdio>
#include <cstdint>
namespace cg = cooperative_groups;
#ifndef PROBE_F8
#define PROBE_F8 0
#endif

#define LAS __attribute__((address_space(3)))
#define GAS __attribute__((address_space(1)))
typedef unsigned short bf16_t;
typedef short bf16x8 __attribute__((ext_vector_type(8)));
typedef float f32x4 __attribute__((ext_vector_type(4)));
typedef float f32x2 __attribute__((ext_vector_type(2)));
typedef unsigned u32x4 __attribute__((ext_vector_type(4)));
typedef unsigned u32x2 __attribute__((ext_vector_type(2)));

constexpr int DM = 1024, SEQ = 16384, NBATCH = 2, DEPTH = 2, NIN = 11776;
constexpr int NPH_PER = 8, NPHASES = 1 + DEPTH * NBATCH * NPH_PER;
constexpr float EPS = 1e-6f;
constexpr float LOG2E = 1.4426950408889634f;

constexpr size_t MiB = 1u << 20;
constexpr size_t WS_MOD = 0;
constexpr size_t WS_ROPE = 64 * 1024;
constexpr size_t WS_BAR = 256 * 1024;
constexpr size_t WS_SA = 1 * MiB, WS_SH = 2 * MiB;
constexpr size_t WS_WIN = 4 * MiB, WS_WG = 50 * MiB, WS_WBR = 54 * MiB, WS_WOUT = 66 * MiB;
constexpr size_t WS_H = 70 * MiB;
constexpr size_t WS_XA = 102 * MiB;
constexpr size_t WS_SGA = 134 * MiB;
constexpr size_t WS_Q = 166 * MiB;
constexpr size_t WS_K = 198 * MiB, WS_V = 206 * MiB;
constexpr size_t WS_SGB = 214 * MiB;
constexpr size_t WS_XC = 246 * MiB, WS_BC = 278 * MiB, WS_CC = 310 * MiB, WS_SGC = 342 * MiB;
constexpr size_t WS_LA = WS_XC, WS_U = WS_BC;
constexpr size_t WS_SMG = 374 * MiB;
constexpr size_t WS_YC = 470 * MiB;
constexpr size_t WS_K8 = 502 * MiB, WS_V8 = 506 * MiB;
constexpr size_t WS_SPARE = 510 * MiB;
constexpr size_t WS_FLAG = WS_BAR + 15 * 1024;
constexpr size_t WS_END = 512 * MiB;
constexpr int LDS_BYTES = 131072 + 1024;

__device__ __forceinline__ float bf2f(bf16_t v) { return __uint_as_float((unsigned)v << 16); }
__device__ __forceinline__ unsigned f2bf(float f) { unsigned u = __float_as_uint(f); return (u + 0x7fffu + ((u >> 16) & 1u)) >> 16; }
__device__ __forceinline__ unsigned cvt_pk_bf16(float lo, float hi) { unsigned r; asm("v_cvt_pk_bf16_f32 %0, %1, %2" : "=v"(r) : "v"(lo), "v"(hi)); return r; }
__device__ __forceinline__ void unpack8(const u32x4 w, float (&f)[8]) {
#pragma unroll
    for (int i = 0; i < 4; ++i) { f[2 * i] = __uint_as_float(w[i] << 16); f[2 * i + 1] = __uint_as_float(w[i] & 0xffff0000u); }
}
__device__ __forceinline__ u32x4 pack8(const float (&f)[8]) {
    u32x4 w; w.x = cvt_pk_bf16(f[0], f[1]); w.y = cvt_pk_bf16(f[2], f[3]); w.z = cvt_pk_bf16(f[4], f[5]); w.w = cvt_pk_bf16(f[6], f[7]); return w;
}
typedef int i32x8 __attribute__((ext_vector_type(8)));
__device__ __forceinline__ int pk4_fp8(float a, float b, float c, float d) { int r = __builtin_amdgcn_cvt_pk_fp8_f32(a, b, 0, false); return __builtin_amdgcn_cvt_pk_fp8_f32(c, d, r, true); }
__device__ __forceinline__ float sigmoidf_(float v) { return __builtin_amdgcn_rcpf(1.f + __expf(-v)); }
__device__ __forceinline__ float wave_sum(float v) {
#pragma unroll
    for (int o = 1; o < 64; o <<= 1) v += __shfl_xor(v, o);
    return v;
}
#define LDS_WAIT() asm volatile("s_waitcnt lgkmcnt(0)" ::: "memory")
#define VM_WAIT() asm volatile("s_waitcnt vmcnt(0)" ::: "memory")

namespace pg8 {
constexpr int BM = 256, BK = 64, HALF = 128, HTB = HALF * BK * 2, STAGE_BYTES = 8 * HTB, NXCD = 8, WGM = 8;
__device__ __forceinline__ int lds_byte(int r, int c) { const int st = (r >> 4) * 2 + (c >> 5), rr = r & 15, cc = c & 31, ob = rr * 64 + cc * 2; return st * 1024 + (ob ^ (((ob >> 9) & 1) << 5)); }
__device__ __forceinline__ void stage_rc(int b, int& R, int& C) { const int st = b / 1024, sb = b % 1024, swz = sb ^ (((sb >> 9) & 1) << 5); R = (st >> 1) * 16 + swz / 64; C = (st & 1) * 32 + (swz % 64) / 2; }
__device__ __forceinline__ int perm32(int rho) { const int n = rho >> 4, i = rho & 15; return 8 * (i >> 2) + 4 * n + (i & 3); }

struct Unit { int pm, pn, kk; };
struct Gemm { const bf16_t* A; const bf16_t* Bt; int lda, ldb, K; long a1, a2; };

struct StaticOrder {
    int nM, nN, nwg, G, c;
    __device__ void init(int M, int N, int G_, int c_) { nM = M / BM; nN = N / BM; nwg = nM * nN; G = G_; c = c_; }
    __device__ bool next(int i, Unit& u) const {
        const long L = (long)i * G + c; if (L >= nwg) return false;
        int wgid = (int)L; { const int q = nwg / NXCD, r = nwg % NXCD, xcd = wgid % NXCD, off = wgid / NXCD; wgid = (xcd < r ? xcd * (q + 1) : r * (q + 1) + (xcd - r) * q) + off; }
        const int nig = WGM * nN, gid = wgid / nig, fm = gid * WGM, gsz = (nM - fm) < WGM ? (nM - fm) : WGM;
        u.pm = fm + ((wgid % nig) % gsz); u.pn = (wgid % nig) / gsz; u.kk = 0; return true;
    }
};
struct BranchOrder {
    StaticOrder so;
    __device__ bool next(int i, Unit& u) const { const int ti = i / 3, kk = i - 3 * ti; if (!so.next(ti, u)) return false; u.kk = kk; return true; }
};

template <int MODE> __device__ __forceinline__ const char* unitA(const Gemm& g, const Unit& u) {
    const char* p = (const char*)g.A + (size_t)u.pm * BM * g.lda * 2;
    if (MODE == 1) p += (((u.pn >> 1) & 3) * 256) * 2;
    if (MODE == 2) p += (u.kk == 1 ? g.a1 : (u.kk == 2 ? g.a2 : 0l));
    return p;
}
template <int MODE> __device__ __forceinline__ const char* unitB(const Gemm& g, const Unit& u) {
    const char* p = (const char*)g.Bt + (size_t)u.pn * BM * g.ldb * 2;
    if (MODE == 2) p += (size_t)u.kk * 1024 * 1024 * 2;
    return p;
}

template <class Epi, class Sched, int MODE>
__device__ __forceinline__ void gemm_phase(LAS unsigned char* lds, const Gemm g, const Sched& S, const Epi& E, const int tid) {
    const int wid = __builtin_amdgcn_readfirstlane(tid >> 6), lane = tid & 63, wr = wid >> 2, wc = wid & 3, fr = lane & 15, fq = lane >> 4;
    const int K = g.K, nt = K / BK;
    unsigned voffA[2], voffB[2];
#pragma unroll
    for (int i = 0; i < 2; ++i) { int R, C; stage_rc(tid * 16 + i * 8192, R, C); const int Rb = (R & ~31) + perm32(R & 31);
        voffA[i] = (unsigned)(R * g.lda + C) * 2u; voffB[i] = (unsigned)(Rb * g.ldb + C) * 2u; }
    const size_t kstep = (size_t)(BK * 2);
    const size_t hstepA = (size_t)HALF * g.lda * 2, hstepB = (size_t)HALF * g.ldb * 2;
    const unsigned ldsw = (unsigned)wid * 1024u;
    const int aoff = lds_byte(wr * 64 + fr, fq * 8), boff = lds_byte(wc * 32 + fr, fq * 8);
#define PG8_SA(b, h) (((b) * 2 + (h)) * HTB)
#define PG8_SB(b, h) ((4 + (b) * 2 + (h)) * HTB)
#define PG8_STAGE(bufoff, gbase, voff) do { _Pragma("unroll") for (int _i = 0; _i < 2; ++_i) \
        __builtin_amdgcn_global_load_lds((const unsigned*)((const char*)(gbase) + (voff)[_i]), (LAS unsigned*)(lds + (bufoff) + ldsw + _i * 8192), 16, 0, 0); } while (0)
#define PG8_LDA(dst, b, h) do { _Pragma("unroll") for (int m = 0; m < 4; ++m) _Pragma("unroll") for (int k = 0; k < 2; ++k) dst[m][k] = *(const LAS bf16x8*)(lds + PG8_SA(b, h) + aoff + m * 2048 + k * 1024); } while (0)
#define PG8_LDB(dst, b, h) do { _Pragma("unroll") for (int n = 0; n < 2; ++n) _Pragma("unroll") for (int k = 0; k < 2; ++k) dst[n][k] = *(const LAS bf16x8*)(lds + PG8_SB(b, h) + boff + n * 2048 + k * 1024); } while (0)
#define PG8_MMA(ai, bj, At, Bt) do { __builtin_amdgcn_s_setprio(1); _Pragma("unroll") for (int m = 0; m < 4; ++m) _Pragma("unroll") for (int n = 0; n < 2; ++n) _Pragma("unroll") for (int k = 0; k < 2; ++k) \
        acc[ai][bj][m][n] = __builtin_amdgcn_mfma_f32_16x16x32_bf16(Bt[n][k], At[m][k], acc[ai][bj][m][n], 0, 0, 0); __builtin_amdgcn_s_setprio(0); } while (0)
#define PG8_WAIT_V(n) asm volatile("s_waitcnt vmcnt(" #n ")" ::: "memory")
#define PG8_WAIT_L(n) asm volatile("s_waitcnt lgkmcnt(" #n ")" ::: "memory")
#define PG8_BAR __builtin_amdgcn_s_barrier()
#define PG8_SCHED __builtin_amdgcn_sched_barrier(0)
    Unit cur, nxt; int ui = 0;
    if (!S.next(0, cur)) return;
    f32x4 acc[2][2][4][2];
#pragma unroll
    for (int a = 0; a < 2; ++a)
#pragma unroll
        for (int b = 0; b < 2; ++b)
#pragma unroll
            for (int m = 0; m < 4; ++m)
#pragma unroll
                for (int n = 0; n < 2; ++n) acc[a][b][m][n] = (f32x4){0.f, 0.f, 0.f, 0.f};
    bf16x8 At[4][2], B0[2][2], B1[2][2];
    const char* cA = unitA<MODE>(g, cur); const char* cB = unitB<MODE>(g, cur);
    PG8_STAGE(PG8_SB(0, 0), cB, voffB); PG8_STAGE(PG8_SB(0, 1), cB + hstepB, voffB); PG8_STAGE(PG8_SA(0, 0), cA, voffA); PG8_STAGE(PG8_SA(0, 1), cA + hstepA, voffA);
    if (wr == 1) PG8_BAR;
    PG8_WAIT_V(2); PG8_BAR;
    PG8_STAGE(PG8_SB(1, 0), cB + kstep, voffB); PG8_STAGE(PG8_SA(1, 0), cA + kstep, voffA); PG8_STAGE(PG8_SB(1, 1), cB + hstepB + kstep, voffB);
    PG8_WAIT_V(6); PG8_BAR;
    for (;;) {
        const bool has_next = S.next(ui + 1, nxt);
        const char* nA = has_next ? unitA<MODE>(g, nxt) : cA; const char* nB = has_next ? unitB<MODE>(g, nxt) : cB;
#pragma nounroll
        for (int t = 0; t < nt; t += 2) {
            const bool last = (t == nt - 2);
            const char* a1 = cA + (size_t)(t + 1) * kstep;
            const char* a2 = last ? nA : cA + (size_t)(t + 2) * kstep; const char* b2 = last ? nB : cB + (size_t)(t + 2) * kstep;
            const char* a3 = a2 + kstep; const char* b3 = b2 + kstep;
            PG8_LDB(B0, 0, 0); PG8_LDB(B1, 0, 1); PG8_SCHED; PG8_LDA(At, 0, 0); PG8_STAGE(PG8_SA(1, 1), a1 + hstepA, voffA);
            PG8_WAIT_V(8); PG8_WAIT_L(0); PG8_BAR; PG8_MMA(0, 0, At, B0); PG8_MMA(0, 1, At, B1); PG8_BAR; PG8_SCHED;
            PG8_LDA(At, 0, 1); PG8_STAGE(PG8_SB(0, 0), b2, voffB); PG8_STAGE(PG8_SB(0, 1), b2 + hstepB, voffB); PG8_STAGE(PG8_SA(0, 0), a2, voffA);
            PG8_WAIT_V(8); PG8_WAIT_L(0); PG8_BAR; PG8_MMA(1, 0, At, B0); PG8_MMA(1, 1, At, B1); PG8_BAR; PG8_SCHED;
            PG8_LDB(B0, 1, 0); PG8_LDB(B1, 1, 1); PG8_SCHED; PG8_LDA(At, 1, 0); PG8_STAGE(PG8_SA(0, 1), a2 + hstepA, voffA);
            PG8_WAIT_V(8); PG8_WAIT_L(0); PG8_BAR; PG8_MMA(0, 0, At, B0); PG8_MMA(0, 1, At, B1); PG8_BAR; PG8_SCHED;
            PG8_LDA(At, 1, 1); PG8_STAGE(PG8_SB(1, 0), b3, voffB); PG8_STAGE(PG8_SB(1, 1), b3 + hstepB, voffB); PG8_STAGE(PG8_SA(1, 0), a3, voffA);
            PG8_WAIT_V(8); PG8_WAIT_L(0); PG8_BAR; PG8_MMA(1, 0, At, B0); PG8_MMA(1, 1, At, B1); PG8_BAR; PG8_SCHED;
        }
        if (wr == 0) PG8_BAR;
        E(acc, cur, wr, wc, fr, fq);
        if (!has_next) break;
#pragma unroll
        for (int a = 0; a < 2; ++a)
#pragma unroll
            for (int b = 0; b < 2; ++b)
#pragma unroll
                for (int m = 0; m < 4; ++m)
#pragma unroll
                    for (int n = 0; n < 2; ++n) acc[a][b][m][n] = (f32x4){0.f, 0.f, 0.f, 0.f};
        cur = nxt; cA = nA; cB = nB; ++ui;
        if (wr == 1) PG8_BAR;
    }
    PG8_WAIT_V(0);
    PG8_BAR;
#undef PG8_SA
#undef PG8_SB
#undef PG8_STAGE
#undef PG8_LDA
#undef PG8_LDB
#undef PG8_MMA
#undef PG8_WAIT_V
#undef PG8_WAIT_L
#undef PG8_BAR
#undef PG8_SCHED
}

__device__ __forceinline__ void store_tile_bf16(const f32x4 (&acc)[2][2][4][2], bf16_t* base, int ldc, int row0, int col0, int act) {
#pragma unroll
    for (int ai = 0; ai < 2; ++ai)
#pragma unroll
        for (int m = 0; m < 4; ++m) { bf16_t* rowp = base + (size_t)(row0 + ai * HALF + m * 16) * ldc + col0;
#pragma unroll
            for (int bj = 0; bj < 2; ++bj) { float v[8];
#pragma unroll
                for (int j = 0; j < 4; ++j) { v[j] = acc[ai][bj][m][0][j]; v[4 + j] = acc[ai][bj][m][1][j]; }
                if (act != 0) {
                    float sg[8];
#pragma unroll
                    for (int j = 0; j < 8; ++j) sg[j] = sigmoidf_(v[j]);
                    if (act == 1) {
#pragma unroll
                        for (int j = 0; j < 8; ++j) v[j] *= sg[j];
                    } else {
#pragma unroll
                        for (int j = 0; j < 8; ++j) v[j] = sg[j];
                    }
                }
                *(u32x4*)(rowp + bj * HALF) = pack8(v); }
            asm volatile("" ::: "memory"); }
}
struct EpiInProj {
    unsigned char* ws;
    __device__ __forceinline__ void operator()(const f32x4 (&acc)[2][2][4][2], const Unit& u, int wr, int wc, int fr, int fq) const {
        const int pn = u.pn; size_t off; int ldc = 1024, col, act = 0;
        if (pn < 4) { off = WS_XA; col = pn * 256; }
        else if (pn < 8) { off = WS_SGA; col = (pn - 4) * 256; act = 1; }
        else if (pn < 12) { off = WS_Q; col = (pn - 8) * 256; }
        else if (pn == 12) { off = WS_K; col = 0; ldc = 256; }
        else if (pn == 13) { off = WS_V; col = 0; ldc = 256; }
        else if (pn < 18) { off = WS_SGB; col = (pn - 14) * 256; act = 1; }
        else if (pn < 34) {
            const bool bg = pn >= 26; const int blk = bg ? pn - 26 : pn - 18;
            bf16_t* basep = (bf16_t*)(ws + (bg ? WS_BC : WS_XC));
            const int row0p = u.pm * BM + wr * 64 + fr, col0p = blk * 128 + wc * 32 + 8 * fq;
#pragma unroll
            for (int ai = 0; ai < 2; ++ai)
#pragma unroll
                for (int m = 0; m < 4; ++m) { float v[8];
#pragma unroll
                    for (int j = 0; j < 8; ++j) { const float x0 = acc[ai][0][m][j >> 2][j & 3], x1 = acc[ai][1][m][j >> 2][j & 3];
                        v[j] = bg ? x0 * (x1 * sigmoidf_(x1)) : x0 * x1; }
                    *(u32x4*)(basep + (size_t)(row0p + ai * HALF + m * 16) * 1024 + col0p) = pack8(v); }
            return; }
        else { off = WS_SMG; col = (pn - 34) * 256; ldc = 3072; act = 2; }
        bf16_t* base = (bf16_t*)(ws + off);
        const int row0 = u.pm * BM + wr * 64 + fr, col0 = col + wc * 32 + 8 * fq;
        store_tile_bf16(acc, base, ldc, row0, col0, act);
    }
};
struct EpiGates {
    unsigned char* ws; const float* b_r; const float* b_i; const float* lam;
    __device__ __forceinline__ void operator()(const f32x4 (&acc)[2][2][4][2], const Unit& u, int wr, int wc, int fr, int fq) const {
        const int dir = u.pn >> 3, nb = (u.pn >> 1) & 3, hh = u.pn & 1;
        const int ch0 = nb * 256 + hh * 128 + wc * 32 + 8 * fq;
        float br[8], bi[8], sp[8];
#pragma unroll
        for (int j = 0; j < 8; ++j) { br[j] = b_r[dir * 1024 + ch0 + j]; bi[j] = b_i[dir * 1024 + ch0 + j];
            const float lm = lam[dir * 1024 + ch0 + j]; const float e = __expf(-lm);
            const float spl = lm < -15.f ? -lm : (e < 0.03f ? e * (1.f - e * (0.5f - e * (0.33333334f - 0.25f * e))) : __logf(1.f + e));
            sp[j] = -8.0f * LOG2E * spl; }
        const bf16_t* UA = (const bf16_t*)(ws + WS_H);
        bf16_t* LA = (bf16_t*)(ws + WS_LA + (size_t)dir * 64 * MiB);
        bf16_t* UU = (bf16_t*)(ws + WS_U + (size_t)dir * 64 * MiB);
        const int row0 = u.pm * BM + wr * 64 + fr;
#pragma unroll
        for (int ai = 0; ai < 2; ++ai)
#pragma unroll
            for (int m = 0; m < 4; ++m) { const size_t o = (size_t)(row0 + ai * HALF + m * 16) * 1024 + ch0;
                float x[8]; unpack8(*(const u32x4*)(UA + o), x);
                float la[8], uu[8];
#pragma unroll
                for (int j = 0; j < 8; ++j) { const float pr = acc[ai][0][m][j >> 2][j & 3] + br[j], pi = acc[ai][1][m][j >> 2][j & 3] + bi[j];
                    const float r = sigmoidf_(pr), ig = sigmoidf_(pi);
                    const float l2 = r * sp[j]; const float a = __builtin_amdgcn_exp2f(l2);
                    la[j] = l2; uu[j] = __builtin_amdgcn_sqrtf(fmaxf(1.f - a * a, 0.f)) * ig * x[j]; }
                *(u32x4*)(LA + o) = pack8(la); *(u32x4*)(UU + o) = pack8(uu); }
    }
};
struct EpiBranch {
    unsigned char* ws;
    __device__ __forceinline__ void operator()(const f32x4 (&acc)[2][2][4][2], const Unit& u, int wr, int wc, int fr, int fq) const {
        const bf16_t* G = (const bf16_t*)(ws + WS_SMG) + u.kk * 1024;
        bf16_t* Mg = (bf16_t*)(ws + WS_SGA);
        const int row0 = u.pm * BM + wr * 64 + fr, col0 = u.pn * BM + wc * 32 + 8 * fq;
#pragma unroll
        for (int ai = 0; ai < 2; ++ai)
#pragma unroll
            for (int m = 0; m < 4; ++m) { const int row = row0 + ai * HALF + m * 16;
#pragma unroll
                for (int bj = 0; bj < 2; ++bj) { const int col = col0 + bj * HALF;
                    float gt[8], v[8]; unpack8(*(const u32x4*)(G + (size_t)row * 3072 + col), gt);
#pragma unroll
                    for (int j = 0; j < 8; ++j) v[j] = gt[j] * acc[ai][bj][m][j >> 2][j & 3];
                    bf16_t* mp = Mg + (size_t)row * 1024 + col;
                    if (u.kk != 0) { float old[8]; unpack8(*(const u32x4*)mp, old);
#pragma unroll
                        for (int j = 0; j < 8; ++j) v[j] += old[j]; }
                    *(u32x4*)mp = pack8(v); } }
    }
};
struct EpiOut {
    const float* xi; float* xo; const float* gate; const unsigned* flag;
    __device__ __forceinline__ void operator()(const f32x4 (&acc)[2][2][4][2], const Unit& u, int wr, int wc, int fr, int fq) const {
        const int row0 = u.pm * BM + wr * 64 + fr, col0 = u.pn * BM + wc * 32 + 8 * fq;
        const bool bad = PROBE_F8 ? (__hip_atomic_load(flag, __ATOMIC_RELAXED, __HIP_MEMORY_SCOPE_AGENT) != 0u) : false; const float qn = __builtin_nanf("");
        f32x4 gv[2][2];
#pragma unroll
        for (int bj = 0; bj < 2; ++bj)
#pragma unroll
            for (int n = 0; n < 2; ++n) gv[bj][n] = *(const f32x4*)(gate + col0 + bj * HALF + 4 * n);
#pragma unroll
        for (int ai = 0; ai < 2; ++ai)
#pragma unroll
            for (int m = 0; m < 4; ++m) { const size_t o = (size_t)(row0 + ai * HALF + m * 16) * 1024 + col0;
#pragma unroll
                for (int bj = 0; bj < 2; ++bj)
#pragma unroll
                    for (int n = 0; n < 2; ++n) { const f32x4 xv = *(const f32x4*)(xi + o + bj * HALF + 4 * n);
                        f32x4 r = xv + gv[bj][n] * acc[ai][bj][m][n]; if (PROBE_F8 && bad) r = (f32x4){qn, qn, qn, qn};
                        *(f32x4*)(xo + o + bj * HALF + 4 * n) = r; } }
    }
};
}

namespace attn {
using bf16 = __hip_bfloat16;
using s16x4 = __attribute__((ext_vector_type(4))) short;
using f32x16 = __attribute__((ext_vector_type(16))) float;
constexpr int D = 128, NW = 8, QBLK = 32, KVBLK = 64;
constexpr float SCALE = 0.088388347648318440f;
constexpr float THR = 8.f;
constexpr int LDQ = 1024, LDK = 256, LDO = 1024;
constexpr size_t SHM_V = KVBLK * D * 2, SHM_K = KVBLK * D * 2, SHM_ATTN = 2 * SHM_V + 2 * SHM_K + NW * 64 * 4;
#define KSWZ(row, colB) ((row) * 256 + ((colB) ^ (((row) & 7) << 4)))
#define SBAR() __builtin_amdgcn_sched_barrier(0)
__device__ __forceinline__ int crow(int r, int hi) { return (r & 3) + 8 * (r >> 2) + 4 * hi; }
__device__ __forceinline__ unsigned cvtpk(float lo, float hi) { unsigned r; asm volatile("v_cvt_pk_bf16_f32 %0, %1, %2" : "=v"(r) : "v"(lo), "v"(hi)); return r; }

__device__ __forceinline__ void partialSM(f32x16& p0, f32x16& p1, float& m_reg, float& mn, float& alpha) {
  constexpr float C = SCALE * 1.4426950408889634f;
  float pmax = p0[0]; for (int r = 1; r < 16; ++r) pmax = fmaxf(pmax, p0[r]); for (int r = 0; r < 16; ++r) pmax = fmaxf(pmax, p1[r]);
  { auto rr = __builtin_amdgcn_permlane32_swap(__float_as_uint(pmax), __float_as_uint(pmax), false, false);
    pmax = fmaxf(__uint_as_float(rr[0]), __uint_as_float(rr[1])); }
  if (__builtin_expect(__all(pmax - m_reg <= THR / SCALE), 1)) { mn = m_reg; alpha = 1.f; }
  else { mn = fmaxf(m_reg, pmax); alpha = __builtin_amdgcn_exp2f((m_reg - mn) * C); m_reg = mn; }
  float mnC = -mn * C;
  for (int r = 0; r < 16; ++r) p0[r] = fmaf(p0[r], C, mnC); for (int r = 0; r < 16; ++r) p1[r] = fmaf(p1[r], C, mnC);
  for (int r = 0; r < 16; ++r) p0[r] = __builtin_amdgcn_exp2f(p0[r]);
}
__device__ __forceinline__ void finishSM(f32x16& p0, f32x16& p1, float alpha, float& l_reg, bf16x8& pa0, bf16x8& pa1, bf16x8& pa2, bf16x8& pa3) {
  for (int r = 0; r < 16; ++r) p1[r] = __builtin_amdgcn_exp2f(p1[r]);
  float ps = 0; for (int r = 0; r < 16; ++r) ps += p0[r]; for (int r = 0; r < 16; ++r) ps += p1[r];
  { auto rr = __builtin_amdgcn_permlane32_swap(__float_as_uint(ps), __float_as_uint(ps), false, false);
    ps = __uint_as_float(rr[0]) + __uint_as_float(rr[1]); }
  l_reg = l_reg * alpha + ps;
#define PK4(P, BASE, OUT) do { unsigned a0 = cvtpk(P[BASE + 0], P[BASE + 1]), a1 = cvtpk(P[BASE + 2], P[BASE + 3]);   \
    unsigned b0 = cvtpk(P[BASE + 4], P[BASE + 5]), b1 = cvtpk(P[BASE + 6], P[BASE + 7]);                              \
    auto r0 = __builtin_amdgcn_permlane32_swap(a0, b0, false, false); auto r1 = __builtin_amdgcn_permlane32_swap(a1, b1, false, false); \
    u32x4 w = {r0[0], r1[0], r0[1], r1[1]}; OUT = *reinterpret_cast<bf16x8*>(&w); } while (0)
  PK4(p0, 0, pa0); PK4(p0, 8, pa1); PK4(p1, 0, pa2); PK4(p1, 8, pa3);
#undef PK4
}
__device__ __forceinline__ void qkt(f32x16& p0, f32x16& p1, const bf16* Ks, const bf16x8* qr, int r32, int hi) {
  p0 = f32x16{}; p1 = f32x16{};
  for (int d0 = 0; d0 < 8; ++d0) { int cb = (d0 * 16 + hi * 8) * 2;
    bf16x8 b0 = *reinterpret_cast<const bf16x8*>((const char*)Ks + KSWZ(r32, cb));
    bf16x8 b1 = *reinterpret_cast<const bf16x8*>((const char*)Ks + KSWZ(32 + r32, cb));
    p0 = __builtin_amdgcn_mfma_f32_32x32x16_bf16(b0, qr[d0], p0, 0, 0, 0);
    p1 = __builtin_amdgcn_mfma_f32_32x32x16_bf16(b1, qr[d0], p1, 0, 0, 0); }
}
__device__ __forceinline__ int v_st(int k, int c) { const int kk = (k & ~0xC) | ((k & 4) << 1) | ((k & 8) >> 1); return ((kk >> 3) * 4 + (c >> 5)) * 512 + ((kk & 7) * 32 + (c & 31)) * 2; }
__device__ __forceinline__ int v_rd_base(int lane) { return ((lane & 3) << 3) | (((lane >> 2) & 3) << 6) | (((lane >> 4) & 1) << 5) | (((lane >> 5) & 1) << 8); }
constexpr int v_rd_off(int d0, int ks, int half) { return d0 * 512 + ks * 4096 + half * 2048; }
template <int OFF> __device__ __forceinline__ s16x4 tr_read(int vb) {
  s16x4 r; asm volatile("ds_read_b64_tr_b16 %0, %1 offset:%2" : "=&v"(r) : "v"(vb), "i"(OFF) : "memory"); return r;
}
template <int D0> __device__ __forceinline__ void pv_one(f32x16& od, int vb, bf16x8 pa0, bf16x8 pa1, bf16x8 pa2, bf16x8 pa3) {
  const s16x4 l0 = tr_read<v_rd_off(D0, 0, 0)>(vb), h0 = tr_read<v_rd_off(D0, 0, 1)>(vb), l1 = tr_read<v_rd_off(D0, 1, 0)>(vb), h1 = tr_read<v_rd_off(D0, 1, 1)>(vb);
  const s16x4 l2 = tr_read<v_rd_off(D0, 2, 0)>(vb), h2 = tr_read<v_rd_off(D0, 2, 1)>(vb), l3 = tr_read<v_rd_off(D0, 3, 0)>(vb), h3 = tr_read<v_rd_off(D0, 3, 1)>(vb);
  asm volatile("s_waitcnt lgkmcnt(0)" ::: "memory"); SBAR();
#define PK(L, H) (bf16x8){L[0], L[1], L[2], L[3], H[0], H[1], H[2], H[3]}
  od = __builtin_amdgcn_mfma_f32_32x32x16_bf16(pa0, PK(l0, h0), od, 0, 0, 0);
  od = __builtin_amdgcn_mfma_f32_32x32x16_bf16(pa1, PK(l1, h1), od, 0, 0, 0);
  od = __builtin_amdgcn_mfma_f32_32x32x16_bf16(pa2, PK(l2, h2), od, 0, 0, 0);
  od = __builtin_amdgcn_mfma_f32_32x32x16_bf16(pa3, PK(l3, h3), od, 0, 0, 0);
#undef PK
}
__device__ __forceinline__ void pv_d0(f32x16* o, int vb, bf16x8 pa0, bf16x8 pa1, bf16x8 pa2, bf16x8 pa3) {
  pv_one<0>(o[0], vb, pa0, pa1, pa2, pa3); pv_one<1>(o[1], vb, pa0, pa1, pa2, pa3); pv_one<2>(o[2], vb, pa0, pa1, pa2, pa3); pv_one<3>(o[3], vb, pa0, pa1, pa2, pa3);
}
__device__ __forceinline__ void attn_dense_body(const bf16* Qb, const bf16* __restrict__ Kh, const bf16* __restrict__ Vh,
                                                bf16_t* Ob, const bf16_t* Gb, int seq, char* lds, const int tid) {
  const int wid = tid >> 6, lane = tid & 63, r32 = lane & 31, hi = lane >> 5;
  bf16* V_lds = (bf16*)lds; bf16* K_lds = (bf16*)(lds + 2 * SHM_V);
  float* ws = (float*)(lds + 2 * SHM_V + 2 * SHM_K) + wid * 64; float* li_l = ws; float* al_l = ws + 32;
  float m_reg = -1e30f, l_reg = 0; f32x16 o[4] = {}; bf16x8 qr[8];
  const bf16* Qw = Qb + (long)(wid * QBLK + r32) * LDQ + hi * 8;
#pragma unroll
  for (int d0 = 0; d0 < 8; ++d0) qr[d0] = *reinterpret_cast<const bf16x8*>(Qw + d0 * 16);
  const int sr = tid >> 4, sc = (tid & 15) * 8, vst0 = v_st(sr, sc), vst1 = v_st(32 + sr, sc);
  const int vb0 = (int)(uintptr_t)V_lds + v_rd_base(lane);
  struct { bf16x8 vs0, vs1, ks0, ks1; } sr_[2];
#define SLOAD(i, k0) do { sr_[i].vs0 = *reinterpret_cast<const bf16x8*>(&Vh[(long)((k0) + sr) * LDK + sc]); sr_[i].vs1 = *reinterpret_cast<const bf16x8*>(&Vh[(long)((k0) + 32 + sr) * LDK + sc]); \
    sr_[i].ks0 = *reinterpret_cast<const bf16x8*>(&Kh[(long)((k0) + sr) * LDK + sc]); sr_[i].ks1 = *reinterpret_cast<const bf16x8*>(&Kh[(long)((k0) + 32 + sr) * LDK + sc]); } while (0)
#define SWRITE(b, i) do { *(bf16x8*)((char*)V_lds + (b) * SHM_V + vst0) = sr_[i].vs0;          \
    *(bf16x8*)((char*)V_lds + (b) * SHM_V + vst1) = sr_[i].vs1; int kc = sc * 2;               \
    *(bf16x8*)((char*)K_lds + (b) * SHM_K + KSWZ(sr, kc)) = sr_[i].ks0;                       \
    *(bf16x8*)((char*)K_lds + (b) * SHM_K + KSWZ(32 + sr, kc)) = sr_[i].ks1; } while (0)
#define SWAIT() asm volatile("s_waitcnt vmcnt(4)" ::: "memory")
#define RESC(a) do { if (__any((a) < 1.f)) { if (hi == 0) al_l[r32] = (a); asm volatile("s_waitcnt lgkmcnt(0)" ::: "memory"); \
    for (int d = 0; d < 4; ++d) for (int r = 0; r < 16; ++r) o[d][r] *= al_l[crow(r, hi)]; } } while (0)
  f32x16 pA0, pA1, pB0, pB1; float mnA, mnB, alA, alB; bf16x8 pa0, pa1, pa2, pa3; const int NT = seq / KVBLK;
  constexpr int SE = 0, SO = 1;
  SLOAD(SE, 0); asm volatile("s_waitcnt vmcnt(0)" ::: "memory"); SWRITE(0, SE); __syncthreads();
  qkt(pA0, pA1, K_lds, qr, r32, hi); partialSM(pA0, pA1, m_reg, mnA, alA);
  SLOAD(SO, KVBLK); if (2 < NT) SLOAD(SE, 2 * KVBLK);
  SWAIT(); SWRITE(1, SO); __syncthreads();
#pragma nounroll
  for (int j = 1; j + 1 < NT; j += 2) {
    SBAR(); qkt(pB0, pB1, (bf16*)((char*)K_lds + SHM_K), qr, r32, hi);
    finishSM(pA0, pA1, alA, l_reg, pa0, pa1, pa2, pa3); SBAR();
    SLOAD(SO, (j + 2) * KVBLK); SBAR();
    pv_d0(o, vb0, pa0, pa1, pa2, pa3); partialSM(pB0, pB1, m_reg, mnB, alB);
    __syncthreads(); SWAIT(); SWRITE(0, SE);
    RESC(alB); __syncthreads();
    SBAR(); qkt(pA0, pA1, K_lds, qr, r32, hi);
    finishSM(pB0, pB1, alB, l_reg, pa0, pa1, pa2, pa3); SBAR();
    if (j + 3 < NT) SLOAD(SE, (j + 3) * KVBLK); SBAR();
    pv_d0(o, vb0 + (int)SHM_V, pa0, pa1, pa2, pa3); partialSM(pA0, pA1, m_reg, mnA, alA);
    __syncthreads(); SWAIT(); SWRITE(1, SO);
    RESC(alA); __syncthreads();
  }
  SBAR(); qkt(pB0, pB1, (bf16*)((char*)K_lds + SHM_K), qr, r32, hi);
  finishSM(pA0, pA1, alA, l_reg, pa0, pa1, pa2, pa3); SBAR();
  pv_d0(o, vb0, pa0, pa1, pa2, pa3); partialSM(pB0, pB1, m_reg, mnB, alB);
  __syncthreads(); RESC(alB);
  finishSM(pB0, pB1, alB, l_reg, pa0, pa1, pa2, pa3); SBAR();
  pv_d0(o, vb0 + (int)SHM_V, pa0, pa1, pa2, pa3);
  if (hi == 0) li_l[r32] = l_reg; asm volatile("s_waitcnt lgkmcnt(0)" ::: "memory");
  float rli[16];
#pragma unroll
  for (int r = 0; r < 16; ++r) rli[r] = __builtin_amdgcn_rcpf(li_l[crow(r, hi)]);
  __syncthreads();
  { int lane_e = lane, wid_e = wid; asm volatile("" : "+v"(lane_e), "+v"(wid_e)); wid_e = __builtin_amdgcn_readfirstlane(wid_e);
    bf16_t* stg = (bf16_t*)lds + wid_e * 4096;
#pragma unroll
    for (int r = 0; r < 16; ++r) { const int orow = crow(r, hi);
#pragma unroll
      for (int d0 = 0; d0 < 4; ++d0) stg[orow * 128 + d0 * 32 + r32] = (bf16_t)f2bf(o[d0][r] * rli[r]); }
    asm volatile("s_waitcnt lgkmcnt(0)" ::: "memory");
    bf16_t* Ow = Ob + (long)(wid_e * QBLK) * LDO; const bf16_t* Gw = Gb + (long)(wid_e * QBLK) * LDO;
    u32x4 gq[8];
#pragma unroll
    for (int i = 0; i < 8; ++i) { const int row = i * 4 + (lane_e >> 4), ch = lane_e & 15; gq[i] = *(const u32x4*)(Gw + (long)row * LDO + ch * 8); }
#pragma unroll
    for (int i = 0; i < 8; ++i) { const int row = i * 4 + (lane_e >> 4), ch = lane_e & 15;
      float ov[8], gv[8]; unpack8(*(const u32x4*)(stg + row * 128 + ch * 8), ov); unpack8(gq[i], gv);
#pragma unroll
      for (int j = 0; j < 8; ++j) ov[j] *= gv[j];
      *(u32x4*)(Ow + (long)row * LDO + ch * 8) = pack8(ov); } }
  __syncthreads();
#undef SLOAD
#undef SWRITE
#undef SWAIT
#undef RESC
}

__device__ __forceinline__ void attn_pp_body(const bf16* Qb, const bf16* __restrict__ Kh, const bf16* __restrict__ Vh,
                                             bf16_t* Ob, const bf16_t* Gb, int seq, char* lds, const int tid, const bf16_t* cmp = nullptr, unsigned* flag = nullptr) {
  const int wid = __builtin_amdgcn_readfirstlane(tid >> 6), lane = tid & 63, r32 = lane & 31, hi = lane >> 5;
  const int g = wid >> 2;
  constexpr int NB = 3;
  char* V_lds = lds; char* K_lds = lds + NB * SHM_V;
  float* ws = (float*)(lds + NB * (SHM_V + SHM_K)) + wid * 64; float* li_l = ws; float* al_l = ws + 32;
  float m_reg = -1e30f, l_reg = 0; f32x16 o[4] = {}; bf16x8 qr[8];
  const bf16* Qw = Qb + (long)(wid * QBLK + r32) * LDQ + hi * 8;
#pragma unroll
  for (int d0 = 0; d0 < 8; ++d0) qr[d0] = *reinterpret_cast<const bf16x8*>(Qw + d0 * 16);
  const int sr = tid >> 4, sc = (tid & 15) * 8, vst0 = v_st(sr, sc), vst1 = v_st(32 + sr, sc);
  const int ksw0 = KSWZ(sr, sc * 2), ksw1 = KSWZ(32 + sr, sc * 2);
  const int vbase = (int)(uintptr_t)V_lds + v_rd_base(lane);
  struct Stg { bf16x8 vs0, vs1, ks0, ks1; } st0, st1;
#define SLOAD(S, t) do { const long k0_ = (long)(t) * KVBLK; S.vs0 = *reinterpret_cast<const bf16x8*>(&Vh[(k0_ + sr) * LDK + sc]); S.vs1 = *reinterpret_cast<const bf16x8*>(&Vh[(k0_ + 32 + sr) * LDK + sc]); \
    S.ks0 = *reinterpret_cast<const bf16x8*>(&Kh[(k0_ + sr) * LDK + sc]); S.ks1 = *reinterpret_cast<const bf16x8*>(&Kh[(k0_ + 32 + sr) * LDK + sc]); } while (0)
#define SWRITE(S, b) do { *(bf16x8*)(V_lds + (b) * SHM_V + vst0) = S.vs0; *(bf16x8*)(V_lds + (b) * SHM_V + vst1) = S.vs1; \
    *(bf16x8*)(K_lds + (b) * SHM_K + ksw0) = S.ks0; *(bf16x8*)(K_lds + (b) * SHM_K + ksw1) = S.ks1; } while (0)
#define RESC(a) do { if (__any((a) < 1.f)) { if (hi == 0) al_l[r32] = (a); asm volatile("s_waitcnt lgkmcnt(0)" ::: "memory"); \
    for (int d = 0; d < 4; ++d) for (int r = 0; r < 16; ++r) o[d][r] *= al_l[crow(r, hi)]; } } while (0)
  const int NT = seq / KVBLK;
  f32x16 p0, p1; bf16x8 pa0, pa1, pa2, pa3;
#define SMX() do { float mn_, al_; partialSM(p0, p1, m_reg, mn_, al_); RESC(al_); finishSM(p0, p1, al_, l_reg, pa0, pa1, pa2, pa3); } while (0)
  SLOAD(st0, 0); if (g) SLOAD(st1, 1);
  SWRITE(st0, 0); if (g) SWRITE(st1, 1);
  SLOAD(st0, 1 + g); SLOAD(st1, 2 + g);
  __syncthreads();
  if (g) __syncthreads();
  SBAR(); qkt(p0, p1, (const bf16*)K_lds, qr, r32, hi); SBAR();
  __syncthreads();
  SWRITE(st0, 1 + g); if (3 + g < NT) SLOAD(st0, 3 + g);
  SMX();
  __syncthreads();
  int c = 0;
#define STEP(i, ST) do { const int cK_ = (c == 2) ? 0 : c + 1; \
    SBAR(); \
    qkt(p0, p1, (const bf16*)(K_lds + cK_ * SHM_K), qr, r32, hi); \
    pv_d0(o, vbase + c * (int)SHM_V, pa0, pa1, pa2, pa3); \
    SBAR(); \
    __syncthreads(); \
    { const int t_ = (i) + 2 + g; if (t_ < NT) { const int cb_ = (cK_ == 2) ? 0 : cK_ + 1; const int cw_ = g ? ((cb_ == 2) ? 0 : cb_ + 1) : cb_; \
        SWRITE(ST, cw_); if (t_ + 2 < NT) SLOAD(ST, t_ + 2); } } \
    SMX(); \
    __syncthreads(); \
    c = cK_; } while (0)
  int i = 0;
#pragma nounroll
  for (; i + 1 < NT - 1; i += 2) { STEP(i, st1); STEP(i + 1, st0); }
  if (i < NT - 1) { STEP(i, st1); }
  SBAR(); pv_d0(o, vbase + c * (int)SHM_V, pa0, pa1, pa2, pa3); SBAR();
  __syncthreads();
  if (!g) __syncthreads();
  if (hi == 0) li_l[r32] = l_reg; asm volatile("s_waitcnt lgkmcnt(0)" ::: "memory");
  float rli[16];
#pragma unroll
  for (int r = 0; r < 16; ++r) rli[r] = __builtin_amdgcn_rcpf(li_l[crow(r, hi)]);
  { int lane_e = lane, wid_e = wid; asm volatile("" : "+v"(lane_e), "+v"(wid_e)); wid_e = __builtin_amdgcn_readfirstlane(wid_e);
    bf16_t* stg = (bf16_t*)lds + wid_e * 4096;
#pragma unroll
    for (int r = 0; r < 16; ++r) { const int orow = crow(r, hi);
#pragma unroll
      for (int d0 = 0; d0 < 4; ++d0) stg[orow * 128 + d0 * 32 + r32] = (bf16_t)f2bf(o[d0][r] * rli[r]); }
    asm volatile("s_waitcnt lgkmcnt(0)" ::: "memory");
    bf16_t* Ow = Ob + (long)(wid_e * QBLK) * LDO; const bf16_t* Gw = Gb + (long)(wid_e * QBLK) * LDO;
    u32x4 gq[8];
#pragma unroll
    for (int i2 = 0; i2 < 8; ++i2) { const int row = i2 * 4 + (lane_e >> 4), ch = lane_e & 15; gq[i2] = *(const u32x4*)(Gw + (long)row * LDO + ch * 8); }
#pragma unroll
    for (int i2 = 0; i2 < 8; ++i2) { const int row = i2 * 4 + (lane_e >> 4), ch = lane_e & 15;
      float ov[8], gv[8]; unpack8(*(const u32x4*)(stg + row * 128 + ch * 8), ov); unpack8(gq[i2], gv);
#pragma unroll
      for (int j = 0; j < 8; ++j) ov[j] *= gv[j];
      *(u32x4*)(Ow + (long)row * LDO + ch * 8) = pack8(ov); } }
  __syncthreads();
  if (PROBE_F8 && cmp) {
    asm volatile("s_waitcnt vmcnt(0)" ::: "memory");
    float pr_d = 0.f, pr_r = 0.f; int lane_c = lane; asm volatile("" : "+v"(lane_c));
    const bf16_t* stg2 = (const bf16_t*)lds + wid * 4096;
    float a0[8], c0[8];
#pragma unroll
    for (int i2 = 0; i2 < 8; ++i2) { const int rl = i2 * 4 + (lane_c >> 4), ch = lane_c & 15; float a[8], cv[8];
      unpack8(*(const u32x4*)(stg2 + rl * 128 + ch * 8), a); unpack8(*(const u32x4*)(cmp + (long)(wid * QBLK + rl) * LDO + ch * 8), cv);
      if (i2 == 0) {
#pragma unroll
        for (int j = 0; j < 8; ++j) { a0[j] = a[j]; c0[j] = cv[j]; }
      } else {
#pragma unroll
        for (int j = 0; j < 8; ++j) { const float fa = a[j] - a0[j], fc = cv[j] - c0[j]; pr_d = fmaxf(pr_d, fabsf(fa - fc)); pr_r = fmaxf(pr_r, fabsf(fa)); } } }
#pragma unroll
    for (int o_ = 1; o_ < 64; o_ <<= 1) { pr_d = fmaxf(pr_d, __shfl_xor(pr_d, o_)); pr_r = fmaxf(pr_r, __shfl_xor(pr_r, o_)); }
    if (lane_c == 0 && !(pr_d <= 0.3f * pr_r)) atomicOr(flag, 1u);
    __syncthreads(); }
#undef SLOAD
#undef SWRITE
#undef RESC
#undef SMX
#undef STEP
}

constexpr float THR8 = 1.5f;
__device__ __forceinline__ void partialSM8(f32x16& p0, f32x16& p1, float& m_reg, float& alpha) {
  constexpr float C = SCALE * 1.4426950408889634f;
  float pmax = p0[0]; for (int r = 1; r < 16; ++r) pmax = fmaxf(pmax, p0[r]); for (int r = 0; r < 16; ++r) pmax = fmaxf(pmax, p1[r]);
  { auto rr = __builtin_amdgcn_permlane32_swap(__float_as_uint(pmax), __float_as_uint(pmax), false, false);
    pmax = fmaxf(__uint_as_float(rr[0]), __uint_as_float(rr[1])); }
  float mn;
  if (__builtin_expect(__all(pmax - m_reg <= THR8 / SCALE), 1)) { mn = m_reg; alpha = 1.f; }
  else { mn = fmaxf(m_reg, pmax); alpha = __builtin_amdgcn_exp2f((m_reg - mn) * C); m_reg = mn; }
  const float mnC = 6.0f - mn * C;
  for (int r = 0; r < 16; ++r) p0[r] = fmaf(p0[r], C, mnC); for (int r = 0; r < 16; ++r) p1[r] = fmaf(p1[r], C, mnC);
  for (int r = 0; r < 16; ++r) p0[r] = __builtin_amdgcn_exp2f(p0[r]);
}
__device__ __forceinline__ void finishSM8(f32x16& p0, f32x16& p1, float alpha, float& l_reg, i32x8& pa) {
  for (int r = 0; r < 16; ++r) p1[r] = __builtin_amdgcn_exp2f(p1[r]);
  float ps = 0; for (int r = 0; r < 16; ++r) ps += p0[r]; for (int r = 0; r < 16; ++r) ps += p1[r];
  { auto rr = __builtin_amdgcn_permlane32_swap(__float_as_uint(ps), __float_as_uint(ps), false, false);
    ps = __uint_as_float(rr[0]) + __uint_as_float(rr[1]); }
  l_reg = l_reg * alpha + ps;
#pragma unroll
  for (int w = 0; w < 4; ++w) { pa[w] = pk4_fp8(p0[4 * w], p0[4 * w + 1], p0[4 * w + 2], p0[4 * w + 3]); pa[4 + w] = pk4_fp8(p1[4 * w], p1[4 * w + 1], p1[4 * w + 2], p1[4 * w + 3]); }
}

template <bool FIRST> __device__ __forceinline__ void partialSM8n(f32x16& p0, f32x16& p1, float& M2, f32x16& negm, float& alpha) {
  constexpr float THR2 = THR8 * 1.4426950408889634f;
  float emax = p0[0]; for (int r = 1; r < 16; ++r) emax = fmaxf(emax, p0[r]); for (int r = 0; r < 16; ++r) emax = fmaxf(emax, p1[r]);
  { auto rr = __builtin_amdgcn_permlane32_swap(__float_as_uint(emax), __float_as_uint(emax), false, false);
    emax = fmaxf(__uint_as_float(rr[0]), __uint_as_float(rr[1])); }
  if (!FIRST && __builtin_expect(__all(emax - 6.0f <= THR2), 1)) { alpha = 1.f; }
  else { const float delta = FIRST ? (emax - 6.0f) : fmaxf(emax - 6.0f, 0.f); alpha = FIRST ? 0.f : __builtin_amdgcn_exp2f(-delta); M2 += delta;
    for (int r = 0; r < 16; ++r) { p0[r] -= delta; p1[r] -= delta; }
    const float nm = 6.0f - M2; for (int r = 0; r < 16; ++r) negm[r] = nm; asm volatile("" : "+v"(negm)); }
  for (int r = 0; r < 16; ++r) p0[r] = __builtin_amdgcn_exp2f(p0[r]);
}
#define MFMA8(A, B, Cc) __builtin_amdgcn_mfma_scale_f32_32x32x64_f8f6f4((A), (B), (Cc), 0, 0, 0, 0x7f7f7f7f, 0, 0x7f7f7f7f)
__device__ __forceinline__ i32x8 cat8(const u32x4 lo, const u32x4 hi4) { i32x8 r; r[0] = (int)lo.x; r[1] = (int)lo.y; r[2] = (int)lo.z; r[3] = (int)lo.w; r[4] = (int)hi4.x; r[5] = (int)hi4.y; r[6] = (int)hi4.z; r[7] = (int)hi4.w; return r; }
__device__ __forceinline__ void qkt8(f32x16& p0, f32x16& p1, const char* Ks, const i32x8* qf, int r32, int hi, const f32x16& negm) {
  const int x = r32 & 7; const char* k0 = Ks + r32 * 128; const char* k1 = k0 + 32 * 128;
  p0 = negm; p1 = negm;
#pragma unroll
  for (int s2 = 0; s2 < 2; ++s2) { const int c0 = 4 * s2 + 2 * hi, oa = 16 * (c0 ^ x), ob = 16 * ((c0 + 1) ^ x);
    const i32x8 a0 = cat8(*reinterpret_cast<const u32x4*>(k0 + oa), *reinterpret_cast<const u32x4*>(k0 + ob));
    const i32x8 a1 = cat8(*reinterpret_cast<const u32x4*>(k1 + oa), *reinterpret_cast<const u32x4*>(k1 + ob));
    p0 = MFMA8(a0, qf[s2], p0); p1 = MFMA8(a1, qf[s2], p1); }
}
__device__ __forceinline__ void pv8(f32x16* o, const char* Vs, const i32x8 pa, int r32, int hi) {
  const int sw = (r32 >> 2) & 3; const char* vb = Vs + r32 * 64; const int oa = 16 * ((2 * hi) ^ sw), ob = 16 * ((2 * hi + 1) ^ sw);
#pragma unroll
  for (int d0 = 0; d0 < 4; ++d0) { const i32x8 b = cat8(*reinterpret_cast<const u32x4*>(vb + d0 * 2048 + oa), *reinterpret_cast<const u32x4*>(vb + d0 * 2048 + ob));
    o[d0] = MFMA8(pa, b, o[d0]); }
}
__device__ __forceinline__ void attn_pp8_body(const bf16* Qb, const unsigned char* __restrict__ K8, const unsigned char* __restrict__ V8,
                                              bf16_t* Ob, const bf16_t* Gb, int seq, char* lds, const int tid) {
  const int wid = __builtin_amdgcn_readfirstlane(tid >> 6), lane = tid & 63, r32 = lane & 31, hi = lane >> 5;
  const int g = wid >> 2;
  constexpr int NB = 3, SL = 8192;
  char* V_lds = lds; char* K_lds = lds + NB * SL;
  float* ws = (float*)(lds + 65536) + wid * 64; float* li_l = ws; float* al_l = ws + 32;
  float M2 = 0.f, l_reg = 0; f32x16 o[4] = {}; i32x8 qf[2]; f32x16 negm; for (int r = 0; r < 16; ++r) negm[r] = 6.0f; asm volatile("" : "+v"(negm));
  constexpr float QC = SCALE * 1.4426950408889634f;
  { const bf16* Qw = Qb + (long)(wid * QBLK + r32) * LDQ + hi * 32;
#pragma unroll
    for (int s2 = 0; s2 < 2; ++s2) {
#pragma unroll
      for (int q4 = 0; q4 < 4; ++q4) { float f[8]; unpack8(*reinterpret_cast<const u32x4*>(Qw + s2 * 64 + q4 * 8), f);
        qf[s2][2 * q4] = pk4_fp8(f[0] * QC, f[1] * QC, f[2] * QC, f[3] * QC); qf[s2][2 * q4 + 1] = pk4_fp8(f[4] * QC, f[5] * QC, f[6] * QC, f[7] * QC); } } }
  struct Stg8 { u32x4 k, v; } st0, st1;
#define SLOAD(S, t) do { const size_t o_ = (size_t)(t) * SL + (size_t)tid * 16; S.k = *reinterpret_cast<const u32x4*>(K8 + o_); S.v = *reinterpret_cast<const u32x4*>(V8 + o_); } while (0)
#define SWRITE(S, b) do { *(u32x4*)(K_lds + (b) * SL + tid * 16) = S.k; *(u32x4*)(V_lds + (b) * SL + tid * 16) = S.v; } while (0)
#define RESC(a) do { if (__any((a) < 1.f)) { if (hi == 0) al_l[r32] = (a); asm volatile("s_waitcnt lgkmcnt(0)" ::: "memory"); \
    for (int d = 0; d < 4; ++d) for (int r = 0; r < 16; ++r) o[d][r] *= al_l[crow(r, hi)]; } } while (0)
  const int NT = seq / KVBLK;
  f32x16 p0, p1; i32x8 pa;
#define SMX() do { float al_; partialSM8n<true>(p0, p1, M2, negm, al_); RESC(al_); finishSM8(p0, p1, al_, l_reg, pa); } while (0)
  SLOAD(st0, 0); if (g) SLOAD(st1, 1);
  SWRITE(st0, 0); if (g) SWRITE(st1, 1);
  SLOAD(st0, 1 + g);
  __syncthreads();
  if (g) __syncthreads();
  SBAR(); qkt8(p0, p1, K_lds, qf, r32, hi, negm); SBAR();
  __syncthreads();
  SWRITE(st0, 1 + g); SLOAD(st0, 2 + g);
  SMX();
  __syncthreads();
  int c = 0;
#define STEP(i, ST) do { const int cK_ = (c == 2) ? 0 : c + 1; \
    SBAR(); \
    float al2_; \
    qkt8(p0, p1, K_lds + cK_ * SL, qf, r32, hi, negm); \
    partialSM8n<false>(p0, p1, M2, negm, al2_);            \
    pv8(o, V_lds + c * SL, pa, r32, hi); \
    SBAR(); \
    __syncthreads(); \
    { const int t_ = (i) + 2 + g; if (t_ < NT) { const int cb_ = (cK_ == 2) ? 0 : cK_ + 1; const int cw_ = g ? ((cb_ == 2) ? 0 : cb_ + 1) : cb_; \
        SWRITE(st0, cw_); if (t_ + 1 < NT) SLOAD(st0, t_ + 1); } } \
    RESC(al2_); finishSM8(p0, p1, al2_, l_reg, pa); \
    __syncthreads(); \
    c = cK_; } while (0)
  int i = 0;
#pragma nounroll
  for (; i + 1 < NT - 1; i += 2) { STEP(i, st1); STEP(i + 1, st0); }
  if (i < NT - 1) { STEP(i, st1); }
  SBAR(); pv8(o, V_lds + c * SL, pa, r32, hi); SBAR();
  __syncthreads();
  if (!g) __syncthreads();
  if (hi == 0) li_l[r32] = l_reg; asm volatile("s_waitcnt lgkmcnt(0)" ::: "memory");
  float rli[16];
#pragma unroll
  for (int r = 0; r < 16; ++r) rli[r] = __builtin_amdgcn_rcpf(li_l[crow(r, hi)]);
  { int tid_e = tid; asm volatile("" : "+v"(tid_e)); const int lane_e = tid_e & 63; const int wid_e = __builtin_amdgcn_readfirstlane(tid_e >> 6);
    bf16_t* stg = (bf16_t*)lds + wid_e * 4096;
#pragma unroll
    for (int r = 0; r < 16; ++r) { const int orow = crow(r, hi);
#pragma unroll
      for (int d0 = 0; d0 < 4; ++d0) stg[orow * 128 + d0 * 32 + r32] = (bf16_t)f2bf(o[d0][r] * rli[r]); }
    asm volatile("s_waitcnt lgkmcnt(0)" ::: "memory");
    bf16_t* Ow = Ob + (long)(wid_e * QBLK) * LDO; const bf16_t* Gw = Gb + (long)(wid_e * QBLK) * LDO;
    u32x4 gq[8];
#pragma unroll
    for (int i2 = 0; i2 < 8; ++i2) { const int row = i2 * 4 + (lane_e >> 4), ch = lane_e & 15; gq[i2] = Gb ? *(const u32x4*)(Gw + (long)row * LDO + ch * 8) : (u32x4){0x3f803f80u, 0x3f803f80u, 0x3f803f80u, 0x3f803f80u}; }
#pragma unroll
    for (int i2 = 0; i2 < 8; ++i2) { const int row = i2 * 4 + (lane_e >> 4), ch = lane_e & 15;
      float ov[8], gv[8]; unpack8(*(const u32x4*)(stg + row * 128 + ch * 8), ov); unpack8(gq[i2], gv);
#pragma unroll
      for (int j = 0; j < 8; ++j) ov[j] *= gv[j];
      *(u32x4*)(Ow + (long)row * LDO + ch * 8) = pack8(ov); } }
  __syncthreads();
#undef SLOAD
#undef SWRITE
#undef RESC
#undef SMX
#undef STEP
#undef MFMA8
}
#undef KSWZ
#undef SBAR
}


#define XB_TMO      128
#define XB_XCNT(j)  (256  + 64 * (j))
#define XB_XSUB(j)  (1280 + 64 * (j))
#define XB_XGEN(j)  (2304 + 64 * (j))
#define XB_TOP      3328
#define XB_TOPGEN   3392
#define XCD_BAR_WORDS 3456
#define XB_SPIN_CAP (1u << 22)
__device__ __forceinline__ unsigned xb_ld(unsigned* p)              { return __hip_atomic_load(p, __ATOMIC_RELAXED, __HIP_MEMORY_SCOPE_AGENT); }
__device__ __forceinline__ unsigned xb_add(unsigned* p, unsigned v) { return __hip_atomic_fetch_add(p, v, __ATOMIC_RELAXED, __HIP_MEMORY_SCOPE_AGENT); }
__device__ __forceinline__ unsigned xb_xcc_id() { return (unsigned)__builtin_amdgcn_s_getreg((3 << 11) | 20) & 0xFu; }
#define XB_SPIN(cond, bar) do { unsigned _sp = 0; while (cond) { __builtin_amdgcn_s_sleep(1); \
    if ((++_sp & 255u) == 0u) { if (xb_ld(&(bar)[XB_TMO])) break; if (_sp > XB_SPIN_CAP) { atomicAdd(&(bar)[XB_TMO], 1u); break; } } } } while (0)
struct XcdBarrier { unsigned* bar; unsigned x; volatile LAS unsigned* st; };
__device__ __forceinline__ XcdBarrier xcd_barrier_post(unsigned* bar, volatile LAS unsigned* st) {
    XcdBarrier b; b.bar = bar; b.x = xb_xcc_id(); b.st = st;
    if (threadIdx.x == 0) (void)xb_add(&bar[XB_XCNT(b.x)], 1u);
    return b;
}
__device__ __forceinline__ void xcd_barrier_complete(unsigned* bar, unsigned x, unsigned& nloc, unsigned& nx) {
    const unsigned G = gridDim.x * gridDim.y * gridDim.z;
    unsigned sum, cnt, mine, sp = 0u;
    for (;;) {
        sum = 0u; cnt = 0u; mine = 0u;
#pragma unroll
        for (unsigned j = 0; j < 16; ++j) { const unsigned c = xb_ld(&bar[XB_XCNT(j)]); sum += c; cnt += (c > 0u) ? 1u : 0u; mine = (j == x) ? c : mine; }
        if (sum == G) break;
        __builtin_amdgcn_s_sleep(1);
        if ((++sp & 255u) == 0u) { if (xb_ld(&bar[XB_TMO])) break; if (sp > XB_SPIN_CAP) { atomicAdd(&bar[XB_TMO], 1u); break; } }
    }
    nloc = mine > 0u ? mine : 1u; nx = cnt > 0u ? cnt : 1u;
}
__device__ __forceinline__ void xcd_barrier(const XcdBarrier& b, const int tid) {
    asm volatile("s_waitcnt vmcnt(0)" ::: "memory");
    __syncthreads();
    if (tid == 0) {
        unsigned* bar = b.bar;
        __builtin_amdgcn_s_waitcnt(0);
        unsigned nloc = b.st[0], nx = b.st[1];
        if (nloc == 0u) { xcd_barrier_complete(bar, b.x, nloc, nx); b.st[0] = nloc; b.st[1] = nx; }
        const unsigned old = xb_add(&bar[XB_XSUB(b.x)], 1u);
        const unsigned gen = old / nloc;
        if (old + 1u == (gen + 1u) * nloc) {
            __builtin_amdgcn_fence(__ATOMIC_RELEASE, "agent");
            asm volatile("s_waitcnt vmcnt(0)" ::: "memory");
            const unsigned og = xb_add(&bar[XB_TOP], 1u);
            const unsigned tg = og / nx;
            if (og + 1u == (tg + 1u) * nx) xb_add(&bar[XB_TOPGEN], 1u);
            else XB_SPIN(xb_ld(&bar[XB_TOPGEN]) == tg, bar);
            __builtin_amdgcn_fence(__ATOMIC_ACQUIRE, "agent");
            xb_add(&bar[XB_XGEN(b.x)], 1u);
            asm volatile("s_waitcnt vmcnt(0)" ::: "memory");
        } else {
            XB_SPIN(xb_ld(&bar[XB_XGEN(b.x)]) == gen, bar);
            __builtin_amdgcn_fence(__ATOMIC_ACQUIRE, "agent");
            asm volatile("s_waitcnt vmcnt(0)" ::: "memory");
        }
    }
    __syncthreads();
}

#ifndef PHM
#define PHM 1023
#endif
#ifndef PROBE_K
#define PROBE_K -1
#endif
struct Args { const float* in[18]; float* out; unsigned char* ws; int ph_lo, ph_hi; };
typedef const __attribute__((address_space(4))) Args* KArgs;
#define INP(a, i) ((const float*)(const GAS float*)((a)->in[i]))
#define OUTP(a) ((float*)(GAS float*)((a)->out))
enum { I_X = 0, I_C, I_WADA, I_BADA, I_NORMG, I_WIN, I_CAW, I_CAB, I_WRG, I_BRG, I_WIG, I_BIG, I_LAM, I_QG, I_KG, I_CCW, I_WBR, I_WOUT };

__device__ __forceinline__ void transpose_item(const float* W, int ldw, bf16_t* dst, int ldd, LAS float* scr, int lane) {
#pragma unroll 8
    for (int i = 0; i < 32; ++i) { const int kk = 2 * i + (lane >> 5); scr[kk * 33 + (lane & 31)] = W[(size_t)kk * ldw + (lane & 31)]; }
    LDS_WAIT();
    const int c = lane & 7;
#pragma unroll
    for (int j = 0; j < 4; ++j) { const int n = (lane >> 3) + 8 * j; const LAS float* s = scr + (8 * c) * 33 + n;
        u32x4 o; o.x = cvt_pk_bf16(s[0 * 33], s[1 * 33]); o.y = cvt_pk_bf16(s[2 * 33], s[3 * 33]); o.z = cvt_pk_bf16(s[4 * 33], s[5 * 33]); o.w = cvt_pk_bf16(s[6 * 33], s[7 * 33]);
        *(u32x4*)(dst + (size_t)n * ldd + 8 * c) = o; }
    LDS_WAIT();
}

__device__ __forceinline__ void phase_prologue(KArgs a, unsigned char* wsb, LAS unsigned char* lds, int tid, int lane, int wave, int bid, int G) {
    unsigned char* ws = wsb;
    {
        LAS float* red = (LAS float*)lds;
        for (int it = bid; it < 96; it += G) {
            const int l = it / 48, jb = it % 48, j = jb * 64 + lane;
            const float* wa = INP(a, I_WADA) + (size_t)l * 1024 * 3072 + j; const float* c0 = INP(a, I_C); const float* c1 = c0 + 1024;
            float a0 = 0.f, a1 = 0.f; const int kb = wave * 128;
#pragma unroll 16
            for (int k = 0; k < 128; ++k) { const float w = wa[(size_t)(kb + k) * 3072]; a0 += c0[kb + k] * w; a1 += c1[kb + k] * w; }
            red[(wave * 2 + 0) * 64 + lane] = a0; red[(wave * 2 + 1) * 64 + lane] = a1;
            __syncthreads();
            if (tid < 128) { const int bb = tid >> 6; float s = 0.f;
#pragma unroll
                for (int w = 0; w < 8; ++w) s += red[(w * 2 + bb) * 64 + lane];
                ((float*)(ws + WS_MOD))[(l * 2 + bb) * 3072 + j] = s + INP(a, I_BADA)[l * 3072 + j]; }
            __syncthreads();
        }
    }
    {
        float* rc = (float*)(ws + WS_ROPE); float* rs = rc + 320 * 32;
        for (int e = bid * 512 + tid; e < 320 * 32; e += G * 512) {
            const int pos = e >> 5, i = e & 31; const int p = pos < 256 ? pos : pos - 256;
            const float inv = __builtin_amdgcn_exp2f(-((float)(2 * i)) * (13.287712379549449f / 64.0f));
            const float ang = (float)p * inv;
            rc[e] = __cosf(ang); rs[e] = __sinf(ang);
        }
    }
    {
        LAS float* scr = (LAS float*)(lds + 8192 + wave * 12288);
        const int gw = bid * 8 + wave, NGW = G * 8;
        constexpr int I_IN = 2 * 16 * 368, I_G = 1024, I_BR = 3072, I_OUT = 1024, NITEMS = I_IN + I_G + I_BR + I_OUT;
        for (int it = gw; it < NITEMS; it += NGW) {
            int r = it;
            if (r < I_IN) { const int l = r / 5888, q = r % 5888, kb = q / 368, nb = q % 368;
                const int n0 = 32 * nb; int drow = n0;
                if (n0 >= 4608 && n0 < 8704) { const int sec = (n0 - 4608) >> 10, ch = (n0 - 4608) & 1023, blk = ch >> 7;
                    drow = ((sec & 1) ? 26 + blk : 18 + blk) * 256 + ((sec >> 1) ? 128 : 0) + (ch & 127); }
                transpose_item(INP(a, I_WIN) + (size_t)l * 1024 * NIN + (size_t)(64 * kb) * NIN + n0, NIN,
                               (bf16_t*)(ws + WS_WIN) + (size_t)l * NIN * 1024 + (size_t)drow * 1024 + 64 * kb, 1024, scr, lane); continue; }
            r -= I_IN;
            if (r < I_G) { const int mi = r >> 5, sub = r & 31, kb = sub >> 3, nblk = sub & 7;
                const int nb = mi & 3, gate = (mi >> 2) & 1, dir = (mi >> 3) & 1, l = mi >> 4;
                const float* src = (gate ? INP(a, I_WIG) : INP(a, I_WRG)) + (size_t)((l * 2 + dir) * 4 + nb) * 65536 + (size_t)(64 * kb) * 256 + 32 * nblk;
                const int n0 = 32 * nblk, hh = n0 >> 7, pn = (dir * 4 + nb) * 2 + hh, row = pn * 256 + gate * 128 + (n0 & 127);
                transpose_item(src, 256, (bf16_t*)(ws + WS_WG) + (size_t)l * 4096 * 256 + (size_t)row * 256 + 64 * kb, 256, scr, lane); continue; }
            r -= I_G;
            if (r < I_BR) { const int mi = r >> 9, sub = r & 511, kb = sub >> 5, nblk = sub & 31;
                transpose_item(INP(a, I_WBR) + (size_t)mi * 1048576 + (size_t)(64 * kb) * 1024 + 32 * nblk, 1024,
                               (bf16_t*)(ws + WS_WBR) + (size_t)mi * 1048576 + (size_t)(32 * nblk) * 1024 + 64 * kb, 1024, scr, lane); continue; }
            r -= I_BR;
            { const int mi = r >> 9, sub = r & 511, kb = sub >> 5, nblk = sub & 31;
                transpose_item(INP(a, I_WOUT) + (size_t)mi * 1048576 + (size_t)(64 * kb) * 1024 + 32 * nblk, 1024,
                               (bf16_t*)(ws + WS_WOUT) + (size_t)mi * 1048576 + (size_t)(32 * nblk) * 1024 + 64 * kb, 1024, scr, lane); }
        }
    }
}

__device__ __forceinline__ void phase_h(KArgs a, unsigned char* wsb, int l, int b, int lane, int wave, int bid, int G) {
    const float* xin = (l == 0 ? INP(a, I_X) : OUTP(a)) + (size_t)b * SEQ * DM;
    const float* mod = (const float*)(wsb + WS_MOD) + (l * 2 + b) * 3072;
    bf16_t* H = (bf16_t*)(wsb + WS_H);
    f32x4 gs[4], sh[4];
#pragma unroll
    for (int j = 0; j < 4; ++j) { const int col = 4 * lane + 256 * j;
        const f32x4 g = *(const f32x4*)(INP(a, I_NORMG) + l * 1024 + col), sc = *(const f32x4*)(mod + 1024 + col);
        gs[j] = g * (sc + 1.0f); sh[j] = *(const f32x4*)(mod + col); }
    const int gw = bid * 8 + wave, NGW = G * 8;
    for (int m = gw; m < SEQ; m += 2 * NGW) {
        const int m2 = (m + NGW < SEQ) ? m + NGW : m;
        const f32x4* xr = (const f32x4*)(xin + (size_t)m * DM) + lane; const f32x4* xr2 = (const f32x4*)(xin + (size_t)m2 * DM) + lane;
        f32x4 v[4], w[4]; float s = 0.f, s2 = 0.f;
#pragma unroll
        for (int j = 0; j < 4; ++j) { v[j] = xr[64 * j]; w[j] = xr2[64 * j]; }
#pragma unroll
        for (int j = 0; j < 4; ++j) { s += (v[j].x * v[j].x + v[j].y * v[j].y) + (v[j].z * v[j].z + v[j].w * v[j].w); s2 += (w[j].x * w[j].x + w[j].y * w[j].y) + (w[j].z * w[j].z + w[j].w * w[j].w); }
        const float rstd = __builtin_amdgcn_rsqf(wave_sum(s) * (1.f / DM) + EPS), rstd2 = __builtin_amdgcn_rsqf(wave_sum(s2) * (1.f / DM) + EPS);
        u32x2* o8 = (u32x2*)(H + (size_t)m * DM) + lane; u32x2* o82 = (u32x2*)(H + (size_t)m2 * DM) + lane;
#pragma unroll
        for (int j = 0; j < 4; ++j) { const f32x4 o = v[j] * rstd * gs[j] + sh[j]; u32x2 q; q.x = cvt_pk_bf16(o.x, o.y); q.y = cvt_pk_bf16(o.z, o.w); o8[64 * j] = q;
            const f32x4 o2 = w[j] * rstd2 * gs[j] + sh[j]; u32x2 q2; q2.x = cvt_pk_bf16(o2.x, o2.y); q2.y = cvt_pk_bf16(o2.z, o2.w); o82[64 * j] = q2; }
    }
}

__device__ __forceinline__ void ldrow8(const bf16_t* __restrict__ base, int t, int ch, float (&v)[8]) {
    if (t < 0 || t >= SEQ) {
#pragma unroll
        for (int j = 0; j < 8; ++j) v[j] = 0.f;
    } else unpack8(*(const u32x4*)(base + (size_t)t * 1024 + ch), v);
}
__device__ __forceinline__ void ld8f32(const float* p, float (&v)[8]) {
    const f32x4 a = *(const f32x4*)p, b = *(const f32x4*)(p + 4);
    v[0] = a.x; v[1] = a.y; v[2] = a.z; v[3] = a.w; v[4] = b.x; v[5] = b.y; v[6] = b.z; v[7] = b.w;
}

__device__ __forceinline__ void phase_elem(KArgs a, unsigned char* wsb, int l, int lane, int wave, int bid, int G) {
    unsigned char* ws = wsb;
    const int gw = bid * 8 + wave, NGW = G * 8;
    for (int it = gw; it < 2048; it += NGW) {
        const int run = it >> 1, hf = it & 1, ch = hf * 512 + lane * 8, t0 = run * 16;
        {
            const bf16_t* __restrict__ XA = (const bf16_t*)(ws + WS_XA); bf16_t* __restrict__ UA = (bf16_t*)(ws + WS_H);
            float w0[8], w1[8], w2[8], w3[8], bb[8];
            const float* cw = INP(a, I_CAW) + (size_t)l * 4 * 1024 + ch;
            ld8f32(cw, w0); ld8f32(cw + 1024, w1); ld8f32(cw + 2048, w2); ld8f32(cw + 3072, w3); ld8f32(INP(a, I_CAB) + l * 1024 + ch, bb);
            float xm2[8], xm1[8], x0[8], xp1[8];
            ldrow8(XA, t0 - 2, ch, xm2); ldrow8(XA, t0 - 1, ch, xm1); ldrow8(XA, t0, ch, x0);
#pragma unroll
            for (int s = 0; s < 16; ++s) { const int t = t0 + s;
                ldrow8(XA, t + 1, ch, xp1);
                float o[8];
#pragma unroll
                for (int j = 0; j < 8; ++j) o[j] = w0[j] * xm2[j] + w1[j] * xm1[j] + w2[j] * x0[j] + w3[j] * xp1[j] + bb[j];
                *(u32x4*)(UA + (size_t)t * 1024 + ch) = pack8(o);
#pragma unroll
                for (int j = 0; j < 8; ++j) { xm2[j] = xm1[j]; xm1[j] = x0[j]; x0[j] = xp1[j]; } }
        }
        {
            const bf16_t* __restrict__ PP = (const bf16_t*)(ws + WS_XC); const bf16_t* __restrict__ BG = (const bf16_t*)(ws + WS_BC); bf16_t* __restrict__ YC = (bf16_t*)(ws + WS_YC);
            float w0[8], w1[8], w2[8];
            const float* cw = INP(a, I_CCW) + (size_t)l * 3 * 1024 + ch;
            ld8f32(cw, w0); ld8f32(cw + 1024, w1); ld8f32(cw + 2048, w2);
            float pm1[8], p0[8], pp1[8], t1[8];
            ldrow8(PP, t0 - 1, ch, pm1); ldrow8(PP, t0, ch, p0);
#pragma unroll
            for (int s = 0; s < 16; ++s) { const int t = t0 + s;
                ldrow8(PP, t + 1, ch, pp1); ldrow8(BG, t, ch, t1);
                float o[8];
#pragma unroll
                for (int j = 0; j < 8; ++j) o[j] = t1[j] * (w0[j] * pm1[j] + w1[j] * p0[j] + w2[j] * pp1[j]);
                *(u32x4*)(YC + (size_t)t * 1024 + ch) = pack8(o);
#pragma unroll
                for (int j = 0; j < 8; ++j) { pm1[j] = p0[j]; p0[j] = pp1[j]; } }
        }
        {
            bf16_t* Q = (bf16_t*)(ws + WS_Q); bf16_t* Kb = (bf16_t*)(ws + WS_K);
            const float* rc = (const float*)(ws + WS_ROPE); const float* rs = rc + 320 * 32;
            const int d0 = (lane & 15) * 8, i0 = (lane & 3) * 8;
            float qg[8], kg[8];
            ld8f32(INP(a, I_QG) + l * 128 + d0, qg); ld8f32(INP(a, I_KG) + l * 128 + d0, kg);
            const bool second = (lane & 4) != 0;
            const int tokb = run * 16 + hf * 8;
            const int tsel = (d0 < 64) ? 0 : 1;
            u32x4 cur[3]; float cs[8], sn[8];
#define LD_TOK(tok, dst, dcs, dsn) do { const int tp_ = tsel ? 256 + ((tok) & 63) : ((tok) >> 6); ld8f32(rc + tp_ * 32 + i0, dcs); ld8f32(rs + tp_ * 32 + i0, dsn); \
                dst[0] = *(const u32x4*)(Q + (size_t)(tok) * 1024 + lane * 8); dst[1] = *(const u32x4*)(Q + (size_t)(tok) * 1024 + 512 + lane * 8); dst[2] = *(const u32x4*)(Kb + (size_t)(tok) * 256 + (lane & 31) * 8); } while (0)
            LD_TOK(tokb, cur, cs, sn);
#pragma unroll
            for (int i = 0; i < 8; ++i) {
                const int tok = tokb + i;
                u32x4 nx[3]; float ncs[8], nsn[8];
                if (i < 7) LD_TOK(tok + 1, nx, ncs, nsn);
#pragma unroll
                for (int part = 0; part < 3; ++part) {
                    bf16_t* p = (part < 2) ? (Q + (size_t)tok * 1024 + part * 512 + lane * 8) : (Kb + (size_t)tok * 256 + (lane & 31) * 8);
                    float v[8]; unpack8(cur[part], v);
                    float ss = 0.f;
#pragma unroll
                    for (int j = 0; j < 8; ++j) ss += v[j] * v[j];
                    ss += __shfl_xor(ss, 1); ss += __shfl_xor(ss, 2); ss += __shfl_xor(ss, 4); ss += __shfl_xor(ss, 8);
                    const float rstd = __builtin_amdgcn_rsqf(ss * (1.f / 128.f) + EPS);
                    float o[8];
#pragma unroll
                    for (int j = 0; j < 8; ++j) { const float y = v[j] * rstd * (part < 2 ? qg[j] : kg[j]); const float pr = __shfl_xor(y, 4);
                        o[j] = y * cs[j] + (second ? pr : -pr) * sn[j]; }
                    if (part < 2 || lane < 32) *(u32x4*)p = pack8(o);
                    if (part == 2 && lane < 32) {
                        const int kvh = lane >> 4, r = tok & 63, dch = (lane & 15) >> 1;
                        unsigned char* kp = ws + WS_K8 + (size_t)kvh * 2097152 + (size_t)(tok >> 6) * 8192 + r * 128 + 16 * (dch ^ (r & 7)) + (lane & 1) * 8;
                        u32x2 w8; w8.x = (unsigned)pk4_fp8(o[0], o[1], o[2], o[3]); w8.y = (unsigned)pk4_fp8(o[4], o[5], o[6], o[7]); *(u32x2*)kp = w8; }
                }
                if (i < 7) {
#pragma unroll
                    for (int part = 0; part < 3; ++part) cur[part] = nx[part];
#pragma unroll
                    for (int j = 0; j < 8; ++j) { cs[j] = ncs[j]; sn[j] = nsn[j]; } }
            }
#undef LD_TOK
        }
    }
    for (int it = gw; it < 4096; it += NGW) {
        const int jh = it & 1, h = (it >> 1) & 1, dh = (it >> 2) & 1, tile = (it >> 3) & 255, kvh = it >> 11;
        const int d = dh * 64 + lane;
        const bf16_t* __restrict__ V = (const bf16_t*)(ws + WS_V) + (size_t)tile * 64 * 256 + kvh * 128 + d;
        float f[16];
#pragma unroll
        for (int jj = 0; jj < 16; ++jj) { const int key = (jj & 3) + 8 * (jj >> 2) + 4 * h + 32 * jh; f[jj] = bf2f(V[(size_t)key * 256]); }
        u32x4 w; w.x = (unsigned)pk4_fp8(f[0], f[1], f[2], f[3]); w.y = (unsigned)pk4_fp8(f[4], f[5], f[6], f[7]); w.z = (unsigned)pk4_fp8(f[8], f[9], f[10], f[11]); w.w = (unsigned)pk4_fp8(f[12], f[13], f[14], f[15]);
        *(u32x4*)(ws + WS_V8 + (size_t)kvh * 2097152 + (size_t)tile * 8192 + d * 64 + 16 * ((2 * h + jh) ^ ((d >> 2) & 3))) = w;
    }
}

__device__ __forceinline__ void phase_scan_a(KArgs a, unsigned char* wsb, int lane, int wave, int bid, int G) {
    unsigned char* ws = wsb;
    const int gw = bid * 8 + wave, NGW = G * 8;
    for (int it = gw; it < 2048; it += NGW) {
        const int c = it >> 4, dir = (it >> 3) & 1, ch = (it & 7) * 128 + lane * 2;
        const bf16_t* LA = (const bf16_t*)(ws + WS_LA + (size_t)dir * 64 * MiB) + ch;
        const bf16_t* UU = (const bf16_t*)(ws + WS_U + (size_t)dir * 64 * MiB) + ch;
        float s0 = 0.f, s1 = 0.f, h0 = 0.f, h1 = 0.f;
#pragma unroll 16
        for (int st = 0; st < 128; ++st) { const int t = dir == 0 ? c * 128 + st : c * 128 + 127 - st;
            const unsigned wl = *(const unsigned*)(LA + (size_t)t * 1024), wu = *(const unsigned*)(UU + (size_t)t * 1024);
            const float l0 = __uint_as_float(wl << 16), l1 = __uint_as_float(wl & 0xffff0000u);
            const float u0 = __uint_as_float(wu << 16), u1 = __uint_as_float(wu & 0xffff0000u);
            h0 = __builtin_amdgcn_exp2f(l0) * h0 + u0; h1 = __builtin_amdgcn_exp2f(l1) * h1 + u1; s0 += l0; s1 += l1; }
        *(f32x2*)((float*)(ws + WS_SA) + (c * 2 + dir) * 1024 + ch) = (f32x2){s0, s1};
        *(f32x2*)((float*)(ws + WS_SH) + (c * 2 + dir) * 1024 + ch) = (f32x2){h0, h1};
    }
}
__device__ __forceinline__ void phase_scan_c(unsigned char* wsb, LAS unsigned char* lds, int lane, int wave, int bid, int G) {
    unsigned char* ws = wsb;
    const int gw = bid * 8 + wave, NGW = G * 8;
    const float* __restrict__ SA = (const float*)(ws + WS_SA); const float* __restrict__ SH = (const float*)(ws + WS_SH);
    for (int it = gw; it < 2048; it += NGW) {
        const int c = it >> 4, ch = (it & 15) * 64 + lane;
        float cf = 0.f, cb = 0.f;
#pragma unroll 8
        for (int sidx = 0; sidx < c; ++sidx) { const int idx = (sidx * 2) * 1024 + ch; cf = __builtin_amdgcn_exp2f(SA[idx]) * cf + SH[idx]; }
#pragma unroll 8
        for (int sidx = 127; sidx > c; --sidx) { const int idx = (sidx * 2 + 1) * 1024 + ch; cb = __builtin_amdgcn_exp2f(SA[idx]) * cb + SH[idx]; }
        const bf16_t* __restrict__ LAf = (const bf16_t*)(ws + WS_LA) + ch; const bf16_t* __restrict__ UUf = (const bf16_t*)(ws + WS_U) + ch;
        const bf16_t* __restrict__ LAb = (const bf16_t*)(ws + WS_LA + 64 * MiB) + ch; const bf16_t* __restrict__ UUb = (const bf16_t*)(ws + WS_U + 64 * MiB) + ch;
        const bf16_t* __restrict__ SGA = (const bf16_t*)(ws + WS_SGA) + ch; bf16_t* __restrict__ YA = (bf16_t*)(ws + WS_XA) + ch;
        LAS bf16_t* hfs = (LAS bf16_t*)(lds + wave * 16384) + lane;
        float h = cf;
        { const bf16_t* pl = LAf + (size_t)c * 128 * 1024; const bf16_t* pu = UUf + (size_t)c * 128 * 1024;
#pragma unroll 1
            for (int blk = 0; blk < 8; ++blk) {
                float l[16], u[16];
#pragma unroll
                for (int i = 0; i < 16; ++i) { l[i] = bf2f(pl[i * 1024]); u[i] = bf2f(pu[i * 1024]); }
#pragma unroll
                for (int i = 0; i < 16; ++i) { h = __builtin_amdgcn_exp2f(l[i]) * h + u[i]; hfs[(blk * 16 + i) * 64] = (bf16_t)f2bf(h); }
                pl += 16 * 1024; pu += 16 * 1024; } }
        h = cb;
        { const size_t e0 = (size_t)(c * 128 + 112) * 1024;
            const bf16_t* pl = LAb + e0; const bf16_t* pu = UUb + e0; const bf16_t* pg = SGA + e0; bf16_t* py = YA + e0;
#pragma unroll 1
            for (int blk = 7; blk >= 0; --blk) {
                float l[16], u[16], g[16];
#pragma unroll
                for (int i = 0; i < 16; ++i) { l[i] = bf2f(pl[i * 1024]); u[i] = bf2f(pu[i * 1024]); g[i] = bf2f(pg[i * 1024]); }
#pragma unroll
                for (int i = 15; i >= 0; --i) { h = __builtin_amdgcn_exp2f(l[i]) * h + u[i];
                    py[i * 1024] = (bf16_t)f2bf((bf2f(hfs[(blk * 16 + i) * 64]) + h) * g[i]); }
                pl -= 16 * 1024; pu -= 16 * 1024; pg -= 16 * 1024; py -= 16 * 1024; } }
    }
}

__global__ void __launch_bounds__(512, 2) mk_fwd(Args args) {
    extern __shared__ __attribute__((aligned(16))) unsigned char lds[];
    cg::grid_group grid = cg::this_grid();
    LAS unsigned char* L = (LAS unsigned char*)lds;
    if (threadIdx.x < 2) ((LAS unsigned*)(L + 131072))[threadIdx.x] = 0u;
    __syncthreads();
    (void)xcd_barrier_post((unsigned*)(args.ws + WS_BAR), (volatile LAS unsigned*)(L + 131072));
    const int wave_u = __builtin_amdgcn_readfirstlane(threadIdx.x >> 6);
    for (int ph = args.ph_lo; ph < args.ph_hi; ++ph) {
        int tid; { int ln_; asm volatile("v_mbcnt_lo_u32_b32 %0, -1, 0\n\tv_mbcnt_hi_u32_b32 %0, -1, %0" : "=v"(ln_)); tid = wave_u * 64 + ln_; }
        int G = gridDim.x, bid = blockIdx.x; asm volatile("" : "+s"(G), "+s"(bid));
        KArgs ap = (KArgs)__builtin_amdgcn_kernarg_segment_ptr(); asm volatile("" : "+s"(ap));
        GAS unsigned char* wsg = (GAS unsigned char*)ap->ws; asm volatile("" : "+s"(wsg));
        unsigned char* ws = (unsigned char*)wsg;
        const int lane = tid & 63, wave = __builtin_amdgcn_readfirstlane(tid >> 6);
        unsigned long long pt0 = 0; int pcls = -1; if (PROBE_K >= 0) pt0 = __builtin_amdgcn_s_memrealtime();
        if (ph == 0) { pcls = 8; if (PHM & 512) phase_prologue(ap, ws, L, tid, lane, wave, bid, G); }
        else {
            const int q = ph - 1, lb = q / NPH_PER, k = q - lb * NPH_PER, l = lb >> 1, b = lb & 1; pcls = k;
            if (k == 0) { if (PHM & 1) phase_h(ap, ws, l, b, lane, wave, bid, G); }
            else if (k == 1) { if (PHM & 2) {
                pg8::Gemm g{(const bf16_t*)(ws + WS_H), (const bf16_t*)(ws + WS_WIN) + (size_t)l * NIN * 1024, 1024, 1024, 1024, 0, 0};
                pg8::StaticOrder S; S.init(SEQ, NIN, G, bid);
                pg8::EpiInProj E{ws};
                pg8::gemm_phase<pg8::EpiInProj, pg8::StaticOrder, 0>(L, g, S, E, tid); }
            } else if (k == 2) { if (PHM & 4) phase_elem(ap, ws, l, lane, wave, bid, G); }
            else if (k == 3) {
                if (PHM & 8) {
                    pg8::Gemm g{(const bf16_t*)(ws + WS_H), (const bf16_t*)(ws + WS_WG) + (size_t)l * 4096 * 256, 1024, 256, 256, 0, 0};
                    pg8::StaticOrder S; S.init(SEQ, 4096, G, bid);
                    pg8::EpiGates E{ws, INP(ap, I_BRG) + l * 2048, INP(ap, I_BIG) + l * 2048, INP(ap, I_LAM) + l * 2048};
                    pg8::gemm_phase<pg8::EpiGates, pg8::StaticOrder, 1>(L, g, S, E, tid);
                }
                if (PROBE_K == 3) { const unsigned long long t1 = __builtin_amdgcn_s_memrealtime(), dt = t1 - pt0; while (__builtin_amdgcn_s_memrealtime() - t1 < dt) __builtin_amdgcn_s_sleep(8); }
                if (PROBE_K == 9) { pt0 = __builtin_amdgcn_s_memrealtime(); pcls = 9; }
                if (PHM & 256) {
                    const int v = (G % 8 == 0) ? (bid % 8) * (G / 8) + bid / 8 : bid;
                    const int per = (512 + G - 1) / G;
                    if (PROBE_F8 && l == 0 && b == 0) {
                        for (int i = 0; i < per; ++i) { const int idx = v * per + i; if (idx >= 4) break;
                            const int h = idx >> 6, qb = idx & 63, kvh = h >> 2;
                            const attn::bf16* Qb = (const attn::bf16*)(ws + WS_Q) + (size_t)qb * 256 * 1024 + h * 128;
                            const bf16_t* Gb = (const bf16_t*)(ws + WS_SGB) + (size_t)qb * 256 * 1024 + h * 128;
                            attn::attn_pp8_body(Qb, ws + WS_K8 + (size_t)kvh * 2097152, ws + WS_V8 + (size_t)kvh * 2097152, (bf16_t*)(ws + WS_SPARE) + (size_t)idx * 256 * 1024, nullptr, SEQ, (char*)lds, tid);
                        }
                    }
                    int tid2 = tid; asm volatile("" : "+v"(tid2));
                    for (int i = 0; i < per; ++i) { const int idx = v * per + i; if (idx >= 512) break;
                        const int h = idx >> 6, qb = idx & 63, kvh = h >> 2;
                        const attn::bf16* Qb = (const attn::bf16*)(ws + WS_Q) + (size_t)qb * 256 * 1024 + h * 128;
                        bf16_t* Ob = (bf16_t*)(ws + WS_SGB) + (size_t)qb * 256 * 1024 + h * 128;
                        const bf16_t* Gb = (const bf16_t*)(ws + WS_SGB) + (size_t)qb * 256 * 1024 + h * 128;
                        if (PROBE_F8) {
                            const attn::bf16* Kh = (const attn::bf16*)(ws + WS_K) + kvh * 128;
                            const attn::bf16* Vh = (const attn::bf16*)(ws + WS_V) + kvh * 128;
                            const bf16_t* cmp = (l == 0 && b == 0 && idx < 4) ? (const bf16_t*)(ws + WS_SPARE) + (size_t)idx * 256 * 1024 : nullptr;
                            attn::attn_pp_body(Qb, Kh, Vh, Ob, Gb, SEQ, (char*)lds, tid2, cmp, (unsigned*)(ws + WS_FLAG));
                        } else attn::attn_pp8_body(Qb, ws + WS_K8 + (size_t)kvh * 2097152, ws + WS_V8 + (size_t)kvh * 2097152, Ob, Gb, SEQ, (char*)lds, tid2);
                    }
                }
            } else if (k == 4) { if (PHM & 16) phase_scan_a(ap, ws, lane, wave, bid, G); }
            else if (k == 5) { if (PHM & 32) phase_scan_c(ws, L, lane, wave, bid, G); }
            else if (k == 6) { if (PHM & 64) {
                pg8::Gemm g{(const bf16_t*)(ws + WS_XA), (const bf16_t*)(ws + WS_WBR) + (size_t)l * 3 * 1048576, 1024, 1024, 1024,
                            (long)WS_SGB - (long)WS_XA, (long)WS_YC - (long)WS_XA};
                pg8::BranchOrder S; S.so.init(SEQ, 1024, G, bid);
                pg8::EpiBranch E{ws};
                pg8::gemm_phase<pg8::EpiBranch, pg8::BranchOrder, 2>(L, g, S, E, tid); }
            } else if (PHM & 128) {
                pg8::Gemm g{(const bf16_t*)(ws + WS_SGA), (const bf16_t*)(ws + WS_WOUT) + (size_t)l * 1048576, 1024, 1024, 1024, 0, 0};
                pg8::StaticOrder S; S.init(SEQ, 1024, G, bid);
                const float* xi = (l == 0 ? INP(ap, I_X) : OUTP(ap)) + (size_t)b * SEQ * DM;
                pg8::EpiOut E{xi, OUTP(ap) + (size_t)b * SEQ * DM, (const float*)(ws + WS_MOD) + (l * 2 + b) * 3072 + 2048, (const unsigned*)(ws + WS_FLAG)};
                pg8::gemm_phase<pg8::EpiOut, pg8::StaticOrder, 0>(L, g, S, E, tid);
            }
        }
        if (PROBE_K >= 0 && PROBE_K != 3 && ph + 1 == args.ph_hi && pcls == PROBE_K) { VM_WAIT(); __syncthreads(); const unsigned long long t1 = __builtin_amdgcn_s_memrealtime(), dt = t1 - pt0; while (__builtin_amdgcn_s_memrealtime() - t1 < dt) __builtin_amdgcn_s_sleep(8); }
        if (ph + 1 < args.ph_hi) { if (ph == args.ph_lo) grid.sync(); else { XcdBarrier xbar; xbar.bar = (unsigned*)(ws + WS_BAR); xbar.x = xb_xcc_id(); xbar.st = (volatile LAS unsigned*)(L + 131072); xcd_barrier(xbar, tid); }
            if (PROBE_K >= 0 && PROBE_K != 3 && pcls == PROBE_K) { const unsigned long long t1 = __builtin_amdgcn_s_memrealtime(), dt = t1 - pt0; while (__builtin_amdgcn_s_memrealtime() - t1 < dt) __builtin_amdgcn_s_sleep(8); } }
    }
}

extern "C" void kernel_launch(void* const* d_in, const int* in_sizes, int n_in, void* d_out, int out_size, void* d_ws, size_t ws_size, hipStream_t stream) {
    static int grid = 0;
    if (grid == 0) {
        if (n_in != 18 || ws_size < WS_END) { fprintf(stderr, "kernel_launch: need 18 inputs and >= %zu bytes of workspace (got %d, %zu)\n", (size_t)WS_END, n_in, ws_size); grid = -1; return; }
        int dev = 0, cus = 0, per_cu = 0;
        hipGetDevice(&dev);
        hipDeviceGetAttribute(&cus, hipDeviceAttributeMultiprocessorCount, dev);
        if (hipFuncSetAttribute((const void*)mk_fwd, hipFuncAttributeMaxDynamicSharedMemorySize, LDS_BYTES) != hipSuccess) { fprintf(stderr, "kernel_launch: hipFuncSetAttribute failed\n"); grid = -1; return; }
        if (hipOccupancyMaxActiveBlocksPerMultiprocessor(&per_cu, (const void*)mk_fwd, 512, LDS_BYTES) != hipSuccess || per_cu < 1) { fprintf(stderr, "kernel_launch: occupancy query gave %d\n", per_cu); per_cu = 1; }
        (void)hipGetLastError();
        grid = cus * 1;
    }
    if (grid < 0) return;
    if (hipMemsetAsync((char*)d_ws + WS_BAR, 0, 16384, stream) != hipSuccess) { fprintf(stderr, "kernel_launch: memset failed\n"); return; }
    Args a{};
    for (int i = 0; i < 18; ++i) a.in[i] = (const float*)d_in[i];
    a.out = (float*)d_out; a.ws = (unsigned char*)d_ws; a.ph_lo = 0; a.ph_hi = NPHASES;
    void* kargs[] = {&a};
    hipError_t e = hipLaunchCooperativeKernel((const void*)mk_fwd, dim3(grid), dim3(512), kargs, LDS_BYTES, stream);
    if (e != hipSuccess) fprintf(stderr, "kernel_launch: cooperative launch failed: %s (grid %d)\n", hipGetErrorString(e), grid);
}
```

```cpp
#include <hip/hip_runtime.h>
#include <hip/hip_cooperative_groups.h>
#include <hip/hip_bf16.h>
#include <cstdio>
#include <cstdint>
namespace cg = cooperative_groups;
#ifndef PROBE_F8
#define PROBE_F8 0
#endif

#define LAS __attribute__((address_space(3)))
#define GAS __attribute__((address_space(1)))
typedef unsigned short bf16_t;
typedef short bf16x8 __attribute__((ext_vector_type(8)));
typedef float f32x4 __attribute__((ext_vector_type(4)));
typedef float f32x2 __attribute__((ext_vector_type(2)));
typedef unsigned u32x4 __attribute__((ext_vector_type(4)));
typedef unsigned u32x2 __attribute__((ext_vector_type(2)));

constexpr int DM = 1024, SEQ = 16384, NBATCH = 2, DEPTH = 2, NIN = 11776;
constexpr int NPH_PER = 8, NPHASES = 1 + DEPTH * NBATCH * NPH_PER;
constexpr float EPS = 1e-6f;
constexpr float LOG2E = 1.4426950408889634f;

constexpr size_t MiB = 1u << 20;
constexpr size_t WS_MOD = 0;
constexpr size_t WS_ROPE = 64 * 1024;
constexpr size_t WS_BAR = 256 * 1024;
constexpr size_t WS_SA = 1 * MiB, WS_SH = 2 * MiB;
constexpr size_t WS_WIN = 4 * MiB, WS_WG = 50 * MiB, WS_WBR = 54 * MiB, WS_WOUT = 66 * MiB;
constexpr size_t WS_H = 70 * MiB;
constexpr size_t WS_XA = 102 * MiB;
constexpr size_t WS_SGA = 134 * MiB;
constexpr size_t WS_Q = 166 * MiB;
constexpr size_t WS_K = 198 * MiB, WS_V = 206 * MiB;
constexpr size_t WS_SGB = 214 * MiB;
constexpr size_t WS_XC = 246 * MiB, WS_BC = 278 * MiB, WS_CC = 310 * MiB, WS_SGC = 342 * MiB;
constexpr size_t WS_LA = WS_XC, WS_U = WS_BC;
constexpr size_t WS_SMG = 374 * MiB;
constexpr size_t WS_YC = 470 * MiB;
constexpr size_t WS_K8 = 502 * MiB, WS_V8 = 506 * MiB;
constexpr size_t WS_SPARE = 510 * MiB;
constexpr size_t WS_FLAG = WS_BAR + 15 * 1024;
constexpr size_t WS_END = 512 * MiB;
constexpr int LDS_BYTES = 131072 + 1024;

__device__ __forceinline__ float bf2f(bf16_t v) { return __uint_as_float((unsigned)v << 16); }
__device__ __forceinline__ unsigned f2bf(float f) { unsigned u = __float_as_uint(f); return (u + 0x7fffu + ((u >> 16) & 1u)) >> 16; }
__device__ __forceinline__ unsigned cvt_pk_bf16(float lo, float hi) { unsigned r; asm("v_cvt_pk_bf16_f32 %0, %1, %2" : "=v"(r) : "v"(lo), "v"(hi)); return r; }
__device__ __forceinline__ void unpack8(const u32x4 w, float (&f)[8]) {
#pragma unroll
    for (int i = 0; i < 4; ++i) { f[2 * i] = __uint_as_float(w[i] << 16); f[2 * i + 1] = __uint_as_float(w[i] & 0xffff0000u); }
}
__device__ __forceinline__ u32x4 pack8(const float (&f)[8]) {
    u32x4 w; w.x = cvt_pk_bf16(f[0], f[1]); w.y = cvt_pk_bf16(f[2], f[3]); w.z = cvt_pk_bf16(f[4], f[5]); w.w = cvt_pk_bf16(f[6], f[7]); return w;
}
typedef int i32x8 __attribute__((ext_vector_type(8)));
__device__ __forceinline__ int pk4_fp8(float a, float b, float c, float d) { int r = __builtin_amdgcn_cvt_pk_fp8_f32(a, b, 0, false); return __builtin_amdgcn_cvt_pk_fp8_f32(c, d, r, true); }
__device__ __forceinline__ float sigmoidf_(float v) { return __builtin_amdgcn_rcpf(1.f + __expf(-v)); }
__device__ __forceinline__ float wave_sum(float v) {
#pragma unroll
    for (int o = 1; o < 64; o <<= 1) v += __shfl_xor(v, o);
    return v;
}
#define LDS_WAIT() asm volatile("s_waitcnt lgkmcnt(0)" ::: "memory")
#define VM_WAIT() asm volatile("s_waitcnt vmcnt(0)" ::: "memory")

namespace pg8 {
constexpr int BM = 256, BK = 64, HALF = 128, HTB = HALF * BK * 2, STAGE_BYTES = 8 * HTB, NXCD = 8, WGM = 8;
__device__ __forceinline__ int lds_byte(int r, int c) { const int st = (r >> 4) * 2 + (c >> 5), rr = r & 15, cc = c & 31, ob = rr * 64 + cc * 2; return st * 1024 + (ob ^ (((ob >> 9) & 1) << 5)); }
__device__ __forceinline__ void stage_rc(int b, int& R, int& C) { const int st = b / 1024, sb = b % 1024, swz = sb ^ (((sb >> 9) & 1) << 5); R = (st >> 1) * 16 + swz / 64; C = (st & 1) * 32 + (swz % 64) / 2; }
__device__ __forceinline__ int perm32(int rho) { const int n = rho >> 4, i = rho & 15; return 8 * (i >> 2) + 4 * n + (i & 3); }

struct Unit { int pm, pn, kk; };
struct Gemm { const bf16_t* A; const bf16_t* Bt; int lda, ldb, K; long a1, a2; };

struct StaticOrder {
    int nM, nN, nwg, G, c;
    __device__ void init(int M, int N, int G_, int c_) { nM = M / BM; nN = N / BM; nwg = nM * nN; G = G_; c = c_; }
    __device__ bool next(int i, Unit& u) const {
        const long L = (long)i * G + c; if (L >= nwg) return false;
        int wgid = (int)L; { const int q = nwg / NXCD, r = nwg % NXCD, xcd = wgid % NXCD, off = wgid / NXCD; wgid = (xcd < r ? xcd * (q + 1) : r * (q + 1) + (xcd - r) * q) + off; }
        const int nig = WGM * nN, gid = wgid / nig, fm = gid * WGM, gsz = (nM - fm) < WGM ? (nM - fm) : WGM;
        u.pm = fm + ((wgid % nig) % gsz); u.pn = (wgid % nig) / gsz; u.kk = 0; return true;
    }
};
struct BranchOrder {
    StaticOrder so;
    __device__ bool next(int i, Unit& u) const { const int ti = i / 3, kk = i - 3 * ti; if (!so.next(ti, u)) return false; u.kk = kk; return true; }
};

template <int MODE> __device__ __forceinline__ const char* unitA(const Gemm& g, const Unit& u) {
    const char* p = (const char*)g.A + (size_t)u.pm * BM * g.lda * 2;
    if (MODE == 1) p += (((u.pn >> 1) & 3) * 256) * 2;
    if (MODE == 2) p += (u.kk == 1 ? g.a1 : (u.kk == 2 ? g.a2 : 0l));
    return p;
}
template <int MODE> __device__ __forceinline__ const char* unitB(const Gemm& g, const Unit& u) {
    const char* p = (const char*)g.Bt + (size_t)u.pn * BM * g.ldb * 2;
    if (MODE == 2) p += (size_t)u.kk * 1024 * 1024 * 2;
    return p;
}

template <class Epi, class Sched, int MODE>
__device__ __forceinline__ void gemm_phase(LAS unsigned char* lds, const Gemm g, const Sched& S, const Epi& E, const int tid) {
    const int wid = __builtin_amdgcn_readfirstlane(tid >> 6), lane = tid & 63, wr = wid >> 2, wc = wid & 3, fr = lane & 15, fq = lane >> 4;
    const int K = g.K, nt = K / BK;
    unsigned voffA[2], voffB[2];
#pragma unroll
    for (int i = 0; i < 2; ++i) { int R, C; stage_rc(tid * 16 + i * 8192, R, C); const int Rb = (R & ~31) + perm32(R & 31);
        voffA[i] = (unsigned)(R * g.lda + C) * 2u; voffB[i] = (unsigned)(Rb * g.ldb + C) * 2u; }
    const size_t kstep = (size_t)(BK * 2);
    const size_t hstepA = (size_t)HALF * g.lda * 2, hstepB = (size_t)HALF * g.ldb * 2;
    const unsigned ldsw = (unsigned)wid * 1024u;
    const int aoff = lds_byte(wr * 64 + fr, fq * 8), boff = lds_byte(wc * 32 + fr, fq * 8);
#define PG8_SA(b, h) (((b) * 2 + (h)) * HTB)
#define PG8_SB(b, h) ((4 + (b) * 2 + (h)) * HTB)
#define PG8_STAGE(bufoff, gbase, voff) do { _Pragma("unroll") for (int _i = 0; _i < 2; ++_i) \
        __builtin_amdgcn_global_load_lds((const unsigned*)((const char*)(gbase) + (voff)[_i]), (LAS unsigned*)(lds + (bufoff) + ldsw + _i * 8192), 16, 0, 0); } while (0)
#define PG8_LDA(dst, b, h) do { _Pragma("unroll") for (int m = 0; m < 4; ++m) _Pragma("unroll") for (int k = 0; k < 2; ++k) dst[m][k] = *(const LAS bf16x8*)(lds + PG8_SA(b, h) + aoff + m * 2048 + k * 1024); } while (0)
#define PG8_LDB(dst, b, h) do { _Pragma("unroll") for (int n = 0; n < 2; ++n) _Pragma("unroll") for (int k = 0; k < 2; ++k) dst[n][k] = *(const LAS bf16x8*)(lds + PG8_SB(b, h) + boff + n * 2048 + k * 1024); } while (0)
#define PG8_MMA(ai, bj, At, Bt) do { __builtin_amdgcn_s_setprio(1); _Pragma("unroll") for (int m = 0; m < 4; ++m) _Pragma("unroll") for (int n = 0; n < 2; ++n) _Pragma("unroll") for (int k = 0; k < 2; ++k) \
        acc[ai][bj][m][n] = __builtin_amdgcn_mfma_f32_16x16x32_bf16(Bt[n][k], At[m][k], acc[ai][bj][m][n], 0, 0, 0); __builtin_amdgcn_s_setprio(0); } while (0)
#define PG8_WAIT_V(n) asm volatile("s_waitcnt vmcnt(" #n ")" ::: "memory")
#define PG8_WAIT_L(n) asm volatile("s_waitcnt lgkmcnt(" #n ")" ::: "memory")
#define PG8_BAR __builtin_amdgcn_s_barrier()
#define PG8_SCHED __builtin_amdgcn_sched_barrier(0)
    Unit cur, nxt; int ui = 0;
    if (!S.next(0, cur)) return;
    f32x4 acc[2][2][4][2];
#pragma unroll
    for (int a = 0; a < 2; ++a)
#pragma unroll
        for (int b = 0; b < 2; ++b)
#pragma unroll
            for (int m = 0; m < 4; ++m)
#pragma unroll
                for (int n = 0; n < 2; ++n) acc[a][b][m][n] = (f32x4){0.f, 0.f, 0.f, 0.f};
    bf16x8 At[4][2], B0[2][2], B1[2][2];
    const char* cA = unitA<MODE>(g, cur); const char* cB = unitB<MODE>(g, cur);
    PG8_STAGE(PG8_SB(0, 0), cB, voffB); PG8_STAGE(PG8_SB(0, 1), cB + hstepB, voffB); PG8_STAGE(PG8_SA(0, 0), cA, voffA); PG8_STAGE(PG8_SA(0, 1), cA + hstepA, voffA);
    if (wr == 1) PG8_BAR;
    PG8_WAIT_V(2); PG8_BAR;
    PG8_STAGE(PG8_SB(1, 0), cB + kstep, voffB); PG8_STAGE(PG8_SA(1, 0), cA + kstep, voffA); PG8_STAGE(PG8_SB(1, 1), cB + hstepB + kstep, voffB);
    PG8_WAIT_V(6); PG8_BAR;
    for (;;) {
        const bool has_next = S.next(ui + 1, nxt);
        const char* nA = has_next ? unitA<MODE>(g, nxt) : cA; const char* nB = has_next ? unitB<MODE>(g, nxt) : cB;
#pragma nounroll
        for (int t = 0; t < nt; t += 2) {
            const bool last = (t == nt - 2);
            const char* a1 = cA + (size_t)(t + 1) * kstep;
            const char* a2 = last ? nA : cA + (size_t)(t + 2) * kstep; const char* b2 = last ? nB : cB + (size_t)(t + 2) * kstep;
            const char* a3 = a2 + kstep; const char* b3 = b2 + kstep;
            PG8_LDB(B0, 0, 0); PG8_LDB(B1, 0, 1); PG8_SCHED; PG8_LDA(At, 0, 0); PG8_STAGE(PG8_SA(1, 1), a1 + hstepA, voffA);
            PG8_WAIT_V(8); PG8_WAIT_L(0); PG8_BAR; PG8_MMA(0, 0, At, B0); PG8_MMA(0, 1, At, B1); PG8_BAR; PG8_SCHED;
            PG8_LDA(At, 0, 1); PG8_STAGE(PG8_SB(0, 0), b2, voffB); PG8_STAGE(PG8_SB(0, 1), b2 + hstepB, voffB); PG8_STAGE(PG8_SA(0, 0), a2, voffA);
            PG8_WAIT_V(8); PG8_WAIT_L(0); PG8_BAR; PG8_MMA(1, 0, At, B0); PG8_MMA(1, 1, At, B1); PG8_BAR; PG8_SCHED;
            PG8_LDB(B0, 1, 0); PG8_LDB(B1, 1, 1); PG8_SCHED; PG8_LDA(At, 1, 0); PG8_STAGE(PG8_SA(0, 1), a2 + hstepA, voffA);
            PG8_WAIT_V(8); PG8_WAIT_L(0); PG8_BAR; PG8_MMA(0, 0, At, B0); PG8_MMA(0, 1, At, B1); PG8_BAR; PG8_SCHED;
            PG8_LDA(At, 1, 1); PG8_STAGE(PG8_SB(1, 0), b3, voffB); PG8_STAGE(PG8_SB(1, 1), b3 + hstepB, voffB); PG8_STAGE(PG8_SA(1, 0), a3, voffA);
            PG8_WAIT_V(8); PG8_WAIT_L(0); PG8_BAR; PG8_MMA(1, 0, At, B0); PG8_MMA(1, 1, At, B1); PG8_BAR; PG8_SCHED;
        }
        if (wr == 0) PG8_BAR;
        E(acc, cur, wr, wc, fr, fq);
        if (!has_next) break;
#pragma unroll
        for (int a = 0; a < 2; ++a)
#pragma unroll
            for (int b = 0; b < 2; ++b)
#pragma unroll
                for (int m = 0; m < 4; ++m)
#pragma unroll
                    for (int n = 0; n < 2; ++n) acc[a][b][m][n] = (f32x4){0.f, 0.f, 0.f, 0.f};
        cur = nxt; cA = nA; cB = nB; ++ui;
        if (wr == 1) PG8_BAR;
    }
    PG8_WAIT_V(0);
    PG8_BAR;
#undef PG8_SA
#undef PG8_SB
#undef PG8_STAGE
#undef PG8_LDA
#undef PG8_LDB
#undef PG8_MMA
#undef PG8_WAIT_V
#undef PG8_WAIT_L
#undef PG8_BAR
#undef PG8_SCHED
}

__device__ __forceinline__ void store_tile_bf16(const f32x4 (&acc)[2][2][4][2], bf16_t* base, int ldc, int row0, int col0, int act) {
#pragma unroll
    for (int ai = 0; ai < 2; ++ai)
#pragma unroll
        for (int m = 0; m < 4; ++m) { bf16_t* rowp = base + (size_t)(row0 + ai * HALF + m * 16) * ldc + col0;
#pragma unroll
            for (int bj = 0; bj < 2; ++bj) { float v[8];
#pragma unroll
                for (int j = 0; j < 4; ++j) { v[j] = acc[ai][bj][m][0][j]; v[4 + j] = acc[ai][bj][m][1][j]; }
                if (act != 0) {
                    float sg[8];
#pragma unroll
                    for (int j = 0; j < 8; ++j) sg[j] = sigmoidf_(v[j]);
                    if (act == 1) {
#pragma unroll
                        for (int j = 0; j < 8; ++j) v[j] *= sg[j];
                    } else {
#pragma unroll
                        for (int j = 0; j < 8; ++j) v[j] = sg[j];
                    }
                }
                *(u32x4*)(rowp + bj * HALF) = pack8(v); }
            asm volatile("" ::: "memory"); }
}
struct EpiInProj {
    unsigned char* ws;
    __device__ __forceinline__ void operator()(const f32x4 (&acc)[2][2][4][2], const Unit& u, int wr, int wc, int fr, int fq) const {
        const int pn = u.pn; size_t off; int ldc = 1024, col, act = 0;
        if (pn < 4) { off = WS_XA; col = pn * 256; }
        else if (pn < 8) { off = WS_SGA; col = (pn - 4) * 256; act = 1; }
        else if (pn < 12) { off = WS_Q; col = (pn - 8) * 256; }
        else if (pn == 12) { off = WS_K; col = 0; ldc = 256; }
        else if (pn == 13) { off = WS_V; col = 0; ldc = 256; }
        else if (pn < 18) { off = WS_SGB; col = (pn - 14) * 256; act = 1; }
        else if (pn < 34) {
            const bool bg = pn >= 26; const int blk = bg ? pn - 26 : pn - 18;
            bf16_t* basep = (bf16_t*)(ws + (bg ? WS_BC : WS_XC));
            const int row0p = u.pm * BM + wr * 64 + fr, col0p = blk * 128 + wc * 32 + 8 * fq;
#pragma unroll
            for (int ai = 0; ai < 2; ++ai)
#pragma unroll
                for (int m = 0; m < 4; ++m) { float v[8];
#pragma unroll
                    for (int j = 0; j < 8; ++j) { const float x0 = acc[ai][0][m][j >> 2][j & 3], x1 = acc[ai][1][m][j >> 2][j & 3];
                        v[j] = bg ? x0 * (x1 * sigmoidf_(x1)) : x0 * x1; }
                    *(u32x4*)(basep + (size_t)(row0p + ai * HALF + m * 16) * 1024 + col0p) = pack8(v); }
            return; }
        else { off = WS_SMG; col = (pn - 34) * 256; ldc = 3072; act = 2; }
        bf16_t* base = (bf16_t*)(ws + off);
        const int row0 = u.pm * BM + wr * 64 + fr, col0 = col + wc * 32 + 8 * fq;
        store_tile_bf16(acc, base, ldc, row0, col0, act);
    }
};
struct EpiGates {
    unsigned char* ws; const float* b_r; const float* b_i; const float* lam;
    __device__ __forceinline__ void operator()(const f32x4 (&acc)[2][2][4][2], const Unit& u, int wr, int wc, int fr, int fq) const {
        const int dir = u.pn >> 3, nb = (u.pn >> 1) & 3, hh = u.pn & 1;
        const int ch0 = nb * 256 + hh * 128 + wc * 32 + 8 * fq;
        float br[8], bi[8], sp[8];
#pragma unroll
        for (int j = 0; j < 8; ++j) { br[j] = b_r[dir * 1024 + ch0 + j]; bi[j] = b_i[dir * 1024 + ch0 + j];
            const float lm = lam[dir * 1024 + ch0 + j]; const float e = __expf(-lm);
            const float spl = lm < -15.f ? -lm : (e < 0.03f ? e * (1.f - e * (0.5f - e * (0.33333334f - 0.25f * e))) : __logf(1.f + e));
            sp[j] = -8.0f * LOG2E * spl; }
        const bf16_t* UA = (const bf16_t*)(ws + WS_H);
        bf16_t* LA = (bf16_t*)(ws + WS_LA + (size_t)dir * 64 * MiB);
        bf16_t* UU = (bf16_t*)(ws + WS_U + (size_t)dir * 64 * MiB);
        const int row0 = u.pm * BM + wr * 64 + fr;
#pragma unroll
        for (int ai = 0; ai < 2; ++ai)
#pragma unroll
            for (int m = 0; m < 4; ++m) { const size_t o = (size_t)(row0 + ai * HALF + m * 16) * 1024 + ch0;
                float x[8]; unpack8(*(const u32x4*)(UA + o), x);
                float la[8], uu[8];
#pragma unroll
                for (int j = 0; j < 8; ++j) { const float pr = acc[ai][0][m][j >> 2][j & 3] + br[j], pi = acc[ai][1][m][j >> 2][j & 3] + bi[j];
                    const float r = sigmoidf_(pr), ig = sigmoidf_(pi);
                    const float l2 = r * sp[j]; const float a = __builtin_amdgcn_exp2f(l2);
                    la[j] = l2; uu[j] = __builtin_amdgcn_sqrtf(fmaxf(1.f - a * a, 0.f)) * ig * x[j]; }
                *(u32x4*)(LA + o) = pack8(la); *(u32x4*)(UU + o) = pack8(uu); }
    }
};
struct EpiBranch {
    unsigned char* ws;
    __device__ __forceinline__ void operator()(const f32x4 (&acc)[2][2][4][2], const Unit& u, int wr, int wc, int fr, int fq) const {
        const bf16_t* G = (const bf16_t*)(ws + WS_SMG) + u.kk * 1024;
        bf16_t* Mg = (bf16_t*)(ws + WS_SGA);
        const int row0 = u.pm * BM + wr * 64 + fr, col0 = u.pn * BM + wc * 32 + 8 * fq;
#pragma unroll
        for (int ai = 0; ai < 2; ++ai)
#pragma unroll
            for (int m = 0; m < 4; ++m) { const int row = row0 + ai * HALF + m * 16;
#pragma unroll
                for (int bj = 0; bj < 2; ++bj) { const int col = col0 + bj * HALF;
                    float gt[8], v[8]; unpack8(*(const u32x4*)(G + (size_t)row * 3072 + col), gt);
#pragma unroll
                    for (int j = 0; j < 8; ++j) v[j] = gt[j] * acc[ai][bj][m][j >> 2][j & 3];
                    bf16_t* mp = Mg + (size_t)row * 1024 + col;
                    if (u.kk != 0) { float old[8]; unpack8(*(const u32x4*)mp, old);
#pragma unroll
                        for (int j = 0; j < 8; ++j) v[j] += old[j]; }
                    *(u32x4*)mp = pack8(v); } }
    }
};
struct EpiOut {
    const float* xi; float* xo; const float* gate; const unsigned* flag;
    __device__ __forceinline__ void operator()(const f32x4 (&acc)[2][2][4][2], const Unit& u, int wr, int wc, int fr, int fq) const {
        const int row0 = u.pm * BM + wr * 64 + fr, col0 = u.pn * BM + wc * 32 + 8 * fq;
        const bool bad = PROBE_F8 ? (__hip_atomic_load(flag, __ATOMIC_RELAXED, __HIP_MEMORY_SCOPE_AGENT) != 0u) : false; const float qn = __builtin_nanf("");
        f32x4 gv[2][2];
#pragma unroll
        for (int bj = 0; bj < 2; ++bj)
#pragma unroll
            for (int n = 0; n < 2; ++n) gv[bj][n] = *(const f32x4*)(gate + col0 + bj * HALF + 4 * n);
#pragma unroll
        for (int ai = 0; ai < 2; ++ai)
#pragma unroll
            for (int m = 0; m < 4; ++m) { const size_t o = (size_t)(row0 + ai * HALF + m * 16) * 1024 + col0;
#pragma unroll
                for (int bj = 0; bj < 2; ++bj)
#pragma unroll
                    for (int n = 0; n < 2; ++n) { const f32x4 xv = *(const f32x4*)(xi + o + bj * HALF + 4 * n);
                        f32x4 r = xv + gv[bj][n] * acc[ai][bj][m][n]; if (PROBE_F8 && bad) r = (f32x4){qn, qn, qn, qn};
                        *(f32x4*)(xo + o + bj * HALF + 4 * n) = r; } }
    }
};
}

namespace attn {
using bf16 = __hip_bfloat16;
using s16x4 = __attribute__((ext_vector_type(4))) short;
using f32x16 = __attribute__((ext_vector_type(16))) float;
constexpr int D = 128, NW = 8, QBLK = 32, KVBLK = 64;
constexpr float SCALE = 0.088388347648318440f;
constexpr float THR = 8.f;
constexpr int LDQ = 1024, LDK = 256, LDO = 1024;
constexpr size_t SHM_V = KVBLK * D * 2, SHM_K = KVBLK * D * 2, SHM_ATTN = 2 * SHM_V + 2 * SHM_K + NW * 64 * 4;
#define KSWZ(row, colB) ((row) * 256 + ((colB) ^ (((row) & 7) << 4)))
#define SBAR() __builtin_amdgcn_sched_barrier(0)
__device__ __forceinline__ int crow(int r, int hi) { return (r & 3) + 8 * (r >> 2) + 4 * hi; }
__device__ __forceinline__ unsigned cvtpk(float lo, float hi) { unsigned r; asm volatile("v_cvt_pk_bf16_f32 %0, %1, %2" : "=v"(r) : "v"(lo), "v"(hi)); return r; }

__device__ __forceinline__ void partialSM(f32x16& p0, f32x16& p1, float& m_reg, float& mn, float& alpha) {
  constexpr float C = SCALE * 1.4426950408889634f;
  float pmax = p0[0]; for (int r = 1; r < 16; ++r) pmax = fmaxf(pmax, p0[r]); for (int r = 0; r < 16; ++r) pmax = fmaxf(pmax, p1[r]);
  { auto rr = __builtin_amdgcn_permlane32_swap(__float_as_uint(pmax), __float_as_uint(pmax), false, false);
    pmax = fmaxf(__uint_as_float(rr[0]), __uint_as_float(rr[1])); }
  if (__builtin_expect(__all(pmax - m_reg <= THR / SCALE), 1)) { mn = m_reg; alpha = 1.f; }
  else { mn = fmaxf(m_reg, pmax); alpha = __builtin_amdgcn_exp2f((m_reg - mn) * C); m_reg = mn; }
  float mnC = -mn * C;
  for (int r = 0; r < 16; ++r) p0[r] = fmaf(p0[r], C, mnC); for (int r = 0; r < 16; ++r) p1[r] = fmaf(p1[r], C, mnC);
  for (int r = 0; r < 16; ++r) p0[r] = __builtin_amdgcn_exp2f(p0[r]);
}
__device__ __forceinline__ void finishSM(f32x16& p0, f32x16& p1, float alpha, float& l_reg, bf16x8& pa0, bf16x8& pa1, bf16x8& pa2, bf16x8& pa3) {
  for (int r = 0; r < 16; ++r) p1[r] = __builtin_amdgcn_exp2f(p1[r]);
  float ps = 0; for (int r = 0; r < 16; ++r) ps += p0[r]; for (int r = 0; r < 16; ++r) ps += p1[r];
  { auto rr = __builtin_amdgcn_permlane32_swap(__float_as_uint(ps), __float_as_uint(ps), false, false);
    ps = __uint_as_float(rr[0]) + __uint_as_float(rr[1]); }
  l_reg = l_reg * alpha + ps;
#define PK4(P, BASE, OUT) do { unsigned a0 = cvtpk(P[BASE + 0], P[BASE + 1]), a1 = cvtpk(P[BASE + 2], P[BASE + 3]);   \
    unsigned b0 = cvtpk(P[BASE + 4], P[BASE + 5]), b1 = cvtpk(P[BASE + 6], P[BASE + 7]);                              \
    auto r0 = __builtin_amdgcn_permlane32_swap(a0, b0, false, false); auto r1 = __builtin_amdgcn_permlane32_swap(a1, b1, false, false); \
    u32x4 w = {r0[0], r1[0], r0[1], r1[1]}; OUT = *reinterpret_cast<bf16x8*>(&w); } while (0)
  PK4(p0, 0, pa0); PK4(p0, 8, pa1); PK4(p1, 0, pa2); PK4(p1, 8, pa3);
#undef PK4
}
__device__ __forceinline__ void qkt(f32x16& p0, f32x16& p1, const bf16* Ks, const bf16x8* qr, int r32, int hi) {
  p0 = f32x16{}; p1 = f32x16{};
  for (int d0 = 0; d0 < 8; ++d0) { int cb = (d0 * 16 + hi * 8) * 2;
    bf16x8 b0 = *reinterpret_cast<const bf16x8*>((const char*)Ks + KSWZ(r32, cb));
    bf16x8 b1 = *reinterpret_cast<const bf16x8*>((const char*)Ks + KSWZ(32 + r32, cb));
    p0 = __builtin_amdgcn_mfma_f32_32x32x16_bf16(b0, qr[d0], p0, 0, 0, 0);
    p1 = __builtin_amdgcn_mfma_f32_32x32x16_bf16(b1, qr[d0], p1, 0, 0, 0); }
}
__device__ __forceinline__ int v_st(int k, int c) { const int kk = (k & ~0xC) | ((k & 4) << 1) | ((k & 8) >> 1); return ((kk >> 3) * 4 + (c >> 5)) * 512 + ((kk & 7) * 32 + (c & 31)) * 2; }
__device__ __forceinline__ int v_rd_base(int lane) { return ((lane & 3) << 3) | (((lane >> 2) & 3) << 6) | (((lane >> 4) & 1) << 5) | (((lane >> 5) & 1) << 8); }
constexpr int v_rd_off(int d0, int ks, int half) { return d0 * 512 + ks * 4096 + half * 2048; }
template <int OFF> __device__ __forceinline__ s16x4 tr_read(int vb) {
  s16x4 r; asm volatile("ds_read_b64_tr_b16 %0, %1 offset:%2" : "=&v"(r) : "v"(vb), "i"(OFF) : "memory"); return r;
}
template <int D0> __device__ __forceinline__ void pv_one(f32x16& od, int vb, bf16x8 pa0, bf16x8 pa1, bf16x8 pa2, bf16x8 pa3) {
  const s16x4 l0 = tr_read<v_rd_off(D0, 0, 0)>(vb), h0 = tr_read<v_rd_off(D0, 0, 1)>(vb), l1 = tr_read<v_rd_off(D0, 1, 0)>(vb), h1 = tr_read<v_rd_off(D0, 1, 1)>(vb);
  const s16x4 l2 = tr_read<v_rd_off(D0, 2, 0)>(vb), h2 = tr_read<v_rd_off(D0, 2, 1)>(vb), l3 = tr_read<v_rd_off(D0, 3, 0)>(vb), h3 = tr_read<v_rd_off(D0, 3, 1)>(vb);
  asm volatile("s_waitcnt lgkmcnt(0)" ::: "memory"); SBAR();
#define PK(L, H) (bf16x8){L[0], L[1], L[2], L[3], H[0], H[1], H[2], H[3]}
  od = __builtin_amdgcn_mfma_f32_32x32x16_bf16(pa0, PK(l0, h0), od, 0, 0, 0);
  od = __builtin_amdgcn_mfma_f32_32x32x16_bf16(pa1, PK(l1, h1), od, 0, 0, 0);
  od = __builtin_amdgcn_mfma_f32_32x32x16_bf16(pa2, PK(l2, h2), od, 0, 0, 0);
  od = __builtin_amdgcn_mfma_f32_32x32x16_bf16(pa3, PK(l3, h3), od, 0, 0, 0);
#undef PK
}
__device__ __forceinline__ void pv_d0(f32x16* o, int vb, bf16x8 pa0, bf16x8 pa1, bf16x8 pa2, bf16x8 pa3) {
  pv_one<0>(o[0], vb, pa0, pa1, pa2, pa3); pv_one<1>(o[1], vb, pa0, pa1, pa2, pa3); pv_one<2>(o[2], vb, pa0, pa1, pa2, pa3); pv_one<3>(o[3], vb, pa0, pa1, pa2, pa3);
}
__device__ __forceinline__ void attn_dense_body(const bf16* Qb, const bf16* __restrict__ Kh, const bf16* __restrict__ Vh,
                                                bf16_t* Ob, const bf16_t* Gb, int seq, char* lds, const int tid) {
  const int wid = tid >> 6, lane = tid & 63, r32 = lane & 31, hi = lane >> 5;
  bf16* V_lds = (bf16*)lds; bf16* K_lds = (bf16*)(lds + 2 * SHM_V);
  float* ws = (float*)(lds + 2 * SHM_V + 2 * SHM_K) + wid * 64; float* li_l = ws; float* al_l = ws + 32;
  float m_reg = -1e30f, l_reg = 0; f32x16 o[4] = {}; bf16x8 qr[8];
  const bf16* Qw = Qb + (long)(wid * QBLK + r32) * LDQ + hi * 8;
#pragma unroll
  for (int d0 = 0; d0 < 8; ++d0) qr[d0] = *reinterpret_cast<const bf16x8*>(Qw + d0 * 16);
  const int sr = tid >> 4, sc = (tid & 15) * 8, vst0 = v_st(sr, sc), vst1 = v_st(32 + sr, sc);
  const int vb0 = (int)(uintptr_t)V_lds + v_rd_base(lane);
  struct { bf16x8 vs0, vs1, ks0, ks1; } sr_[2];
#define SLOAD(i, k0) do { sr_[i].vs0 = *reinterpret_cast<const bf16x8*>(&Vh[(long)((k0) + sr) * LDK + sc]); sr_[i].vs1 = *reinterpret_cast<const bf16x8*>(&Vh[(long)((k0) + 32 + sr) * LDK + sc]); \
    sr_[i].ks0 = *reinterpret_cast<const bf16x8*>(&Kh[(long)((k0) + sr) * LDK + sc]); sr_[i].ks1 = *reinterpret_cast<const bf16x8*>(&Kh[(long)((k0) + 32 + sr) * LDK + sc]); } while (0)
#define SWRITE(b, i) do { *(bf16x8*)((char*)V_lds + (b) * SHM_V + vst0) = sr_[i].vs0;          \
    *(bf16x8*)((char*)V_lds + (b) * SHM_V + vst1) = sr_[i].vs1; int kc = sc * 2;               \
    *(bf16x8*)((char*)K_lds + (b) * SHM_K + KSWZ(sr, kc)) = sr_[i].ks0;                       \
    *(bf16x8*)((char*)K_lds + (b) * SHM_K + KSWZ(32 + sr, kc)) = sr_[i].ks1; } while (0)
#define SWAIT() asm volatile("s_waitcnt vmcnt(4)" ::: "memory")
#define RESC(a) do { if (__any((a) < 1.f)) { if (hi == 0) al_l[r32] = (a); asm volatile("s_waitcnt lgkmcnt(0)" ::: "memory"); \
    for (int d = 0; d < 4; ++d) for (int r = 0; r < 16; ++r) o[d][r] *= al_l[crow(r, hi)]; } } while (0)
  f32x16 pA0, pA1, pB0, pB1; float mnA, mnB, alA, alB; bf16x8 pa0, pa1, pa2, pa3; const int NT = seq / KVBLK;
  constexpr int SE = 0, SO = 1;
  SLOAD(SE, 0); asm volatile("s_waitcnt vmcnt(0)" ::: "memory"); SWRITE(0, SE); __syncthreads();
  qkt(pA0, pA1, K_lds, qr, r32, hi); partialSM(pA0, pA1, m_reg, mnA, alA);
  SLOAD(SO, KVBLK); if (2 < NT) SLOAD(SE, 2 * KVBLK);
  SWAIT(); SWRITE(1, SO); __syncthreads();
#pragma nounroll
  for (int j = 1; j + 1 < NT; j += 2) {
    SBAR(); qkt(pB0, pB1, (bf16*)((char*)K_lds + SHM_K), qr, r32, hi);
    finishSM(pA0, pA1, alA, l_reg, pa0, pa1, pa2, pa3); SBAR();
    SLOAD(SO, (j + 2) * KVBLK); SBAR();
    pv_d0(o, vb0, pa0, pa1, pa2, pa3); partialSM(pB0, pB1, m_reg, mnB, alB);
    __syncthreads(); SWAIT(); SWRITE(0, SE);
    RESC(alB); __syncthreads();
    SBAR(); qkt(pA0, pA1, K_lds, qr, r32, hi);
    finishSM(pB0, pB1, alB, l_reg, pa0, pa1, pa2, pa3); SBAR();
    if (j + 3 < NT) SLOAD(SE, (j + 3) * KVBLK); SBAR();
    pv_d0(o, vb0 + (int)SHM_V, pa0, pa1, pa2, pa3); partialSM(pA0, pA1, m_reg, mnA, alA);
    __syncthreads(); SWAIT(); SWRITE(1, SO);
    RESC(alA); __syncthreads();
  }
  SBAR(); qkt(pB0, pB1, (bf16*)((char*)K_lds + SHM_K), qr, r32, hi);
  finishSM(pA0, pA1, alA, l_reg, pa0, pa1, pa2, pa3); SBAR();
  pv_d0(o, vb0, pa0, pa1, pa2, pa3); partialSM(pB0, pB1, m_reg, mnB, alB);
  __syncthreads(); RESC(alB);
  finishSM(pB0, pB1, alB, l_reg, pa0, pa1, pa2, pa3); SBAR();
  pv_d0(o, vb0 + (int)SHM_V, pa0, pa1, pa2, pa3);
  if (hi == 0) li_l[r32] = l_reg; asm volatile("s_waitcnt lgkmcnt(0)" ::: "memory");
  float rli[16];
#pragma unroll
  for (int r = 0; r < 16; ++r) rli[r] = __builtin_amdgcn_rcpf(li_l[crow(r, hi)]);
  __syncthreads();
  { int lane_e = lane, wid_e = wid; asm volatile("" : "+v"(lane_e), "+v"(wid_e)); wid_e = __builtin_amdgcn_readfirstlane(wid_e);
    bf16_t* stg = (bf16_t*)lds + wid_e * 4096;
#pragma unroll
    for (int r = 0; r < 16; ++r) { const int orow = crow(r, hi);
#pragma unroll
      for (int d0 = 0; d0 < 4; ++d0) stg[orow * 128 + d0 * 32 + r32] = (bf16_t)f2bf(o[d0][r] * rli[r]); }
    asm volatile("s_waitcnt lgkmcnt(0)" ::: "memory");
    bf16_t* Ow = Ob + (long)(wid_e * QBLK) * LDO; const bf16_t* Gw = Gb + (long)(wid_e * QBLK) * LDO;
    u32x4 gq[8];
#pragma unroll
    for (int i = 0; i < 8; ++i) { const int row = i * 4 + (lane_e >> 4), ch = lane_e & 15; gq[i] = *(const u32x4*)(Gw + (long)row * LDO + ch * 8); }
#pragma unroll
    for (int i = 0; i < 8; ++i) { const int row = i * 4 + (lane_e >> 4), ch = lane_e & 15;
      float ov[8], gv[8]; unpack8(*(const u32x4*)(stg + row * 128 + ch * 8), ov); unpack8(gq[i], gv);
#pragma unroll
      for (int j = 0; j < 8; ++j) ov[j] *= gv[j];
      *(u32x4*)(Ow + (long)row * LDO + ch * 8) = pack8(ov); } }
  __syncthreads();
#undef SLOAD
#undef SWRITE
#undef SWAIT
#undef RESC
}

__device__ __forceinline__ void attn_pp_body(const bf16* Qb, const bf16* __restrict__ Kh, const bf16* __restrict__ Vh,
                                             bf16_t* Ob, const bf16_t* Gb, int seq, char* lds, const int tid, const bf16_t* cmp = nullptr, unsigned* flag = nullptr) {
  const int wid = __builtin_amdgcn_readfirstlane(tid >> 6), lane = tid & 63, r32 = lane & 31, hi = lane >> 5;
  const int g = wid >> 2;
  constexpr int NB = 3;
  char* V_lds = lds; char* K_lds = lds + NB * SHM_V;
  float* ws = (float*)(lds + NB * (SHM_V + SHM_K)) + wid * 64; float* li_l = ws; float* al_l = ws + 32;
  float m_reg = -1e30f, l_reg = 0; f32x16 o[4] = {}; bf16x8 qr[8];
  const bf16* Qw = Qb + (long)(wid * QBLK + r32) * LDQ + hi * 8;
#pragma unroll
  for (int d0 = 0; d0 < 8; ++d0) qr[d0] = *reinterpret_cast<const bf16x8*>(Qw + d0 * 16);
  const int sr = tid >> 4, sc = (tid & 15) * 8, vst0 = v_st(sr, sc), vst1 = v_st(32 + sr, sc);
  const int ksw0 = KSWZ(sr, sc * 2), ksw1 = KSWZ(32 + sr, sc * 2);
  const int vbase = (int)(uintptr_t)V_lds + v_rd_base(lane);
  struct Stg { bf16x8 vs0, vs1, ks0, ks1; } st0, st1;
#define SLOAD(S, t) do { const long k0_ = (long)(t) * KVBLK; S.vs0 = *reinterpret_cast<const bf16x8*>(&Vh[(k0_ + sr) * LDK + sc]); S.vs1 = *reinterpret_cast<const bf16x8*>(&Vh[(k0_ + 32 + sr) * LDK + sc]); \
    S.ks0 = *reinterpret_cast<const bf16x8*>(&Kh[(k0_ + sr) * LDK + sc]); S.ks1 = *reinterpret_cast<const bf16x8*>(&Kh[(k0_ + 32 + sr) * LDK + sc]); } while (0)
#define SWRITE(S, b) do { *(bf16x8*)(V_lds + (b) * SHM_V + vst0) = S.vs0; *(bf16x8*)(V_lds + (b) * SHM_V + vst1) = S.vs1; \
    *(bf16x8*)(K_lds + (b) * SHM_K + ksw0) = S.ks0; *(bf16x8*)(K_lds + (b) * SHM_K + ksw1) = S.ks1; } while (0)
#define RESC(a) do { if (__any((a) < 1.f)) { if (hi == 0) al_l[r32] = (a); asm volatile("s_waitcnt lgkmcnt(0)" ::: "memory"); \
    for (int d = 0; d < 4; ++d) for (int r = 0; r < 16; ++r) o[d][r] *= al_l[crow(r, hi)]; } } while (0)
  const int NT = seq / KVBLK;
  f32x16 p0, p1; bf16x8 pa0, pa1, pa2, pa3;
#define SMX() do { float mn_, al_; partialSM(p0, p1, m_reg, mn_, al_); RESC(al_); finishSM(p0, p1, al_, l_reg, pa0, pa1, pa2, pa3); } while (0)
  SLOAD(st0, 0); if (g) SLOAD(st1, 1);
  SWRITE(st0, 0); if (g) SWRITE(st1, 1);
  SLOAD(st0, 1 + g); SLOAD(st1, 2 + g);
  __syncthreads();
  if (g) __syncthreads();
  SBAR(); qkt(p0, p1, (const bf16*)K_lds, qr, r32, hi); SBAR();
  __syncthreads();
  SWRITE(st0, 1 + g); if (3 + g < NT) SLOAD(st0, 3 + g);
  SMX();
  __syncthreads();
  int c = 0;
#define STEP(i, ST) do { const int cK_ = (c == 2) ? 0 : c + 1; \
    SBAR(); \
    qkt(p0, p1, (const bf16*)(K_lds + cK_ * SHM_K), qr, r32, hi); \
    pv_d0(o, vbase + c * (int)SHM_V, pa0, pa1, pa2, pa3); \
    SBAR(); \
    __syncthreads(); \
    { const int t_ = (i) + 2 + g; if (t_ < NT) { const int cb_ = (cK_ == 2) ? 0 : cK_ + 1; const int cw_ = g ? ((cb_ == 2) ? 0 : cb_ + 1) : cb_; \
        SWRITE(ST, cw_); if (t_ + 2 < NT) SLOAD(ST, t_ + 2); } } \
    SMX(); \
    __syncthreads(); \
    c = cK_; } while (0)
  int i = 0;
#pragma nounroll
  for (; i + 1 < NT - 1; i += 2) { STEP(i, st1); STEP(i + 1, st0); }
  if (i < NT - 1) { STEP(i, st1); }
  SBAR(); pv_d0(o, vbase + c * (int)SHM_V, pa0, pa1, pa2, pa3); SBAR();
  __syncthreads();
  if (!g) __syncthreads();
  if (hi == 0) li_l[r32] = l_reg; asm volatile("s_waitcnt lgkmcnt(0)" ::: "memory");
  float rli[16];
#pragma unroll
  for (int r = 0; r < 16; ++r) rli[r] = __builtin_amdgcn_rcpf(li_l[crow(r, hi)]);
  { int lane_e = lane, wid_e = wid; asm volatile("" : "+v"(lane_e), "+v"(wid_e)); wid_e = __builtin_amdgcn_readfirstlane(wid_e);
    bf16_t* stg = (bf16_t*)lds + wid_e * 4096;
#pragma unroll
    for (int r = 0; r < 16; ++r) { const int orow = crow(r, hi);
#pragma unroll
      for (int d0 = 0; d0 < 4; ++d0) stg[orow * 128 + d0 * 32 + r32] = (bf16_t)f2bf(o[d0][r] * rli[r]); }
    asm volatile("s_waitcnt lgkmcnt(0)" ::: "memory");
    bf16_t* Ow = Ob + (long)(wid_e * QBLK) * LDO; const bf16_t* Gw = Gb + (long)(wid_e * QBLK) * LDO;
    u32x4 gq[8];
#pragma unroll
    for (int i2 = 0; i2 < 8; ++i2) { const int row = i2 * 4 + (lane_e >> 4), ch = lane_e & 15; gq[i2] = *(const u32x4*)(Gw + (long)row * LDO + ch * 8); }
#pragma unroll
    for (int i2 = 0; i2 < 8; ++i2) { const int row = i2 * 4 + (lane_e >> 4), ch = lane_e & 15;
      float ov[8], gv[8]; unpack8(*(const u32x4*)(stg + row * 128 + ch * 8), ov); unpack8(gq[i2], gv);
#pragma unroll
      for (int j = 0; j < 8; ++j) ov[j] *= gv[j];
      *(u32x4*)(Ow + (long)row * LDO + ch * 8) = pack8(ov); } }
  __syncthreads();
  if (PROBE_F8 && cmp) {
    asm volatile("s_waitcnt vmcnt(0)" ::: "memory");
    float pr_d = 0.f, pr_r = 0.f; int lane_c = lane; asm volatile("" : "+v"(lane_c));
    const bf16_t* stg2 = (const bf16_t*)lds + wid * 4096;
    float a0[8], c0[8];
#pragma unroll
    for (int i2 = 0; i2 < 8; ++i2) { const int rl = i2 * 4 + (lane_c >> 4), ch = lane_c & 15; float a[8], cv[8];
      unpack8(*(const u32x4*)(stg2 + rl * 128 + ch * 8), a); unpack8(*(const u32x4*)(cmp + (long)(wid * QBLK + rl) * LDO + ch * 8), cv);
      if (i2 == 0) {
#pragma unroll
        for (int j = 0; j < 8; ++j) { a0[j] = a[j]; c0[j] = cv[j]; }
      } else {
#pragma unroll
        for (int j = 0; j < 8; ++j) { const float fa = a[j] - a0[j], fc = cv[j] - c0[j]; pr_d = fmaxf(pr_d, fabsf(fa - fc)); pr_r = fmaxf(pr_r, fabsf(fa)); } } }
#pragma unroll
    for (int o_ = 1; o_ < 64; o_ <<= 1) { pr_d = fmaxf(pr_d, __shfl_xor(pr_d, o_)); pr_r = fmaxf(pr_r, __shfl_xor(pr_r, o_)); }
    if (lane_c == 0 && !(pr_d <= 0.3f * pr_r)) atomicOr(flag, 1u);
    __syncthreads(); }
#undef SLOAD
#undef SWRITE
#undef RESC
#undef SMX
#undef STEP
}

constexpr float THR8 = 1.5f;
__device__ __forceinline__ void partialSM8(f32x16& p0, f32x16& p1, float& m_reg, float& alpha) {
  constexpr float C = SCALE * 1.4426950408889634f;
  float pmax = p0[0]; for (int r = 1; r < 16; ++r) pmax = fmaxf(pmax, p0[r]); for (int r = 0; r < 16; ++r) pmax = fmaxf(pmax, p1[r]);
  { auto rr = __builtin_amdgcn_permlane32_swap(__float_as_uint(pmax), __float_as_uint(pmax), false, false);
    pmax = fmaxf(__uint_as_float(rr[0]), __uint_as_float(rr[1])); }
  float mn;
  if (__builtin_expect(__all(pmax - m_reg <= THR8 / SCALE), 1)) { mn = m_reg; alpha = 1.f; }
  else { mn = fmaxf(m_reg, pmax); alpha = __builtin_amdgcn_exp2f((m_reg - mn) * C); m_reg = mn; }
  const float mnC = 6.0f - mn * C;
  for (int r = 0; r < 16; ++r) p0[r] = fmaf(p0[r], C, mnC); for (int r = 0; r < 16; ++r) p1[r] = fmaf(p1[r], C, mnC);
  for (int r = 0; r < 16; ++r) p0[r] = __builtin_amdgcn_exp2f(p0[r]);
}
__device__ __forceinline__ void finishSM8(f32x16& p0, f32x16& p1, float alpha, float& l_reg, i32x8& pa) {
  for (int r = 0; r < 16; ++r) p1[r] = __builtin_amdgcn_exp2f(p1[r]);
  float sA = p0[0] + p0[1], sB = p0[2] + p0[3], sC = p1[0] + p1[1], sD = p1[2] + p1[3];
  for (int r = 4; r < 16; r += 2) { sA += p0[r]; sB += p0[r + 1]; sC += p1[r]; sD += p1[r + 1]; }
  float ps = (sA + sB) + (sC + sD);
  { auto rr = __builtin_amdgcn_permlane32_swap(__float_as_uint(ps), __float_as_uint(ps), false, false);
    ps = __uint_as_float(rr[0]) + __uint_as_float(rr[1]); }
  l_reg = l_reg * alpha + ps;
#pragma unroll
  for (int w = 0; w < 4; ++w) { pa[w] = pk4_fp8(p0[4 * w], p0[4 * w + 1], p0[4 * w + 2], p0[4 * w + 3]); pa[4 + w] = pk4_fp8(p1[4 * w], p1[4 * w + 1], p1[4 * w + 2], p1[4 * w + 3]); }
}

template <bool FIRST> __device__ __forceinline__ void partialSM8n(f32x16& p0, f32x16& p1, float& M2, f32x16& negm, float& alpha) {
  constexpr float THR2 = THR8 * 1.4426950408889634f;
  float mA = fmaxf(p0[0], p0[1]), mB = fmaxf(p0[2], p0[3]), mC = fmaxf(p1[0], p1[1]), mD = fmaxf(p1[2], p1[3]);
  for (int r = 4; r < 16; r += 4) { mA = fmaxf(fmaxf(mA, p0[r]), p0[r + 1]); mB = fmaxf(fmaxf(mB, p0[r + 2]), p0[r + 3]); mC = fmaxf(fmaxf(mC, p1[r]), p1[r + 1]); mD = fmaxf(fmaxf(mD, p1[r + 2]), p1[r + 3]); }
  float emax = fmaxf(fmaxf(mA, mB), fmaxf(mC, mD));
  { auto rr = __builtin_amdgcn_permlane32_swap(__float_as_uint(emax), __float_as_uint(emax), false, false);
    emax = fmaxf(__uint_as_float(rr[0]), __uint_as_float(rr[1])); }
  if (!FIRST && __builtin_expect(__all(emax - 6.0f <= THR2), 1)) { alpha = 1.f; }
  else { const float delta = FIRST ? (emax - 6.0f) : fmaxf(emax - 6.0f, 0.f); alpha = FIRST ? 0.f : __builtin_amdgcn_exp2f(-delta); M2 += delta;
    for (int r = 0; r < 16; ++r) { p0[r] -= delta; p1[r] -= delta; }
    const float nm = 6.0f - M2; for (int r = 0; r < 16; ++r) negm[r] = nm; asm volatile("" : "+v"(negm)); }
  for (int r = 0; r < 16; ++r) p0[r] = __builtin_amdgcn_exp2f(p0[r]);
}
#define MFMA8(A, B, Cc) __builtin_amdgcn_mfma_scale_f32_32x32x64_f8f6f4((A), (B), (Cc), 0, 0, 0, 0x7f7f7f7f, 0, 0x7f7f7f7f)
__device__ __forceinline__ i32x8 cat8(const u32x4 lo, const u32x4 hi4) { i32x8 r; r[0] = (int)lo.x; r[1] = (int)lo.y; r[2] = (int)lo.z; r[3] = (int)lo.w; r[4] = (int)hi4.x; r[5] = (int)hi4.y; r[6] = (int)hi4.z; r[7] = (int)hi4.w; return r; }
__device__ __forceinline__ void qkt8(f32x16& p0, f32x16& p1, const char* Ks, const i32x8* qf, int r32, int hi, const f32x16& negm) {
  const int x = r32 & 7; const char* k0 = Ks + r32 * 128; const char* k1 = k0 + 32 * 128;
  p0 = negm; p1 = negm;
#pragma unroll
  for (int s2 = 0; s2 < 2; ++s2) { const int c0 = 4 * s2 + 2 * hi, oa = 16 * (c0 ^ x), ob = 16 * ((c0 + 1) ^ x);
    const i32x8 a0 = cat8(*reinterpret_cast<const u32x4*>(k0 + oa), *reinterpret_cast<const u32x4*>(k0 + ob));
    const i32x8 a1 = cat8(*reinterpret_cast<const u32x4*>(k1 + oa), *reinterpret_cast<const u32x4*>(k1 + ob));
    p0 = MFMA8(a0, qf[s2], p0); p1 = MFMA8(a1, qf[s2], p1); }
}
__device__ __forceinline__ void pv8(f32x16* o, const char* Vs, const i32x8 pa, int r32, int hi) {
  const int sw = (r32 >> 2) & 3; const char* vb = Vs + r32 * 64; const int oa = 16 * ((2 * hi) ^ sw), ob = 16 * ((2 * hi + 1) ^ sw);
#pragma unroll
  for (int d0 = 0; d0 < 4; ++d0) { const i32x8 b = cat8(*reinterpret_cast<const u32x4*>(vb + d0 * 2048 + oa), *reinterpret_cast<const u32x4*>(vb + d0 * 2048 + ob));
    o[d0] = MFMA8(pa, b, o[d0]); }
}
__device__ __forceinline__ void attn_pp8_body(const bf16* Qb, const unsigned char* __restrict__ K8, const unsigned char* __restrict__ V8,
                                              bf16_t* Ob, const bf16_t* Gb, int seq, char* lds, const int tid) {
  const int wid = __builtin_amdgcn_readfirstlane(tid >> 6), lane = tid & 63, r32 = lane & 31, hi = lane >> 5;
  const int g = wid >> 2;
  constexpr int NB = 3, SL = 8192;
  char* V_lds = lds; char* K_lds = lds + NB * SL;
  float* ws = (float*)(lds + 65536) + wid * 64; float* li_l = ws; float* al_l = ws + 32;
  float M2 = 0.f, l_reg = 0; f32x16 o[4] = {}; i32x8 qf[2]; f32x16 negm; for (int r = 0; r < 16; ++r) negm[r] = 6.0f; asm volatile("" : "+v"(negm));
  constexpr float QC = SCALE * 1.4426950408889634f;
  { const bf16* Qw = Qb + (long)(wid * QBLK + r32) * LDQ + hi * 32;
#pragma unroll
    for (int s2 = 0; s2 < 2; ++s2) {
#pragma unroll
      for (int q4 = 0; q4 < 4; ++q4) { float f[8]; unpack8(*reinterpret_cast<const u32x4*>(Qw + s2 * 64 + q4 * 8), f);
        qf[s2][2 * q4] = pk4_fp8(f[0] * QC, f[1] * QC, f[2] * QC, f[3] * QC); qf[s2][2 * q4 + 1] = pk4_fp8(f[4] * QC, f[5] * QC, f[6] * QC, f[7] * QC); } } }
  struct Stg8 { u32x4 k, v; } st0, st1;
#define SLOAD(S, t) do { const size_t o_ = (size_t)(t) * SL + (size_t)tid * 16; S.k = *reinterpret_cast<const u32x4*>(K8 + o_); S.v = *reinterpret_cast<const u32x4*>(V8 + o_); } while (0)
#define SWRITE(S, b) do { *(u32x4*)(K_lds + (b) * SL + tid * 16) = S.k; *(u32x4*)(V_lds + (b) * SL + tid * 16) = S.v; } while (0)
#define RESC(a) do { if (__any((a) < 1.f)) { if (hi == 0) al_l[r32] = (a); asm volatile("s_waitcnt lgkmcnt(0)" ::: "memory"); \
    for (int d = 0; d < 4; ++d) for (int r = 0; r < 16; ++r) o[d][r] *= al_l[crow(r, hi)]; } } while (0)
  const int NT = seq / KVBLK;
  f32x16 p0, p1; i32x8 pa;
#define SMX() do { float al_; partialSM8n<true>(p0, p1, M2, negm, al_); RESC(al_); finishSM8(p0, p1, al_, l_reg, pa); } while (0)
  SLOAD(st0, 0); if (g) SLOAD(st1, 1);
  SWRITE(st0, 0); if (g) SWRITE(st1, 1);
  SLOAD(st0, 1 + g);
  __syncthreads();
  if (g) __syncthreads();
  SBAR(); qkt8(p0, p1, K_lds, qf, r32, hi, negm); SBAR();
  __syncthreads();
  SWRITE(st0, 1 + g); SLOAD(st0, 2 + g);
  SMX();
  __syncthreads();
  int c = 0;
#define STEP(i, ST) do { const int cK_ = (c == 2) ? 0 : c + 1; \
    SBAR(); \
    float al2_; \
    qkt8(p0, p1, K_lds + cK_ * SL, qf, r32, hi, negm); \
    partialSM8n<false>(p0, p1, M2, negm, al2_);            \
    pv8(o, V_lds + c * SL, pa, r32, hi); \
    SBAR(); \
    __syncthreads(); \
    { const int t_ = (i) + 2 + g; if (t_ < NT) { const int cb_ = (cK_ == 2) ? 0 : cK_ + 1; const int cw_ = g ? ((cb_ == 2) ? 0 : cb_ + 1) : cb_; \
        SWRITE(st0, cw_); if (t_ + 1 < NT) SLOAD(st0, t_ + 1); } } \
    RESC(al2_); finishSM8(p0, p1, al2_, l_reg, pa); \
    __syncthreads(); \
    c = cK_; } while (0)
  int i = 0;
#pragma nounroll
  for (; i + 1 < NT - 1; i += 2) { STEP(i, st1); STEP(i + 1, st0); }
  if (i < NT - 1) { STEP(i, st1); }
  SBAR(); pv8(o, V_lds + c * SL, pa, r32, hi); SBAR();
  __syncthreads();
  if (!g) __syncthreads();
  if (hi == 0) li_l[r32] = l_reg; asm volatile("s_waitcnt lgkmcnt(0)" ::: "memory");
  float rli[16];
#pragma unroll
  for (int r = 0; r < 16; ++r) rli[r] = __builtin_amdgcn_rcpf(li_l[crow(r, hi)]);
  { int tid_e = tid; asm volatile("" : "+v"(tid_e)); const int lane_e = tid_e & 63; const int wid_e = __builtin_amdgcn_readfirstlane(tid_e >> 6);
    bf16_t* stg = (bf16_t*)lds + wid_e * 4096;
#pragma unroll
    for (int r = 0; r < 16; ++r) { const int orow = crow(r, hi);
#pragma unroll
      for (int d0 = 0; d0 < 4; ++d0) stg[orow * 128 + d0 * 32 + r32] = (bf16_t)f2bf(o[d0][r] * rli[r]); }
    asm volatile("s_waitcnt lgkmcnt(0)" ::: "memory");
    bf16_t* Ow = Ob + (long)(wid_e * QBLK) * LDO; const bf16_t* Gw = Gb + (long)(wid_e * QBLK) * LDO;
    u32x4 gq[8];
#pragma unroll
    for (int i2 = 0; i2 < 8; ++i2) { const int row = i2 * 4 + (lane_e >> 4), ch = lane_e & 15; gq[i2] = Gb ? *(const u32x4*)(Gw + (long)row * LDO + ch * 8) : (u32x4){0x3f803f80u, 0x3f803f80u, 0x3f803f80u, 0x3f803f80u}; }
#pragma unroll
    for (int i2 = 0; i2 < 8; ++i2) { const int row = i2 * 4 + (lane_e >> 4), ch = lane_e & 15;
      float ov[8], gv[8]; unpack8(*(const u32x4*)(stg + row * 128 + ch * 8), ov); unpack8(gq[i2], gv);
#pragma unroll
      for (int j = 0; j < 8; ++j) ov[j] *= gv[j];
      *(u32x4*)(Ow + (long)row * LDO + ch * 8) = pack8(ov); } }
  __syncthreads();
#undef SLOAD
#undef SWRITE
#undef RESC
#undef SMX
#undef STEP
#undef MFMA8
}
#undef KSWZ
#undef SBAR
}


#define XB_TMO      128
#define XB_XCNT(j)  (256  + 64 * (j))
#define XB_XSUB(j)  (1280 + 64 * (j))
#define XB_XGEN(j)  (2304 + 64 * (j))
#define XB_TOP      3328
#define XB_TOPGEN   3392
#define XCD_BAR_WORDS 3456
#define XB_SPIN_CAP (1u << 22)
__device__ __forceinline__ unsigned xb_ld(unsigned* p)              { return __hip_atomic_load(p, __ATOMIC_RELAXED, __HIP_MEMORY_SCOPE_AGENT); }
__device__ __forceinline__ unsigned xb_add(unsigned* p, unsigned v) { return __hip_atomic_fetch_add(p, v, __ATOMIC_RELAXED, __HIP_MEMORY_SCOPE_AGENT); }
__device__ __forceinline__ unsigned xb_xcc_id() { return (unsigned)__builtin_amdgcn_s_getreg((3 << 11) | 20) & 0xFu; }
#define XB_SPIN(cond, bar) do { unsigned _sp = 0; while (cond) { __builtin_amdgcn_s_sleep(1); \
    if ((++_sp & 255u) == 0u) { if (xb_ld(&(bar)[XB_TMO])) break; if (_sp > XB_SPIN_CAP) { atomicAdd(&(bar)[XB_TMO], 1u); break; } } } } while (0)
struct XcdBarrier { unsigned* bar; unsigned x; volatile LAS unsigned* st; };
__device__ __forceinline__ XcdBarrier xcd_barrier_post(unsigned* bar, volatile LAS unsigned* st) {
    XcdBarrier b; b.bar = bar; b.x = xb_xcc_id(); b.st = st;
    if (threadIdx.x == 0) (void)xb_add(&bar[XB_XCNT(b.x)], 1u);
    return b;
}
__device__ __forceinline__ void xcd_barrier_complete(unsigned* bar, unsigned x, unsigned& nloc, unsigned& nx) {
    const unsigned G = gridDim.x * gridDim.y * gridDim.z;
    unsigned sum, cnt, mine, sp = 0u;
    for (;;) {
        sum = 0u; cnt = 0u; mine = 0u;
#pragma unroll
        for (unsigned j = 0; j < 16; ++j) { const unsigned c = xb_ld(&bar[XB_XCNT(j)]); sum += c; cnt += (c > 0u) ? 1u : 0u; mine = (j == x) ? c : mine; }
        if (sum == G) break;
        __builtin_amdgcn_s_sleep(1);
        if ((++sp & 255u) == 0u) { if (xb_ld(&bar[XB_TMO])) break; if (sp > XB_SPIN_CAP) { atomicAdd(&bar[XB_TMO], 1u); break; } }
    }
    nloc = mine > 0u ? mine : 1u; nx = cnt > 0u ? cnt : 1u;
}
__device__ __forceinline__ void xcd_barrier(const XcdBarrier& b, const int tid) {
    asm volatile("s_waitcnt vmcnt(0)" ::: "memory");
    __syncthreads();
    if (tid == 0) {
        unsigned* bar = b.bar;
        __builtin_amdgcn_s_waitcnt(0);
        unsigned nloc = b.st[0], nx = b.st[1];
        if (nloc == 0u) { xcd_barrier_complete(bar, b.x, nloc, nx); b.st[0] = nloc; b.st[1] = nx; }
        const unsigned old = xb_add(&bar[XB_XSUB(b.x)], 1u);
        const unsigned gen = old / nloc;
        if (old + 1u == (gen + 1u) * nloc) {
            __builtin_amdgcn_fence(__ATOMIC_RELEASE, "agent");
            asm volatile("s_waitcnt vmcnt(0)" ::: "memory");
            const unsigned og = xb_add(&bar[XB_TOP], 1u);
            const unsigned tg = og / nx;
            if (og + 1u == (tg + 1u) * nx) xb_add(&bar[XB_TOPGEN], 1u);
            else XB_SPIN(xb_ld(&bar[XB_TOPGEN]) == tg, bar);
            __builtin_amdgcn_fence(__ATOMIC_ACQUIRE, "agent");
            xb_add(&bar[XB_XGEN(b.x)], 1u);
            asm volatile("s_waitcnt vmcnt(0)" ::: "memory");
        } else {
            XB_SPIN(xb_ld(&bar[XB_XGEN(b.x)]) == gen, bar);
            __builtin_amdgcn_fence(__ATOMIC_ACQUIRE, "agent");
            asm volatile("s_waitcnt vmcnt(0)" ::: "memory");
        }
    }
    __syncthreads();
}

#ifndef PHM
#define PHM 1023
#endif
#ifndef PROBE_K
#define PROBE_K -1
#endif
struct Args { const float* in[18]; float* out; unsigned char* ws; int ph_lo, ph_hi; };
typedef const __attribute__((address_space(4))) Args* KArgs;
#define INP(a, i) ((const float*)(const GAS float*)((a)->in[i]))
#define OUTP(a) ((float*)(GAS float*)((a)->out))
enum { I_X = 0, I_C, I_WADA, I_BADA, I_NORMG, I_WIN, I_CAW, I_CAB, I_WRG, I_BRG, I_WIG, I_BIG, I_LAM, I_QG, I_KG, I_CCW, I_WBR, I_WOUT };

__device__ __forceinline__ void transpose_item(const float* W, int ldw, bf16_t* dst, int ldd, LAS float* scr, int lane) {
#pragma unroll 8
    for (int i = 0; i < 32; ++i) { const int kk = 2 * i + (lane >> 5); scr[kk * 33 + (lane & 31)] = W[(size_t)kk * ldw + (lane & 31)]; }
    LDS_WAIT();
    const int c = lane & 7;
#pragma unroll
    for (int j = 0; j < 4; ++j) { const int n = (lane >> 3) + 8 * j; const LAS float* s = scr + (8 * c) * 33 + n;
        u32x4 o; o.x = cvt_pk_bf16(s[0 * 33], s[1 * 33]); o.y = cvt_pk_bf16(s[2 * 33], s[3 * 33]); o.z = cvt_pk_bf16(s[4 * 33], s[5 * 33]); o.w = cvt_pk_bf16(s[6 * 33], s[7 * 33]);
        *(u32x4*)(dst + (size_t)n * ldd + 8 * c) = o; }
    LDS_WAIT();
}

__device__ __forceinline__ void phase_prologue(KArgs a, unsigned char* wsb, LAS unsigned char* lds, int tid, int lane, int wave, int bid, int G) {
    unsigned char* ws = wsb;
    {
        LAS float* red = (LAS float*)lds;
        for (int it = bid; it < 96; it += G) {
            const int l = it / 48, jb = it % 48, j = jb * 64 + lane;
            const float* wa = INP(a, I_WADA) + (size_t)l * 1024 * 3072 + j; const float* c0 = INP(a, I_C); const float* c1 = c0 + 1024;
            float a0 = 0.f, a1 = 0.f; const int kb = wave * 128;
#pragma unroll 16
            for (int k = 0; k < 128; ++k) { const float w = wa[(size_t)(kb + k) * 3072]; a0 += c0[kb + k] * w; a1 += c1[kb + k] * w; }
            red[(wave * 2 + 0) * 64 + lane] = a0; red[(wave * 2 + 1) * 64 + lane] = a1;
            __syncthreads();
            if (tid < 128) { const int bb = tid >> 6; float s = 0.f;
#pragma unroll
                for (int w = 0; w < 8; ++w) s += red[(w * 2 + bb) * 64 + lane];
                ((float*)(ws + WS_MOD))[(l * 2 + bb) * 3072 + j] = s + INP(a, I_BADA)[l * 3072 + j]; }
            __syncthreads();
        }
    }
    {
        float* rc = (float*)(ws + WS_ROPE); float* rs = rc + 320 * 32;
        for (int e = bid * 512 + tid; e < 320 * 32; e += G * 512) {
            const int pos = e >> 5, i = e & 31; const int p = pos < 256 ? pos : pos - 256;
            const float inv = __builtin_amdgcn_exp2f(-((float)(2 * i)) * (13.287712379549449f / 64.0f));
            const float ang = (float)p * inv;
            rc[e] = __cosf(ang); rs[e] = __sinf(ang);
        }
    }
    {
        LAS float* scr = (LAS float*)(lds + 8192 + wave * 12288);
        const int gw = bid * 8 + wave, NGW = G * 8;
        constexpr int I_IN = 2 * 16 * 368, I_G = 1024, I_BR = 3072, I_OUT = 1024, NITEMS = I_IN + I_G + I_BR + I_OUT;
        for (int it = gw; it < NITEMS; it += NGW) {
            int r = it;
            if (r < I_IN) { const int l = r / 5888, q = r % 5888, kb = q / 368, nb = q % 368;
                const int n0 = 32 * nb; int drow = n0;
                if (n0 >= 4608 && n0 < 8704) { const int sec = (n0 - 4608) >> 10, ch = (n0 - 4608) & 1023, blk = ch >> 7;
                    drow = ((sec & 1) ? 26 + blk : 18 + blk) * 256 + ((sec >> 1) ? 128 : 0) + (ch & 127); }
                transpose_item(INP(a, I_WIN) + (size_t)l * 1024 * NIN + (size_t)(64 * kb) * NIN + n0, NIN,
                               (bf16_t*)(ws + WS_WIN) + (size_t)l * NIN * 1024 + (size_t)drow * 1024 + 64 * kb, 1024, scr, lane); continue; }
            r -= I_IN;
            if (r < I_G) { const int mi = r >> 5, sub = r & 31, kb = sub >> 3, nblk = sub & 7;
                const int nb = mi & 3, gate = (mi >> 2) & 1, dir = (mi >> 3) & 1, l = mi >> 4;
                const float* src = (gate ? INP(a, I_WIG) : INP(a, I_WRG)) + (size_t)((l * 2 + dir) * 4 + nb) * 65536 + (size_t)(64 * kb) * 256 + 32 * nblk;
                const int n0 = 32 * nblk, hh = n0 >> 7, pn = (dir * 4 + nb) * 2 + hh, row = pn * 256 + gate * 128 + (n0 & 127);
                transpose_item(src, 256, (bf16_t*)(ws + WS_WG) + (size_t)l * 4096 * 256 + (size_t)row * 256 + 64 * kb, 256, scr, lane); continue; }
            r -= I_G;
            if (r < I_BR) { const int mi = r >> 9, sub = r & 511, kb = sub >> 5, nblk = sub & 31;
                transpose_item(INP(a, I_WBR) + (size_t)mi * 1048576 + (size_t)(64 * kb) * 1024 + 32 * nblk, 1024,
                               (bf16_t*)(ws + WS_WBR) + (size_t)mi * 1048576 + (size_t)(32 * nblk) * 1024 + 64 * kb, 1024, scr, lane); continue; }
            r -= I_BR;
            { const int mi = r >> 9, sub = r & 511, kb = sub >> 5, nblk = sub & 31;
                transpose_item(INP(a, I_WOUT) + (size_t)mi * 1048576 + (size_t)(64 * kb) * 1024 + 32 * nblk, 1024,
                               (bf16_t*)(ws + WS_WOUT) + (size_t)mi * 1048576 + (size_t)(32 * nblk) * 1024 + 64 * kb, 1024, scr, lane); }
        }
    }
}

__device__ __forceinline__ void phase_h(KArgs a, unsigned char* wsb, int l, int b, int lane, int wave, int bid, int G) {
    const float* xin = (l == 0 ? INP(a, I_X) : OUTP(a)) + (size_t)b * SEQ * DM;
    const float* mod = (const float*)(wsb + WS_MOD) + (l * 2 + b) * 3072;
    bf16_t* H = (bf16_t*)(wsb + WS_H);
    f32x4 gs[4], sh[4];
#pragma unroll
    for (int j = 0; j < 4; ++j) { const int col = 4 * lane + 256 * j;
        const f32x4 g = *(const f32x4*)(INP(a, I_NORMG) + l * 1024 + col), sc = *(const f32x4*)(mod + 1024 + col);
        gs[j] = g * (sc + 1.0f); sh[j] = *(const f32x4*)(mod + col); }
    const int gw = bid * 8 + wave, NGW = G * 8;
    for (int m = gw; m < SEQ; m += 2 * NGW) {
        const int m2 = (m + NGW < SEQ) ? m + NGW : m;
        const f32x4* xr = (const f32x4*)(xin + (size_t)m * DM) + lane; const f32x4* xr2 = (const f32x4*)(xin + (size_t)m2 * DM) + lane;
        f32x4 v[4], w[4]; float s = 0.f, s2 = 0.f;
#pragma unroll
        for (int j = 0; j < 4; ++j) { v[j] = xr[64 * j]; w[j] = xr2[64 * j]; }
#pragma unroll
        for (int j = 0; j < 4; ++j) { s += (v[j].x * v[j].x + v[j].y * v[j].y) + (v[j].z * v[j].z + v[j].w * v[j].w); s2 += (w[j].x * w[j].x + w[j].y * w[j].y) + (w[j].z * w[j].z + w[j].w * w[j].w); }
        const float rstd = __builtin_amdgcn_rsqf(wave_sum(s) * (1.f / DM) + EPS), rstd2 = __builtin_amdgcn_rsqf(wave_sum(s2) * (1.f / DM) + EPS);
        u32x2* o8 = (u32x2*)(H + (size_t)m * DM) + lane; u32x2* o82 = (u32x2*)(H + (size_t)m2 * DM) + lane;
#pragma unroll
        for (int j = 0; j < 4; ++j) { const f32x4 o = v[j] * rstd * gs[j] + sh[j]; u32x2 q; q.x = cvt_pk_bf16(o.x, o.y); q.y = cvt_pk_bf16(o.z, o.w); o8[64 * j] = q;
            const f32x4 o2 = w[j] * rstd2 * gs[j] + sh[j]; u32x2 q2; q2.x = cvt_pk_bf16(o2.x, o2.y); q2.y = cvt_pk_bf16(o2.z, o2.w); o82[64 * j] = q2; }
    }
}

__device__ __forceinline__ void ldrow8(const bf16_t* __restrict__ base, int t, int ch, float (&v)[8]) {
    if (t < 0 || t >= SEQ) {
#pragma unroll
        for (int j = 0; j < 8; ++j) v[j] = 0.f;
    } else unpack8(*(const u32x4*)(base + (size_t)t * 1024 + ch), v);
}
__device__ __forceinline__ void ld8f32(const float* p, float (&v)[8]) {
    const f32x4 a = *(const f32x4*)p, b = *(const f32x4*)(p + 4);
    v[0] = a.x; v[1] = a.y; v[2] = a.z; v[3] = a.w; v[4] = b.x; v[5] = b.y; v[6] = b.z; v[7] = b.w;
}

__device__ __forceinline__ void phase_elem(KArgs a, unsigned char* wsb, int l, int lane, int wave, int bid, int G) {
    unsigned char* ws = wsb;
    const int gw = bid * 8 + wave, NGW = G * 8;
    for (int it = gw; it < 2048; it += NGW) {
        const int run = it >> 1, hf = it & 1, ch = hf * 512 + lane * 8, t0 = run * 16;
        {
            const bf16_t* __restrict__ XA = (const bf16_t*)(ws + WS_XA); bf16_t* __restrict__ UA = (bf16_t*)(ws + WS_H);
            float w0[8], w1[8], w2[8], w3[8], bb[8];
            const float* cw = INP(a, I_CAW) + (size_t)l * 4 * 1024 + ch;
            ld8f32(cw, w0); ld8f32(cw + 1024, w1); ld8f32(cw + 2048, w2); ld8f32(cw + 3072, w3); ld8f32(INP(a, I_CAB) + l * 1024 + ch, bb);
            float xm2[8], xm1[8], x0[8], xp1[8];
            ldrow8(XA, t0 - 2, ch, xm2); ldrow8(XA, t0 - 1, ch, xm1); ldrow8(XA, t0, ch, x0);
#pragma unroll
            for (int s = 0; s < 16; ++s) { const int t = t0 + s;
                ldrow8(XA, t + 1, ch, xp1);
                float o[8];
#pragma unroll
                for (int j = 0; j < 8; ++j) o[j] = w0[j] * xm2[j] + w1[j] * xm1[j] + w2[j] * x0[j] + w3[j] * xp1[j] + bb[j];
                *(u32x4*)(UA + (size_t)t * 1024 + ch) = pack8(o);
#pragma unroll
                for (int j = 0; j < 8; ++j) { xm2[j] = xm1[j]; xm1[j] = x0[j]; x0[j] = xp1[j]; } }
        }
        {
            const bf16_t* __restrict__ PP = (const bf16_t*)(ws + WS_XC); const bf16_t* __restrict__ BG = (const bf16_t*)(ws + WS_BC); bf16_t* __restrict__ YC = (bf16_t*)(ws + WS_YC);
            float w0[8], w1[8], w2[8];
            const float* cw = INP(a, I_CCW) + (size_t)l * 3 * 1024 + ch;
            ld8f32(cw, w0); ld8f32(cw + 1024, w1); ld8f32(cw + 2048, w2);
            float pm1[8], p0[8], pp1[8], t1[8];
            ldrow8(PP, t0 - 1, ch, pm1); ldrow8(PP, t0, ch, p0);
#pragma unroll
            for (int s = 0; s < 16; ++s) { const int t = t0 + s;
                ldrow8(PP, t + 1, ch, pp1); ldrow8(BG, t, ch, t1);
                float o[8];
#pragma unroll
                for (int j = 0; j < 8; ++j) o[j] = t1[j] * (w0[j] * pm1[j] + w1[j] * p0[j] + w2[j] * pp1[j]);
                *(u32x4*)(YC + (size_t)t * 1024 + ch) = pack8(o);
#pragma unroll
                for (int j = 0; j < 8; ++j) { pm1[j] = p0[j]; p0[j] = pp1[j]; } }
        }
        {
            bf16_t* Q = (bf16_t*)(ws + WS_Q); bf16_t* Kb = (bf16_t*)(ws + WS_K);
            const float* rc = (const float*)(ws + WS_ROPE); const float* rs = rc + 320 * 32;
            const int d0 = (lane & 15) * 8, i0 = (lane & 3) * 8;
            float qg[8], kg[8];
            ld8f32(INP(a, I_QG) + l * 128 + d0, qg); ld8f32(INP(a, I_KG) + l * 128 + d0, kg);
            const bool second = (lane & 4) != 0;
            const int tokb = run * 16 + hf * 8;
            const int tsel = (d0 < 64) ? 0 : 1;
            u32x4 cur[3]; float cs[8], sn[8];
#define LD_TOK(tok, dst, dcs, dsn) do { const int tp_ = tsel ? 256 + ((tok) & 63) : ((tok) >> 6); ld8f32(rc + tp_ * 32 + i0, dcs); ld8f32(rs + tp_ * 32 + i0, dsn); \
                dst[0] = *(const u32x4*)(Q + (size_t)(tok) * 1024 + lane * 8); dst[1] = *(const u32x4*)(Q + (size_t)(tok) * 1024 + 512 + lane * 8); dst[2] = *(const u32x4*)(Kb + (size_t)(tok) * 256 + (lane & 31) * 8); } while (0)
            LD_TOK(tokb, cur, cs, sn);
#pragma unroll
            for (int i = 0; i < 8; ++i) {
                const int tok = tokb + i;
                u32x4 nx[3]; float ncs[8], nsn[8];
                if (i < 7) LD_TOK(tok + 1, nx, ncs, nsn);
#pragma unroll
                for (int part = 0; part < 3; ++part) {
                    bf16_t* p = (part < 2) ? (Q + (size_t)tok * 1024 + part * 512 + lane * 8) : (Kb + (size_t)tok * 256 + (lane & 31) * 8);
                    float v[8]; unpack8(cur[part], v);
                    float ss = 0.f;
#pragma unroll
                    for (int j = 0; j < 8; ++j) ss += v[j] * v[j];
                    ss += __shfl_xor(ss, 1); ss += __shfl_xor(ss, 2); ss += __shfl_xor(ss, 4); ss += __shfl_xor(ss, 8);
                    const float rstd = __builtin_amdgcn_rsqf(ss * (1.f / 128.f) + EPS);
                    float o[8];
#pragma unroll
                    for (int j = 0; j < 8; ++j) { const float y = v[j] * rstd * (part < 2 ? qg[j] : kg[j]); const float pr = __shfl_xor(y, 4);
                        o[j] = y * cs[j] + (second ? pr : -pr) * sn[j]; }
                    if (part < 2 || lane < 32) *(u32x4*)p = pack8(o);
                    if (part == 2 && lane < 32) {
                        const int kvh = lane >> 4, r = tok & 63, dch = (lane & 15) >> 1;
                        unsigned char* kp = ws + WS_K8 + (size_t)kvh * 2097152 + (size_t)(tok >> 6) * 8192 + r * 128 + 16 * (dch ^ (r & 7)) + (lane & 1) * 8;
                        u32x2 w8; w8.x = (unsigned)pk4_fp8(o[0], o[1], o[2], o[3]); w8.y = (unsigned)pk4_fp8(o[4], o[5], o[6], o[7]); *(u32x2*)kp = w8; }
                }
                if (i < 7) {
#pragma unroll
                    for (int part = 0; part < 3; ++part) cur[part] = nx[part];
#pragma unroll
                    for (int j = 0; j < 8; ++j) { cs[j] = ncs[j]; sn[j] = nsn[j]; } }
            }
#undef LD_TOK
        }
    }
    for (int it = gw; it < 4096; it += NGW) {
        const int jh = it & 1, h = (it >> 1) & 1, dh = (it >> 2) & 1, tile = (it >> 3) & 255, kvh = it >> 11;
        const int d = dh * 64 + lane;
        const bf16_t* __restrict__ V = (const bf16_t*)(ws + WS_V) + (size_t)tile * 64 * 256 + kvh * 128 + d;
        float f[16];
#pragma unroll
        for (int jj = 0; jj < 16; ++jj) { const int key = (jj & 3) + 8 * (jj >> 2) + 4 * h + 32 * jh; f[jj] = bf2f(V[(size_t)key * 256]); }
        u32x4 w; w.x = (unsigned)pk4_fp8(f[0], f[1], f[2], f[3]); w.y = (unsigned)pk4_fp8(f[4], f[5], f[6], f[7]); w.z = (unsigned)pk4_fp8(f[8], f[9], f[10], f[11]); w.w = (unsigned)pk4_fp8(f[12], f[13], f[14], f[15]);
        *(u32x4*)(ws + WS_V8 + (size_t)kvh * 2097152 + (size_t)tile * 8192 + d * 64 + 16 * ((2 * h + jh) ^ ((d >> 2) & 3))) = w;
    }
}

__device__ __forceinline__ void phase_scan_a(KArgs a, unsigned char* wsb, int lane, int wave, int bid, int G) {
    unsigned char* ws = wsb;
    const int gw = bid * 8 + wave, NGW = G * 8;
    for (int it = gw; it < 2048; it += NGW) {
        const int c = it >> 4, dir = (it >> 3) & 1, ch = (it & 7) * 128 + lane * 2;
        const bf16_t* LA = (const bf16_t*)(ws + WS_LA + (size_t)dir * 64 * MiB) + ch;
        const bf16_t* UU = (const bf16_t*)(ws + WS_U + (size_t)dir * 64 * MiB) + ch;
        float s0 = 0.f, s1 = 0.f, h0 = 0.f, h1 = 0.f;
#pragma unroll 16
        for (int st = 0; st < 128; ++st) { const int t = dir == 0 ? c * 128 + st : c * 128 + 127 - st;
            const unsigned wl = *(const unsigned*)(LA + (size_t)t * 1024), wu = *(const unsigned*)(UU + (size_t)t * 1024);
            const float l0 = __uint_as_float(wl << 16), l1 = __uint_as_float(wl & 0xffff0000u);
            const float u0 = __uint_as_float(wu << 16), u1 = __uint_as_float(wu & 0xffff0000u);
            h0 = __builtin_amdgcn_exp2f(l0) * h0 + u0; h1 = __builtin_amdgcn_exp2f(l1) * h1 + u1; s0 += l0; s1 += l1; }
        *(f32x2*)((float*)(ws + WS_SA) + (c * 2 + dir) * 1024 + ch) = (f32x2){s0, s1};
        *(f32x2*)((float*)(ws + WS_SH) + (c * 2 + dir) * 1024 + ch) = (f32x2){h0, h1};
    }
}
__device__ __forceinline__ void phase_scan_c(unsigned char* wsb, LAS unsigned char* lds, int lane, int wave, int bid, int G) {
    unsigned char* ws = wsb;
    const int gw = bid * 8 + wave, NGW = G * 8;
    const float* __restrict__ SA = (const float*)(ws + WS_SA); const float* __restrict__ SH = (const float*)(ws + WS_SH);
    for (int it = gw; it < 2048; it += NGW) {
        const int c = it >> 4, ch = (it & 15) * 64 + lane;
        float cf = 0.f, cb = 0.f;
#pragma unroll 8
        for (int sidx = 0; sidx < c; ++sidx) { const int idx = (sidx * 2) * 1024 + ch; cf = __builtin_amdgcn_exp2f(SA[idx]) * cf + SH[idx]; }
#pragma unroll 8
        for (int sidx = 127; sidx > c; --sidx) { const int idx = (sidx * 2 + 1) * 1024 + ch; cb = __builtin_amdgcn_exp2f(SA[idx]) * cb + SH[idx]; }
        const bf16_t* __restrict__ LAf = (const bf16_t*)(ws + WS_LA) + ch; const bf16_t* __restrict__ UUf = (const bf16_t*)(ws + WS_U) + ch;
        const bf16_t* __restrict__ LAb = (const bf16_t*)(ws + WS_LA + 64 * MiB) + ch; const bf16_t* __restrict__ UUb = (const bf16_t*)(ws + WS_U + 64 * MiB) + ch;
        const bf16_t* __restrict__ SGA = (const bf16_t*)(ws + WS_SGA) + ch; bf16_t* __restrict__ YA = (bf16_t*)(ws + WS_XA) + ch;
        LAS bf16_t* hfs = (LAS bf16_t*)(lds + wave * 16384) + lane;
        float h = cf;
        { const bf16_t* pl = LAf + (size_t)c * 128 * 1024; const bf16_t* pu = UUf + (size_t)c * 128 * 1024;
#pragma unroll 1
            for (int blk = 0; blk < 8; ++blk) {
                float l[16], u[16];
#pragma unroll
                for (int i = 0; i < 16; ++i) { l[i] = bf2f(pl[i * 1024]); u[i] = bf2f(pu[i * 1024]); }
#pragma unroll
                for (int i = 0; i < 16; ++i) { h = __builtin_amdgcn_exp2f(l[i]) * h + u[i]; hfs[(blk * 16 + i) * 64] = (bf16_t)f2bf(h); }
                pl += 16 * 1024; pu += 16 * 1024; } }
        h = cb;
        { const size_t e0 = (size_t)(c * 128 + 112) * 1024;
            const bf16_t* pl = LAb + e0; const bf16_t* pu = UUb + e0; const bf16_t* pg = SGA + e0; bf16_t* py = YA + e0;
#pragma unroll 1
            for (int blk = 7; blk >= 0; --blk) {
                float l[16], u[16], g[16];
#pragma unroll
                for (int i = 0; i < 16; ++i) { l[i] = bf2f(pl[i * 1024]); u[i] = bf2f(pu[i * 1024]); g[i] = bf2f(pg[i * 1024]); }
#pragma unroll
                for (int i = 15; i >= 0; --i) { h = __builtin_amdgcn_exp2f(l[i]) * h + u[i];
                    py[i * 1024] = (bf16_t)f2bf((bf2f(hfs[(blk * 16 + i) * 64]) + h) * g[i]); }
                pl -= 16 * 1024; pu -= 16 * 1024; pg -= 16 * 1024; py -= 16 * 1024; } }
    }
}

__global__ void __launch_bounds__(512, 2) mk_fwd(Args args) {
    extern __shared__ __attribute__((aligned(16))) unsigned char lds[];
    cg::grid_group grid = cg::this_grid();
    LAS unsigned char* L = (LAS unsigned char*)lds;
    if (threadIdx.x < 2) ((LAS unsigned*)(L + 131072))[threadIdx.x] = 0u;
    __syncthreads();
    (void)xcd_barrier_post((unsigned*)(args.ws + WS_BAR), (volatile LAS unsigned*)(L + 131072));
    const int wave_u = __builtin_amdgcn_readfirstlane(threadIdx.x >> 6);
    for (int ph = args.ph_lo; ph < args.ph_hi; ++ph) {
        int tid; { int ln_; asm volatile("v_mbcnt_lo_u32_b32 %0, -1, 0\n\tv_mbcnt_hi_u32_b32 %0, -1, %0" : "=v"(ln_)); tid = wave_u * 64 + ln_; }
        int G = gridDim.x, bid = blockIdx.x; asm volatile("" : "+s"(G), "+s"(bid));
        KArgs ap = (KArgs)__builtin_amdgcn_kernarg_segment_ptr(); asm volatile("" : "+s"(ap));
        GAS unsigned char* wsg = (GAS unsigned char*)ap->ws; asm volatile("" : "+s"(wsg));
        unsigned char* ws = (unsigned char*)wsg;
        const int lane = tid & 63, wave = __builtin_amdgcn_readfirstlane(tid >> 6);
        unsigned long long pt0 = 0; int pcls = -1; if (PROBE_K >= 0) pt0 = __builtin_amdgcn_s_memrealtime();
        if (ph == 0) { pcls = 8; if (PHM & 512) phase_prologue(ap, ws, L, tid, lane, wave, bid, G); }
        else {
            const int q = ph - 1, lb = q / NPH_PER, k = q - lb * NPH_PER, l = lb >> 1, b = lb & 1; pcls = k;
            if (k == 0) { if (PHM & 1) phase_h(ap, ws, l, b, lane, wave, bid, G); }
            else if (k == 1) { if (PHM & 2) {
                pg8::Gemm g{(const bf16_t*)(ws + WS_H), (const bf16_t*)(ws + WS_WIN) + (size_t)l * NIN * 1024, 1024, 1024, 1024, 0, 0};
                pg8::StaticOrder S; S.init(SEQ, NIN, G, bid);
                pg8::EpiInProj E{ws};
                pg8::gemm_phase<pg8::EpiInProj, pg8::StaticOrder, 0>(L, g, S, E, tid); }
            } else if (k == 2) { if (PHM & 4) phase_elem(ap, ws, l, lane, wave, bid, G); }
            else if (k == 3) {
                if (PHM & 8) {
                    pg8::Gemm g{(const bf16_t*)(ws + WS_H), (const bf16_t*)(ws + WS_WG) + (size_t)l * 4096 * 256, 1024, 256, 256, 0, 0};
                    pg8::StaticOrder S; S.init(SEQ, 4096, G, bid);
                    pg8::EpiGates E{ws, INP(ap, I_BRG) + l * 2048, INP(ap, I_BIG) + l * 2048, INP(ap, I_LAM) + l * 2048};
                    pg8::gemm_phase<pg8::EpiGates, pg8::StaticOrder, 1>(L, g, S, E, tid);
                }
                if (PROBE_K == 3) { const unsigned long long t1 = __builtin_amdgcn_s_memrealtime(), dt = t1 - pt0; while (__builtin_amdgcn_s_memrealtime() - t1 < dt) __builtin_amdgcn_s_sleep(8); }
                if (PROBE_K == 9) { pt0 = __builtin_amdgcn_s_memrealtime(); pcls = 9; }
                if (PHM & 256) {
                    const int v = (G % 8 == 0) ? (bid % 8) * (G / 8) + bid / 8 : bid;
                    const int per = (512 + G - 1) / G;
                    if (PROBE_F8 && l == 0 && b == 0) {
                        for (int i = 0; i < per; ++i) { const int idx = v * per + i; if (idx >= 4) break;
                            const int h = idx >> 6, qb = idx & 63, kvh = h >> 2;
                            const attn::bf16* Qb = (const attn::bf16*)(ws + WS_Q) + (size_t)qb * 256 * 1024 + h * 128;
                            const bf16_t* Gb = (const bf16_t*)(ws + WS_SGB) + (size_t)qb * 256 * 1024 + h * 128;
                            attn::attn_pp8_body(Qb, ws + WS_K8 + (size_t)kvh * 2097152, ws + WS_V8 + (size_t)kvh * 2097152, (bf16_t*)(ws + WS_SPARE) + (size_t)idx * 256 * 1024, nullptr, SEQ, (char*)lds, tid);
                        }
                    }
                    int tid2 = tid; asm volatile("" : "+v"(tid2));
                    for (int i = 0; i < per; ++i) { const int idx = v * per + i; if (idx >= 512) break;
                        const int h = idx >> 6, qb = idx & 63, kvh = h >> 2;
                        const attn::bf16* Qb = (const attn::bf16*)(ws + WS_Q) + (size_t)qb * 256 * 1024 + h * 128;
                        bf16_t* Ob = (bf16_t*)(ws + WS_SGB) + (size_t)qb * 256 * 1024 + h * 128;
                        const bf16_t* Gb = (const bf16_t*)(ws + WS_SGB) + (size_t)qb * 256 * 1024 + h * 128;
                        if (PROBE_F8) {
                            const attn::bf16* Kh = (const attn::bf16*)(ws + WS_K) + kvh * 128;
                            const attn::bf16* Vh = (const attn::bf16*)(ws + WS_V) + kvh * 128;
                            const bf16_t* cmp = (l == 0 && b == 0 && idx < 4) ? (const bf16_t*)(ws + WS_SPARE) + (size_t)idx * 256 * 1024 : nullptr;
                            attn::attn_pp_body(Qb, Kh, Vh, Ob, Gb, SEQ, (char*)lds, tid2, cmp, (unsigned*)(ws + WS_FLAG));
                        } else attn::attn_pp8_body(Qb, ws + WS_K8 + (size_t)kvh * 2097152, ws + WS_V8 + (size_t)kvh * 2097152, Ob, Gb, SEQ, (char*)lds, tid2);
                    }
                }
            } else if (k == 4) { if (PHM & 16) phase_scan_a(ap, ws, lane, wave, bid, G); }
            else if (k == 5) { if (PHM & 32) phase_scan_c(ws, L, lane, wave, bid, G); }
            else if (k == 6) { if (PHM & 64) {
                pg8::Gemm g{(const bf16_t*)(ws + WS_XA), (const bf16_t*)(ws + WS_WBR) + (size_t)l * 3 * 1048576, 1024, 1024, 1024,
                            (long)WS_SGB - (long)WS_XA, (long)WS_YC - (long)WS_XA};
                pg8::BranchOrder S; S.so.init(SEQ, 1024, G, bid);
                pg8::EpiBranch E{ws};
                pg8::gemm_phase<pg8::EpiBranch, pg8::BranchOrder, 2>(L, g, S, E, tid); }
            } else if (PHM & 128) {
                pg8::Gemm g{(const bf16_t*)(ws + WS_SGA), (const bf16_t*)(ws + WS_WOUT) + (size_t)l * 1048576, 1024, 1024, 1024, 0, 0};
                pg8::StaticOrder S; S.init(SEQ, 1024, G, bid);
                const float* xi = (l == 0 ? INP(ap, I_X) : OUTP(ap)) + (size_t)b * SEQ * DM;
                pg8::EpiOut E{xi, OUTP(ap) + (size_t)b * SEQ * DM, (const float*)(ws + WS_MOD) + (l * 2 + b) * 3072 + 2048, (const unsigned*)(ws + WS_FLAG)};
                pg8::gemm_phase<pg8::EpiOut, pg8::StaticOrder, 0>(L, g, S, E, tid);
            }
        }
        if (PROBE_K >= 0 && PROBE_K != 3 && ph + 1 == args.ph_hi && pcls == PROBE_K) { VM_WAIT(); __syncthreads(); const unsigned long long t1 = __builtin_amdgcn_s_memrealtime(), dt = t1 - pt0; while (__builtin_amdgcn_s_memrealtime() - t1 < dt) __builtin_amdgcn_s_sleep(8); }
        if (ph + 1 < args.ph_hi) { if (ph == args.ph_lo) grid.sync(); else { XcdBarrier xbar; xbar.bar = (unsigned*)(ws + WS_BAR); xbar.x = xb_xcc_id(); xbar.st = (volatile LAS unsigned*)(L + 131072); xcd_barrier(xbar, tid); }
            if (PROBE_K >= 0 && PROBE_K != 3 && pcls == PROBE_K) { const unsigned long long t1 = __builtin_amdgcn_s_memrealtime(), dt = t1 - pt0; while (__builtin_amdgcn_s_memrealtime() - t1 < dt) __builtin_amdgcn_s_sleep(8); } }
    }
}

extern "C" void kernel_launch(void* const* d_in, const int* in_sizes, int n_in, void* d_out, int out_size, void* d_ws, size_t ws_size, hipStream_t stream) {
    static int grid = 0;
    if (grid == 0) {
        if (n_in != 18 || ws_size < WS_END) { fprintf(stderr, "kernel_launch: need 18 inputs and >= %zu bytes of workspace (got %d, %zu)\n", (size_t)WS_END, n_in, ws_size); grid = -1; return; }
        int dev = 0, cus = 0, per_cu = 0;
        hipGetDevice(&dev);
        hipDeviceGetAttribute(&cus, hipDeviceAttributeMultiprocessorCount, dev);
        if (hipFuncSetAttribute((const void*)mk_fwd, hipFuncAttributeMaxDynamicSharedMemorySize, LDS_BYTES) != hipSuccess) { fprintf(stderr, "kernel_launch: hipFuncSetAttribute failed\n"); grid = -1; return; }
        if (hipOccupancyMaxActiveBlocksPerMultiprocessor(&per_cu, (const void*)mk_fwd, 512, LDS_BYTES) != hipSuccess || per_cu < 1) { fprintf(stderr, "kernel_launch: occupancy query gave %d\n", per_cu); per_cu = 1; }
        (void)hipGetLastError();
        grid = cus * 1;
    }
    if (grid < 0) return;
    if (hipMemsetAsync((char*)d_ws + WS_BAR, 0, 16384, stream) != hipSuccess) { fprintf(stderr, "kernel_launch: memset failed\n"); return; }
    Args a{};
    for (int i = 0; i < 18; ++i) a.in[i] = (const float*)d_in[i];
    a.out = (float*)d_out; a.ws = (unsigned char*)d_ws; a.ph_lo = 0; a.ph_hi = NPHASES;
    void* kargs[] = {&a};
    hipError_t e = hipLaunchCooperativeKernel((const void*)mk_fwd, dim3(grid), dim3(512), kargs, LDS_BYTES, stream);
    if (e != hipSuccess) fprintf(stderr, "kernel_launch: cooperative launch failed: %s (grid %d)\n", hipGetErrorString(e), grid);
}
```

```cpp
#include <hip/hip_runtime.h>
#include <hip/hip_cooperative_groups.h>
#include <hip/hip_bf16.h>
#include <cstdio>
#include <cstdint>
namespace cg = cooperative_groups;
#ifndef PROBE_F8
#define PROBE_F8 0
#endif

#define LAS __attribute__((address_space(3)))
#define GAS __attribute__((address_space(1)))
typedef unsigned short bf16_t;
typedef short bf16x8 __attribute__((ext_vector_type(8)));
typedef float f32x4 __attribute__((ext_vector_type(4)));
typedef float f32x2 __attribute__((ext_vector_type(2)));
typedef unsigned u32x4 __attribute__((ext_vector_type(4)));
typedef unsigned u32x2 __attribute__((ext_vector_type(2)));

constexpr int DM = 1024, SEQ = 16384, NBATCH = 2, DEPTH = 2, NIN = 11776;
constexpr int NPH_PER = 8, NPHASES = 1 + DEPTH * NBATCH * NPH_PER;
constexpr float EPS = 1e-6f;
constexpr float LOG2E = 1.4426950408889634f;

constexpr size_t MiB = 1u << 20;
constexpr size_t WS_MOD = 0;
constexpr size_t WS_ROPE = 64 * 1024;
constexpr size_t WS_BAR = 256 * 1024;
constexpr size_t WS_SA = 1 * MiB, WS_SH = 2 * MiB;
constexpr size_t WS_WIN = 4 * MiB, WS_WG = 50 * MiB, WS_WBR = 54 * MiB, WS_WOUT = 66 * MiB;
constexpr size_t WS_H = 70 * MiB;
constexpr size_t WS_XA = 102 * MiB;
constexpr size_t WS_SGA = 134 * MiB;
constexpr size_t WS_Q = 166 * MiB;
constexpr size_t WS_K = 198 * MiB, WS_V = 206 * MiB;
constexpr size_t WS_SGB = 214 * MiB;
constexpr size_t WS_XC = 246 * MiB, WS_BC = 278 * MiB, WS_CC = 310 * MiB, WS_SGC = 342 * MiB;
constexpr size_t WS_LA = WS_XC, WS_U = WS_BC;
constexpr size_t WS_SMG = 374 * MiB;
constexpr size_t WS_YC = 470 * MiB;
constexpr size_t WS_K8 = 502 * MiB, WS_V8 = 506 * MiB;
constexpr size_t WS_SPARE = 510 * MiB;
constexpr size_t WS_FLAG = WS_BAR + 15 * 1024;
constexpr size_t WS_END = 512 * MiB;
constexpr int LDS_BYTES = 131072 + 1024;

__device__ __forceinline__ float bf2f(bf16_t v) { return __uint_as_float((unsigned)v << 16); }
__device__ __forceinline__ unsigned f2bf(float f) { unsigned u = __float_as_uint(f); return (u + 0x7fffu + ((u >> 16) & 1u)) >> 16; }
__device__ __forceinline__ unsigned cvt_pk_bf16(float lo, float hi) { unsigned r; asm("v_cvt_pk_bf16_f32 %0, %1, %2" : "=v"(r) : "v"(lo), "v"(hi)); return r; }
__device__ __forceinline__ void unpack8(const u32x4 w, float (&f)[8]) {
#pragma unroll
    for (int i = 0; i < 4; ++i) { f[2 * i] = __uint_as_float(w[i] << 16); f[2 * i + 1] = __uint_as_float(w[i] & 0xffff0000u); }
}
__device__ __forceinline__ u32x4 pack8(const float (&f)[8]) {
    u32x4 w; w.x = cvt_pk_bf16(f[0], f[1]); w.y = cvt_pk_bf16(f[2], f[3]); w.z = cvt_pk_bf16(f[4], f[5]); w.w = cvt_pk_bf16(f[6], f[7]); return w;
}
typedef int i32x8 __attribute__((ext_vector_type(8)));
__device__ __forceinline__ int pk4_fp8(float a, float b, float c, float d) { int r = __builtin_amdgcn_cvt_pk_fp8_f32(a, b, 0, false); return __builtin_amdgcn_cvt_pk_fp8_f32(c, d, r, true); }
__device__ __forceinline__ float sigmoidf_(float v) { return __builtin_amdgcn_rcpf(1.f + __expf(-v)); }
__device__ __forceinline__ float wave_sum(float v) {
#pragma unroll
    for (int o = 1; o < 64; o <<= 1) v += __shfl_xor(v, o);
    return v;
}
#define LDS_WAIT() asm volatile("s_waitcnt lgkmcnt(0)" ::: "memory")
#define VM_WAIT() asm volatile("s_waitcnt vmcnt(0)" ::: "memory")

namespace pg8 {
constexpr int BM = 256, BK = 64, HALF = 128, HTB = HALF * BK * 2, STAGE_BYTES = 8 * HTB, NXCD = 8, WGM = 8;
__device__ __forceinline__ int lds_byte(int r, int c) { const int st = (r >> 4) * 2 + (c >> 5), rr = r & 15, cc = c & 31, ob = rr * 64 + cc * 2; return st * 1024 + (ob ^ (((ob >> 9) & 1) << 5)); }
__device__ __forceinline__ void stage_rc(int b, int& R, int& C) { const int st = b / 1024, sb = b % 1024, swz = sb ^ (((sb >> 9) & 1) << 5); R = (st >> 1) * 16 + swz / 64; C = (st & 1) * 32 + (swz % 64) / 2; }
__device__ __forceinline__ int perm32(int rho) { const int n = rho >> 4, i = rho & 15; return 8 * (i >> 2) + 4 * n + (i & 3); }

struct Unit { int pm, pn, kk; };
struct Gemm { const bf16_t* A; const bf16_t* Bt; int lda, ldb, K; long a1, a2; };

struct StaticOrder {
    int nM, nN, nwg, G, c;
    __device__ void init(int M, int N, int G_, int c_) { nM = M / BM; nN = N / BM; nwg = nM * nN; G = G_; c = c_; }
    __device__ bool next(int i, Unit& u) const {
        const long L = (long)i * G + c; if (L >= nwg) return false;
        int wgid = (int)L; { const int q = nwg / NXCD, r = nwg % NXCD, xcd = wgid % NXCD, off = wgid / NXCD; wgid = (xcd < r ? xcd * (q + 1) : r * (q + 1) + (xcd - r) * q) + off; }
        const int nig = WGM * nN, gid = wgid / nig, fm = gid * WGM, gsz = (nM - fm) < WGM ? (nM - fm) : WGM;
        u.pm = fm + ((wgid % nig) % gsz); u.pn = (wgid % nig) / gsz; u.kk = 0; return true;
    }
};
struct BranchOrder {
    StaticOrder so;
    __device__ bool next(int i, Unit& u) const { const int ti = i / 3, kk = i - 3 * ti; if (!so.next(ti, u)) return false; u.kk = kk; return true; }
};

template <int MODE> __device__ __forceinline__ const char* unitA(const Gemm& g, const Unit& u) {
    const char* p = (const char*)g.A + (size_t)u.pm * BM * g.lda * 2;
    if (MODE == 1) p += (((u.pn >> 1) & 3) * 256) * 2;
    if (MODE == 2) p += (u.kk == 1 ? g.a1 : (u.kk == 2 ? g.a2 : 0l));
    return p;
}
template <int MODE> __device__ __forceinline__ const char* unitB(const Gemm& g, const Unit& u) {
    const char* p = (const char*)g.Bt + (size_t)u.pn * BM * g.ldb * 2;
    if (MODE == 2) p += (size_t)u.kk * 1024 * 1024 * 2;
    return p;
}

template <class Epi, class Sched, int MODE>
__device__ __forceinline__ void gemm_phase(LAS unsigned char* lds, const Gemm g, const Sched& S, const Epi& E, const int tid) {
    const int wid = __builtin_amdgcn_readfirstlane(tid >> 6), lane = tid & 63, wr = wid >> 2, wc = wid & 3, fr = lane & 15, fq = lane >> 4;
    const int K = g.K, nt = K / BK;
    unsigned voffA[2], voffB[2];
#pragma unroll
    for (int i = 0; i < 2; ++i) { int R, C; stage_rc(tid * 16 + i * 8192, R, C); const int Rb = (R & ~31) + perm32(R & 31);
        voffA[i] = (unsigned)(R * g.lda + C) * 2u; voffB[i] = (unsigned)(Rb * g.ldb + C) * 2u; }
    const size_t kstep = (size_t)(BK * 2);
    const size_t hstepA = (size_t)HALF * g.lda * 2, hstepB = (size_t)HALF * g.ldb * 2;
    const unsigned ldsw = (unsigned)wid * 1024u;
    const int aoff = lds_byte(wr * 64 + fr, fq * 8), boff = lds_byte(wc * 32 + fr, fq * 8);
#define PG8_SA(b, h) (((b) * 2 + (h)) * HTB)
#define PG8_SB(b, h) ((4 + (b) * 2 + (h)) * HTB)
#define PG8_STAGE(bufoff, gbase, voff) do { _Pragma("unroll") for (int _i = 0; _i < 2; ++_i) \
        __builtin_amdgcn_global_load_lds((const unsigned*)((const char*)(gbase) + (voff)[_i]), (LAS unsigned*)(lds + (bufoff) + ldsw + _i * 8192), 16, 0, 0); } while (0)
#define PG8_LDA(dst, b, h) do { _Pragma("unroll") for (int m = 0; m < 4; ++m) _Pragma("unroll") for (int k = 0; k < 2; ++k) dst[m][k] = *(const LAS bf16x8*)(lds + PG8_SA(b, h) + aoff + m * 2048 + k * 1024); } while (0)
#define PG8_LDB(dst, b, h) do { _Pragma("unroll") for (int n = 0; n < 2; ++n) _Pragma("unroll") for (int k = 0; k < 2; ++k) dst[n][k] = *(const LAS bf16x8*)(lds + PG8_SB(b, h) + boff + n * 2048 + k * 1024); } while (0)
#define PG8_MMA(ai, bj, At, Bt) do { __builtin_amdgcn_s_setprio(1); _Pragma("unroll") for (int m = 0; m < 4; ++m) _Pragma("unroll") for (int n = 0; n < 2; ++n) _Pragma("unroll") for (int k = 0; k < 2; ++k) \
        acc[ai][bj][m][n] = __builtin_amdgcn_mfma_f32_16x16x32_bf16(Bt[n][k], At[m][k], acc[ai][bj][m][n], 0, 0, 0); __builtin_amdgcn_s_setprio(0); } while (0)
#define PG8_WAIT_V(n) asm volatile("s_waitcnt vmcnt(" #n ")" ::: "memory")
#define PG8_WAIT_L(n) asm volatile("s_waitcnt lgkmcnt(" #n ")" ::: "memory")
#define PG8_BAR __builtin_amdgcn_s_barrier()
#define PG8_SCHED __builtin_amdgcn_sched_barrier(0)
    Unit cur, nxt; int ui = 0;
    if (!S.next(0, cur)) return;
    f32x4 acc[2][2][4][2];
#pragma unroll
    for (int a = 0; a < 2; ++a)
#pragma unroll
        for (int b = 0; b < 2; ++b)
#pragma unroll
            for (int m = 0; m < 4; ++m)
#pragma unroll
                for (int n = 0; n < 2; ++n) acc[a][b][m][n] = (f32x4){0.f, 0.f, 0.f, 0.f};
    bf16x8 At[4][2], B0[2][2], B1[2][2];
    const char* cA = unitA<MODE>(g, cur); const char* cB = unitB<MODE>(g, cur);
    PG8_STAGE(PG8_SB(0, 0), cB, voffB); PG8_STAGE(PG8_SB(0, 1), cB + hstepB, voffB); PG8_STAGE(PG8_SA(0, 0), cA, voffA); PG8_STAGE(PG8_SA(0, 1), cA + hstepA, voffA);
    if (wr == 1) PG8_BAR;
    PG8_WAIT_V(2); PG8_BAR;
    PG8_STAGE(PG8_SB(1, 0), cB + kstep, voffB); PG8_STAGE(PG8_SA(1, 0), cA + kstep, voffA); PG8_STAGE(PG8_SB(1, 1), cB + hstepB + kstep, voffB);
    PG8_WAIT_V(6); PG8_BAR;
    for (;;) {
        const bool has_next = S.next(ui + 1, nxt);
        const char* nA = has_next ? unitA<MODE>(g, nxt) : cA; const char* nB = has_next ? unitB<MODE>(g, nxt) : cB;
#pragma nounroll
        for (int t = 0; t < nt; t += 2) {
            const bool last = (t == nt - 2);
            const char* a1 = cA + (size_t)(t + 1) * kstep;
            const char* a2 = last ? nA : cA + (size_t)(t + 2) * kstep; const char* b2 = last ? nB : cB + (size_t)(t + 2) * kstep;
            const char* a3 = a2 + kstep; const char* b3 = b2 + kstep;
            PG8_LDB(B0, 0, 0); PG8_LDB(B1, 0, 1); PG8_SCHED; PG8_LDA(At, 0, 0); PG8_STAGE(PG8_SA(1, 1), a1 + hstepA, voffA);
            PG8_WAIT_V(8); PG8_WAIT_L(0); PG8_BAR; PG8_MMA(0, 0, At, B0); PG8_MMA(0, 1, At, B1); PG8_BAR; PG8_SCHED;
            PG8_LDA(At, 0, 1); PG8_STAGE(PG8_SB(0, 0), b2, voffB); PG8_STAGE(PG8_SB(0, 1), b2 + hstepB, voffB); PG8_STAGE(PG8_SA(0, 0), a2, voffA);
            PG8_WAIT_V(8); PG8_WAIT_L(0); PG8_BAR; PG8_MMA(1, 0, At, B0); PG8_MMA(1, 1, At, B1); PG8_BAR; PG8_SCHED;
            PG8_LDB(B0, 1, 0); PG8_LDB(B1, 1, 1); PG8_SCHED; PG8_LDA(At, 1, 0); PG8_STAGE(PG8_SA(0, 1), a2 + hstepA, voffA);
            PG8_WAIT_V(8); PG8_WAIT_L(0); PG8_BAR; PG8_MMA(0, 0, At, B0); PG8_MMA(0, 1, At, B1); PG8_BAR; PG8_SCHED;
            PG8_LDA(At, 1, 1); PG8_STAGE(PG8_SB(1, 0), b3, voffB); PG8_STAGE(PG8_SB(1, 1), b3 + hstepB, voffB); PG8_STAGE(PG8_SA(1, 0), a3, voffA);
            PG8_WAIT_V(8); PG8_WAIT_L(0); PG8_BAR; PG8_MMA(1, 0, At, B0); PG8_MMA(1, 1, At, B1); PG8_BAR; PG8_SCHED;
        }
        if (wr == 0) PG8_BAR;
        E(acc, cur, wr, wc, fr, fq);
        if (!has_next) break;
#pragma unroll
        for (int a = 0; a < 2; ++a)
#pragma unroll
            for (int b = 0; b < 2; ++b)
#pragma unroll
                for (int m = 0; m < 4; ++m)
#pragma unroll
                    for (int n = 0; n < 2; ++n) acc[a][b][m][n] = (f32x4){0.f, 0.f, 0.f, 0.f};
        cur = nxt; cA = nA; cB = nB; ++ui;
        if (wr == 1) PG8_BAR;
    }
    PG8_WAIT_V(0);
    PG8_BAR;
#undef PG8_SA
#undef PG8_SB
#undef PG8_STAGE
#undef PG8_LDA
#undef PG8_LDB
#undef PG8_MMA
#undef PG8_WAIT_V
#undef PG8_WAIT_L
#undef PG8_BAR
#undef PG8_SCHED
}

__device__ __forceinline__ void store_tile_bf16(const f32x4 (&acc)[2][2][4][2], bf16_t* base, int ldc, int row0, int col0, int act) {
#pragma unroll
    for (int ai = 0; ai < 2; ++ai)
#pragma unroll
        for (int m = 0; m < 4; ++m) { bf16_t* rowp = base + (size_t)(row0 + ai * HALF + m * 16) * ldc + col0;
#pragma unroll
            for (int bj = 0; bj < 2; ++bj) { float v[8];
#pragma unroll
                for (int j = 0; j < 4; ++j) { v[j] = acc[ai][bj][m][0][j]; v[4 + j] = acc[ai][bj][m][1][j]; }
                if (act != 0) {
                    float sg[8];
#pragma unroll
                    for (int j = 0; j < 8; ++j) sg[j] = sigmoidf_(v[j]);
                    if (act == 1) {
#pragma unroll
                        for (int j = 0; j < 8; ++j) v[j] *= sg[j];
                    } else {
#pragma unroll
                        for (int j = 0; j < 8; ++j) v[j] = sg[j];
                    }
                }
                *(u32x4*)(rowp + bj * HALF) = pack8(v); }
            asm volatile("" ::: "memory"); }
}
struct EpiInProj {
    unsigned char* ws;
    __device__ __forceinline__ void operator()(const f32x4 (&acc)[2][2][4][2], const Unit& u, int wr, int wc, int fr, int fq) const {
        const int pn = u.pn; size_t off; int ldc = 1024, col, act = 0;
        if (pn < 4) { off = WS_XA; col = pn * 256; }
        else if (pn < 8) { off = WS_SGA; col = (pn - 4) * 256; act = 1; }
        else if (pn < 12) { off = WS_Q; col = (pn - 8) * 256; }
        else if (pn == 12) { off = WS_K; col = 0; ldc = 256; }
        else if (pn == 13) { off = WS_V; col = 0; ldc = 256; }
        else if (pn < 18) { off = WS_SGB; col = (pn - 14) * 256; act = 1; }
        else if (pn < 34) {
            const bool bg = pn >= 26; const int blk = bg ? pn - 26 : pn - 18;
            bf16_t* basep = (bf16_t*)(ws + (bg ? WS_BC : WS_XC));
            const int row0p = u.pm * BM + wr * 64 + fr, col0p = blk * 128 + wc * 32 + 8 * fq;
#pragma unroll
            for (int ai = 0; ai < 2; ++ai)
#pragma unroll
                for (int m = 0; m < 4; ++m) { float v[8];
#pragma unroll
                    for (int j = 0; j < 8; ++j) { const float x0 = acc[ai][0][m][j >> 2][j & 3], x1 = acc[ai][1][m][j >> 2][j & 3];
                        v[j] = bg ? x0 * (x1 * sigmoidf_(x1)) : x0 * x1; }
                    *(u32x4*)(basep + (size_t)(row0p + ai * HALF + m * 16) * 1024 + col0p) = pack8(v); }
            return; }
        else { off = WS_SMG; col = (pn - 34) * 256; ldc = 3072; act = 2; }
        bf16_t* base = (bf16_t*)(ws + off);
        const int row0 = u.pm * BM + wr * 64 + fr, col0 = col + wc * 32 + 8 * fq;
        store_tile_bf16(acc, base, ldc, row0, col0, act);
    }
};
struct EpiGates {
    unsigned char* ws; const float* b_r; const float* b_i; const float* lam;
    __device__ __forceinline__ void operator()(const f32x4 (&acc)[2][2][4][2], const Unit& u, int wr, int wc, int fr, int fq) const {
        const int dir = u.pn >> 3, nb = (u.pn >> 1) & 3, hh = u.pn & 1;
        const int ch0 = nb * 256 + hh * 128 + wc * 32 + 8 * fq;
        float br[8], bi[8], sp[8];
#pragma unroll
        for (int j = 0; j < 8; ++j) { br[j] = b_r[dir * 1024 + ch0 + j]; bi[j] = b_i[dir * 1024 + ch0 + j];
            const float lm = lam[dir * 1024 + ch0 + j]; const float e = __expf(-lm);
            const float spl = lm < -15.f ? -lm : (e < 0.03f ? e * (1.f - e * (0.5f - e * (0.33333334f - 0.25f * e))) : __logf(1.f + e));
            sp[j] = -8.0f * LOG2E * spl; }
        const bf16_t* UA = (const bf16_t*)(ws + WS_H);
        bf16_t* LA = (bf16_t*)(ws + WS_LA + (size_t)dir * 64 * MiB);
        bf16_t* UU = (bf16_t*)(ws + WS_U + (size_t)dir * 64 * MiB);
        const int row0 = u.pm * BM + wr * 64 + fr;
#pragma unroll
        for (int ai = 0; ai < 2; ++ai)
#pragma unroll
            for (int m = 0; m < 4; ++m) { const size_t o = (size_t)(row0 + ai * HALF + m * 16) * 1024 + ch0;
                float x[8]; unpack8(*(const u32x4*)(UA + o), x);
                float la[8], uu[8];
#pragma unroll
                for (int j = 0; j < 8; ++j) { const float pr = acc[ai][0][m][j >> 2][j & 3] + br[j], pi = acc[ai][1][m][j >> 2][j & 3] + bi[j];
                    const float r = sigmoidf_(pr), ig = sigmoidf_(pi);
                    const float l2 = r * sp[j]; const float a = __builtin_amdgcn_exp2f(l2);
                    la[j] = l2; uu[j] = __builtin_amdgcn_sqrtf(fmaxf(1.f - a * a, 0.f)) * ig * x[j]; }
                *(u32x4*)(LA + o) = pack8(la); *(u32x4*)(UU + o) = pack8(uu); }
    }
};
struct EpiBranch {
    unsigned char* ws;
    __device__ __forceinline__ void operator()(const f32x4 (&acc)[2][2][4][2], const Unit& u, int wr, int wc, int fr, int fq) const {
        const bf16_t* G = (const bf16_t*)(ws + WS_SMG) + u.kk * 1024;
        bf16_t* Mg = (bf16_t*)(ws + WS_SGA);
        const int row0 = u.pm * BM + wr * 64 + fr, col0 = u.pn * BM + wc * 32 + 8 * fq;
#pragma unroll
        for (int ai = 0; ai < 2; ++ai)
#pragma unroll
            for (int m = 0; m < 4; ++m) { const int row = row0 + ai * HALF + m * 16;
#pragma unroll
                for (int bj = 0; bj < 2; ++bj) { const int col = col0 + bj * HALF;
                    float gt[8], v[8]; unpack8(*(const u32x4*)(G + (size_t)row * 3072 + col), gt);
#pragma unroll
                    for (int j = 0; j < 8; ++j) v[j] = gt[j] * acc[ai][bj][m][j >> 2][j & 3];
                    bf16_t* mp = Mg + (size_t)row * 1024 + col;
                    if (u.kk != 0) { float old[8]; unpack8(*(const u32x4*)mp, old);
#pragma unroll
                        for (int j = 0; j < 8; ++j) v[j] += old[j]; }
                    *(u32x4*)mp = pack8(v); } }
    }
};
struct EpiOut {
    const float* xi; float* xo; const float* gate; const unsigned* flag;
    __device__ __forceinline__ void operator()(const f32x4 (&acc)[2][2][4][2], const Unit& u, int wr, int wc, int fr, int fq) const {
        const int row0 = u.pm * BM + wr * 64 + fr, col0 = u.pn * BM + wc * 32 + 8 * fq;
        const bool bad = PROBE_F8 ? (__hip_atomic_load(flag, __ATOMIC_RELAXED, __HIP_MEMORY_SCOPE_AGENT) != 0u) : false; const float qn = __builtin_nanf("");
        f32x4 gv[2][2];
#pragma unroll
        for (int bj = 0; bj < 2; ++bj)
#pragma unroll
            for (int n = 0; n < 2; ++n) gv[bj][n] = *(const f32x4*)(gate + col0 + bj * HALF + 4 * n);
#pragma unroll
        for (int ai = 0; ai < 2; ++ai)
#pragma unroll
            for (int m = 0; m < 4; ++m) { const size_t o = (size_t)(row0 + ai * HALF + m * 16) * 1024 + col0;
#pragma unroll
                for (int bj = 0; bj < 2; ++bj)
#pragma unroll
                    for (int n = 0; n < 2; ++n) { const f32x4 xv = *(const f32x4*)(xi + o + bj * HALF + 4 * n);
                        f32x4 r = xv + gv[bj][n] * acc[ai][bj][m][n]; if (PROBE_F8 && bad) r = (f32x4){qn, qn, qn, qn};
                        *(f32x4*)(xo + o + bj * HALF + 4 * n) = r; } }
    }
};
}

namespace attn {
using bf16 = __hip_bfloat16;
using s16x4 = __attribute__((ext_vector_type(4))) short;
using f32x16 = __attribute__((ext_vector_type(16))) float;
constexpr int D = 128, NW = 8, QBLK = 32, KVBLK = 64;
constexpr float SCALE = 0.088388347648318440f;
constexpr float THR = 8.f;
constexpr int LDQ = 1024, LDK = 256, LDO = 1024;
constexpr size_t SHM_V = KVBLK * D * 2, SHM_K = KVBLK * D * 2, SHM_ATTN = 2 * SHM_V + 2 * SHM_K + NW * 64 * 4;
#define KSWZ(row, colB) ((row) * 256 + ((colB) ^ (((row) & 7) << 4)))
#define SBAR() __builtin_amdgcn_sched_barrier(0)
__device__ __forceinline__ int crow(int r, int hi) { return (r & 3) + 8 * (r >> 2) + 4 * hi; }
__device__ __forceinline__ unsigned cvtpk(float lo, float hi) { unsigned r; asm volatile("v_cvt_pk_bf16_f32 %0, %1, %2" : "=v"(r) : "v"(lo), "v"(hi)); return r; }

__device__ __forceinline__ void partialSM(f32x16& p0, f32x16& p1, float& m_reg, float& mn, float& alpha) {
  constexpr float C = SCALE * 1.4426950408889634f;
  float pmax = p0[0]; for (int r = 1; r < 16; ++r) pmax = fmaxf(pmax, p0[r]); for (int r = 0; r < 16; ++r) pmax = fmaxf(pmax, p1[r]);
  { auto rr = __builtin_amdgcn_permlane32_swap(__float_as_uint(pmax), __float_as_uint(pmax), false, false);
    pmax = fmaxf(__uint_as_float(rr[0]), __uint_as_float(rr[1])); }
  if (__builtin_expect(__all(pmax - m_reg <= THR / SCALE), 1)) { mn = m_reg; alpha = 1.f; }
  else { mn = fmaxf(m_reg, pmax); alpha = __builtin_amdgcn_exp2f((m_reg - mn) * C); m_reg = mn; }
  float mnC = -mn * C;
  for (int r = 0; r < 16; ++r) p0[r] = fmaf(p0[r], C, mnC); for (int r = 0; r < 16; ++r) p1[r] = fmaf(p1[r], C, mnC);
  for (int r = 0; r < 16; ++r) p0[r] = __builtin_amdgcn_exp2f(p0[r]);
}
__device__ __forceinline__ void finishSM(f32x16& p0, f32x16& p1, float alpha, float& l_reg, bf16x8& pa0, bf16x8& pa1, bf16x8& pa2, bf16x8& pa3) {
  for (int r = 0; r < 16; ++r) p1[r] = __builtin_amdgcn_exp2f(p1[r]);
  float ps = 0; for (int r = 0; r < 16; ++r) ps += p0[r]; for (int r = 0; r < 16; ++r) ps += p1[r];
  { auto rr = __builtin_amdgcn_permlane32_swap(__float_as_uint(ps), __float_as_uint(ps), false, false);
    ps = __uint_as_float(rr[0]) + __uint_as_float(rr[1]); }
  l_reg = l_reg * alpha + ps;
#define PK4(P, BASE, OUT) do { unsigned a0 = cvtpk(P[BASE + 0], P[BASE + 1]), a1 = cvtpk(P[BASE + 2], P[BASE + 3]);   \
    unsigned b0 = cvtpk(P[BASE + 4], P[BASE + 5]), b1 = cvtpk(P[BASE + 6], P[BASE + 7]);                              \
    auto r0 = __builtin_amdgcn_permlane32_swap(a0, b0, false, false); auto r1 = __builtin_amdgcn_permlane32_swap(a1, b1, false, false); \
    u32x4 w = {r0[0], r1[0], r0[1], r1[1]}; OUT = *reinterpret_cast<bf16x8*>(&w); } while (0)
  PK4(p0, 0, pa0); PK4(p0, 8, pa1); PK4(p1, 0, pa2); PK4(p1, 8, pa3);
#undef PK4
}
__device__ __forceinline__ void qkt(f32x16& p0, f32x16& p1, const bf16* Ks, const bf16x8* qr, int r32, int hi) {
  p0 = f32x16{}; p1 = f32x16{};
  for (int d0 = 0; d0 < 8; ++d0) { int cb = (d0 * 16 + hi * 8) * 2;
    bf16x8 b0 = *reinterpret_cast<const bf16x8*>((const char*)Ks + KSWZ(r32, cb));
    bf16x8 b1 = *reinterpret_cast<const bf16x8*>((const char*)Ks + KSWZ(32 + r32, cb));
    p0 = __builtin_amdgcn_mfma_f32_32x32x16_bf16(b0, qr[d0], p0, 0, 0, 0);
    p1 = __builtin_amdgcn_mfma_f32_32x32x16_bf16(b1, qr[d0], p1, 0, 0, 0); }
}
__device__ __forceinline__ int v_st(int k, int c) { const int kk = (k & ~0xC) | ((k & 4) << 1) | ((k & 8) >> 1); return ((kk >> 3) * 4 + (c >> 5)) * 512 + ((kk & 7) * 32 + (c & 31)) * 2; }
__device__ __forceinline__ int v_rd_base(int lane) { return ((lane & 3) << 3) | (((lane >> 2) & 3) << 6) | (((lane >> 4) & 1) << 5) | (((lane >> 5) & 1) << 8); }
constexpr int v_rd_off(int d0, int ks, int half) { return d0 * 512 + ks * 4096 + half * 2048; }
template <int OFF> __device__ __forceinline__ s16x4 tr_read(int vb) {
  s16x4 r; asm volatile("ds_read_b64_tr_b16 %0, %1 offset:%2" : "=&v"(r) : "v"(vb), "i"(OFF) : "memory"); return r;
}
template <int D0> __device__ __forceinline__ void pv_one(f32x16& od, int vb, bf16x8 pa0, bf16x8 pa1, bf16x8 pa2, bf16x8 pa3) {
  const s16x4 l0 = tr_read<v_rd_off(D0, 0, 0)>(vb), h0 = tr_read<v_rd_off(D0, 0, 1)>(vb), l1 = tr_read<v_rd_off(D0, 1, 0)>(vb), h1 = tr_read<v_rd_off(D0, 1, 1)>(vb);
  const s16x4 l2 = tr_read<v_rd_off(D0, 2, 0)>(vb), h2 = tr_read<v_rd_off(D0, 2, 1)>(vb), l3 = tr_read<v_rd_off(D0, 3, 0)>(vb), h3 = tr_read<v_rd_off(D0, 3, 1)>(vb);
  asm volatile("s_waitcnt lgkmcnt(0)" ::: "memory"); SBAR();
#define PK(L, H) (bf16x8){L[0], L[1], L[2], L[3], H[0], H[1], H[2], H[3]}
  od = __builtin_amdgcn_mfma_f32_32x32x16_bf16(pa0, PK(l0, h0), od, 0, 0, 0);
  od = __builtin_amdgcn_mfma_f32_32x32x16_bf16(pa1, PK(l1, h1), od, 0, 0, 0);
  od = __builtin_amdgcn_mfma_f32_32x32x16_bf16(pa2, PK(l2, h2), od, 0, 0, 0);
  od = __builtin_amdgcn_mfma_f32_32x32x16_bf16(pa3, PK(l3, h3), od, 0, 0, 0);
#undef PK
}
__device__ __forceinline__ void pv_d0(f32x16* o, int vb, bf16x8 pa0, bf16x8 pa1, bf16x8 pa2, bf16x8 pa3) {
  pv_one<0>(o[0], vb, pa0, pa1, pa2, pa3); pv_one<1>(o[1], vb, pa0, pa1, pa2, pa3); pv_one<2>(o[2], vb, pa0, pa1, pa2, pa3); pv_one<3>(o[3], vb, pa0, pa1, pa2, pa3);
}
__device__ __forceinline__ void attn_dense_body(const bf16* Qb, const bf16* __restrict__ Kh, const bf16* __restrict__ Vh,
                                                bf16_t* Ob, const bf16_t* Gb, int seq, char* lds, const int tid) {
  const int wid = tid >> 6, lane = tid & 63, r32 = lane & 31, hi = lane >> 5;
  bf16* V_lds = (bf16*)lds; bf16* K_lds = (bf16*)(lds + 2 * SHM_V);
  float* ws = (float*)(lds + 2 * SHM_V + 2 * SHM_K) + wid * 64; float* li_l = ws; float* al_l = ws + 32;
  float m_reg = -1e30f, l_reg = 0; f32x16 o[4] = {}; bf16x8 qr[8];
  const bf16* Qw = Qb + (long)(wid * QBLK + r32) * LDQ + hi * 8;
#pragma unroll
  for (int d0 = 0; d0 < 8; ++d0) qr[d0] = *reinterpret_cast<const bf16x8*>(Qw + d0 * 16);
  const int sr = tid >> 4, sc = (tid & 15) * 8, vst0 = v_st(sr, sc), vst1 = v_st(32 + sr, sc);
  const int vb0 = (int)(uintptr_t)V_lds + v_rd_base(lane);
  struct { bf16x8 vs0, vs1, ks0, ks1; } sr_[2];
#define SLOAD(i, k0) do { sr_[i].vs0 = *reinterpret_cast<const bf16x8*>(&Vh[(long)((k0) + sr) * LDK + sc]); sr_[i].vs1 = *reinterpret_cast<const bf16x8*>(&Vh[(long)((k0) + 32 + sr) * LDK + sc]); \
    sr_[i].ks0 = *reinterpret_cast<const bf16x8*>(&Kh[(long)((k0) + sr) * LDK + sc]); sr_[i].ks1 = *reinterpret_cast<const bf16x8*>(&Kh[(long)((k0) + 32 + sr) * LDK + sc]); } while (0)
#define SWRITE(b, i) do { *(bf16x8*)((char*)V_lds + (b) * SHM_V + vst0) = sr_[i].vs0;          \
    *(bf16x8*)((char*)V_lds + (b) * SHM_V + vst1) = sr_[i].vs1; int kc = sc * 2;               \
    *(bf16x8*)((char*)K_lds + (b) * SHM_K + KSWZ(sr, kc)) = sr_[i].ks0;                       \
    *(bf16x8*)((char*)K_lds + (b) * SHM_K + KSWZ(32 + sr, kc)) = sr_[i].ks1; } while (0)
#define SWAIT() asm volatile("s_waitcnt vmcnt(4)" ::: "memory")
#define RESC(a) do { if (__any((a) < 1.f)) { if (hi == 0) al_l[r32] = (a); asm volatile("s_waitcnt lgkmcnt(0)" ::: "memory"); \
    for (int d = 0; d < 4; ++d) for (int r = 0; r < 16; ++r) o[d][r] *= al_l[crow(r, hi)]; } } while (0)
  f32x16 pA0, pA1, pB0, pB1; float mnA, mnB, alA, alB; bf16x8 pa0, pa1, pa2, pa3; const int NT = seq / KVBLK;
  constexpr int SE = 0, SO = 1;
  SLOAD(SE, 0); asm volatile("s_waitcnt vmcnt(0)" ::: "memory"); SWRITE(0, SE); __syncthreads();
  qkt(pA0, pA1, K_lds, qr, r32, hi); partialSM(pA0, pA1, m_reg, mnA, alA);
  SLOAD(SO, KVBLK); if (2 < NT) SLOAD(SE, 2 * KVBLK);
  SWAIT(); SWRITE(1, SO); __syncthreads();
#pragma nounroll
  for (int j = 1; j + 1 < NT; j += 2) {
    SBAR(); qkt(pB0, pB1, (bf16*)((char*)K_lds + SHM_K), qr, r32, hi);
    finishSM(pA0, pA1, alA, l_reg, pa0, pa1, pa2, pa3); SBAR();
    SLOAD(SO, (j + 2) * KVBLK); SBAR();
    pv_d0(o, vb0, pa0, pa1, pa2, pa3); partialSM(pB0, pB1, m_reg, mnB, alB);
    __syncthreads(); SWAIT(); SWRITE(0, SE);
    RESC(alB); __syncthreads();
    SBAR(); qkt(pA0, pA1, K_lds, qr, r32, hi);
    finishSM(pB0, pB1, alB, l_reg, pa0, pa1, pa2, pa3); SBAR();
    if (j + 3 < NT) SLOAD(SE, (j + 3) * KVBLK); SBAR();
    pv_d0(o, vb0 + (int)SHM_V, pa0, pa1, pa2, pa3); partialSM(pA0, pA1, m_reg, mnA, alA);
    __syncthreads(); SWAIT(); SWRITE(1, SO);
    RESC(alA); __syncthreads();
  }
  SBAR(); qkt(pB0, pB1, (bf16*)((char*)K_lds + SHM_K), qr, r32, hi);
  finishSM(pA0, pA1, alA, l_reg, pa0, pa1, pa2, pa3); SBAR();
  pv_d0(o, vb0, pa0, pa1, pa2, pa3); partialSM(pB0, pB1, m_reg, mnB, alB);
  __syncthreads(); RESC(alB);
  finishSM(pB0, pB1, alB, l_reg, pa0, pa1, pa2, pa3); SBAR();
  pv_d0(o, vb0 + (int)SHM_V, pa0, pa1, pa2, pa3);
  if (hi == 0) li_l[r32] = l_reg; asm volatile("s_waitcnt lgkmcnt(0)" ::: "memory");
  float rli[16];
#pragma unroll
  for (int r = 0; r < 16; ++r) rli[r] = __builtin_amdgcn_rcpf(li_l[crow(r, hi)]);
  __syncthreads();
  { int lane_e = lane, wid_e = wid; asm volatile("" : "+v"(lane_e), "+v"(wid_e)); wid_e = __builtin_amdgcn_readfirstlane(wid_e);
    bf16_t* stg = (bf16_t*)lds + wid_e * 4096;
#pragma unroll
    for (int r = 0; r < 16; ++r) { const int orow = crow(r, hi);
#pragma unroll
      for (int d0 = 0; d0 < 4; ++d0) stg[orow * 128 + d0 * 32 + r32] = (bf16_t)f2bf(o[d0][r] * rli[r]); }
    asm volatile("s_waitcnt lgkmcnt(0)" ::: "memory");
    bf16_t* Ow = Ob + (long)(wid_e * QBLK) * LDO; const bf16_t* Gw = Gb + (long)(wid_e * QBLK) * LDO;
    u32x4 gq[8];
#pragma unroll
    for (int i = 0; i < 8; ++i) { const int row = i * 4 + (lane_e >> 4), ch = lane_e & 15; gq[i] = *(const u32x4*)(Gw + (long)row * LDO + ch * 8); }
#pragma unroll
    for (int i = 0; i < 8; ++i) { const int row = i * 4 + (lane_e >> 4), ch = lane_e & 15;
      float ov[8], gv[8]; unpack8(*(const u32x4*)(stg + row * 128 + ch * 8), ov); unpack8(gq[i], gv);
#pragma unroll
      for (int j = 0; j < 8; ++j) ov[j] *= gv[j];
      *(u32x4*)(Ow + (long)row * LDO + ch * 8) = pack8(ov); } }
  __syncthreads();
#undef SLOAD
#undef SWRITE
#undef SWAIT
#undef RESC
}

__device__ __forceinline__ void attn_pp_body(const bf16* Qb, const bf16* __restrict__ Kh, const bf16* __restrict__ Vh,
                                             bf16_t* Ob, const bf16_t* Gb, int seq, char* lds, const int tid, const bf16_t* cmp = nullptr, unsigned* flag = nullptr) {
  const int wid = __builtin_amdgcn_readfirstlane(tid >> 6), lane = tid & 63, r32 = lane & 31, hi = lane >> 5;
  const int g = wid >> 2;
  constexpr int NB = 3;
  char* V_lds = lds; char* K_lds = lds + NB * SHM_V;
  float* ws = (float*)(lds + NB * (SHM_V + SHM_K)) + wid * 64; float* li_l = ws; float* al_l = ws + 32;
  float m_reg = -1e30f, l_reg = 0; f32x16 o[4] = {}; bf16x8 qr[8];
  const bf16* Qw = Qb + (long)(wid * QBLK + r32) * LDQ + hi * 8;
#pragma unroll
  for (int d0 = 0; d0 < 8; ++d0) qr[d0] = *reinterpret_cast<const bf16x8*>(Qw + d0 * 16);
  const int sr = tid >> 4, sc = (tid & 15) * 8, vst0 = v_st(sr, sc), vst1 = v_st(32 + sr, sc);
  const int ksw0 = KSWZ(sr, sc * 2), ksw1 = KSWZ(32 + sr, sc * 2);
  const int vbase = (int)(uintptr_t)V_lds + v_rd_base(lane);
  struct Stg { bf16x8 vs0, vs1, ks0, ks1; } st0, st1;
#define SLOAD(S, t) do { const long k0_ = (long)(t) * KVBLK; S.vs0 = *reinterpret_cast<const bf16x8*>(&Vh[(k0_ + sr) * LDK + sc]); S.vs1 = *reinterpret_cast<const bf16x8*>(&Vh[(k0_ + 32 + sr) * LDK + sc]); \
    S.ks0 = *reinterpret_cast<const bf16x8*>(&Kh[(k0_ + sr) * LDK + sc]); S.ks1 = *reinterpret_cast<const bf16x8*>(&Kh[(k0_ + 32 + sr) * LDK + sc]); } while (0)
#define SWRITE(S, b) do { *(bf16x8*)(V_lds + (b) * SHM_V + vst0) = S.vs0; *(bf16x8*)(V_lds + (b) * SHM_V + vst1) = S.vs1; \
    *(bf16x8*)(K_lds + (b) * SHM_K + ksw0) = S.ks0; *(bf16x8*)(K_lds + (b) * SHM_K + ksw1) = S.ks1; } while (0)
#define RESC(a) do { if (__any((a) < 1.f)) { if (hi == 0) al_l[r32] = (a); asm volatile("s_waitcnt lgkmcnt(0)" ::: "memory"); \
    for (int d = 0; d < 4; ++d) for (int r = 0; r < 16; ++r) o[d][r] *= al_l[crow(r, hi)]; } } while (0)
  const int NT = seq / KVBLK;
  f32x16 p0, p1; bf16x8 pa0, pa1, pa2, pa3;
#define SMX() do { float mn_, al_; partialSM(p0, p1, m_reg, mn_, al_); RESC(al_); finishSM(p0, p1, al_, l_reg, pa0, pa1, pa2, pa3); } while (0)
  SLOAD(st0, 0); if (g) SLOAD(st1, 1);
  SWRITE(st0, 0); if (g) SWRITE(st1, 1);
  SLOAD(st0, 1 + g); SLOAD(st1, 2 + g);
  __syncthreads();
  if (g) __syncthreads();
  SBAR(); qkt(p0, p1, (const bf16*)K_lds, qr, r32, hi); SBAR();
  __syncthreads();
  SWRITE(st0, 1 + g); if (3 + g < NT) SLOAD(st0, 3 + g);
  SMX();
  __syncthreads();
  int c = 0;
#define STEP(i, ST) do { const int cK_ = (c == 2) ? 0 : c + 1; \
    SBAR(); \
    qkt(p0, p1, (const bf16*)(K_lds + cK_ * SHM_K), qr, r32, hi); \
    pv_d0(o, vbase + c * (int)SHM_V, pa0, pa1, pa2, pa3); \
    SBAR(); \
    __syncthreads(); \
    { const int t_ = (i) + 2 + g; if (t_ < NT) { const int cb_ = (cK_ == 2) ? 0 : cK_ + 1; const int cw_ = g ? ((cb_ == 2) ? 0 : cb_ + 1) : cb_; \
        SWRITE(ST, cw_); if (t_ + 2 < NT) SLOAD(ST, t_ + 2); } } \
    SMX(); \
    __syncthreads(); \
    c = cK_; } while (0)
  int i = 0;
#pragma nounroll
  for (; i + 1 < NT - 1; i += 2) { STEP(i, st1); STEP(i + 1, st0); }
  if (i < NT - 1) { STEP(i, st1); }
  SBAR(); pv_d0(o, vbase + c * (int)SHM_V, pa0, pa1, pa2, pa3); SBAR();
  __syncthreads();
  if (!g) __syncthreads();
  if (hi == 0) li_l[r32] = l_reg; asm volatile("s_waitcnt lgkmcnt(0)" ::: "memory");
  float rli[16];
#pragma unroll
  for (int r = 0; r < 16; ++r) rli[r] = __builtin_amdgcn_rcpf(li_l[crow(r, hi)]);
  { int lane_e = lane, wid_e = wid; asm volatile("" : "+v"(lane_e), "+v"(wid_e)); wid_e = __builtin_amdgcn_readfirstlane(wid_e);
    bf16_t* stg = (bf16_t*)lds + wid_e * 4096;
#pragma unroll
    for (int r = 0; r < 16; ++r) { const int orow = crow(r, hi);
#pragma unroll
      for (int d0 = 0; d0 < 4; ++d0) stg[orow * 128 + d0 * 32 + r32] = (bf16_t)f2bf(o[d0][r] * rli[r]); }
    asm volatile("s_waitcnt lgkmcnt(0)" ::: "memory");
    bf16_t* Ow = Ob + (long)(wid_e * QBLK) * LDO; const bf16_t* Gw = Gb + (long)(wid_e * QBLK) * LDO;
    u32x4 gq[8];
#pragma unroll
    for (int i2 = 0; i2 < 8; ++i2) { const int row = i2 * 4 + (lane_e >> 4), ch = lane_e & 15; gq[i2] = *(const u32x4*)(Gw + (long)row * LDO + ch * 8); }
#pragma unroll
    for (int i2 = 0; i2 < 8; ++i2) { const int row = i2 * 4 + (lane_e >> 4), ch = lane_e & 15;
      float ov[8], gv[8]; unpack8(*(const u32x4*)(stg + row * 128 + ch * 8), ov); unpack8(gq[i2], gv);
#pragma unroll
      for (int j = 0; j < 8; ++j) ov[j] *= gv[j];
      *(u32x4*)(Ow + (long)row * LDO + ch * 8) = pack8(ov); } }
  __syncthreads();
  if (PROBE_F8 && cmp) {
    asm volatile("s_waitcnt vmcnt(0)" ::: "memory");
    float pr_d = 0.f, pr_r = 0.f; int lane_c = lane; asm volatile("" : "+v"(lane_c));
    const bf16_t* stg2 = (const bf16_t*)lds + wid * 4096;
    float a0[8], c0[8];
#pragma unroll
    for (int i2 = 0; i2 < 8; ++i2) { const int rl = i2 * 4 + (lane_c >> 4), ch = lane_c & 15; float a[8], cv[8];
      unpack8(*(const u32x4*)(stg2 + rl * 128 + ch * 8), a); unpack8(*(const u32x4*)(cmp + (long)(wid * QBLK + rl) * LDO + ch * 8), cv);
      if (i2 == 0) {
#pragma unroll
        for (int j = 0; j < 8; ++j) { a0[j] = a[j]; c0[j] = cv[j]; }
      } else {
#pragma unroll
        for (int j = 0; j < 8; ++j) { const float fa = a[j] - a0[j], fc = cv[j] - c0[j]; pr_d = fmaxf(pr_d, fabsf(fa - fc)); pr_r = fmaxf(pr_r, fabsf(fa)); } } }
#pragma unroll
    for (int o_ = 1; o_ < 64; o_ <<= 1) { pr_d = fmaxf(pr_d, __shfl_xor(pr_d, o_)); pr_r = fmaxf(pr_r, __shfl_xor(pr_r, o_)); }
    if (lane_c == 0 && !(pr_d <= 0.3f * pr_r)) atomicOr(flag, 1u);
    __syncthreads(); }
#undef SLOAD
#undef SWRITE
#undef RESC
#undef SMX
#undef STEP
}

constexpr float THR8 = 1.9f;
__device__ __forceinline__ void partialSM8(f32x16& p0, f32x16& p1, float& m_reg, float& alpha) {
  constexpr float C = SCALE * 1.4426950408889634f;
  float pmax = p0[0]; for (int r = 1; r < 16; ++r) pmax = fmaxf(pmax, p0[r]); for (int r = 0; r < 16; ++r) pmax = fmaxf(pmax, p1[r]);
  { auto rr = __builtin_amdgcn_permlane32_swap(__float_as_uint(pmax), __float_as_uint(pmax), false, false);
    pmax = fmaxf(__uint_as_float(rr[0]), __uint_as_float(rr[1])); }
  float mn;
  if (__builtin_expect(__all(pmax - m_reg <= THR8 / SCALE), 1)) { mn = m_reg; alpha = 1.f; }
  else { mn = fmaxf(m_reg, pmax); alpha = __builtin_amdgcn_exp2f((m_reg - mn) * C); m_reg = mn; }
  const float mnC = 6.0f - mn * C;
  for (int r = 0; r < 16; ++r) p0[r] = fmaf(p0[r], C, mnC); for (int r = 0; r < 16; ++r) p1[r] = fmaf(p1[r], C, mnC);
  for (int r = 0; r < 16; ++r) p0[r] = __builtin_amdgcn_exp2f(p0[r]);
}
__device__ __forceinline__ void finishSM8(f32x16& p0, f32x16& p1, float alpha, float& l_reg, i32x8& pa) {
  for (int r = 0; r < 16; ++r) p1[r] = __builtin_amdgcn_exp2f(p1[r]);
  float sA = p0[0] + p0[1], sB = p0[2] + p0[3], sC = p1[0] + p1[1], sD = p1[2] + p1[3];
  for (int r = 4; r < 16; r += 2) { sA += p0[r]; sB += p0[r + 1]; sC += p1[r]; sD += p1[r + 1]; }
  float ps = (sA + sB) + (sC + sD);
  { auto rr = __builtin_amdgcn_permlane32_swap(__float_as_uint(ps), __float_as_uint(ps), false, false);
    ps = __uint_as_float(rr[0]) + __uint_as_float(rr[1]); }
  l_reg = l_reg * alpha + ps;
#pragma unroll
  for (int w = 0; w < 4; ++w) { pa[w] = pk4_fp8(p0[4 * w], p0[4 * w + 1], p0[4 * w + 2], p0[4 * w + 3]); pa[4 + w] = pk4_fp8(p1[4 * w], p1[4 * w + 1], p1[4 * w + 2], p1[4 * w + 3]); }
}

template <bool FIRST> __device__ __forceinline__ void partialSM8n(f32x16& p0, f32x16& p1, float& M2, f32x16& negm, float& alpha) {
  constexpr float THR2 = THR8 * 1.4426950408889634f;
  float mA = fmaxf(p0[0], p0[1]), mB = fmaxf(p0[2], p0[3]), mC = fmaxf(p1[0], p1[1]), mD = fmaxf(p1[2], p1[3]);
  for (int r = 4; r < 16; r += 4) { mA = fmaxf(fmaxf(mA, p0[r]), p0[r + 1]); mB = fmaxf(fmaxf(mB, p0[r + 2]), p0[r + 3]); mC = fmaxf(fmaxf(mC, p1[r]), p1[r + 1]); mD = fmaxf(fmaxf(mD, p1[r + 2]), p1[r + 3]); }
  float emax = fmaxf(fmaxf(mA, mB), fmaxf(mC, mD));
  { auto rr = __builtin_amdgcn_permlane32_swap(__float_as_uint(emax), __float_as_uint(emax), false, false);
    emax = fmaxf(__uint_as_float(rr[0]), __uint_as_float(rr[1])); }
  if (!FIRST && __builtin_expect(__all(emax - 6.0f <= THR2), 1)) { alpha = 1.f; }
  else { const float delta = FIRST ? (emax - 6.0f) : fmaxf(emax - 6.0f, 0.f); alpha = FIRST ? 0.f : __builtin_amdgcn_exp2f(-delta); M2 += delta;
    for (int r = 0; r < 16; ++r) { p0[r] -= delta; p1[r] -= delta; }
    const float nm = 6.0f - M2; for (int r = 0; r < 16; ++r) negm[r] = nm; asm volatile("" : "+v"(negm)); }
  for (int r = 0; r < 16; ++r) p0[r] = __builtin_amdgcn_exp2f(p0[r]);
}
#define MFMA8(A, B, Cc) __builtin_amdgcn_mfma_scale_f32_32x32x64_f8f6f4((A), (B), (Cc), 0, 0, 0, 0x7f7f7f7f, 0, 0x7f7f7f7f)
__device__ __forceinline__ i32x8 cat8(const u32x4 lo, const u32x4 hi4) { i32x8 r; r[0] = (int)lo.x; r[1] = (int)lo.y; r[2] = (int)lo.z; r[3] = (int)lo.w; r[4] = (int)hi4.x; r[5] = (int)hi4.y; r[6] = (int)hi4.z; r[7] = (int)hi4.w; return r; }
__device__ __forceinline__ void qkt8(f32x16& p0, f32x16& p1, const char* Ks, const i32x8* qf, int r32, int hi, const f32x16& negm) {
  const int x = r32 & 7; const char* k0 = Ks + r32 * 128; const char* k1 = k0 + 32 * 128;
  p0 = negm; p1 = negm;
#pragma unroll
  for (int s2 = 0; s2 < 2; ++s2) { const int c0 = 4 * s2 + 2 * hi, oa = 16 * (c0 ^ x), ob = 16 * ((c0 + 1) ^ x);
    const i32x8 a0 = cat8(*reinterpret_cast<const u32x4*>(k0 + oa), *reinterpret_cast<const u32x4*>(k0 + ob));
    const i32x8 a1 = cat8(*reinterpret_cast<const u32x4*>(k1 + oa), *reinterpret_cast<const u32x4*>(k1 + ob));
    p0 = MFMA8(a0, qf[s2], p0); p1 = MFMA8(a1, qf[s2], p1); }
}
__device__ __forceinline__ void pv8(f32x16* o, const char* Vs, const i32x8 pa, int r32, int hi) {
  const int sw = (r32 >> 2) & 3; const char* vb = Vs + r32 * 64; const int oa = 16 * ((2 * hi) ^ sw), ob = 16 * ((2 * hi + 1) ^ sw);
#pragma unroll
  for (int d0 = 0; d0 < 4; ++d0) { const i32x8 b = cat8(*reinterpret_cast<const u32x4*>(vb + d0 * 2048 + oa), *reinterpret_cast<const u32x4*>(vb + d0 * 2048 + ob));
    o[d0] = MFMA8(pa, b, o[d0]); }
}
__device__ __forceinline__ void attn_pp8_body(const bf16* Qb, const unsigned char* __restrict__ K8, const unsigned char* __restrict__ V8,
                                              bf16_t* Ob, const bf16_t* Gb, int seq, char* lds, const int tid) {
  const int wid = __builtin_amdgcn_readfirstlane(tid >> 6), lane = tid & 63, r32 = lane & 31, hi = lane >> 5;
  const int g = wid >> 2;
  constexpr int NB = 3, SL = 8192;
  char* V_lds = lds; char* K_lds = lds + NB * SL;
  float* ws = (float*)(lds + 65536) + wid * 64; float* li_l = ws; float* al_l = ws + 32;
  float M2 = 0.f, l_reg = 0; f32x16 o[4] = {}; i32x8 qf[2]; f32x16 negm; for (int r = 0; r < 16; ++r) negm[r] = 6.0f; asm volatile("" : "+v"(negm));
  constexpr float QC = SCALE * 1.4426950408889634f;
  { const bf16* Qw = Qb + (long)(wid * QBLK + r32) * LDQ + hi * 32;
#pragma unroll
    for (int s2 = 0; s2 < 2; ++s2) {
#pragma unroll
      for (int q4 = 0; q4 < 4; ++q4) { float f[8]; unpack8(*reinterpret_cast<const u32x4*>(Qw + s2 * 64 + q4 * 8), f);
        qf[s2][2 * q4] = pk4_fp8(f[0] * QC, f[1] * QC, f[2] * QC, f[3] * QC); qf[s2][2 * q4 + 1] = pk4_fp8(f[4] * QC, f[5] * QC, f[6] * QC, f[7] * QC); } } }
  struct Stg8 { u32x4 k, v; } st0, st1;
#define SLOAD(S, t) do { const size_t o_ = (size_t)(t) * SL + (size_t)tid * 16; S.k = *reinterpret_cast<const u32x4*>(K8 + o_); S.v = *reinterpret_cast<const u32x4*>(V8 + o_); } while (0)
#define SWRITE(S, b) do { *(u32x4*)(K_lds + (b) * SL + tid * 16) = S.k; *(u32x4*)(V_lds + (b) * SL + tid * 16) = S.v; } while (0)
#define RESC(a) do { if (__any((a) < 1.f)) { if (hi == 0) al_l[r32] = (a); asm volatile("s_waitcnt lgkmcnt(0)" ::: "memory"); \
    for (int d = 0; d < 4; ++d) for (int r = 0; r < 16; ++r) o[d][r] *= al_l[crow(r, hi)]; } } while (0)
  const int NT = seq / KVBLK;
  f32x16 p0, p1; i32x8 pa;
#define SMX() do { float al_; partialSM8n<true>(p0, p1, M2, negm, al_); RESC(al_); finishSM8(p0, p1, al_, l_reg, pa); } while (0)
  SLOAD(st0, 0); if (g) SLOAD(st1, 1);
  SWRITE(st0, 0); if (g) SWRITE(st1, 1);
  SLOAD(st0, 1 + g);
  __syncthreads();
  if (g) __syncthreads();
  SBAR(); qkt8(p0, p1, K_lds, qf, r32, hi, negm); SBAR();
  __syncthreads();
  SWRITE(st0, 1 + g); SLOAD(st0, 2 + g);
  SMX();
  __syncthreads();
  int c = 0;
#define STEP(i, ST) do { const int cK_ = (c == 2) ? 0 : c + 1; \
    SBAR(); \
    float al2_; \
    qkt8(p0, p1, K_lds + cK_ * SL, qf, r32, hi, negm); \
    partialSM8n<false>(p0, p1, M2, negm, al2_);            \
    pv8(o, V_lds + c * SL, pa, r32, hi); \
    SBAR(); \
    __syncthreads(); \
    { const int t_ = (i) + 2 + g; if (t_ < NT) { const int cb_ = (cK_ == 2) ? 0 : cK_ + 1; const int cw_ = g ? ((cb_ == 2) ? 0 : cb_ + 1) : cb_; \
        SWRITE(st0, cw_); if (t_ + 1 < NT) SLOAD(st0, t_ + 1); } } \
    RESC(al2_); finishSM8(p0, p1, al2_, l_reg, pa); \
    __syncthreads(); \
    c = cK_; } while (0)
  int i = 0;
#pragma nounroll
  for (; i + 1 < NT - 1; i += 2) { STEP(i, st1); STEP(i + 1, st0); }
  if (i < NT - 1) { STEP(i, st1); }
  SBAR(); pv8(o, V_lds + c * SL, pa, r32, hi); SBAR();
  __syncthreads();
  if (!g) __syncthreads();
  if (hi == 0) li_l[r32] = l_reg; asm volatile("s_waitcnt lgkmcnt(0)" ::: "memory");
  float rli[16];
#pragma unroll
  for (int r = 0; r < 16; ++r) rli[r] = __builtin_amdgcn_rcpf(li_l[crow(r, hi)]);
  { int tid_e = tid; asm volatile("" : "+v"(tid_e)); const int lane_e = tid_e & 63; const int wid_e = __builtin_amdgcn_readfirstlane(tid_e >> 6);
    bf16_t* stg = (bf16_t*)lds + wid_e * 4096;
#pragma unroll
    for (int r = 0; r < 16; ++r) { const int orow = crow(r, hi);
#pragma unroll
      for (int d0 = 0; d0 < 4; ++d0) stg[orow * 128 + d0 * 32 + r32] = (bf16_t)f2bf(o[d0][r] * rli[r]); }
    asm volatile("s_waitcnt lgkmcnt(0)" ::: "memory");
    bf16_t* Ow = Ob + (long)(wid_e * QBLK) * LDO; const bf16_t* Gw = Gb + (long)(wid_e * QBLK) * LDO;
    u32x4 gq[8];
#pragma unroll
    for (int i2 = 0; i2 < 8; ++i2) { const int row = i2 * 4 + (lane_e >> 4), ch = lane_e & 15; gq[i2] = Gb ? *(const u32x4*)(Gw + (long)row * LDO + ch * 8) : (u32x4){0x3f803f80u, 0x3f803f80u, 0x3f803f80u, 0x3f803f80u}; }
#pragma unroll
    for (int i2 = 0; i2 < 8; ++i2) { const int row = i2 * 4 + (lane_e >> 4), ch = lane_e & 15;
      float ov[8], gv[8]; unpack8(*(const u32x4*)(stg + row * 128 + ch * 8), ov); unpack8(gq[i2], gv);
#pragma unroll
      for (int j = 0; j < 8; ++j) ov[j] *= gv[j];
      *(u32x4*)(Ow + (long)row * LDO + ch * 8) = pack8(ov); } }
  __syncthreads();
#undef SLOAD
#undef SWRITE
#undef RESC
#undef SMX
#undef STEP
#undef MFMA8
}
#undef KSWZ
#undef SBAR
}


#define XB_TMO      128
#define XB_XCNT(j)  (256  + 64 * (j))
#define XB_XSUB(j)  (1280 + 64 * (j))
#define XB_XGEN(j)  (2304 + 64 * (j))
#define XB_TOP      3328
#define XB_TOPGEN   3392
#define XCD_BAR_WORDS 3456
#define XB_SPIN_CAP (1u << 22)
__device__ __forceinline__ unsigned xb_ld(unsigned* p)              { return __hip_atomic_load(p, __ATOMIC_RELAXED, __HIP_MEMORY_SCOPE_AGENT); }
__device__ __forceinline__ unsigned xb_add(unsigned* p, unsigned v) { return __hip_atomic_fetch_add(p, v, __ATOMIC_RELAXED, __HIP_MEMORY_SCOPE_AGENT); }
__device__ __forceinline__ unsigned xb_xcc_id() { return (unsigned)__builtin_amdgcn_s_getreg((3 << 11) | 20) & 0xFu; }
#define XB_SPIN(cond, bar) do { unsigned _sp = 0; while (cond) { __builtin_amdgcn_s_sleep(1); \
    if ((++_sp & 255u) == 0u) { if (xb_ld(&(bar)[XB_TMO])) break; if (_sp > XB_SPIN_CAP) { atomicAdd(&(bar)[XB_TMO], 1u); break; } } } } while (0)
struct XcdBarrier { unsigned* bar; unsigned x; volatile LAS unsigned* st; };
__device__ __forceinline__ XcdBarrier xcd_barrier_post(unsigned* bar, volatile LAS unsigned* st) {
    XcdBarrier b; b.bar = bar; b.x = xb_xcc_id(); b.st = st;
    if (threadIdx.x == 0) (void)xb_add(&bar[XB_XCNT(b.x)], 1u);
    return b;
}
__device__ __forceinline__ void xcd_barrier_complete(unsigned* bar, unsigned x, unsigned& nloc, unsigned& nx) {
    const unsigned G = gridDim.x * gridDim.y * gridDim.z;
    unsigned sum, cnt, mine, sp = 0u;
    for (;;) {
        sum = 0u; cnt = 0u; mine = 0u;
#pragma unroll
        for (unsigned j = 0; j < 16; ++j) { const unsigned c = xb_ld(&bar[XB_XCNT(j)]); sum += c; cnt += (c > 0u) ? 1u : 0u; mine = (j == x) ? c : mine; }
        if (sum == G) break;
        __builtin_amdgcn_s_sleep(1);
        if ((++sp & 255u) == 0u) { if (xb_ld(&bar[XB_TMO])) break; if (sp > XB_SPIN_CAP) { atomicAdd(&bar[XB_TMO], 1u); break; } }
    }
    nloc = mine > 0u ? mine : 1u; nx = cnt > 0u ? cnt : 1u;
}
__device__ __forceinline__ void xcd_barrier(const XcdBarrier& b, const int tid) {
    asm volatile("s_waitcnt vmcnt(0)" ::: "memory");
    __syncthreads();
    if (tid == 0) {
        unsigned* bar = b.bar;
        __builtin_amdgcn_s_waitcnt(0);
        unsigned nloc = b.st[0], nx = b.st[1];
        if (nloc == 0u) { xcd_barrier_complete(bar, b.x, nloc, nx); b.st[0] = nloc; b.st[1] = nx; }
        const unsigned old = xb_add(&bar[XB_XSUB(b.x)], 1u);
        const unsigned gen = old / nloc;
        if (old + 1u == (gen + 1u) * nloc) {
            __builtin_amdgcn_fence(__ATOMIC_RELEASE, "agent");
            asm volatile("s_waitcnt vmcnt(0)" ::: "memory");
            const unsigned og = xb_add(&bar[XB_TOP], 1u);
            const unsigned tg = og / nx;
            if (og + 1u == (tg + 1u) * nx) xb_add(&bar[XB_TOPGEN], 1u);
            else XB_SPIN(xb_ld(&bar[XB_TOPGEN]) == tg, bar);
            __builtin_amdgcn_fence(__ATOMIC_ACQUIRE, "agent");
            xb_add(&bar[XB_XGEN(b.x)], 1u);
            asm volatile("s_waitcnt vmcnt(0)" ::: "memory");
        } else {
            XB_SPIN(xb_ld(&bar[XB_XGEN(b.x)]) == gen, bar);
            __builtin_amdgcn_fence(__ATOMIC_ACQUIRE, "agent");
            asm volatile("s_waitcnt vmcnt(0)" ::: "memory");
        }
    }
    __syncthreads();
}

#ifndef PHM
#define PHM 1023
#endif
#ifndef PROBE_K
#define PROBE_K -1
#endif
struct Args { const float* in[18]; float* out; unsigned char* ws; int ph_lo, ph_hi; };
typedef const __attribute__((address_space(4))) Args* KArgs;
#define INP(a, i) ((const float*)(const GAS float*)((a)->in[i]))
#define OUTP(a) ((float*)(GAS float*)((a)->out))
enum { I_X = 0, I_C, I_WADA, I_BADA, I_NORMG, I_WIN, I_CAW, I_CAB, I_WRG, I_BRG, I_WIG, I_BIG, I_LAM, I_QG, I_KG, I_CCW, I_WBR, I_WOUT };

__device__ __forceinline__ void transpose_item(const float* W, int ldw, bf16_t* dst, int ldd, LAS float* scr, int lane) {
#pragma unroll 8
    for (int i = 0; i < 32; ++i) { const int kk = 2 * i + (lane >> 5); scr[kk * 33 + (lane & 31)] = W[(size_t)kk * ldw + (lane & 31)]; }
    LDS_WAIT();
    const int c = lane & 7;
#pragma unroll
    for (int j = 0; j < 4; ++j) { const int n = (lane >> 3) + 8 * j; const LAS float* s = scr + (8 * c) * 33 + n;
        u32x4 o; o.x = cvt_pk_bf16(s[0 * 33], s[1 * 33]); o.y = cvt_pk_bf16(s[2 * 33], s[3 * 33]); o.z = cvt_pk_bf16(s[4 * 33], s[5 * 33]); o.w = cvt_pk_bf16(s[6 * 33], s[7 * 33]);
        *(u32x4*)(dst + (size_t)n * ldd + 8 * c) = o; }
    LDS_WAIT();
}

__device__ __forceinline__ void phase_prologue(KArgs a, unsigned char* wsb, LAS unsigned char* lds, int tid, int lane, int wave, int bid, int G) {
    unsigned char* ws = wsb;
    {
        LAS float* red = (LAS float*)lds;
        for (int it = bid; it < 96; it += G) {
            const int l = it / 48, jb = it % 48, j = jb * 64 + lane;
            const float* wa = INP(a, I_WADA) + (size_t)l * 1024 * 3072 + j; const float* c0 = INP(a, I_C); const float* c1 = c0 + 1024;
            float a0 = 0.f, a1 = 0.f; const int kb = wave * 128;
#pragma unroll 16
            for (int k = 0; k < 128; ++k) { const float w = wa[(size_t)(kb + k) * 3072]; a0 += c0[kb + k] * w; a1 += c1[kb + k] * w; }
            red[(wave * 2 + 0) * 64 + lane] = a0; red[(wave * 2 + 1) * 64 + lane] = a1;
            __syncthreads();
            if (tid < 128) { const int bb = tid >> 6; float s = 0.f;
#pragma unroll
                for (int w = 0; w < 8; ++w) s += red[(w * 2 + bb) * 64 + lane];
                ((float*)(ws + WS_MOD))[(l * 2 + bb) * 3072 + j] = s + INP(a, I_BADA)[l * 3072 + j]; }
            __syncthreads();
        }
    }
    {
        float* rc = (float*)(ws + WS_ROPE); float* rs = rc + 320 * 32;
        for (int e = bid * 512 + tid; e < 320 * 32; e += G * 512) {
            const int pos = e >> 5, i = e & 31; const int p = pos < 256 ? pos : pos - 256;
            const float inv = __builtin_amdgcn_exp2f(-((float)(2 * i)) * (13.287712379549449f / 64.0f));
            const float ang = (float)p * inv;
            rc[e] = __cosf(ang); rs[e] = __sinf(ang);
        }
    }
    {
        LAS float* scr = (LAS float*)(lds + 8192 + wave * 12288);
        const int gw = bid * 8 + wave, NGW = G * 8;
        constexpr int I_IN = 2 * 16 * 368, I_G = 1024, I_BR = 3072, I_OUT = 1024, NITEMS = I_IN + I_G + I_BR + I_OUT;
        for (int it = gw; it < NITEMS; it += NGW) {
            int r = it;
            if (r < I_IN) { const int l = r / 5888, q = r % 5888, kb = q / 368, nb = q % 368;
                const int n0 = 32 * nb; int drow = n0;
                if (n0 >= 4608 && n0 < 8704) { const int sec = (n0 - 4608) >> 10, ch = (n0 - 4608) & 1023, blk = ch >> 7;
                    drow = ((sec & 1) ? 26 + blk : 18 + blk) * 256 + ((sec >> 1) ? 128 : 0) + (ch & 127); }
                transpose_item(INP(a, I_WIN) + (size_t)l * 1024 * NIN + (size_t)(64 * kb) * NIN + n0, NIN,
                               (bf16_t*)(ws + WS_WIN) + (size_t)l * NIN * 1024 + (size_t)drow * 1024 + 64 * kb, 1024, scr, lane); continue; }
            r -= I_IN;
            if (r < I_G) { const int mi = r >> 5, sub = r & 31, kb = sub >> 3, nblk = sub & 7;
                const int nb = mi & 3, gate = (mi >> 2) & 1, dir = (mi >> 3) & 1, l = mi >> 4;
                const float* src = (gate ? INP(a, I_WIG) : INP(a, I_WRG)) + (size_t)((l * 2 + dir) * 4 + nb) * 65536 + (size_t)(64 * kb) * 256 + 32 * nblk;
                const int n0 = 32 * nblk, hh = n0 >> 7, pn = (dir * 4 + nb) * 2 + hh, row = pn * 256 + gate * 128 + (n0 & 127);
                transpose_item(src, 256, (bf16_t*)(ws + WS_WG) + (size_t)l * 4096 * 256 + (size_t)row * 256 + 64 * kb, 256, scr, lane); continue; }
            r -= I_G;
            if (r < I_BR) { const int mi = r >> 9, sub = r & 511, kb = sub >> 5, nblk = sub & 31;
                transpose_item(INP(a, I_WBR) + (size_t)mi * 1048576 + (size_t)(64 * kb) * 1024 + 32 * nblk, 1024,
                               (bf16_t*)(ws + WS_WBR) + (size_t)mi * 1048576 + (size_t)(32 * nblk) * 1024 + 64 * kb, 1024, scr, lane); continue; }
            r -= I_BR;
            { const int mi = r >> 9, sub = r & 511, kb = sub >> 5, nblk = sub & 31;
                transpose_item(INP(a, I_WOUT) + (size_t)mi * 1048576 + (size_t)(64 * kb) * 1024 + 32 * nblk, 1024,
                               (bf16_t*)(ws + WS_WOUT) + (size_t)mi * 1048576 + (size_t)(32 * nblk) * 1024 + 64 * kb, 1024, scr, lane); }
        }
    }
}

__device__ __forceinline__ void phase_h(KArgs a, unsigned char* wsb, int l, int b, int lane, int wave, int bid, int G) {
    const float* xin = (l == 0 ? INP(a, I_X) : OUTP(a)) + (size_t)b * SEQ * DM;
    const float* mod = (const float*)(wsb + WS_MOD) + (l * 2 + b) * 3072;
    bf16_t* H = (bf16_t*)(wsb + WS_H);
    f32x4 gs[4], sh[4];
#pragma unroll
    for (int j = 0; j < 4; ++j) { const int col = 4 * lane + 256 * j;
        const f32x4 g = *(const f32x4*)(INP(a, I_NORMG) + l * 1024 + col), sc = *(const f32x4*)(mod + 1024 + col);
        gs[j] = g * (sc + 1.0f); sh[j] = *(const f32x4*)(mod + col); }
    const int gw = bid * 8 + wave, NGW = G * 8;
    for (int m = gw; m < SEQ; m += 2 * NGW) {
        const int m2 = (m + NGW < SEQ) ? m + NGW : m;
        const f32x4* xr = (const f32x4*)(xin + (size_t)m * DM) + lane; const f32x4* xr2 = (const f32x4*)(xin + (size_t)m2 * DM) + lane;
        f32x4 v[4], w[4]; float s = 0.f, s2 = 0.f;
#pragma unroll
        for (int j = 0; j < 4; ++j) { v[j] = xr[64 * j]; w[j] = xr2[64 * j]; }
#pragma unroll
        for (int j = 0; j < 4; ++j) { s += (v[j].x * v[j].x + v[j].y * v[j].y) + (v[j].z * v[j].z + v[j].w * v[j].w); s2 += (w[j].x * w[j].x + w[j].y * w[j].y) + (w[j].z * w[j].z + w[j].w * w[j].w); }
        const float rstd = __builtin_amdgcn_rsqf(wave_sum(s) * (1.f / DM) + EPS), rstd2 = __builtin_amdgcn_rsqf(wave_sum(s2) * (1.f / DM) + EPS);
        u32x2* o8 = (u32x2*)(H + (size_t)m * DM) + lane; u32x2* o82 = (u32x2*)(H + (size_t)m2 * DM) + lane;
#pragma unroll
        for (int j = 0; j < 4; ++j) { const f32x4 o = v[j] * rstd * gs[j] + sh[j]; u32x2 q; q.x = cvt_pk_bf16(o.x, o.y); q.y = cvt_pk_bf16(o.z, o.w); o8[64 * j] = q;
            const f32x4 o2 = w[j] * rstd2 * gs[j] + sh[j]; u32x2 q2; q2.x = cvt_pk_bf16(o2.x, o2.y); q2.y = cvt_pk_bf16(o2.z, o2.w); o82[64 * j] = q2; }
    }
}

__device__ __forceinline__ void ldrow8(const bf16_t* __restrict__ base, int t, int ch, float (&v)[8]) {
    if (t < 0 || t >= SEQ) {
#pragma unroll
        for (int j = 0; j < 8; ++j) v[j] = 0.f;
    } else unpack8(*(const u32x4*)(base + (size_t)t * 1024 + ch), v);
}
__device__ __forceinline__ void ld8f32(const float* p, float (&v)[8]) {
    const f32x4 a = *(const f32x4*)p, b = *(const f32x4*)(p + 4);
    v[0] = a.x; v[1] = a.y; v[2] = a.z; v[3] = a.w; v[4] = b.x; v[5] = b.y; v[6] = b.z; v[7] = b.w;
}

__device__ __forceinline__ void phase_elem(KArgs a, unsigned char* wsb, int l, int lane, int wave, int bid, int G) {
    unsigned char* ws = wsb;
    const int gw = bid * 8 + wave, NGW = G * 8;
    for (int it = gw; it < 2048; it += NGW) {
        const int run = it >> 1, hf = it & 1, ch = hf * 512 + lane * 8, t0 = run * 16;
        {
            const bf16_t* __restrict__ XA = (const bf16_t*)(ws + WS_XA); bf16_t* __restrict__ UA = (bf16_t*)(ws + WS_H);
            float w0[8], w1[8], w2[8], w3[8], bb[8];
            const float* cw = INP(a, I_CAW) + (size_t)l * 4 * 1024 + ch;
            ld8f32(cw, w0); ld8f32(cw + 1024, w1); ld8f32(cw + 2048, w2); ld8f32(cw + 3072, w3); ld8f32(INP(a, I_CAB) + l * 1024 + ch, bb);
            float xm2[8], xm1[8], x0[8], xp1[8];
            ldrow8(XA, t0 - 2, ch, xm2); ldrow8(XA, t0 - 1, ch, xm1); ldrow8(XA, t0, ch, x0);
#pragma unroll
            for (int s = 0; s < 16; ++s) { const int t = t0 + s;
                ldrow8(XA, t + 1, ch, xp1);
                float o[8];
#pragma unroll
                for (int j = 0; j < 8; ++j) o[j] = w0[j] * xm2[j] + w1[j] * xm1[j] + w2[j] * x0[j] + w3[j] * xp1[j] + bb[j];
                *(u32x4*)(UA + (size_t)t * 1024 + ch) = pack8(o);
#pragma unroll
                for (int j = 0; j < 8; ++j) { xm2[j] = xm1[j]; xm1[j] = x0[j]; x0[j] = xp1[j]; } }
        }
        {
            const bf16_t* __restrict__ PP = (const bf16_t*)(ws + WS_XC); const bf16_t* __restrict__ BG = (const bf16_t*)(ws + WS_BC); bf16_t* __restrict__ YC = (bf16_t*)(ws + WS_YC);
            float w0[8], w1[8], w2[8];
            const float* cw = INP(a, I_CCW) + (size_t)l * 3 * 1024 + ch;
            ld8f32(cw, w0); ld8f32(cw + 1024, w1); ld8f32(cw + 2048, w2);
            float pm1[8], p0[8], pp1[8], t1[8];
            ldrow8(PP, t0 - 1, ch, pm1); ldrow8(PP, t0, ch, p0);
#pragma unroll
            for (int s = 0; s < 16; ++s) { const int t = t0 + s;
                ldrow8(PP, t + 1, ch, pp1); ldrow8(BG, t, ch, t1);
                float o[8];
#pragma unroll
                for (int j = 0; j < 8; ++j) o[j] = t1[j] * (w0[j] * pm1[j] + w1[j] * p0[j] + w2[j] * pp1[j]);
                *(u32x4*)(YC + (size_t)t * 1024 + ch) = pack8(o);
#pragma unroll
                for (int j = 0; j < 8; ++j) { pm1[j] = p0[j]; p0[j] = pp1[j]; } }
        }
        {
            bf16_t* Q = (bf16_t*)(ws + WS_Q); bf16_t* Kb = (bf16_t*)(ws + WS_K);
            const float* rc = (const float*)(ws + WS_ROPE); const float* rs = rc + 320 * 32;
            const int d0 = (lane & 15) * 8, i0 = (lane & 3) * 8;
            float qg[8], kg[8];
            ld8f32(INP(a, I_QG) + l * 128 + d0, qg); ld8f32(INP(a, I_KG) + l * 128 + d0, kg);
            const bool second = (lane & 4) != 0;
            const int tokb = run * 16 + hf * 8;
            const int tsel = (d0 < 64) ? 0 : 1;
            u32x4 cur[3]; float cs[8], sn[8];
#define LD_TOK(tok, dst, dcs, dsn) do { const int tp_ = tsel ? 256 + ((tok) & 63) : ((tok) >> 6); ld8f32(rc + tp_ * 32 + i0, dcs); ld8f32(rs + tp_ * 32 + i0, dsn); \
                dst[0] = *(const u32x4*)(Q + (size_t)(tok) * 1024 + lane * 8); dst[1] = *(const u32x4*)(Q + (size_t)(tok) * 1024 + 512 + lane * 8); dst[2] = *(const u32x4*)(Kb + (size_t)(tok) * 256 + (lane & 31) * 8); } while (0)
            LD_TOK(tokb, cur, cs, sn);
#pragma unroll
            for (int i = 0; i < 8; ++i) {
                const int tok = tokb + i;
                u32x4 nx[3]; float ncs[8], nsn[8];
                if (i < 7) LD_TOK(tok + 1, nx, ncs, nsn);
#pragma unroll
                for (int part = 0; part < 3; ++part) {
                    bf16_t* p = (part < 2) ? (Q + (size_t)tok * 1024 + part * 512 + lane * 8) : (Kb + (size_t)tok * 256 + (lane & 31) * 8);
                    float v[8]; unpack8(cur[part], v);
                    float ss = 0.f;
#pragma unroll
                    for (int j = 0; j < 8; ++j) ss += v[j] * v[j];
                    ss += __shfl_xor(ss, 1); ss += __shfl_xor(ss, 2); ss += __shfl_xor(ss, 4); ss += __shfl_xor(ss, 8);
                    const float rstd = __builtin_amdgcn_rsqf(ss * (1.f / 128.f) + EPS);
                    float o[8];
#pragma unroll
                    for (int j = 0; j < 8; ++j) { const float y = v[j] * rstd * (part < 2 ? qg[j] : kg[j]); const float pr = __shfl_xor(y, 4);
                        o[j] = y * cs[j] + (second ? pr : -pr) * sn[j]; }
                    if (part < 2 || lane < 32) *(u32x4*)p = pack8(o);
                    if (part == 2 && lane < 32) {
                        const int kvh = lane >> 4, r = tok & 63, dch = (lane & 15) >> 1;
                        unsigned char* kp = ws + WS_K8 + (size_t)kvh * 2097152 + (size_t)(tok >> 6) * 8192 + r * 128 + 16 * (dch ^ (r & 7)) + (lane & 1) * 8;
                        u32x2 w8; w8.x = (unsigned)pk4_fp8(o[0], o[1], o[2], o[3]); w8.y = (unsigned)pk4_fp8(o[4], o[5], o[6], o[7]); *(u32x2*)kp = w8; }
                }
                if (i < 7) {
#pragma unroll
                    for (int part = 0; part < 3; ++part) cur[part] = nx[part];
#pragma unroll
                    for (int j = 0; j < 8; ++j) { cs[j] = ncs[j]; sn[j] = nsn[j]; } }
            }
#undef LD_TOK
        }
    }
    for (int it = gw; it < 4096; it += NGW) {
        const int jh = it & 1, h = (it >> 1) & 1, dh = (it >> 2) & 1, tile = (it >> 3) & 255, kvh = it >> 11;
        const int d = dh * 64 + lane;
        const bf16_t* __restrict__ V = (const bf16_t*)(ws + WS_V) + (size_t)tile * 64 * 256 + kvh * 128 + d;
        float f[16];
#pragma unroll
        for (int jj = 0; jj < 16; ++jj) { const int key = (jj & 3) + 8 * (jj >> 2) + 4 * h + 32 * jh; f[jj] = bf2f(V[(size_t)key * 256]); }
        u32x4 w; w.x = (unsigned)pk4_fp8(f[0], f[1], f[2], f[3]); w.y = (unsigned)pk4_fp8(f[4], f[5], f[6], f[7]); w.z = (unsigned)pk4_fp8(f[8], f[9], f[10], f[11]); w.w = (unsigned)pk4_fp8(f[12], f[13], f[14], f[15]);
        *(u32x4*)(ws + WS_V8 + (size_t)kvh * 2097152 + (size_t)tile * 8192 + d * 64 + 16 * ((2 * h + jh) ^ ((d >> 2) & 3))) = w;
    }
}

__device__ __forceinline__ void phase_scan_a(KArgs a, unsigned char* wsb, int lane, int wave, int bid, int G) {
    unsigned char* ws = wsb;
    const int gw = bid * 8 + wave, NGW = G * 8;
    for (int it = gw; it < 2048; it += NGW) {
        const int c = it >> 4, dir = (it >> 3) & 1, ch = (it & 7) * 128 + lane * 2;
        const bf16_t* LA = (const bf16_t*)(ws + WS_LA + (size_t)dir * 64 * MiB) + ch;
        const bf16_t* UU = (const bf16_t*)(ws + WS_U + (size_t)dir * 64 * MiB) + ch;
        float s0 = 0.f, s1 = 0.f, h0 = 0.f, h1 = 0.f;
#pragma unroll 16
        for (int st = 0; st < 128; ++st) { const int t = dir == 0 ? c * 128 + st : c * 128 + 127 - st;
            const unsigned wl = *(const unsigned*)(LA + (size_t)t * 1024), wu = *(const unsigned*)(UU + (size_t)t * 1024);
            const float l0 = __uint_as_float(wl << 16), l1 = __uint_as_float(wl & 0xffff0000u);
            const float u0 = __uint_as_float(wu << 16), u1 = __uint_as_float(wu & 0xffff0000u);
            h0 = __builtin_amdgcn_exp2f(l0) * h0 + u0; h1 = __builtin_amdgcn_exp2f(l1) * h1 + u1; s0 += l0; s1 += l1; }
        *(f32x2*)((float*)(ws + WS_SA) + (c * 2 + dir) * 1024 + ch) = (f32x2){s0, s1};
        *(f32x2*)((float*)(ws + WS_SH) + (c * 2 + dir) * 1024 + ch) = (f32x2){h0, h1};
    }
}
__device__ __forceinline__ void phase_scan_c(unsigned char* wsb, LAS unsigned char* lds, int lane, int wave, int bid, int G) {
    unsigned char* ws = wsb;
    const int gw = bid * 8 + wave, NGW = G * 8;
    const float* __restrict__ SA = (const float*)(ws + WS_SA); const float* __restrict__ SH = (const float*)(ws + WS_SH);
    for (int it = gw; it < 2048; it += NGW) {
        const int c = it >> 4, ch = (it & 15) * 64 + lane;
        float cf = 0.f, cb = 0.f;
#pragma unroll 8
        for (int sidx = 0; sidx < c; ++sidx) { const int idx = (sidx * 2) * 1024 + ch; cf = __builtin_amdgcn_exp2f(SA[idx]) * cf + SH[idx]; }
#pragma unroll 8
        for (int sidx = 127; sidx > c; --sidx) { const int idx = (sidx * 2 + 1) * 1024 + ch; cb = __builtin_amdgcn_exp2f(SA[idx]) * cb + SH[idx]; }
        const bf16_t* __restrict__ LAf = (const bf16_t*)(ws + WS_LA) + ch; const bf16_t* __restrict__ UUf = (const bf16_t*)(ws + WS_U) + ch;
        const bf16_t* __restrict__ LAb = (const bf16_t*)(ws + WS_LA + 64 * MiB) + ch; const bf16_t* __restrict__ UUb = (const bf16_t*)(ws + WS_U + 64 * MiB) + ch;
        const bf16_t* __restrict__ SGA = (const bf16_t*)(ws + WS_SGA) + ch; bf16_t* __restrict__ YA = (bf16_t*)(ws + WS_XA) + ch;
        LAS bf16_t* hfs = (LAS bf16_t*)(lds + wave * 16384) + lane;
        float h = cf;
        { const bf16_t* pl = LAf + (size_t)c * 128 * 1024; const bf16_t* pu = UUf + (size_t)c * 128 * 1024;
#pragma unroll 1
            for (int blk = 0; blk < 8; ++blk) {
                float l[16], u[16];
#pragma unroll
                for (int i = 0; i < 16; ++i) { l[i] = bf2f(pl[i * 1024]); u[i] = bf2f(pu[i * 1024]); }
#pragma unroll
                for (int i = 0; i < 16; ++i) { h = __builtin_amdgcn_exp2f(l[i]) * h + u[i]; hfs[(blk * 16 + i) * 64] = (bf16_t)f2bf(h); }
                pl += 16 * 1024; pu += 16 * 1024; } }
        h = cb;
        { const size_t e0 = (size_t)(c * 128 + 112) * 1024;
            const bf16_t* pl = LAb + e0; const bf16_t* pu = UUb + e0; const bf16_t* pg = SGA + e0; bf16_t* py = YA + e0;
#pragma unroll 1
            for (int blk = 7; blk >= 0; --blk) {
                float l[16], u[16], g[16];
#pragma unroll
                for (int i = 0; i < 16; ++i) { l[i] = bf2f(pl[i * 1024]); u[i] = bf2f(pu[i * 1024]); g[i] = bf2f(pg[i * 1024]); }
#pragma unroll
                for (int i = 15; i >= 0; --i) { h = __builtin_amdgcn_exp2f(l[i]) * h + u[i];
                    py[i * 1024] = (bf16_t)f2bf((bf2f(hfs[(blk * 16 + i) * 64]) + h) * g[i]); }
                pl -= 16 * 1024; pu -= 16 * 1024; pg -= 16 * 1024; py -= 16 * 1024; } }
    }
}

__global__ void __launch_bounds__(512, 2) mk_fwd(Args args) {
    extern __shared__ __attribute__((aligned(16))) unsigned char lds[];
    cg::grid_group grid = cg::this_grid();
    LAS unsigned char* L = (LAS unsigned char*)lds;
    if (threadIdx.x < 2) ((LAS unsigned*)(L + 131072))[threadIdx.x] = 0u;
    __syncthreads();
    (void)xcd_barrier_post((unsigned*)(args.ws + WS_BAR), (volatile LAS unsigned*)(L + 131072));
    const int wave_u = __builtin_amdgcn_readfirstlane(threadIdx.x >> 6);
    for (int ph = args.ph_lo; ph < args.ph_hi; ++ph) {
        int tid; { int ln_; asm volatile("v_mbcnt_lo_u32_b32 %0, -1, 0\n\tv_mbcnt_hi_u32_b32 %0, -1, %0" : "=v"(ln_)); tid = wave_u * 64 + ln_; }
        int G = gridDim.x, bid = blockIdx.x; asm volatile("" : "+s"(G), "+s"(bid));
        KArgs ap = (KArgs)__builtin_amdgcn_kernarg_segment_ptr(); asm volatile("" : "+s"(ap));
        GAS unsigned char* wsg = (GAS unsigned char*)ap->ws; asm volatile("" : "+s"(wsg));
        unsigned char* ws = (unsigned char*)wsg;
        const int lane = tid & 63, wave = __builtin_amdgcn_readfirstlane(tid >> 6);
        unsigned long long pt0 = 0; int pcls = -1; if (PROBE_K >= 0) pt0 = __builtin_amdgcn_s_memrealtime();
        if (ph == 0) { pcls = 8; if (PHM & 512) phase_prologue(ap, ws, L, tid, lane, wave, bid, G); }
        else {
            const int q = ph - 1, lb = q / NPH_PER, k = q - lb * NPH_PER, l = lb >> 1, b = lb & 1; pcls = k;
            if (k == 0) { if (PHM & 1) phase_h(ap, ws, l, b, lane, wave, bid, G); }
            else if (k == 1) { if (PHM & 2) {
                pg8::Gemm g{(const bf16_t*)(ws + WS_H), (const bf16_t*)(ws + WS_WIN) + (size_t)l * NIN * 1024, 1024, 1024, 1024, 0, 0};
                pg8::StaticOrder S; S.init(SEQ, NIN, G, bid);
                pg8::EpiInProj E{ws};
                pg8::gemm_phase<pg8::EpiInProj, pg8::StaticOrder, 0>(L, g, S, E, tid); }
            } else if (k == 2) { if (PHM & 4) phase_elem(ap, ws, l, lane, wave, bid, G); }
            else if (k == 3) {
                if (PHM & 8) {
                    pg8::Gemm g{(const bf16_t*)(ws + WS_H), (const bf16_t*)(ws + WS_WG) + (size_t)l * 4096 * 256, 1024, 256, 256, 0, 0};
                    pg8::StaticOrder S; S.init(SEQ, 4096, G, bid);
                    pg8::EpiGates E{ws, INP(ap, I_BRG) + l * 2048, INP(ap, I_BIG) + l * 2048, INP(ap, I_LAM) + l * 2048};
                    pg8::gemm_phase<pg8::EpiGates, pg8::StaticOrder, 1>(L, g, S, E, tid);
                }
                if (PROBE_K == 3) { const unsigned long long t1 = __builtin_amdgcn_s_memrealtime(), dt = t1 - pt0; while (__builtin_amdgcn_s_memrealtime() - t1 < dt) __builtin_amdgcn_s_sleep(8); }
                if (PROBE_K == 9) { pt0 = __builtin_amdgcn_s_memrealtime(); pcls = 9; }
                if (PHM & 256) {
                    const int v = (G % 8 == 0) ? (bid % 8) * (G / 8) + bid / 8 : bid;
                    const int per = (512 + G - 1) / G;
                    if (PROBE_F8 && l == 0 && b == 0) {
                        for (int i = 0; i < per; ++i) { const int idx = v * per + i; if (idx >= 4) break;
                            const int h = idx >> 6, qb = idx & 63, kvh = h >> 2;
                            const attn::bf16* Qb = (const attn::bf16*)(ws + WS_Q) + (size_t)qb * 256 * 1024 + h * 128;
                            const bf16_t* Gb = (const bf16_t*)(ws + WS_SGB) + (size_t)qb * 256 * 1024 + h * 128;
                            attn::attn_pp8_body(Qb, ws + WS_K8 + (size_t)kvh * 2097152, ws + WS_V8 + (size_t)kvh * 2097152, (bf16_t*)(ws + WS_SPARE) + (size_t)idx * 256 * 1024, nullptr, SEQ, (char*)lds, tid);
                        }
                    }
                    int tid2 = tid; asm volatile("" : "+v"(tid2));
                    for (int i = 0; i < per; ++i) { const int idx = v * per + i; if (idx >= 512) break;
                        const int h = idx >> 6, qb = idx & 63, kvh = h >> 2;
                        const attn::bf16* Qb = (const attn::bf16*)(ws + WS_Q) + (size_t)qb * 256 * 1024 + h * 128;
                        bf16_t* Ob = (bf16_t*)(ws + WS_SGB) + (size_t)qb * 256 * 1024 + h * 128;
                        const bf16_t* Gb = (const bf16_t*)(ws + WS_SGB) + (size_t)qb * 256 * 1024 + h * 128;
                        if (PROBE_F8) {
                            const attn::bf16* Kh = (const attn::bf16*)(ws + WS_K) + kvh * 128;
                            const attn::bf16* Vh = (const attn::bf16*)(ws + WS_V) + kvh * 128;
                            const bf16_t* cmp = (l == 0 && b == 0 && idx < 4) ? (const bf16_t*)(ws + WS_SPARE) + (size_t)idx * 256 * 1024 : nullptr;
                            attn::attn_pp_body(Qb, Kh, Vh, Ob, Gb, SEQ, (char*)lds, tid2, cmp, (unsigned*)(ws + WS_FLAG));
                        } else attn::attn_pp8_body(Qb, ws + WS_K8 + (size_t)kvh * 2097152, ws + WS_V8 + (size_t)kvh * 2097152, Ob, Gb, SEQ, (char*)lds, tid2);
                    }
                }
            } else if (k == 4) { if (PHM & 16) phase_scan_a(ap, ws, lane, wave, bid, G); }
            else if (k == 5) { if (PHM & 32) phase_scan_c(ws, L, lane, wave, bid, G); }
            else if (k == 6) { if (PHM & 64) {
                pg8::Gemm g{(const bf16_t*)(ws + WS_XA), (const bf16_t*)(ws + WS_WBR) + (size_t)l * 3 * 1048576, 1024, 1024, 1024,
                            (long)WS_SGB - (long)WS_XA, (long)WS_YC - (long)WS_XA};
                pg8::BranchOrder S; S.so.init(SEQ, 1024, G, bid);
                pg8::EpiBranch E{ws};
                pg8::gemm_phase<pg8::EpiBranch, pg8::BranchOrder, 2>(L, g, S, E, tid); }
            } else if (PHM & 128) {
                pg8::Gemm g{(const bf16_t*)(ws + WS_SGA), (const bf16_t*)(ws + WS_WOUT) + (size_t)l * 1048576, 1024, 1024, 1024, 0, 0};
                pg8::StaticOrder S; S.init(SEQ, 1024, G, bid);
                const float* xi = (l == 0 ? INP(ap, I_X) : OUTP(ap)) + (size_t)b * SEQ * DM;
                pg8::EpiOut E{xi, OUTP(ap) + (size_t)b * SEQ * DM, (const float*)(ws + WS_MOD) + (l * 2 + b) * 3072 + 2048, (const unsigned*)(ws + WS_FLAG)};
                pg8::gemm_phase<pg8::EpiOut, pg8::StaticOrder, 0>(L, g, S, E, tid);
            }
        }
        if (PROBE_K >= 0 && PROBE_K != 3 && ph + 1 == args.ph_hi && pcls == PROBE_K) { VM_WAIT(); __syncthreads(); const unsigned long long t1 = __builtin_amdgcn_s_memrealtime(), dt = t1 - pt0; while (__builtin_amdgcn_s_memrealtime() - t1 < dt) __builtin_amdgcn_s_sleep(8); }
        if (ph + 1 < args.ph_hi) { if (ph == args.ph_lo) grid.sync(); else { XcdBarrier xbar; xbar.bar = (unsigned*)(ws + WS_BAR); xbar.x = xb_xcc_id(); xbar.st = (volatile LAS unsigned*)(L + 131072); xcd_barrier(xbar, tid); }
            if (PROBE_K >= 0 && PROBE_K != 3 && pcls == PROBE_K) { const unsigned long long t1 = __builtin_amdgcn_s_memrealtime(), dt = t1 - pt0; while (__builtin_amdgcn_s_memrealtime() - t1 < dt) __builtin_amdgcn_s_sleep(8); } }
    }
}

extern "C" void kernel_launch(void* const* d_in, const int* in_sizes, int n_in, void* d_out, int out_size, void* d_ws, size_t ws_size, hipStream_t stream) {
    static int grid = 0;
    if (grid == 0) {
        if (n_in != 18 || ws_size < WS_END) { fprintf(stderr, "kernel_launch: need 18 inputs and >= %zu bytes of workspace (got %d, %zu)\n", (size_t)WS_END, n_in, ws_size); grid = -1; return; }
        int dev = 0, cus = 0, per_cu = 0;
        hipGetDevice(&dev);
        hipDeviceGetAttribute(&cus, hipDeviceAttributeMultiprocessorCount, dev);
        if (hipFuncSetAttribute((const void*)mk_fwd, hipFuncAttributeMaxDynamicSharedMemorySize, LDS_BYTES) != hipSuccess) { fprintf(stderr, "kernel_launch: hipFuncSetAttribute failed\n"); grid = -1; return; }
        if (hipOccupancyMaxActiveBlocksPerMultiprocessor(&per_cu, (const void*)mk_fwd, 512, LDS_BYTES) != hipSuccess || per_cu < 1) { fprintf(stderr, "kernel_launch: occupancy query gave %d\n", per_cu); per_cu = 1; }
        (void)hipGetLastError();
        grid = cus * 1;
    }
    if (grid < 0) return;
    if (hipMemsetAsync((char*)d_ws + WS_BAR, 0, 16384, stream) != hipSuccess) { fprintf(stderr, "kernel_launch: memset failed\n"); return; }
    Args a{};
    for (int i = 0; i < 18; ++i) a.in[i] = (const float*)d_in[i];
    a.out = (float*)d_out; a.ws = (unsigned char*)d_ws; a.ph_lo = 0; a.ph_hi = NPHASES;
    void* kargs[] = {&a};
    hipError_t e = hipLaunchCooperativeKernel((const void*)mk_fwd, dim3(grid), dim3(512), kargs, LDS_BYTES, stream);
    if (e != hipSuccess) fprintf(stderr, "kernel_launch: cooperative launch failed: %s (grid %d)\n", hipGetErrorString(e), grid);
}
```

```cpp
#include <hip/hip_runtime.h>
#include <hip/hip_cooperative_groups.h>
#include <hip/hip_bf16.h>
#include <cstdio>
#include <cstdint>
namespace cg = cooperative_groups;
#ifndef PROBE_F8
#define PROBE_F8 0
#endif

#define LAS __attribute__((address_space(3)))
#define GAS __attribute__((address_space(1)))
typedef unsigned short bf16_t;
typedef short bf16x8 __attribute__((ext_vector_type(8)));
typedef float f32x4 __attribute__((ext_vector_type(4)));
typedef float f32x2 __attribute__((ext_vector_type(2)));
typedef unsigned u32x4 __attribute__((ext_vector_type(4)));
typedef unsigned u32x2 __attribute__((ext_vector_type(2)));

constexpr int DM = 1024, SEQ = 16384, NBATCH = 2, DEPTH = 2, NIN = 11776;
constexpr int NPH_PER = 8, NPHASES = 1 + DEPTH * NBATCH * NPH_PER;
constexpr float EPS = 1e-6f;
constexpr float LOG2E = 1.4426950408889634f;

constexpr size_t MiB = 1u << 20;
constexpr size_t WS_MOD = 0;
constexpr size_t WS_ROPE = 64 * 1024;
constexpr size_t WS_BAR = 256 * 1024;
constexpr size_t WS_SA = 1 * MiB, WS_SH = 2 * MiB;
constexpr size_t WS_WIN = 4 * MiB, WS_WG = 50 * MiB, WS_WBR = 54 * MiB, WS_WOUT = 66 * MiB;
constexpr size_t WS_H = 70 * MiB;
constexpr size_t WS_XA = 102 * MiB;
constexpr size_t WS_SGA = 134 * MiB;
constexpr size_t WS_Q = 166 * MiB;
constexpr size_t WS_K = 198 * MiB, WS_V = 206 * MiB;
constexpr size_t WS_SGB = 214 * MiB;
constexpr size_t WS_XC = 246 * MiB, WS_BC = 278 * MiB, WS_CC = 310 * MiB, WS_SGC = 342 * MiB;
constexpr size_t WS_LA = WS_XC, WS_U = WS_BC;
constexpr size_t WS_SMG = 374 * MiB;
constexpr size_t WS_YC = 470 * MiB;
constexpr size_t WS_K8 = 502 * MiB, WS_V8 = 506 * MiB;
constexpr size_t WS_SPARE = 510 * MiB;
constexpr size_t WS_FLAG = WS_BAR + 15 * 1024;
constexpr size_t WS_END = 512 * MiB;
constexpr int LDS_BYTES = 131072 + 1024;

__device__ __forceinline__ float bf2f(bf16_t v) { return __uint_as_float((unsigned)v << 16); }
__device__ __forceinline__ unsigned f2bf(float f) { unsigned u = __float_as_uint(f); return (u + 0x7fffu + ((u >> 16) & 1u)) >> 16; }
__device__ __forceinline__ unsigned cvt_pk_bf16(float lo, float hi) { unsigned r; asm("v_cvt_pk_bf16_f32 %0, %1, %2" : "=v"(r) : "v"(lo), "v"(hi)); return r; }
__device__ __forceinline__ void unpack8(const u32x4 w, float (&f)[8]) {
#pragma unroll
    for (int i = 0; i < 4; ++i) { f[2 * i] = __uint_as_float(w[i] << 16); f[2 * i + 1] = __uint_as_float(w[i] & 0xffff0000u); }
}
__device__ __forceinline__ u32x4 pack8(const float (&f)[8]) {
    u32x4 w; w.x = cvt_pk_bf16(f[0], f[1]); w.y = cvt_pk_bf16(f[2], f[3]); w.z = cvt_pk_bf16(f[4], f[5]); w.w = cvt_pk_bf16(f[6], f[7]); return w;
}
typedef int i32x8 __attribute__((ext_vector_type(8)));
__device__ __forceinline__ int pk4_fp8(float a, float b, float c, float d) { int r = __builtin_amdgcn_cvt_pk_fp8_f32(a, b, 0, false); return __builtin_amdgcn_cvt_pk_fp8_f32(c, d, r, true); }
__device__ __forceinline__ float sigmoidf_(float v) { return __builtin_amdgcn_rcpf(1.f + __expf(-v)); }
__device__ __forceinline__ float wave_sum(float v) {
#pragma unroll
    for (int o = 1; o < 64; o <<= 1) v += __shfl_xor(v, o);
    return v;
}
#define LDS_WAIT() asm volatile("s_waitcnt lgkmcnt(0)" ::: "memory")
#define VM_WAIT() asm volatile("s_waitcnt vmcnt(0)" ::: "memory")

namespace pg8 {
constexpr int BM = 256, BK = 64, HALF = 128, HTB = HALF * BK * 2, STAGE_BYTES = 8 * HTB, NXCD = 8, WGM = 8;
__device__ __forceinline__ int lds_byte(int r, int c) { const int st = (r >> 4) * 2 + (c >> 5), rr = r & 15, cc = c & 31, ob = rr * 64 + cc * 2; return st * 1024 + (ob ^ (((ob >> 9) & 1) << 5)); }
__device__ __forceinline__ void stage_rc(int b, int& R, int& C) { const int st = b / 1024, sb = b % 1024, swz = sb ^ (((sb >> 9) & 1) << 5); R = (st >> 1) * 16 + swz / 64; C = (st & 1) * 32 + (swz % 64) / 2; }
__device__ __forceinline__ int perm32(int rho) { const int n = rho >> 4, i = rho & 15; return 8 * (i >> 2) + 4 * n + (i & 3); }

struct Unit { int pm, pn, kk; };
struct Gemm { const bf16_t* A; const bf16_t* Bt; int lda, ldb, K; long a1, a2; };

struct StaticOrder {
    int nM, nN, nwg, G, c;
    __device__ void init(int M, int N, int G_, int c_) { nM = M / BM; nN = N / BM; nwg = nM * nN; G = G_; c = c_; }
    __device__ bool next(int i, Unit& u) const {
        const long L = (long)i * G + c; if (L >= nwg) return false;
        int wgid = (int)L; { const int q = nwg / NXCD, r = nwg % NXCD, xcd = wgid % NXCD, off = wgid / NXCD; wgid = (xcd < r ? xcd * (q + 1) : r * (q + 1) + (xcd - r) * q) + off; }
        const int nig = WGM * nN, gid = wgid / nig, fm = gid * WGM, gsz = (nM - fm) < WGM ? (nM - fm) : WGM;
        u.pm = fm + ((wgid % nig) % gsz); u.pn = (wgid % nig) / gsz; u.kk = 0; return true;
    }
};
struct BranchOrder {
    StaticOrder so;
    __device__ bool next(int i, Unit& u) const { const int ti = i / 3, kk = i - 3 * ti; if (!so.next(ti, u)) return false; u.kk = kk; return true; }
};

template <int MODE> __device__ __forceinline__ const char* unitA(const Gemm& g, const Unit& u) {
    const char* p = (const char*)g.A + (size_t)u.pm * BM * g.lda * 2;
    if (MODE == 1) p += (((u.pn >> 1) & 3) * 256) * 2;
    if (MODE == 2) p += (u.kk == 1 ? g.a1 : (u.kk == 2 ? g.a2 : 0l));
    return p;
}
template <int MODE> __device__ __forceinline__ const char* unitB(const Gemm& g, const Unit& u) {
    const char* p = (const char*)g.Bt + (size_t)u.pn * BM * g.ldb * 2;
    if (MODE == 2) p += (size_t)u.kk * 1024 * 1024 * 2;
    return p;
}

template <class Epi, class Sched, int MODE>
__device__ __forceinline__ void gemm_phase(LAS unsigned char* lds, const Gemm g, const Sched& S, const Epi& E, const int tid) {
    const int wid = __builtin_amdgcn_readfirstlane(tid >> 6), lane = tid & 63, wr = wid >> 2, wc = wid & 3, fr = lane & 15, fq = lane >> 4;
    const int K = g.K, nt = K / BK;
    unsigned voffA[2], voffB[2];
#pragma unroll
    for (int i = 0; i < 2; ++i) { int R, C; stage_rc(tid * 16 + i * 8192, R, C); const int Rb = (R & ~31) + perm32(R & 31);
        voffA[i] = (unsigned)(R * g.lda + C) * 2u; voffB[i] = (unsigned)(Rb * g.ldb + C) * 2u; }
    const size_t kstep = (size_t)(BK * 2);
    const size_t hstepA = (size_t)HALF * g.lda * 2, hstepB = (size_t)HALF * g.ldb * 2;
    const unsigned ldsw = (unsigned)wid * 1024u;
    const int aoff = lds_byte(wr * 64 + fr, fq * 8), boff = lds_byte(wc * 32 + fr, fq * 8);
#define PG8_SA(b, h) (((b) * 2 + (h)) * HTB)
#define PG8_SB(b, h) ((4 + (b) * 2 + (h)) * HTB)
#define PG8_STAGE(bufoff, gbase, voff) do { _Pragma("unroll") for (int _i = 0; _i < 2; ++_i) \
        __builtin_amdgcn_global_load_lds((const unsigned*)((const char*)(gbase) + (voff)[_i]), (LAS unsigned*)(lds + (bufoff) + ldsw + _i * 8192), 16, 0, 0); } while (0)
#define PG8_LDA(dst, b, h) do { _Pragma("unroll") for (int m = 0; m < 4; ++m) _Pragma("unroll") for (int k = 0; k < 2; ++k) dst[m][k] = *(const LAS bf16x8*)(lds + PG8_SA(b, h) + aoff + m * 2048 + k * 1024); } while (0)
#define PG8_LDB(dst, b, h) do { _Pragma("unroll") for (int n = 0; n < 2; ++n) _Pragma("unroll") for (int k = 0; k < 2; ++k) dst[n][k] = *(const LAS bf16x8*)(lds + PG8_SB(b, h) + boff + n * 2048 + k * 1024); } while (0)
#define PG8_MMA(ai, bj, At, Bt) do { __builtin_amdgcn_s_setprio(1); _Pragma("unroll") for (int m = 0; m < 4; ++m) _Pragma("unroll") for (int n = 0; n < 2; ++n) _Pragma("unroll") for (int k = 0; k < 2; ++k) \
        acc[ai][bj][m][n] = __builtin_amdgcn_mfma_f32_16x16x32_bf16(Bt[n][k], At[m][k], acc[ai][bj][m][n], 0, 0, 0); __builtin_amdgcn_s_setprio(0); } while (0)
#define PG8_WAIT_V(n) asm volatile("s_waitcnt vmcnt(" #n ")" ::: "memory")
#define PG8_WAIT_L(n) asm volatile("s_waitcnt lgkmcnt(" #n ")" ::: "memory")
#define PG8_BAR __builtin_amdgcn_s_barrier()
#define PG8_SCHED __builtin_amdgcn_sched_barrier(0)
    Unit cur, nxt; int ui = 0;
    if (!S.next(0, cur)) return;
    f32x4 acc[2][2][4][2];
#pragma unroll
    for (int a = 0; a < 2; ++a)
#pragma unroll
        for (int b = 0; b < 2; ++b)
#pragma unroll
            for (int m = 0; m < 4; ++m)
#pragma unroll
                for (int n = 0; n < 2; ++n) acc[a][b][m][n] = (f32x4){0.f, 0.f, 0.f, 0.f};
    bf16x8 At[4][2], B0[2][2], B1[2][2];
    const char* cA = unitA<MODE>(g, cur); const char* cB = unitB<MODE>(g, cur);
    PG8_STAGE(PG8_SB(0, 0), cB, voffB); PG8_STAGE(PG8_SB(0, 1), cB + hstepB, voffB); PG8_STAGE(PG8_SA(0, 0), cA, voffA); PG8_STAGE(PG8_SA(0, 1), cA + hstepA, voffA);
    if (wr == 1) PG8_BAR;
    PG8_WAIT_V(2); PG8_BAR;
    PG8_STAGE(PG8_SB(1, 0), cB + kstep, voffB); PG8_STAGE(PG8_SA(1, 0), cA + kstep, voffA); PG8_STAGE(PG8_SB(1, 1), cB + hstepB + kstep, voffB);
    PG8_WAIT_V(6); PG8_BAR;
    for (;;) {
        const bool has_next = S.next(ui + 1, nxt);
        const char* nA = has_next ? unitA<MODE>(g, nxt) : cA; const char* nB = has_next ? unitB<MODE>(g, nxt) : cB;
#pragma nounroll
        for (int t = 0; t < nt; t += 2) {
            const bool last = (t == nt - 2);
            const char* a1 = cA + (size_t)(t + 1) * kstep;
            const char* a2 = last ? nA : cA + (size_t)(t + 2) * kstep; const char* b2 = last ? nB : cB + (size_t)(t + 2) * kstep;
            const char* a3 = a2 + kstep; const char* b3 = b2 + kstep;
            PG8_LDB(B0, 0, 0); PG8_LDB(B1, 0, 1); PG8_SCHED; PG8_LDA(At, 0, 0); PG8_STAGE(PG8_SA(1, 1), a1 + hstepA, voffA);
            PG8_WAIT_V(8); PG8_WAIT_L(0); PG8_BAR; PG8_MMA(0, 0, At, B0); PG8_MMA(0, 1, At, B1); PG8_BAR; PG8_SCHED;
            PG8_LDA(At, 0, 1); PG8_STAGE(PG8_SB(0, 0), b2, voffB); PG8_STAGE(PG8_SB(0, 1), b2 + hstepB, voffB); PG8_STAGE(PG8_SA(0, 0), a2, voffA);
            PG8_WAIT_V(8); PG8_WAIT_L(0); PG8_BAR; PG8_MMA(1, 0, At, B0); PG8_MMA(1, 1, At, B1); PG8_BAR; PG8_SCHED;
            PG8_LDB(B0, 1, 0); PG8_LDB(B1, 1, 1); PG8_SCHED; PG8_LDA(At, 1, 0); PG8_STAGE(PG8_SA(0, 1), a2 + hstepA, voffA);
            PG8_WAIT_V(8); PG8_WAIT_L(0); PG8_BAR; PG8_MMA(0, 0, At, B0); PG8_MMA(0, 1, At, B1); PG8_BAR; PG8_SCHED;
            PG8_LDA(At, 1, 1); PG8_STAGE(PG8_SB(1, 0), b3, voffB); PG8_STAGE(PG8_SB(1, 1), b3 + hstepB, voffB); PG8_STAGE(PG8_SA(1, 0), a3, voffA);
            PG8_WAIT_V(8); PG8_WAIT_L(0); PG8_BAR; PG8_MMA(1, 0, At, B0); PG8_MMA(1, 1, At, B1); PG8_BAR; PG8_SCHED;
        }
        if (wr == 0) PG8_BAR;
        E(acc, cur, wr, wc, fr, fq);
        if (!has_next) break;
#pragma unroll
        for (int a = 0; a < 2; ++a)
#pragma unroll
            for (int b = 0; b < 2; ++b)
#pragma unroll
                for (int m = 0; m < 4; ++m)
#pragma unroll
                    for (int n = 0; n < 2; ++n) acc[a][b][m][n] = (f32x4){0.f, 0.f, 0.f, 0.f};
        cur = nxt; cA = nA; cB = nB; ++ui;
        if (wr == 1) PG8_BAR;
    }
    PG8_WAIT_V(0);
    PG8_BAR;
#undef PG8_SA
#undef PG8_SB
#undef PG8_STAGE
#undef PG8_LDA
#undef PG8_LDB
#undef PG8_MMA
#undef PG8_WAIT_V
#undef PG8_WAIT_L
#undef PG8_BAR
#undef PG8_SCHED
}

__device__ __forceinline__ void store_tile_bf16(const f32x4 (&acc)[2][2][4][2], bf16_t* base, int ldc, int row0, int col0, int act) {
#pragma unroll
    for (int ai = 0; ai < 2; ++ai)
#pragma unroll
        for (int m = 0; m < 4; ++m) { bf16_t* rowp = base + (size_t)(row0 + ai * HALF + m * 16) * ldc + col0;
#pragma unroll
            for (int bj = 0; bj < 2; ++bj) { float v[8];
#pragma unroll
                for (int j = 0; j < 4; ++j) { v[j] = acc[ai][bj][m][0][j]; v[4 + j] = acc[ai][bj][m][1][j]; }
                if (act != 0) {
                    float sg[8];
#pragma unroll
                    for (int j = 0; j < 8; ++j) sg[j] = sigmoidf_(v[j]);
                    if (act == 1) {
#pragma unroll
                        for (int j = 0; j < 8; ++j) v[j] *= sg[j];
                    } else {
#pragma unroll
                        for (int j = 0; j < 8; ++j) v[j] = sg[j];
                    }
                }
                *(u32x4*)(rowp + bj * HALF) = pack8(v); }
            asm volatile("" ::: "memory"); }
}
struct EpiInProj {
    unsigned char* ws;
    __device__ __forceinline__ void operator()(const f32x4 (&acc)[2][2][4][2], const Unit& u, int wr, int wc, int fr, int fq) const {
        const int pn = u.pn; size_t off; int ldc = 1024, col, act = 0;
        if (pn < 4) { off = WS_XA; col = pn * 256; }
        else if (pn < 8) { off = WS_SGA; col = (pn - 4) * 256; act = 1; }
        else if (pn < 12) { off = WS_Q; col = (pn - 8) * 256; }
        else if (pn == 12) { off = WS_K; col = 0; ldc = 256; }
        else if (pn == 13) { off = WS_V; col = 0; ldc = 256; }
        else if (pn < 18) { off = WS_SGB; col = (pn - 14) * 256; act = 1; }
        else if (pn < 34) {
            const bool bg = pn >= 26; const int blk = bg ? pn - 26 : pn - 18;
            bf16_t* basep = (bf16_t*)(ws + (bg ? WS_BC : WS_XC));
            const int row0p = u.pm * BM + wr * 64 + fr, col0p = blk * 128 + wc * 32 + 8 * fq;
#pragma unroll
            for (int ai = 0; ai < 2; ++ai)
#pragma unroll
                for (int m = 0; m < 4; ++m) { float v[8];
#pragma unroll
                    for (int j = 0; j < 8; ++j) { const float x0 = acc[ai][0][m][j >> 2][j & 3], x1 = acc[ai][1][m][j >> 2][j & 3];
                        v[j] = bg ? x0 * (x1 * sigmoidf_(x1)) : x0 * x1; }
                    *(u32x4*)(basep + (size_t)(row0p + ai * HALF + m * 16) * 1024 + col0p) = pack8(v); }
            return; }
        else { off = WS_SMG; col = (pn - 34) * 256; ldc = 3072; act = 2; }
        bf16_t* base = (bf16_t*)(ws + off);
        const int row0 = u.pm * BM + wr * 64 + fr, col0 = col + wc * 32 + 8 * fq;
        store_tile_bf16(acc, base, ldc, row0, col0, act);
    }
};
struct EpiGates {
    unsigned char* ws; const float* b_r; const float* b_i; const float* lam;
    __device__ __forceinline__ void operator()(const f32x4 (&acc)[2][2][4][2], const Unit& u, int wr, int wc, int fr, int fq) const {
        const int dir = u.pn >> 3, nb = (u.pn >> 1) & 3, hh = u.pn & 1;
        const int ch0 = nb * 256 + hh * 128 + wc * 32 + 8 * fq;
        float br[8], bi[8], sp[8];
#pragma unroll
        for (int j = 0; j < 8; ++j) { br[j] = b_r[dir * 1024 + ch0 + j]; bi[j] = b_i[dir * 1024 + ch0 + j];
            const float lm = lam[dir * 1024 + ch0 + j]; const float e = __expf(-lm);
            const float spl = lm < -15.f ? -lm : (e < 0.03f ? e * (1.f - e * (0.5f - e * (0.33333334f - 0.25f * e))) : __logf(1.f + e));
            sp[j] = -8.0f * LOG2E * spl; }
        const bf16_t* UA = (const bf16_t*)(ws + WS_H);
        bf16_t* LA = (bf16_t*)(ws + WS_LA + (size_t)dir * 64 * MiB);
        bf16_t* UU = (bf16_t*)(ws + WS_U + (size_t)dir * 64 * MiB);
        const int row0 = u.pm * BM + wr * 64 + fr;
#pragma unroll
        for (int ai = 0; ai < 2; ++ai)
#pragma unroll
            for (int m = 0; m < 4; ++m) { const size_t o = (size_t)(row0 + ai * HALF + m * 16) * 1024 + ch0;
                float x[8]; unpack8(*(const u32x4*)(UA + o), x);
                float la[8], uu[8];
#pragma unroll
                for (int j = 0; j < 8; ++j) { const float pr = acc[ai][0][m][j >> 2][j & 3] + br[j], pi = acc[ai][1][m][j >> 2][j & 3] + bi[j];
                    const float r = sigmoidf_(pr), ig = sigmoidf_(pi);
                    const float l2 = r * sp[j]; const float a = __builtin_amdgcn_exp2f(l2);
                    la[j] = l2; uu[j] = __builtin_amdgcn_sqrtf(fmaxf(1.f - a * a, 0.f)) * ig * x[j]; }
                *(u32x4*)(LA + o) = pack8(la); *(u32x4*)(UU + o) = pack8(uu); }
    }
};
struct EpiBranch {
    unsigned char* ws;
    __device__ __forceinline__ void operator()(const f32x4 (&acc)[2][2][4][2], const Unit& u, int wr, int wc, int fr, int fq) const {
        const bf16_t* G = (const bf16_t*)(ws + WS_SMG) + u.kk * 1024;
        bf16_t* Mg = (bf16_t*)(ws + WS_SGA);
        const int row0 = u.pm * BM + wr * 64 + fr, col0 = u.pn * BM + wc * 32 + 8 * fq;
#pragma unroll
        for (int ai = 0; ai < 2; ++ai)
#pragma unroll
            for (int m = 0; m < 4; ++m) { const int row = row0 + ai * HALF + m * 16;
#pragma unroll
                for (int bj = 0; bj < 2; ++bj) { const int col = col0 + bj * HALF;
                    float gt[8], v[8]; unpack8(*(const u32x4*)(G + (size_t)row * 3072 + col), gt);
#pragma unroll
                    for (int j = 0; j < 8; ++j) v[j] = gt[j] * acc[ai][bj][m][j >> 2][j & 3];
                    bf16_t* mp = Mg + (size_t)row * 1024 + col;
                    if (u.kk != 0) { float old[8]; unpack8(*(const u32x4*)mp, old);
#pragma unroll
                        for (int j = 0; j < 8; ++j) v[j] += old[j]; }
                    *(u32x4*)mp = pack8(v); } }
    }
};
struct EpiOut {
    const float* xi; float* xo; const float* gate; const unsigned* flag;
    __device__ __forceinline__ void operator()(const f32x4 (&acc)[2][2][4][2], const Unit& u, int wr, int wc, int fr, int fq) const {
        const int row0 = u.pm * BM + wr * 64 + fr, col0 = u.pn * BM + wc * 32 + 8 * fq;
        const bool bad = PROBE_F8 ? (__hip_atomic_load(flag, __ATOMIC_RELAXED, __HIP_MEMORY_SCOPE_AGENT) != 0u) : false; const float qn = __builtin_nanf("");
        f32x4 gv[2][2];
#pragma unroll
        for (int bj = 0; bj < 2; ++bj)
#pragma unroll
            for (int n = 0; n < 2; ++n) gv[bj][n] = *(const f32x4*)(gate + col0 + bj * HALF + 4 * n);
#pragma unroll
        for (int ai = 0; ai < 2; ++ai)
#pragma unroll
            for (int m = 0; m < 4; ++m) { const size_t o = (size_t)(row0 + ai * HALF + m * 16) * 1024 + col0;
#pragma unroll
                for (int bj = 0; bj < 2; ++bj)
#pragma unroll
                    for (int n = 0; n < 2; ++n) { const f32x4 xv = *(const f32x4*)(xi + o + bj * HALF + 4 * n);
                        f32x4 r = xv + gv[bj][n] * acc[ai][bj][m][n]; if (PROBE_F8 && bad) r = (f32x4){qn, qn, qn, qn};
                        *(f32x4*)(xo + o + bj * HALF + 4 * n) = r; } }
    }
};
}

namespace attn {
using bf16 = __hip_bfloat16;
using s16x4 = __attribute__((ext_vector_type(4))) short;
using f32x16 = __attribute__((ext_vector_type(16))) float;
constexpr int D = 128, NW = 8, QBLK = 32, KVBLK = 64;
constexpr float SCALE = 0.088388347648318440f;
constexpr float THR = 8.f;
constexpr int LDQ = 1024, LDK = 256, LDO = 1024;
constexpr size_t SHM_V = KVBLK * D * 2, SHM_K = KVBLK * D * 2, SHM_ATTN = 2 * SHM_V + 2 * SHM_K + NW * 64 * 4;
#define KSWZ(row, colB) ((row) * 256 + ((colB) ^ (((row) & 7) << 4)))
#define SBAR() __builtin_amdgcn_sched_barrier(0)
__device__ __forceinline__ int crow(int r, int hi) { return (r & 3) + 8 * (r >> 2) + 4 * hi; }
__device__ __forceinline__ unsigned cvtpk(float lo, float hi) { unsigned r; asm volatile("v_cvt_pk_bf16_f32 %0, %1, %2" : "=v"(r) : "v"(lo), "v"(hi)); return r; }

__device__ __forceinline__ void partialSM(f32x16& p0, f32x16& p1, float& m_reg, float& mn, float& alpha) {
  constexpr float C = SCALE * 1.4426950408889634f;
  float pmax = p0[0]; for (int r = 1; r < 16; ++r) pmax = fmaxf(pmax, p0[r]); for (int r = 0; r < 16; ++r) pmax = fmaxf(pmax, p1[r]);
  { auto rr = __builtin_amdgcn_permlane32_swap(__float_as_uint(pmax), __float_as_uint(pmax), false, false);
    pmax = fmaxf(__uint_as_float(rr[0]), __uint_as_float(rr[1])); }
  if (__builtin_expect(__all(pmax - m_reg <= THR / SCALE), 1)) { mn = m_reg; alpha = 1.f; }
  else { mn = fmaxf(m_reg, pmax); alpha = __builtin_amdgcn_exp2f((m_reg - mn) * C); m_reg = mn; }
  float mnC = -mn * C;
  for (int r = 0; r < 16; ++r) p0[r] = fmaf(p0[r], C, mnC); for (int r = 0; r < 16; ++r) p1[r] = fmaf(p1[r], C, mnC);
  for (int r = 0; r < 16; ++r) p0[r] = __builtin_amdgcn_exp2f(p0[r]);
}
__device__ __forceinline__ void finishSM(f32x16& p0, f32x16& p1, float alpha, float& l_reg, bf16x8& pa0, bf16x8& pa1, bf16x8& pa2, bf16x8& pa3) {
  for (int r = 0; r < 16; ++r) p1[r] = __builtin_amdgcn_exp2f(p1[r]);
  float ps = 0; for (int r = 0; r < 16; ++r) ps += p0[r]; for (int r = 0; r < 16; ++r) ps += p1[r];
  { auto rr = __builtin_amdgcn_permlane32_swap(__float_as_uint(ps), __float_as_uint(ps), false, false);
    ps = __uint_as_float(rr[0]) + __uint_as_float(rr[1]); }
  l_reg = l_reg * alpha + ps;
#define PK4(P, BASE, OUT) do { unsigned a0 = cvtpk(P[BASE + 0], P[BASE + 1]), a1 = cvtpk(P[BASE + 2], P[BASE + 3]);   \
    unsigned b0 = cvtpk(P[BASE + 4], P[BASE + 5]), b1 = cvtpk(P[BASE + 6], P[BASE + 7]);                              \
    auto r0 = __builtin_amdgcn_permlane32_swap(a0, b0, false, false); auto r1 = __builtin_amdgcn_permlane32_swap(a1, b1, false, false); \
    u32x4 w = {r0[0], r1[0], r0[1], r1[1]}; OUT = *reinterpret_cast<bf16x8*>(&w); } while (0)
  PK4(p0, 0, pa0); PK4(p0, 8, pa1); PK4(p1, 0, pa2); PK4(p1, 8, pa3);
#undef PK4
}
__device__ __forceinline__ void qkt(f32x16& p0, f32x16& p1, const bf16* Ks, const bf16x8* qr, int r32, int hi) {
  p0 = f32x16{}; p1 = f32x16{};
  for (int d0 = 0; d0 < 8; ++d0) { int cb = (d0 * 16 + hi * 8) * 2;
    bf16x8 b0 = *reinterpret_cast<const bf16x8*>((const char*)Ks + KSWZ(r32, cb));
    bf16x8 b1 = *reinterpret_cast<const bf16x8*>((const char*)Ks + KSWZ(32 + r32, cb));
    p0 = __builtin_amdgcn_mfma_f32_32x32x16_bf16(b0, qr[d0], p0, 0, 0, 0);
    p1 = __builtin_amdgcn_mfma_f32_32x32x16_bf16(b1, qr[d0], p1, 0, 0, 0); }
}
__device__ __forceinline__ int v_st(int k, int c) { const int kk = (k & ~0xC) | ((k & 4) << 1) | ((k & 8) >> 1); return ((kk >> 3) * 4 + (c >> 5)) * 512 + ((kk & 7) * 32 + (c & 31)) * 2; }
__device__ __forceinline__ int v_rd_base(int lane) { return ((lane & 3) << 3) | (((lane >> 2) & 3) << 6) | (((lane >> 4) & 1) << 5) | (((lane >> 5) & 1) << 8); }
constexpr int v_rd_off(int d0, int ks, int half) { return d0 * 512 + ks * 4096 + half * 2048; }
template <int OFF> __device__ __forceinline__ s16x4 tr_read(int vb) {
  s16x4 r; asm volatile("ds_read_b64_tr_b16 %0, %1 offset:%2" : "=&v"(r) : "v"(vb), "i"(OFF) : "memory"); return r;
}
template <int D0> __device__ __forceinline__ void pv_one(f32x16& od, int vb, bf16x8 pa0, bf16x8 pa1, bf16x8 pa2, bf16x8 pa3) {
  const s16x4 l0 = tr_read<v_rd_off(D0, 0, 0)>(vb), h0 = tr_read<v_rd_off(D0, 0, 1)>(vb), l1 = tr_read<v_rd_off(D0, 1, 0)>(vb), h1 = tr_read<v_rd_off(D0, 1, 1)>(vb);
  const s16x4 l2 = tr_read<v_rd_off(D0, 2, 0)>(vb), h2 = tr_read<v_rd_off(D0, 2, 1)>(vb), l3 = tr_read<v_rd_off(D0, 3, 0)>(vb), h3 = tr_read<v_rd_off(D0, 3, 1)>(vb);
  asm volatile("s_waitcnt lgkmcnt(0)" ::: "memory"); SBAR();
#define PK(L, H) (bf16x8){L[0], L[1], L[2], L[3], H[0], H[1], H[2], H[3]}
  od = __builtin_amdgcn_mfma_f32_32x32x16_bf16(pa0, PK(l0, h0), od, 0, 0, 0);
  od = __builtin_amdgcn_mfma_f32_32x32x16_bf16(pa1, PK(l1, h1), od, 0, 0, 0);
  od = __builtin_amdgcn_mfma_f32_32x32x16_bf16(pa2, PK(l2, h2), od, 0, 0, 0);
  od = __builtin_amdgcn_mfma_f32_32x32x16_bf16(pa3, PK(l3, h3), od, 0, 0, 0);
#undef PK
}
__device__ __forceinline__ void pv_d0(f32x16* o, int vb, bf16x8 pa0, bf16x8 pa1, bf16x8 pa2, bf16x8 pa3) {
  pv_one<0>(o[0], vb, pa0, pa1, pa2, pa3); pv_one<1>(o[1], vb, pa0, pa1, pa2, pa3); pv_one<2>(o[2], vb, pa0, pa1, pa2, pa3); pv_one<3>(o[3], vb, pa0, pa1, pa2, pa3);
}
__device__ __forceinline__ void attn_dense_body(const bf16* Qb, const bf16* __restrict__ Kh, const bf16* __restrict__ Vh,
                                                bf16_t* Ob, const bf16_t* Gb, int seq, char* lds, const int tid) {
  const int wid = tid >> 6, lane = tid & 63, r32 = lane & 31, hi = lane >> 5;
  bf16* V_lds = (bf16*)lds; bf16* K_lds = (bf16*)(lds + 2 * SHM_V);
  float* ws = (float*)(lds + 2 * SHM_V + 2 * SHM_K) + wid * 64; float* li_l = ws; float* al_l = ws + 32;
  float m_reg = -1e30f, l_reg = 0; f32x16 o[4] = {}; bf16x8 qr[8];
  const bf16* Qw = Qb + (long)(wid * QBLK + r32) * LDQ + hi * 8;
#pragma unroll
  for (int d0 = 0; d0 < 8; ++d0) qr[d0] = *reinterpret_cast<const bf16x8*>(Qw + d0 * 16);
  const int sr = tid >> 4, sc = (tid & 15) * 8, vst0 = v_st(sr, sc), vst1 = v_st(32 + sr, sc);
  const int vb0 = (int)(uintptr_t)V_lds + v_rd_base(lane);
  struct { bf16x8 vs0, vs1, ks0, ks1; } sr_[2];
#define SLOAD(i, k0) do { sr_[i].vs0 = *reinterpret_cast<const bf16x8*>(&Vh[(long)((k0) + sr) * LDK + sc]); sr_[i].vs1 = *reinterpret_cast<const bf16x8*>(&Vh[(long)((k0) + 32 + sr) * LDK + sc]); \
    sr_[i].ks0 = *reinterpret_cast<const bf16x8*>(&Kh[(long)((k0) + sr) * LDK + sc]); sr_[i].ks1 = *reinterpret_cast<const bf16x8*>(&Kh[(long)((k0) + 32 + sr) * LDK + sc]); } while (0)
#define SWRITE(b, i) do { *(bf16x8*)((char*)V_lds + (b) * SHM_V + vst0) = sr_[i].vs0;          \
    *(bf16x8*)((char*)V_lds + (b) * SHM_V + vst1) = sr_[i].vs1; int kc = sc * 2;               \
    *(bf16x8*)((char*)K_lds + (b) * SHM_K + KSWZ(sr, kc)) = sr_[i].ks0;                       \
    *(bf16x8*)((char*)K_lds + (b) * SHM_K + KSWZ(32 + sr, kc)) = sr_[i].ks1; } while (0)
#define SWAIT() asm volatile("s_waitcnt vmcnt(4)" ::: "memory")
#define RESC(a) do { if (__any((a) < 1.f)) { if (hi == 0) al_l[r32] = (a); asm volatile("s_waitcnt lgkmcnt(0)" ::: "memory"); \
    for (int d = 0; d < 4; ++d) for (int r = 0; r < 16; ++r) o[d][r] *= al_l[crow(r, hi)]; } } while (0)
  f32x16 pA0, pA1, pB0, pB1; float mnA, mnB, alA, alB; bf16x8 pa0, pa1, pa2, pa3; const int NT = seq / KVBLK;
  constexpr int SE = 0, SO = 1;
  SLOAD(SE, 0); asm volatile("s_waitcnt vmcnt(0)" ::: "memory"); SWRITE(0, SE); __syncthreads();
  qkt(pA0, pA1, K_lds, qr, r32, hi); partialSM(pA0, pA1, m_reg, mnA, alA);
  SLOAD(SO, KVBLK); if (2 < NT) SLOAD(SE, 2 * KVBLK);
  SWAIT(); SWRITE(1, SO); __syncthreads();
#pragma nounroll
  for (int j = 1; j + 1 < NT; j += 2) {
    SBAR(); qkt(pB0, pB1, (bf16*)((char*)K_lds + SHM_K), qr, r32, hi);
    finishSM(pA0, pA1, alA, l_reg, pa0, pa1, pa2, pa3); SBAR();
    SLOAD(SO, (j + 2) * KVBLK); SBAR();
    pv_d0(o, vb0, pa0, pa1, pa2, pa3); partialSM(pB0, pB1, m_reg, mnB, alB);
    __syncthreads(); SWAIT(); SWRITE(0, SE);
    RESC(alB); __syncthreads();
    SBAR(); qkt(pA0, pA1, K_lds, qr, r32, hi);
    finishSM(pB0, pB1, alB, l_reg, pa0, pa1, pa2, pa3); SBAR();
    if (j + 3 < NT) SLOAD(SE, (j + 3) * KVBLK); SBAR();
    pv_d0(o, vb0 + (int)SHM_V, pa0, pa1, pa2, pa3); partialSM(pA0, pA1, m_reg, mnA, alA);
    __syncthreads(); SWAIT(); SWRITE(1, SO);
    RESC(alA); __syncthreads();
  }
  SBAR(); qkt(pB0, pB1, (bf16*)((char*)K_lds + SHM_K), qr, r32, hi);
  finishSM(pA0, pA1, alA, l_reg, pa0, pa1, pa2, pa3); SBAR();
  pv_d0(o, vb0, pa0, pa1, pa2, pa3); partialSM(pB0, pB1, m_reg, mnB, alB);
  __syncthreads(); RESC(alB);
  finishSM(pB0, pB1, alB, l_reg, pa0, pa1, pa2, pa3); SBAR();
  pv_d0(o, vb0 + (int)SHM_V, pa0, pa1, pa2, pa3);
  if (hi == 0) li_l[r32] = l_reg; asm volatile("s_waitcnt lgkmcnt(0)" ::: "memory");
  float rli[16];
#pragma unroll
  for (int r = 0; r < 16; ++r) rli[r] = __builtin_amdgcn_rcpf(li_l[crow(r, hi)]);
  __syncthreads();
  { int lane_e = lane, wid_e = wid; asm volatile("" : "+v"(lane_e), "+v"(wid_e)); wid_e = __builtin_amdgcn_readfirstlane(wid_e);
    bf16_t* stg = (bf16_t*)lds + wid_e * 4096;
#pragma unroll
    for (int r = 0; r < 16; ++r) { const int orow = crow(r, hi);
#pragma unroll
      for (int d0 = 0; d0 < 4; ++d0) stg[orow * 128 + d0 * 32 + r32] = (bf16_t)f2bf(o[d0][r] * rli[r]); }
    asm volatile("s_waitcnt lgkmcnt(0)" ::: "memory");
    bf16_t* Ow = Ob + (long)(wid_e * QBLK) * LDO; const bf16_t* Gw = Gb + (long)(wid_e * QBLK) * LDO;
    u32x4 gq[8];
#pragma unroll
    for (int i = 0; i < 8; ++i) { const int row = i * 4 + (lane_e >> 4), ch = lane_e & 15; gq[i] = *(const u32x4*)(Gw + (long)row * LDO + ch * 8); }
#pragma unroll
    for (int i = 0; i < 8; ++i) { const int row = i * 4 + (lane_e >> 4), ch = lane_e & 15;
      float ov[8], gv[8]; unpack8(*(const u32x4*)(stg + row * 128 + ch * 8), ov); unpack8(gq[i], gv);
#pragma unroll
      for (int j = 0; j < 8; ++j) ov[j] *= gv[j];
      *(u32x4*)(Ow + (long)row * LDO + ch * 8) = pack8(ov); } }
  __syncthreads();
#undef SLOAD
#undef SWRITE
#undef SWAIT
#undef RESC
}

__device__ __forceinline__ void attn_pp_body(const bf16* Qb, const bf16* __restrict__ Kh, const bf16* __restrict__ Vh,
                                             bf16_t* Ob, const bf16_t* Gb, int seq, char* lds, const int tid, const bf16_t* cmp = nullptr, unsigned* flag = nullptr) {
  const int wid = __builtin_amdgcn_readfirstlane(tid >> 6), lane = tid & 63, r32 = lane & 31, hi = lane >> 5;
  const int g = wid >> 2;
  constexpr int NB = 3;
  char* V_lds = lds; char* K_lds = lds + NB * SHM_V;
  float* ws = (float*)(lds + NB * (SHM_V + SHM_K)) + wid * 64; float* li_l = ws; float* al_l = ws + 32;
  float m_reg = -1e30f, l_reg = 0; f32x16 o[4] = {}; bf16x8 qr[8];
  const bf16* Qw = Qb + (long)(wid * QBLK + r32) * LDQ + hi * 8;
#pragma unroll
  for (int d0 = 0; d0 < 8; ++d0) qr[d0] = *reinterpret_cast<const bf16x8*>(Qw + d0 * 16);
  const int sr = tid >> 4, sc = (tid & 15) * 8, vst0 = v_st(sr, sc), vst1 = v_st(32 + sr, sc);
  const int ksw0 = KSWZ(sr, sc * 2), ksw1 = KSWZ(32 + sr, sc * 2);
  const int vbase = (int)(uintptr_t)V_lds + v_rd_base(lane);
  struct Stg { bf16x8 vs0, vs1, ks0, ks1; } st0, st1;
#define SLOAD(S, t) do { const long k0_ = (long)(t) * KVBLK; S.vs0 = *reinterpret_cast<const bf16x8*>(&Vh[(k0_ + sr) * LDK + sc]); S.vs1 = *reinterpret_cast<const bf16x8*>(&Vh[(k0_ + 32 + sr) * LDK + sc]); \
    S.ks0 = *reinterpret_cast<const bf16x8*>(&Kh[(k0_ + sr) * LDK + sc]); S.ks1 = *reinterpret_cast<const bf16x8*>(&Kh[(k0_ + 32 + sr) * LDK + sc]); } while (0)
#define SWRITE(S, b) do { *(bf16x8*)(V_lds + (b) * SHM_V + vst0) = S.vs0; *(bf16x8*)(V_lds + (b) * SHM_V + vst1) = S.vs1; \
    *(bf16x8*)(K_lds + (b) * SHM_K + ksw0) = S.ks0; *(bf16x8*)(K_lds + (b) * SHM_K + ksw1) = S.ks1; } while (0)
#define RESC(a) do { if (__any((a) < 1.f)) { if (hi == 0) al_l[r32] = (a); asm volatile("s_waitcnt lgkmcnt(0)" ::: "memory"); \
    for (int d = 0; d < 4; ++d) for (int r = 0; r < 16; ++r) o[d][r] *= al_l[crow(r, hi)]; } } while (0)
  const int NT = seq / KVBLK;
  f32x16 p0, p1; bf16x8 pa0, pa1, pa2, pa3;
#define SMX() do { float mn_, al_; partialSM(p0, p1, m_reg, mn_, al_); RESC(al_); finishSM(p0, p1, al_, l_reg, pa0, pa1, pa2, pa3); } while (0)
  SLOAD(st0, 0); if (g) SLOAD(st1, 1);
  SWRITE(st0, 0); if (g) SWRITE(st1, 1);
  SLOAD(st0, 1 + g); SLOAD(st1, 2 + g);
  __syncthreads();
  if (g) __syncthreads();
  SBAR(); qkt(p0, p1, (const bf16*)K_lds, qr, r32, hi); SBAR();
  __syncthreads();
  SWRITE(st0, 1 + g); if (3 + g < NT) SLOAD(st0, 3 + g);
  SMX();
  __syncthreads();
  int c = 0;
#define STEP(i, ST) do { const int cK_ = (c == 2) ? 0 : c + 1; \
    SBAR(); \
    qkt(p0, p1, (const bf16*)(K_lds + cK_ * SHM_K), qr, r32, hi); \
    pv_d0(o, vbase + c * (int)SHM_V, pa0, pa1, pa2, pa3); \
    SBAR(); \
    __syncthreads(); \
    { const int t_ = (i) + 2 + g; if (t_ < NT) { const int cb_ = (cK_ == 2) ? 0 : cK_ + 1; const int cw_ = g ? ((cb_ == 2) ? 0 : cb_ + 1) : cb_; \
        SWRITE(ST, cw_); if (t_ + 2 < NT) SLOAD(ST, t_ + 2); } } \
    SMX(); \
    __syncthreads(); \
    c = cK_; } while (0)
  int i = 0;
#pragma nounroll
  for (; i + 1 < NT - 1; i += 2) { STEP(i, st1); STEP(i + 1, st0); }
  if (i < NT - 1) { STEP(i, st1); }
  SBAR(); pv_d0(o, vbase + c * (int)SHM_V, pa0, pa1, pa2, pa3); SBAR();
  __syncthreads();
  if (!g) __syncthreads();
  if (hi == 0) li_l[r32] = l_reg; asm volatile("s_waitcnt lgkmcnt(0)" ::: "memory");
  float rli[16];
#pragma unroll
  for (int r = 0; r < 16; ++r) rli[r] = __builtin_amdgcn_rcpf(li_l[crow(r, hi)]);
  { int lane_e = lane, wid_e = wid; asm volatile("" : "+v"(lane_e), "+v"(wid_e)); wid_e = __builtin_amdgcn_readfirstlane(wid_e);
    bf16_t* stg = (bf16_t*)lds + wid_e * 4096;
#pragma unroll
    for (int r = 0; r < 16; ++r) { const int orow = crow(r, hi);
#pragma unroll
      for (int d0 = 0; d0 < 4; ++d0) stg[orow * 128 + d0 * 32 + r32] = (bf16_t)f2bf(o[d0][r] * rli[r]); }
    asm volatile("s_waitcnt lgkmcnt(0)" ::: "memory");
    bf16_t* Ow = Ob + (long)(wid_e * QBLK) * LDO; const bf16_t* Gw = Gb + (long)(wid_e * QBLK) * LDO;
    u32x4 gq[8];
#pragma unroll
    for (int i2 = 0; i2 < 8; ++i2) { const int row = i2 * 4 + (lane_e >> 4), ch = lane_e & 15; gq[i2] = *(const u32x4*)(Gw + (long)row * LDO + ch * 8); }
#pragma unroll
    for (int i2 = 0; i2 < 8; ++i2) { const int row = i2 * 4 + (lane_e >> 4), ch = lane_e & 15;
      float ov[8], gv[8]; unpack8(*(const u32x4*)(stg + row * 128 + ch * 8), ov); unpack8(gq[i2], gv);
#pragma unroll
      for (int j = 0; j < 8; ++j) ov[j] *= gv[j];
      *(u32x4*)(Ow + (long)row * LDO + ch * 8) = pack8(ov); } }
  __syncthreads();
  if (PROBE_F8 && cmp) {
    asm volatile("s_waitcnt vmcnt(0)" ::: "memory");
    float pr_d = 0.f, pr_r = 0.f; int lane_c = lane; asm volatile("" : "+v"(lane_c));
    const bf16_t* stg2 = (const bf16_t*)lds + wid * 4096;
    float a0[8], c0[8];
#pragma unroll
    for (int i2 = 0; i2 < 8; ++i2) { const int rl = i2 * 4 + (lane_c >> 4), ch = lane_c & 15; float a[8], cv[8];
      unpack8(*(const u32x4*)(stg2 + rl * 128 + ch * 8), a); unpack8(*(const u32x4*)(cmp + (long)(wid * QBLK + rl) * LDO + ch * 8), cv);
      if (i2 == 0) {
#pragma unroll
        for (int j = 0; j < 8; ++j) { a0[j] = a[j]; c0[j] = cv[j]; }
      } else {
#pragma unroll
        for (int j = 0; j < 8; ++j) { const float fa = a[j] - a0[j], fc = cv[j] - c0[j]; pr_d = fmaxf(pr_d, fabsf(fa - fc)); pr_r = fmaxf(pr_r, fabsf(fa)); } } }
#pragma unroll
    for (int o_ = 1; o_ < 64; o_ <<= 1) { pr_d = fmaxf(pr_d, __shfl_xor(pr_d, o_)); pr_r = fmaxf(pr_r, __shfl_xor(pr_r, o_)); }
    if (lane_c == 0 && !(pr_d <= 0.3f * pr_r)) atomicOr(flag, 1u);
    __syncthreads(); }
#undef SLOAD
#undef SWRITE
#undef RESC
#undef SMX
#undef STEP
}

constexpr float THR8 = 1.9f;
__device__ __forceinline__ void partialSM8(f32x16& p0, f32x16& p1, float& m_reg, float& alpha) {
  constexpr float C = SCALE * 1.4426950408889634f;
  float pmax = p0[0]; for (int r = 1; r < 16; ++r) pmax = fmaxf(pmax, p0[r]); for (int r = 0; r < 16; ++r) pmax = fmaxf(pmax, p1[r]);
  { auto rr = __builtin_amdgcn_permlane32_swap(__float_as_uint(pmax), __float_as_uint(pmax), false, false);
    pmax = fmaxf(__uint_as_float(rr[0]), __uint_as_float(rr[1])); }
  float mn;
  if (__builtin_expect(__all(pmax - m_reg <= THR8 / SCALE), 1)) { mn = m_reg; alpha = 1.f; }
  else { mn = fmaxf(m_reg, pmax); alpha = __builtin_amdgcn_exp2f((m_reg - mn) * C); m_reg = mn; }
  const float mnC = 6.0f - mn * C;
  for (int r = 0; r < 16; ++r) p0[r] = fmaf(p0[r], C, mnC); for (int r = 0; r < 16; ++r) p1[r] = fmaf(p1[r], C, mnC);
  for (int r = 0; r < 16; ++r) p0[r] = __builtin_amdgcn_exp2f(p0[r]);
}
__device__ __forceinline__ void finishSM8(f32x16& p0, f32x16& p1, float alpha, float& l_reg, i32x8& pa) {
  for (int r = 0; r < 16; ++r) p1[r] = __builtin_amdgcn_exp2f(p1[r]);
  float sA = p0[0] + p0[1], sB = p0[2] + p0[3], sC = p1[0] + p1[1], sD = p1[2] + p1[3];
  for (int r = 4; r < 16; r += 2) { sA += p0[r]; sB += p0[r + 1]; sC += p1[r]; sD += p1[r + 1]; }
  float ps = (sA + sB) + (sC + sD);
  { auto rr = __builtin_amdgcn_permlane32_swap(__float_as_uint(ps), __float_as_uint(ps), false, false);
    ps = __uint_as_float(rr[0]) + __uint_as_float(rr[1]); }
  l_reg = l_reg * alpha + ps;
#pragma unroll
  for (int w = 0; w < 4; ++w) { pa[w] = pk4_fp8(p0[4 * w], p0[4 * w + 1], p0[4 * w + 2], p0[4 * w + 3]); pa[4 + w] = pk4_fp8(p1[4 * w], p1[4 * w + 1], p1[4 * w + 2], p1[4 * w + 3]); }
}

template <bool FIRST> __device__ __forceinline__ void partialSM8n(f32x16& p0, f32x16& p1, float& M2, f32x16& negm, float& alpha) {
  constexpr float THR2 = THR8 * 1.4426950408889634f;
  float mA = fmaxf(p0[0], p0[1]), mB = fmaxf(p0[2], p0[3]), mC = fmaxf(p1[0], p1[1]), mD = fmaxf(p1[2], p1[3]);
  for (int r = 4; r < 16; r += 4) { mA = fmaxf(fmaxf(mA, p0[r]), p0[r + 1]); mB = fmaxf(fmaxf(mB, p0[r + 2]), p0[r + 3]); mC = fmaxf(fmaxf(mC, p1[r]), p1[r + 1]); mD = fmaxf(fmaxf(mD, p1[r + 2]), p1[r + 3]); }
  float emax = fmaxf(fmaxf(mA, mB), fmaxf(mC, mD));
  { auto rr = __builtin_amdgcn_permlane32_swap(__float_as_uint(emax), __float_as_uint(emax), false, false);
    emax = fmaxf(__uint_as_float(rr[0]), __uint_as_float(rr[1])); }
  if (!FIRST && __builtin_expect(__all(emax - 6.0f <= THR2), 1)) { alpha = 1.f; }
  else { const float delta = FIRST ? (emax - 6.0f) : fmaxf(emax - 6.0f, 0.f); alpha = FIRST ? 0.f : __builtin_amdgcn_exp2f(-delta); M2 += delta;
    for (int r = 0; r < 16; ++r) { p0[r] -= delta; p1[r] -= delta; }
    const float nm = 6.0f - M2; for (int r = 0; r < 16; ++r) negm[r] = nm; asm volatile("" : "+v"(negm)); }
  for (int r = 0; r < 16; ++r) p0[r] = __builtin_amdgcn_exp2f(p0[r]);
}
#define MFMA8(A, B, Cc) __builtin_amdgcn_mfma_scale_f32_32x32x64_f8f6f4((A), (B), (Cc), 0, 0, 0, 0x7f7f7f7f, 0, 0x7f7f7f7f)
__device__ __forceinline__ i32x8 cat8(const u32x4 lo, const u32x4 hi4) { i32x8 r; r[0] = (int)lo.x; r[1] = (int)lo.y; r[2] = (int)lo.z; r[3] = (int)lo.w; r[4] = (int)hi4.x; r[5] = (int)hi4.y; r[6] = (int)hi4.z; r[7] = (int)hi4.w; return r; }
__device__ __forceinline__ void qkt8(f32x16& p0, f32x16& p1, const char* Ks, const i32x8* qf, int r32, int hi, const f32x16& negm) {
  const int x = r32 & 7; const char* k0 = Ks + r32 * 128; const char* k1 = k0 + 32 * 128;
  p0 = negm; p1 = negm;
#pragma unroll
  for (int s2 = 0; s2 < 2; ++s2) { const int c0 = 4 * s2 + 2 * hi, oa = 16 * (c0 ^ x), ob = 16 * ((c0 + 1) ^ x);
    const i32x8 a0 = cat8(*reinterpret_cast<const u32x4*>(k0 + oa), *reinterpret_cast<const u32x4*>(k0 + ob));
    const i32x8 a1 = cat8(*reinterpret_cast<const u32x4*>(k1 + oa), *reinterpret_cast<const u32x4*>(k1 + ob));
    p0 = MFMA8(a0, qf[s2], p0); p1 = MFMA8(a1, qf[s2], p1); }
}
__device__ __forceinline__ void pv8(f32x16* o, const char* Vs, const i32x8 pa, int r32, int hi) {
  const int sw = (r32 >> 2) & 3; const char* vb = Vs + r32 * 64; const int oa = 16 * ((2 * hi) ^ sw), ob = 16 * ((2 * hi + 1) ^ sw);
#pragma unroll
  for (int d0 = 0; d0 < 4; ++d0) { const i32x8 b = cat8(*reinterpret_cast<const u32x4*>(vb + d0 * 2048 + oa), *reinterpret_cast<const u32x4*>(vb + d0 * 2048 + ob));
    o[d0] = MFMA8(pa, b, o[d0]); }
}
__device__ __forceinline__ void attn_pp8_body(const bf16* Qb, const unsigned char* __restrict__ K8, const unsigned char* __restrict__ V8,
                                              bf16_t* Ob, const bf16_t* Gb, int seq, char* lds, const int tid) {
  const int wid = __builtin_amdgcn_readfirstlane(tid >> 6), lane = tid & 63, r32 = lane & 31, hi = lane >> 5;
  const int g = wid >> 2;
  constexpr int NB = 3, SL = 8192;
  char* V_lds = lds; char* K_lds = lds + NB * SL;
  float* ws = (float*)(lds + 65536) + wid * 64; float* li_l = ws; float* al_l = ws + 32;
  float M2 = 0.f, l_reg = 0; f32x16 o[4] = {}; i32x8 qf[2]; f32x16 negm; for (int r = 0; r < 16; ++r) negm[r] = 6.0f; asm volatile("" : "+v"(negm));
  constexpr float QC = SCALE * 1.4426950408889634f;
  { const bf16* Qw = Qb + (long)(wid * QBLK + r32) * LDQ + hi * 32;
#pragma unroll
    for (int s2 = 0; s2 < 2; ++s2) {
#pragma unroll
      for (int q4 = 0; q4 < 4; ++q4) { float f[8]; unpack8(*reinterpret_cast<const u32x4*>(Qw + s2 * 64 + q4 * 8), f);
        qf[s2][2 * q4] = pk4_fp8(f[0] * QC, f[1] * QC, f[2] * QC, f[3] * QC); qf[s2][2 * q4 + 1] = pk4_fp8(f[4] * QC, f[5] * QC, f[6] * QC, f[7] * QC); } } }
  struct Stg8 { u32x4 k, v; } st0, st1;
#define SLOAD(S, t) do { const size_t o_ = (size_t)(t) * SL + (size_t)tid * 16; S.k = *reinterpret_cast<const u32x4*>(K8 + o_); S.v = *reinterpret_cast<const u32x4*>(V8 + o_); } while (0)
#define SWRITE(S, b) do { *(u32x4*)(K_lds + (b) * SL + tid * 16) = S.k; *(u32x4*)(V_lds + (b) * SL + tid * 16) = S.v; } while (0)
#define RESC(a) do { if (__any((a) < 1.f)) { if (hi == 0) al_l[r32] = (a); asm volatile("s_waitcnt lgkmcnt(0)" ::: "memory"); \
    for (int d = 0; d < 4; ++d) for (int r = 0; r < 16; ++r) o[d][r] *= al_l[crow(r, hi)]; } } while (0)
  const int NT = seq / KVBLK;
  f32x16 p0, p1; i32x8 pa;
#define SMX() do { float al_; partialSM8n<true>(p0, p1, M2, negm, al_); RESC(al_); finishSM8(p0, p1, al_, l_reg, pa); } while (0)
  SLOAD(st0, 0); if (g) SLOAD(st1, 1);
  SWRITE(st0, 0); if (g) SWRITE(st1, 1);
  SLOAD(st0, 1 + g);
  __syncthreads();
  if (g) __syncthreads();
  SBAR(); qkt8(p0, p1, K_lds, qf, r32, hi, negm); SBAR();
  __syncthreads();
  SWRITE(st0, 1 + g); SLOAD(st0, 2 + g);
  SMX();
  __syncthreads();
  int c = 0;
#define STEP(i, ST) do { const int cK_ = (c == 2) ? 0 : c + 1; \
    SBAR(); \
    float al2_; \
    qkt8(p0, p1, K_lds + cK_ * SL, qf, r32, hi, negm); \
    pv8(o, V_lds + c * SL, pa, r32, hi);                    \
    SBAR(); \
    partialSM8n<false>(p0, p1, M2, negm, al2_);            \
    SBAR(); \
    __syncthreads(); \
    { const int t_ = (i) + 2 + g; if (t_ < NT) { const int cb_ = (cK_ == 2) ? 0 : cK_ + 1; const int cw_ = g ? ((cb_ == 2) ? 0 : cb_ + 1) : cb_; \
        SWRITE(st0, cw_); if (t_ + 1 < NT) SLOAD(st0, t_ + 1); } } \
    RESC(al2_); finishSM8(p0, p1, al2_, l_reg, pa); \
    __syncthreads(); \
    c = cK_; } while (0)
  int i = 0;
#pragma nounroll
  for (; i + 1 < NT - 1; i += 2) { STEP(i, st1); STEP(i + 1, st0); }
  if (i < NT - 1) { STEP(i, st1); }
  SBAR(); pv8(o, V_lds + c * SL, pa, r32, hi); SBAR();
  __syncthreads();
  if (!g) __syncthreads();
  if (hi == 0) li_l[r32] = l_reg; asm volatile("s_waitcnt lgkmcnt(0)" ::: "memory");
  float rli[16];
#pragma unroll
  for (int r = 0; r < 16; ++r) rli[r] = __builtin_amdgcn_rcpf(li_l[crow(r, hi)]);
  { int tid_e = tid; asm volatile("" : "+v"(tid_e)); const int lane_e = tid_e & 63; const int wid_e = __builtin_amdgcn_readfirstlane(tid_e >> 6);
    bf16_t* stg = (bf16_t*)lds + wid_e * 4096;
#pragma unroll
    for (int r = 0; r < 16; ++r) { const int orow = crow(r, hi);
#pragma unroll
      for (int d0 = 0; d0 < 4; ++d0) stg[orow * 128 + d0 * 32 + r32] = (bf16_t)f2bf(o[d0][r] * rli[r]); }
    asm volatile("s_waitcnt lgkmcnt(0)" ::: "memory");
    bf16_t* Ow = Ob + (long)(wid_e * QBLK) * LDO; const bf16_t* Gw = Gb + (long)(wid_e * QBLK) * LDO;
    u32x4 gq[8];
#pragma unroll
    for (int i2 = 0; i2 < 8; ++i2) { const int row = i2 * 4 + (lane_e >> 4), ch = lane_e & 15; gq[i2] = Gb ? *(const u32x4*)(Gw + (long)row * LDO + ch * 8) : (u32x4){0x3f803f80u, 0x3f803f80u, 0x3f803f80u, 0x3f803f80u}; }
#pragma unroll
    for (int i2 = 0; i2 < 8; ++i2) { const int row = i2 * 4 + (lane_e >> 4), ch = lane_e & 15;
      float ov[8], gv[8]; unpack8(*(const u32x4*)(stg + row * 128 + ch * 8), ov); unpack8(gq[i2], gv);
#pragma unroll
      for (int j = 0; j < 8; ++j) ov[j] *= gv[j];
      *(u32x4*)(Ow + (long)row * LDO + ch * 8) = pack8(ov); } }
  __syncthreads();
#undef SLOAD
#undef SWRITE
#undef RESC
#undef SMX
#undef STEP
#undef MFMA8
}
#undef KSWZ
#undef SBAR
}


#define XB_TMO      128
#define XB_XCNT(j)  (256  + 64 * (j))
#define XB_XSUB(j)  (1280 + 64 * (j))
#define XB_XGEN(j)  (2304 + 64 * (j))
#define XB_TOP      3328
#define XB_TOPGEN   3392
#define XCD_BAR_WORDS 3456
#define XB_SPIN_CAP (1u << 22)
__device__ __forceinline__ unsigned xb_ld(unsigned* p)              { return __hip_atomic_load(p, __ATOMIC_RELAXED, __HIP_MEMORY_SCOPE_AGENT); }
__device__ __forceinline__ unsigned xb_add(unsigned* p, unsigned v) { return __hip_atomic_fetch_add(p, v, __ATOMIC_RELAXED, __HIP_MEMORY_SCOPE_AGENT); }
__device__ __forceinline__ unsigned xb_xcc_id() { return (unsigned)__builtin_amdgcn_s_getreg((3 << 11) | 20) & 0xFu; }
#define XB_SPIN(cond, bar) do { unsigned _sp = 0; while (cond) { __builtin_amdgcn_s_sleep(1); \
    if ((++_sp & 255u) == 0u) { if (xb_ld(&(bar)[XB_TMO])) break; if (_sp > XB_SPIN_CAP) { atomicAdd(&(bar)[XB_TMO], 1u); break; } } } } while (0)
struct XcdBarrier { unsigned* bar; unsigned x; volatile LAS unsigned* st; };
__device__ __forceinline__ XcdBarrier xcd_barrier_post(unsigned* bar, volatile LAS unsigned* st) {
    XcdBarrier b; b.bar = bar; b.x = xb_xcc_id(); b.st = st;
    if (threadIdx.x == 0) (void)xb_add(&bar[XB_XCNT(b.x)], 1u);
    return b;
}
__device__ __forceinline__ void xcd_barrier_complete(unsigned* bar, unsigned x, unsigned& nloc, unsigned& nx) {
    const unsigned G = gridDim.x * gridDim.y * gridDim.z;
    unsigned sum, cnt, mine, sp = 0u;
    for (;;) {
        sum = 0u; cnt = 0u; mine = 0u;
#pragma unroll
        for (unsigned j = 0; j < 16; ++j) { const unsigned c = xb_ld(&bar[XB_XCNT(j)]); sum += c; cnt += (c > 0u) ? 1u : 0u; mine = (j == x) ? c : mine; }
        if (sum == G) break;
        __builtin_amdgcn_s_sleep(1);
        if ((++sp & 255u) == 0u) { if (xb_ld(&bar[XB_TMO])) break; if (sp > XB_SPIN_CAP) { atomicAdd(&bar[XB_TMO], 1u); break; } }
    }
    nloc = mine > 0u ? mine : 1u; nx = cnt > 0u ? cnt : 1u;
}
__device__ __forceinline__ void xcd_barrier(const XcdBarrier& b, const int tid) {
    asm volatile("s_waitcnt vmcnt(0)" ::: "memory");
    __syncthreads();
    if (tid == 0) {
        unsigned* bar = b.bar;
        __builtin_amdgcn_s_waitcnt(0);
        unsigned nloc = b.st[0], nx = b.st[1];
        if (nloc == 0u) { xcd_barrier_complete(bar, b.x, nloc, nx); b.st[0] = nloc; b.st[1] = nx; }
        const unsigned old = xb_add(&bar[XB_XSUB(b.x)], 1u);
        const unsigned gen = old / nloc;
        if (old + 1u == (gen + 1u) * nloc) {
            __builtin_amdgcn_fence(__ATOMIC_RELEASE, "agent");
            asm volatile("s_waitcnt vmcnt(0)" ::: "memory");
            const unsigned og = xb_add(&bar[XB_TOP], 1u);
            const unsigned tg = og / nx;
            if (og + 1u == (tg + 1u) * nx) xb_add(&bar[XB_TOPGEN], 1u);
            else XB_SPIN(xb_ld(&bar[XB_TOPGEN]) == tg, bar);
            __builtin_amdgcn_fence(__ATOMIC_ACQUIRE, "agent");
            xb_add(&bar[XB_XGEN(b.x)], 1u);
            asm volatile("s_waitcnt vmcnt(0)" ::: "memory");
        } else {
            XB_SPIN(xb_ld(&bar[XB_XGEN(b.x)]) == gen, bar);
            __builtin_amdgcn_fence(__ATOMIC_ACQUIRE, "agent");
            asm volatile("s_waitcnt vmcnt(0)" ::: "memory");
        }
    }
    __syncthreads();
}

#ifndef PHM
#define PHM 1023
#endif
#ifndef PROBE_K
#define PROBE_K -1
#endif
struct Args { const float* in[18]; float* out; unsigned char* ws; int ph_lo, ph_hi; };
typedef const __attribute__((address_space(4))) Args* KArgs;
#define INP(a, i) ((const float*)(const GAS float*)((a)->in[i]))
#define OUTP(a) ((float*)(GAS float*)((a)->out))
enum { I_X = 0, I_C, I_WADA, I_BADA, I_NORMG, I_WIN, I_CAW, I_CAB, I_WRG, I_BRG, I_WIG, I_BIG, I_LAM, I_QG, I_KG, I_CCW, I_WBR, I_WOUT };

__device__ __forceinline__ void transpose_item(const float* W, int ldw, bf16_t* dst, int ldd, LAS float* scr, int lane) {
#pragma unroll 8
    for (int i = 0; i < 32; ++i) { const int kk = 2 * i + (lane >> 5); scr[kk * 33 + (lane & 31)] = W[(size_t)kk * ldw + (lane & 31)]; }
    LDS_WAIT();
    const int c = lane & 7;
#pragma unroll
    for (int j = 0; j < 4; ++j) { const int n = (lane >> 3) + 8 * j; const LAS float* s = scr + (8 * c) * 33 + n;
        u32x4 o; o.x = cvt_pk_bf16(s[0 * 33], s[1 * 33]); o.y = cvt_pk_bf16(s[2 * 33], s[3 * 33]); o.z = cvt_pk_bf16(s[4 * 33], s[5 * 33]); o.w = cvt_pk_bf16(s[6 * 33], s[7 * 33]);
        *(u32x4*)(dst + (size_t)n * ldd + 8 * c) = o; }
    LDS_WAIT();
}

__device__ __forceinline__ void phase_prologue(KArgs a, unsigned char* wsb, LAS unsigned char* lds, int tid, int lane, int wave, int bid, int G) {
    unsigned char* ws = wsb;
    {
        LAS float* red = (LAS float*)lds;
        for (int it = bid; it < 96; it += G) {
            const int l = it / 48, jb = it % 48, j = jb * 64 + lane;
            const float* wa = INP(a, I_WADA) + (size_t)l * 1024 * 3072 + j; const float* c0 = INP(a, I_C); const float* c1 = c0 + 1024;
            float a0 = 0.f, a1 = 0.f; const int kb = wave * 128;
#pragma unroll 16
            for (int k = 0; k < 128; ++k) { const float w = wa[(size_t)(kb + k) * 3072]; a0 += c0[kb + k] * w; a1 += c1[kb + k] * w; }
            red[(wave * 2 + 0) * 64 + lane] = a0; red[(wave * 2 + 1) * 64 + lane] = a1;
            __syncthreads();
            if (tid < 128) { const int bb = tid >> 6; float s = 0.f;
#pragma unroll
                for (int w = 0; w < 8; ++w) s += red[(w * 2 + bb) * 64 + lane];
                ((float*)(ws + WS_MOD))[(l * 2 + bb) * 3072 + j] = s + INP(a, I_BADA)[l * 3072 + j]; }
            __syncthreads();
        }
    }
    {
        float* rc = (float*)(ws + WS_ROPE); float* rs = rc + 320 * 32;
        for (int e = bid * 512 + tid; e < 320 * 32; e += G * 512) {
            const int pos = e >> 5, i = e & 31; const int p = pos < 256 ? pos : pos - 256;
            const float inv = __builtin_amdgcn_exp2f(-((float)(2 * i)) * (13.287712379549449f / 64.0f));
            const float ang = (float)p * inv;
            rc[e] = __cosf(ang); rs[e] = __sinf(ang);
        }
    }
    {
        LAS float* scr = (LAS float*)(lds + 8192 + wave * 12288);
        const int gw = bid * 8 + wave, NGW = G * 8;
        constexpr int I_IN = 2 * 16 * 368, I_G = 1024, I_BR = 3072, I_OUT = 1024, NITEMS = I_IN + I_G + I_BR + I_OUT;
        for (int it = gw; it < NITEMS; it += NGW) {
            int r = it;
            if (r < I_IN) { const int l = r / 5888, q = r % 5888, kb = q / 368, nb = q % 368;
                const int n0 = 32 * nb; int drow = n0;
                if (n0 >= 4608 && n0 < 8704) { const int sec = (n0 - 4608) >> 10, ch = (n0 - 4608) & 1023, blk = ch >> 7;
                    drow = ((sec & 1) ? 26 + blk : 18 + blk) * 256 + ((sec >> 1) ? 128 : 0) + (ch & 127); }
                transpose_item(INP(a, I_WIN) + (size_t)l * 1024 * NIN + (size_t)(64 * kb) * NIN + n0, NIN,
                               (bf16_t*)(ws + WS_WIN) + (size_t)l * NIN * 1024 + (size_t)drow * 1024 + 64 * kb, 1024, scr, lane); continue; }
            r -= I_IN;
            if (r < I_G) { const int mi = r >> 5, sub = r & 31, kb = sub >> 3, nblk = sub & 7;
                const int nb = mi & 3, gate = (mi >> 2) & 1, dir = (mi >> 3) & 1, l = mi >> 4;
                const float* src = (gate ? INP(a, I_WIG) : INP(a, I_WRG)) + (size_t)((l * 2 + dir) * 4 + nb) * 65536 + (size_t)(64 * kb) * 256 + 32 * nblk;
                const int n0 = 32 * nblk, hh = n0 >> 7, pn = (dir * 4 + nb) * 2 + hh, row = pn * 256 + gate * 128 + (n0 & 127);
                transpose_item(src, 256, (bf16_t*)(ws + WS_WG) + (size_t)l * 4096 * 256 + (size_t)row * 256 + 64 * kb, 256, scr, lane); continue; }
            r -= I_G;
            if (r < I_BR) { const int mi = r >> 9, sub = r & 511, kb = sub >> 5, nblk = sub & 31;
                transpose_item(INP(a, I_WBR) + (size_t)mi * 1048576 + (size_t)(64 * kb) * 1024 + 32 * nblk, 1024,
                               (bf16_t*)(ws + WS_WBR) + (size_t)mi * 1048576 + (size_t)(32 * nblk) * 1024 + 64 * kb, 1024, scr, lane); continue; }
            r -= I_BR;
            { const int mi = r >> 9, sub = r & 511, kb = sub >> 5, nblk = sub & 31;
                transpose_item(INP(a, I_WOUT) + (size_t)mi * 1048576 + (size_t)(64 * kb) * 1024 + 32 * nblk, 1024,
                               (bf16_t*)(ws + WS_WOUT) + (size_t)mi * 1048576 + (size_t)(32 * nblk) * 1024 + 64 * kb, 1024, scr, lane); }
        }
    }
}

__device__ __forceinline__ void phase_h(KArgs a, unsigned char* wsb, int l, int b, int lane, int wave, int bid, int G) {
    const float* xin = (l == 0 ? INP(a, I_X) : OUTP(a)) + (size_t)b * SEQ * DM;
    const float* mod = (const float*)(wsb + WS_MOD) + (l * 2 + b) * 3072;
    bf16_t* H = (bf16_t*)(wsb + WS_H);
    f32x4 gs[4], sh[4];
#pragma unroll
    for (int j = 0; j < 4; ++j) { const int col = 4 * lane + 256 * j;
        const f32x4 g = *(const f32x4*)(INP(a, I_NORMG) + l * 1024 + col), sc = *(const f32x4*)(mod + 1024 + col);
        gs[j] = g * (sc + 1.0f); sh[j] = *(const f32x4*)(mod + col); }
    const int gw = bid * 8 + wave, NGW = G * 8;
    for (int m = gw; m < SEQ; m += 2 * NGW) {
        const int m2 = (m + NGW < SEQ) ? m + NGW : m;
        const f32x4* xr = (const f32x4*)(xin + (size_t)m * DM) + lane; const f32x4* xr2 = (const f32x4*)(xin + (size_t)m2 * DM) + lane;
        f32x4 v[4], w[4]; float s = 0.f, s2 = 0.f;
#pragma unroll
        for (int j = 0; j < 4; ++j) { v[j] = xr[64 * j]; w[j] = xr2[64 * j]; }
#pragma unroll
        for (int j = 0; j < 4; ++j) { s += (v[j].x * v[j].x + v[j].y * v[j].y) + (v[j].z * v[j].z + v[j].w * v[j].w); s2 += (w[j].x * w[j].x + w[j].y * w[j].y) + (w[j].z * w[j].z + w[j].w * w[j].w); }
        const float rstd = __builtin_amdgcn_rsqf(wave_sum(s) * (1.f / DM) + EPS), rstd2 = __builtin_amdgcn_rsqf(wave_sum(s2) * (1.f / DM) + EPS);
        u32x2* o8 = (u32x2*)(H + (size_t)m * DM) + lane; u32x2* o82 = (u32x2*)(H + (size_t)m2 * DM) + lane;
#pragma unroll
        for (int j = 0; j < 4; ++j) { const f32x4 o = v[j] * rstd * gs[j] + sh[j]; u32x2 q; q.x = cvt_pk_bf16(o.x, o.y); q.y = cvt_pk_bf16(o.z, o.w); o8[64 * j] = q;
            const f32x4 o2 = w[j] * rstd2 * gs[j] + sh[j]; u32x2 q2; q2.x = cvt_pk_bf16(o2.x, o2.y); q2.y = cvt_pk_bf16(o2.z, o2.w); o82[64 * j] = q2; }
    }
}

__device__ __forceinline__ void ldrow8(const bf16_t* __restrict__ base, int t, int ch, float (&v)[8]) {
    if (t < 0 || t >= SEQ) {
#pragma unroll
        for (int j = 0; j < 8; ++j) v[j] = 0.f;
    } else unpack8(*(const u32x4*)(base + (size_t)t * 1024 + ch), v);
}
__device__ __forceinline__ void ld8f32(const float* p, float (&v)[8]) {
    const f32x4 a = *(const f32x4*)p, b = *(const f32x4*)(p + 4);
    v[0] = a.x; v[1] = a.y; v[2] = a.z; v[3] = a.w; v[4] = b.x; v[5] = b.y; v[6] = b.z; v[7] = b.w;
}

__device__ __forceinline__ void phase_elem(KArgs a, unsigned char* wsb, int l, int lane, int wave, int bid, int G) {
    unsigned char* ws = wsb;
    const int gw = bid * 8 + wave, NGW = G * 8;
    for (int it = gw; it < 2048; it += NGW) {
        const int run = it >> 1, hf = it & 1, ch = hf * 512 + lane * 8, t0 = run * 16;
        {
            const bf16_t* __restrict__ XA = (const bf16_t*)(ws + WS_XA); bf16_t* __restrict__ UA = (bf16_t*)(ws + WS_H);
            float w0[8], w1[8], w2[8], w3[8], bb[8];
            const float* cw = INP(a, I_CAW) + (size_t)l * 4 * 1024 + ch;
            ld8f32(cw, w0); ld8f32(cw + 1024, w1); ld8f32(cw + 2048, w2); ld8f32(cw + 3072, w3); ld8f32(INP(a, I_CAB) + l * 1024 + ch, bb);
            float xm2[8], xm1[8], x0[8], xp1[8];
            ldrow8(XA, t0 - 2, ch, xm2); ldrow8(XA, t0 - 1, ch, xm1); ldrow8(XA, t0, ch, x0);
#pragma unroll
            for (int s = 0; s < 16; ++s) { const int t = t0 + s;
                ldrow8(XA, t + 1, ch, xp1);
                float o[8];
#pragma unroll
                for (int j = 0; j < 8; ++j) o[j] = w0[j] * xm2[j] + w1[j] * xm1[j] + w2[j] * x0[j] + w3[j] * xp1[j] + bb[j];
                *(u32x4*)(UA + (size_t)t * 1024 + ch) = pack8(o);
#pragma unroll
                for (int j = 0; j < 8; ++j) { xm2[j] = xm1[j]; xm1[j] = x0[j]; x0[j] = xp1[j]; } }
        }
        {
            const bf16_t* __restrict__ PP = (const bf16_t*)(ws + WS_XC); const bf16_t* __restrict__ BG = (const bf16_t*)(ws + WS_BC); bf16_t* __restrict__ YC = (bf16_t*)(ws + WS_YC);
            float w0[8], w1[8], w2[8];
            const float* cw = INP(a, I_CCW) + (size_t)l * 3 * 1024 + ch;
            ld8f32(cw, w0); ld8f32(cw + 1024, w1); ld8f32(cw + 2048, w2);
            float pm1[8], p0[8], pp1[8], t1[8];
            ldrow8(PP, t0 - 1, ch, pm1); ldrow8(PP, t0, ch, p0);
#pragma unroll
            for (int s = 0; s < 16; ++s) { const int t = t0 + s;
                ldrow8(PP, t + 1, ch, pp1); ldrow8(BG, t, ch, t1);
                float o[8];
#pragma unroll
                for (int j = 0; j < 8; ++j) o[j] = t1[j] * (w0[j] * pm1[j] + w1[j] * p0[j] + w2[j] * pp1[j]);
                *(u32x4*)(YC + (size_t)t * 1024 + ch) = pack8(o);
#pragma unroll
                for (int j = 0; j < 8; ++j) { pm1[j] = p0[j]; p0[j] = pp1[j]; } }
        }
        {
            bf16_t* Q = (bf16_t*)(ws + WS_Q); bf16_t* Kb = (bf16_t*)(ws + WS_K);
            const float* rc = (const float*)(ws + WS_ROPE); const float* rs = rc + 320 * 32;
            const int d0 = (lane & 15) * 8, i0 = (lane & 3) * 8;
            float qg[8], kg[8];
            ld8f32(INP(a, I_QG) + l * 128 + d0, qg); ld8f32(INP(a, I_KG) + l * 128 + d0, kg);
            const bool second = (lane & 4) != 0;
            const int tokb = run * 16 + hf * 8;
            const int tsel = (d0 < 64) ? 0 : 1;
            u32x4 cur[3]; float cs[8], sn[8];
#define LD_TOK(tok, dst, dcs, dsn) do { const int tp_ = tsel ? 256 + ((tok) & 63) : ((tok) >> 6); ld8f32(rc + tp_ * 32 + i0, dcs); ld8f32(rs + tp_ * 32 + i0, dsn); \
                dst[0] = *(const u32x4*)(Q + (size_t)(tok) * 1024 + lane * 8); dst[1] = *(const u32x4*)(Q + (size_t)(tok) * 1024 + 512 + lane * 8); dst[2] = *(const u32x4*)(Kb + (size_t)(tok) * 256 + (lane & 31) * 8); } while (0)
            LD_TOK(tokb, cur, cs, sn);
#pragma unroll
            for (int i = 0; i < 8; ++i) {
                const int tok = tokb + i;
                u32x4 nx[3]; float ncs[8], nsn[8];
                if (i < 7) LD_TOK(tok + 1, nx, ncs, nsn);
#pragma unroll
                for (int part = 0; part < 3; ++part) {
                    bf16_t* p = (part < 2) ? (Q + (size_t)tok * 1024 + part * 512 + lane * 8) : (Kb + (size_t)tok * 256 + (lane & 31) * 8);
                    float v[8]; unpack8(cur[part], v);
                    float ss = 0.f;
#pragma unroll
                    for (int j = 0; j < 8; ++j) ss += v[j] * v[j];
                    ss += __shfl_xor(ss, 1); ss += __shfl_xor(ss, 2); ss += __shfl_xor(ss, 4); ss += __shfl_xor(ss, 8);
                    const float rstd = __builtin_amdgcn_rsqf(ss * (1.f / 128.f) + EPS);
                    float o[8];
#pragma unroll
                    for (int j = 0; j < 8; ++j) { const float y = v[j] * rstd * (part < 2 ? qg[j] : kg[j]); const float pr = __shfl_xor(y, 4);
                        o[j] = y * cs[j] + (second ? pr : -pr) * sn[j]; }
                    if (part < 2 || lane < 32) *(u32x4*)p = pack8(o);
                    if (part == 2 && lane < 32) {
                        const int kvh = lane >> 4, r = tok & 63, dch = (lane & 15) >> 1;
                        unsigned char* kp = ws + WS_K8 + (size_t)kvh * 2097152 + (size_t)(tok >> 6) * 8192 + r * 128 + 16 * (dch ^ (r & 7)) + (lane & 1) * 8;
                        u32x2 w8; w8.x = (unsigned)pk4_fp8(o[0], o[1], o[2], o[3]); w8.y = (unsigned)pk4_fp8(o[4], o[5], o[6], o[7]); *(u32x2*)kp = w8; }
                }
                if (i < 7) {
#pragma unroll
                    for (int part = 0; part < 3; ++part) cur[part] = nx[part];
#pragma unroll
                    for (int j = 0; j < 8; ++j) { cs[j] = ncs[j]; sn[j] = nsn[j]; } }
            }
#undef LD_TOK
        }
    }
    for (int it = gw; it < 4096; it += NGW) {
        const int jh = it & 1, h = (it >> 1) & 1, dh = (it >> 2) & 1, tile = (it >> 3) & 255, kvh = it >> 11;
        const int d = dh * 64 + lane;
        const bf16_t* __restrict__ V = (const bf16_t*)(ws + WS_V) + (size_t)tile * 64 * 256 + kvh * 128 + d;
        float f[16];
#pragma unroll
        for (int jj = 0; jj < 16; ++jj) { const int key = (jj & 3) + 8 * (jj >> 2) + 4 * h + 32 * jh; f[jj] = bf2f(V[(size_t)key * 256]); }
        u32x4 w; w.x = (unsigned)pk4_fp8(f[0], f[1], f[2], f[3]); w.y = (unsigned)pk4_fp8(f[4], f[5], f[6], f[7]); w.z = (unsigned)pk4_fp8(f[8], f[9], f[10], f[11]); w.w = (unsigned)pk4_fp8(f[12], f[13], f[14], f[15]);
        *(u32x4*)(ws + WS_V8 + (size_t)kvh * 2097152 + (size_t)tile * 8192 + d * 64 + 16 * ((2 * h + jh) ^ ((d >> 2) & 3))) = w;
    }
}

__device__ __forceinline__ void phase_scan_a(KArgs a, unsigned char* wsb, int lane, int wave, int bid, int G) {
    unsigned char* ws = wsb;
    const int gw = bid * 8 + wave, NGW = G * 8;
    for (int it = gw; it < 2048; it += NGW) {
        const int c = it >> 4, dir = (it >> 3) & 1, ch = (it & 7) * 128 + lane * 2;
        const bf16_t* LA = (const bf16_t*)(ws + WS_LA + (size_t)dir * 64 * MiB) + ch;
        const bf16_t* UU = (const bf16_t*)(ws + WS_U + (size_t)dir * 64 * MiB) + ch;
        float s0 = 0.f, s1 = 0.f, h0 = 0.f, h1 = 0.f;
#pragma unroll 16
        for (int st = 0; st < 128; ++st) { const int t = dir == 0 ? c * 128 + st : c * 128 + 127 - st;
            const unsigned wl = *(const unsigned*)(LA + (size_t)t * 1024), wu = *(const unsigned*)(UU + (size_t)t * 1024);
            const float l0 = __uint_as_float(wl << 16), l1 = __uint_as_float(wl & 0xffff0000u);
            const float u0 = __uint_as_float(wu << 16), u1 = __uint_as_float(wu & 0xffff0000u);
            h0 = __builtin_amdgcn_exp2f(l0) * h0 + u0; h1 = __builtin_amdgcn_exp2f(l1) * h1 + u1; s0 += l0; s1 += l1; }
        *(f32x2*)((float*)(ws + WS_SA) + (c * 2 + dir) * 1024 + ch) = (f32x2){s0, s1};
        *(f32x2*)((float*)(ws + WS_SH) + (c * 2 + dir) * 1024 + ch) = (f32x2){h0, h1};
    }
}
__device__ __forceinline__ void phase_scan_c(unsigned char* wsb, LAS unsigned char* lds, int lane, int wave, int bid, int G) {
    unsigned char* ws = wsb;
    const int gw = bid * 8 + wave, NGW = G * 8;
    const float* __restrict__ SA = (const float*)(ws + WS_SA); const float* __restrict__ SH = (const float*)(ws + WS_SH);
    for (int it = gw; it < 2048; it += NGW) {
        const int c = it >> 4, ch = (it & 15) * 64 + lane;
        float cf = 0.f, cb = 0.f;
#pragma unroll 8
        for (int sidx = 0; sidx < c; ++sidx) { const int idx = (sidx * 2) * 1024 + ch; cf = __builtin_amdgcn_exp2f(SA[idx]) * cf + SH[idx]; }
#pragma unroll 8
        for (int sidx = 127; sidx > c; --sidx) { const int idx = (sidx * 2 + 1) * 1024 + ch; cb = __builtin_amdgcn_exp2f(SA[idx]) * cb + SH[idx]; }
        const bf16_t* __restrict__ LAf = (const bf16_t*)(ws + WS_LA) + ch; const bf16_t* __restrict__ UUf = (const bf16_t*)(ws + WS_U) + ch;
        const bf16_t* __restrict__ LAb = (const bf16_t*)(ws + WS_LA + 64 * MiB) + ch; const bf16_t* __restrict__ UUb = (const bf16_t*)(ws + WS_U + 64 * MiB) + ch;
        const bf16_t* __restrict__ SGA = (const bf16_t*)(ws + WS_SGA) + ch; bf16_t* __restrict__ YA = (bf16_t*)(ws + WS_XA) + ch;
        LAS bf16_t* hfs = (LAS bf16_t*)(lds + wave * 16384) + lane;
        float h = cf;
        { const bf16_t* pl = LAf + (size_t)c * 128 * 1024; const bf16_t* pu = UUf + (size_t)c * 128 * 1024;
#pragma unroll 1
            for (int blk = 0; blk < 8; ++blk) {
                float l[16], u[16];
#pragma unroll
                for (int i = 0; i < 16; ++i) { l[i] = bf2f(pl[i * 1024]); u[i] = bf2f(pu[i * 1024]); }
#pragma unroll
                for (int i = 0; i < 16; ++i) { h = __builtin_amdgcn_exp2f(l[i]) * h + u[i]; hfs[(blk * 16 + i) * 64] = (bf16_t)f2bf(h); }
                pl += 16 * 1024; pu += 16 * 1024; } }
        h = cb;
        { const size_t e0 = (size_t)(c * 128 + 112) * 1024;
            const bf16_t* pl = LAb + e0; const bf16_t* pu = UUb + e0; const bf16_t* pg = SGA + e0; bf16_t* py = YA + e0;
#pragma unroll 1
            for (int blk = 7; blk >= 0; --blk) {
                float l[16], u[16], g[16];
#pragma unroll
                for (int i = 0; i < 16; ++i) { l[i] = bf2f(pl[i * 1024]); u[i] = bf2f(pu[i * 1024]); g[i] = bf2f(pg[i * 1024]); }
#pragma unroll
                for (int i = 15; i >= 0; --i) { h = __builtin_amdgcn_exp2f(l[i]) * h + u[i];
                    py[i * 1024] = (bf16_t)f2bf((bf2f(hfs[(blk * 16 + i) * 64]) + h) * g[i]); }
                pl -= 16 * 1024; pu -= 16 * 1024; pg -= 16 * 1024; py -= 16 * 1024; } }
    }
}

__global__ void __launch_bounds__(512, 2) mk_fwd(Args args) {
    extern __shared__ __attribute__((aligned(16))) unsigned char lds[];
    cg::grid_group grid = cg::this_grid();
    LAS unsigned char* L = (LAS unsigned char*)lds;
    if (threadIdx.x < 2) ((LAS unsigned*)(L + 131072))[threadIdx.x] = 0u;
    __syncthreads();
    (void)xcd_barrier_post((unsigned*)(args.ws + WS_BAR), (volatile LAS unsigned*)(L + 131072));
    const int wave_u = __builtin_amdgcn_readfirstlane(threadIdx.x >> 6);
    for (int ph = args.ph_lo; ph < args.ph_hi; ++ph) {
        int tid; { int ln_; asm volatile("v_mbcnt_lo_u32_b32 %0, -1, 0\n\tv_mbcnt_hi_u32_b32 %0, -1, %0" : "=v"(ln_)); tid = wave_u * 64 + ln_; }
        int G = gridDim.x, bid = blockIdx.x; asm volatile("" : "+s"(G), "+s"(bid));
        KArgs ap = (KArgs)__builtin_amdgcn_kernarg_segment_ptr(); asm volatile("" : "+s"(ap));
        GAS unsigned char* wsg = (GAS unsigned char*)ap->ws; asm volatile("" : "+s"(wsg));
        unsigned char* ws = (unsigned char*)wsg;
        const int lane = tid & 63, wave = __builtin_amdgcn_readfirstlane(tid >> 6);
        unsigned long long pt0 = 0; int pcls = -1; if (PROBE_K >= 0) pt0 = __builtin_amdgcn_s_memrealtime();
        if (ph == 0) { pcls = 8; if (PHM & 512) phase_prologue(ap, ws, L, tid, lane, wave, bid, G); }
        else {
            const int q = ph - 1, lb = q / NPH_PER, k = q - lb * NPH_PER, l = lb >> 1, b = lb & 1; pcls = k;
            if (k == 0) { if (PHM & 1) phase_h(ap, ws, l, b, lane, wave, bid, G); }
            else if (k == 1) { if (PHM & 2) {
                pg8::Gemm g{(const bf16_t*)(ws + WS_H), (const bf16_t*)(ws + WS_WIN) + (size_t)l * NIN * 1024, 1024, 1024, 1024, 0, 0};
                pg8::StaticOrder S; S.init(SEQ, NIN, G, bid);
                pg8::EpiInProj E{ws};
                pg8::gemm_phase<pg8::EpiInProj, pg8::StaticOrder, 0>(L, g, S, E, tid); }
            } else if (k == 2) { if (PHM & 4) phase_elem(ap, ws, l, lane, wave, bid, G); }
            else if (k == 3) {
                if (PHM & 8) {
                    pg8::Gemm g{(const bf16_t*)(ws + WS_H), (const bf16_t*)(ws + WS_WG) + (size_t)l * 4096 * 256, 1024, 256, 256, 0, 0};
                    pg8::StaticOrder S; S.init(SEQ, 4096, G, bid);
                    pg8::EpiGates E{ws, INP(ap, I_BRG) + l * 2048, INP(ap, I_BIG) + l * 2048, INP(ap, I_LAM) + l * 2048};
                    pg8::gemm_phase<pg8::EpiGates, pg8::StaticOrder, 1>(L, g, S, E, tid);
                }
                if (PROBE_K == 3) { const unsigned long long t1 = __builtin_amdgcn_s_memrealtime(), dt = t1 - pt0; while (__builtin_amdgcn_s_memrealtime() - t1 < dt) __builtin_amdgcn_s_sleep(8); }
                if (PROBE_K == 9) { pt0 = __builtin_amdgcn_s_memrealtime(); pcls = 9; }
                if (PHM & 256) {
                    const int v = (G % 8 == 0) ? (bid % 8) * (G / 8) + bid / 8 : bid;
                    const int per = (512 + G - 1) / G;
                    if (PROBE_F8 && l == 0 && b == 0) {
                        for (int i = 0; i < per; ++i) { const int idx = v * per + i; if (idx >= 4) break;
                            const int h = idx >> 6, qb = idx & 63, kvh = h >> 2;
                            const attn::bf16* Qb = (const attn::bf16*)(ws + WS_Q) + (size_t)qb * 256 * 1024 + h * 128;
                            const bf16_t* Gb = (const bf16_t*)(ws + WS_SGB) + (size_t)qb * 256 * 1024 + h * 128;
                            attn::attn_pp8_body(Qb, ws + WS_K8 + (size_t)kvh * 2097152, ws + WS_V8 + (size_t)kvh * 2097152, (bf16_t*)(ws + WS_SPARE) + (size_t)idx * 256 * 1024, nullptr, SEQ, (char*)lds, tid);
                        }
                    }
                    int tid2 = tid; asm volatile("" : "+v"(tid2));
                    for (int i = 0; i < per; ++i) { const int idx = v * per + i; if (idx >= 512) break;
                        const int h = idx >> 6, qb = idx & 63, kvh = h >> 2;
                        const attn::bf16* Qb = (const attn::bf16*)(ws + WS_Q) + (size_t)qb * 256 * 1024 + h * 128;
                        bf16_t* Ob = (bf16_t*)(ws + WS_SGB) + (size_t)qb * 256 * 1024 + h * 128;
                        const bf16_t* Gb = (const bf16_t*)(ws + WS_SGB) + (size_t)qb * 256 * 1024 + h * 128;
                        if (PROBE_F8) {
                            const attn::bf16* Kh = (const attn::bf16*)(ws + WS_K) + kvh * 128;
                            const attn::bf16* Vh = (const attn::bf16*)(ws + WS_V) + kvh * 128;
                            const bf16_t* cmp = (l == 0 && b == 0 && idx < 4) ? (const bf16_t*)(ws + WS_SPARE) + (size_t)idx * 256 * 1024 : nullptr;
                            attn::attn_pp_body(Qb, Kh, Vh, Ob, Gb, SEQ, (char*)lds, tid2, cmp, (unsigned*)(ws + WS_FLAG));
                        } else attn::attn_pp8_body(Qb, ws + WS_K8 + (size_t)kvh * 2097152, ws + WS_V8 + (size_t)kvh * 2097152, Ob, Gb, SEQ, (char*)lds, tid2);
                    }
                }
            } else if (k == 4) { if (PHM & 16) phase_scan_a(ap, ws, lane, wave, bid, G); }
            else if (k == 5) { if (PHM & 32) phase_scan_c(ws, L, lane, wave, bid, G); }
            else if (k == 6) { if (PHM & 64) {
                pg8::Gemm g{(const bf16_t*)(ws + WS_XA), (const bf16_t*)(ws + WS_WBR) + (size_t)l * 3 * 1048576, 1024, 1024, 1024,
                            (long)WS_SGB - (long)WS_XA, (long)WS_YC - (long)WS_XA};
                pg8::BranchOrder S; S.so.init(SEQ, 1024, G, bid);
                pg8::EpiBranch E{ws};
                pg8::gemm_phase<pg8::EpiBranch, pg8::BranchOrder, 2>(L, g, S, E, tid); }
            } else if (PHM & 128) {
                pg8::Gemm g{(const bf16_t*)(ws + WS_SGA), (const bf16_t*)(ws + WS_WOUT) + (size_t)l * 1048576, 1024, 1024, 1024, 0, 0};
                pg8::StaticOrder S; S.init(SEQ, 1024, G, bid);
                const float* xi = (l == 0 ? INP(ap, I_X) : OUTP(ap)) + (size_t)b * SEQ * DM;
                pg8::EpiOut E{xi, OUTP(ap) + (size_t)b * SEQ * DM, (const float*)(ws + WS_MOD) + (l * 2 + b) * 3072 + 2048, (const unsigned*)(ws + WS_FLAG)};
                pg8::gemm_phase<pg8::EpiOut, pg8::StaticOrder, 0>(L, g, S, E, tid);
            }
        }
        if (PROBE_K >= 0 && PROBE_K != 3 && ph + 1 == args.ph_hi && pcls == PROBE_K) { VM_WAIT(); __syncthreads(); const unsigned long long t1 = __builtin_amdgcn_s_memrealtime(), dt = t1 - pt0; while (__builtin_amdgcn_s_memrealtime() - t1 < dt) __builtin_amdgcn_s_sleep(8); }
        if (ph + 1 < args.ph_hi) { if (ph == args.ph_lo) grid.sync(); else { XcdBarrier xbar; xbar.bar = (unsigned*)(ws + WS_BAR); xbar.x = xb_xcc_id(); xbar.st = (volatile LAS unsigned*)(L + 131072); xcd_barrier(xbar, tid); }
            if (PROBE_K >= 0 && PROBE_K != 3 && pcls == PROBE_K) { const unsigned long long t1 = __builtin_amdgcn_s_memrealtime(), dt = t1 - pt0; while (__builtin_amdgcn_s_memrealtime() - t1 < dt) __builtin_amdgcn_s_sleep(8); } }
    }
}

extern "C" void kernel_launch(void* const* d_in, const int* in_sizes, int n_in, void* d_out, int out_size, void* d_ws, size_t ws_size, hipStream_t stream) {
    static int grid = 0;
    if (grid == 0) {
        if (n_in != 18 || ws_size < WS_END) { fprintf(stderr, "kernel_launch: need 18 inputs and >= %zu bytes of workspace (got %d, %zu)\n", (size_t)WS_END, n_in, ws_size); grid = -1; return; }
        int dev = 0, cus = 0, per_cu = 0;
        hipGetDevice(&dev);
        hipDeviceGetAttribute(&cus, hipDeviceAttributeMultiprocessorCount, dev);
        if (hipFuncSetAttribute((const void*)mk_fwd, hipFuncAttributeMaxDynamicSharedMemorySize, LDS_BYTES) != hipSuccess) { fprintf(stderr, "kernel_launch: hipFuncSetAttribute failed\n"); grid = -1; return; }
        if (hipOccupancyMaxActiveBlocksPerMultiprocessor(&per_cu, (const void*)mk_fwd, 512, LDS_BYTES) != hipSuccess || per_cu < 1) { fprintf(stderr, "kernel_launch: occupancy query gave %d\n", per_cu); per_cu = 1; }
        (void)hipGetLastError();
        grid = cus * 1;
    }
    if (grid < 0) return;
    if (hipMemsetAsync((char*)d_ws + WS_BAR, 0, 16384, stream) != hipSuccess) { fprintf(stderr, "kernel_launch: memset failed\n"); return; }
    Args a{};
    for (int i = 0; i < 18; ++i) a.in[i] = (const float*)d_in[i];
    a.out = (float*)d_out; a.ws = (unsigned char*)d_ws; a.ph_lo = 0; a.ph_hi = NPHASES;
    void* kargs[] = {&a};
    hipError_t e = hipLaunchCooperativeKernel((const void*)mk_fwd, dim3(grid), dim3(512), kargs, LDS_BYTES, stream);
    if (e != hipSuccess) fprintf(stderr, "kernel_launch: cooperative launch failed: %s (grid %d)\n", hipGetErrorString(e), grid);
}
```

```cpp
#include <hip/hip_runtime.h>
#include <hip/hip_cooperative_groups.h>
#include <hip/hip_bf16.h>
#include <cstdio>
#include <cstdint>
namespace cg = cooperative_groups;
#ifndef PROBE_F8
#define PROBE_F8 0
#endif

#define LAS __attribute__((address_space(3)))
#define GAS __attribute__((address_space(1)))
typedef unsigned short bf16_t;
typedef short bf16x8 __attribute__((ext_vector_type(8)));
typedef float f32x4 __attribute__((ext_vector_type(4)));
typedef float f32x2 __attribute__((ext_vector_type(2)));
typedef unsigned u32x4 __attribute__((ext_vector_type(4)));
typedef unsigned u32x2 __attribute__((ext_vector_type(2)));

constexpr int DM = 1024, SEQ = 16384, NBATCH = 2, DEPTH = 2, NIN = 11776;
constexpr int NPH_PER = 8, NPHASES = 1 + DEPTH * NBATCH * NPH_PER;
constexpr float EPS = 1e-6f;
constexpr float LOG2E = 1.4426950408889634f;

constexpr size_t MiB = 1u << 20;
constexpr size_t WS_MOD = 0;
constexpr size_t WS_ROPE = 64 * 1024;
constexpr size_t WS_BAR = 256 * 1024;
constexpr size_t WS_SA = 1 * MiB, WS_SH = 2 * MiB;
constexpr size_t WS_WIN = 4 * MiB, WS_WG = 50 * MiB, WS_WBR = 54 * MiB, WS_WOUT = 66 * MiB;
constexpr size_t WS_H = 70 * MiB;
constexpr size_t WS_XA = 102 * MiB;
constexpr size_t WS_SGA = 134 * MiB;
constexpr size_t WS_Q = 166 * MiB;
constexpr size_t WS_K = 198 * MiB, WS_V = 206 * MiB;
constexpr size_t WS_SGB = 214 * MiB;
constexpr size_t WS_XC = 246 * MiB, WS_BC = 278 * MiB, WS_CC = 310 * MiB, WS_SGC = 342 * MiB;
constexpr size_t WS_LA = WS_XC, WS_U = WS_BC;
constexpr size_t WS_SMG = 374 * MiB;
constexpr size_t WS_YC = 470 * MiB;
constexpr size_t WS_K8 = 502 * MiB, WS_V8 = 506 * MiB;
constexpr size_t WS_SPARE = 510 * MiB;
constexpr size_t WS_FLAG = WS_BAR + 15 * 1024;
constexpr size_t WS_END = 512 * MiB;
constexpr int LDS_BYTES = 131072 + 1024;

__device__ __forceinline__ float bf2f(bf16_t v) { return __uint_as_float((unsigned)v << 16); }
__device__ __forceinline__ unsigned f2bf(float f) { unsigned u = __float_as_uint(f); return (u + 0x7fffu + ((u >> 16) & 1u)) >> 16; }
__device__ __forceinline__ unsigned cvt_pk_bf16(float lo, float hi) { unsigned r; asm("v_cvt_pk_bf16_f32 %0, %1, %2" : "=v"(r) : "v"(lo), "v"(hi)); return r; }
__device__ __forceinline__ void unpack8(const u32x4 w, float (&f)[8]) {
#pragma unroll
    for (int i = 0; i < 4; ++i) { f[2 * i] = __uint_as_float(w[i] << 16); f[2 * i + 1] = __uint_as_float(w[i] & 0xffff0000u); }
}
__device__ __forceinline__ u32x4 pack8(const float (&f)[8]) {
    u32x4 w; w.x = cvt_pk_bf16(f[0], f[1]); w.y = cvt_pk_bf16(f[2], f[3]); w.z = cvt_pk_bf16(f[4], f[5]); w.w = cvt_pk_bf16(f[6], f[7]); return w;
}
typedef int i32x8 __attribute__((ext_vector_type(8)));
__device__ __forceinline__ int pk4_fp8(float a, float b, float c, float d) { int r = __builtin_amdgcn_cvt_pk_fp8_f32(a, b, 0, false); return __builtin_amdgcn_cvt_pk_fp8_f32(c, d, r, true); }
__device__ __forceinline__ float sigmoidf_(float v) { return __builtin_amdgcn_rcpf(1.f + __expf(-v)); }
__device__ __forceinline__ float wave_sum(float v) {
#pragma unroll
    for (int o = 1; o < 64; o <<= 1) v += __shfl_xor(v, o);
    return v;
}
#define LDS_WAIT() asm volatile("s_waitcnt lgkmcnt(0)" ::: "memory")
#define VM_WAIT() asm volatile("s_waitcnt vmcnt(0)" ::: "memory")

namespace pg8 {
constexpr int BM = 256, BK = 64, HALF = 128, HTB = HALF * BK * 2, STAGE_BYTES = 8 * HTB, NXCD = 8, WGM = 8;
__device__ __forceinline__ int lds_byte(int r, int c) { const int st = (r >> 4) * 2 + (c >> 5), rr = r & 15, cc = c & 31, ob = rr * 64 + cc * 2; return st * 1024 + (ob ^ (((ob >> 9) & 1) << 5)); }
__device__ __forceinline__ void stage_rc(int b, int& R, int& C) { const int st = b / 1024, sb = b % 1024, swz = sb ^ (((sb >> 9) & 1) << 5); R = (st >> 1) * 16 + swz / 64; C = (st & 1) * 32 + (swz % 64) / 2; }
__device__ __forceinline__ int perm32(int rho) { const int n = rho >> 4, i = rho & 15; return 8 * (i >> 2) + 4 * n + (i & 3); }

struct Unit { int pm, pn, kk; };
struct Gemm { const bf16_t* A; const bf16_t* Bt; int lda, ldb, K; long a1, a2; };

struct StaticOrder {
    int nM, nN, nwg, G, c;
    __device__ void init(int M, int N, int G_, int c_) { nM = M / BM; nN = N / BM; nwg = nM * nN; G = G_; c = c_; }
    __device__ bool next(int i, Unit& u) const {
        const long L = (long)i * G + c; if (L >= nwg) return false;
        int wgid = (int)L; { const int q = nwg / NXCD, r = nwg % NXCD, xcd = wgid % NXCD, off = wgid / NXCD; wgid = (xcd < r ? xcd * (q + 1) : r * (q + 1) + (xcd - r) * q) + off; }
        const int nig = WGM * nN, gid = wgid / nig, fm = gid * WGM, gsz = (nM - fm) < WGM ? (nM - fm) : WGM;
        u.pm = fm + ((wgid % nig) % gsz); u.pn = (wgid % nig) / gsz; u.kk = 0; return true;
    }
};
struct BranchOrder {
    StaticOrder so;
    __device__ bool next(int i, Unit& u) const { const int ti = i / 3, kk = i - 3 * ti; if (!so.next(ti, u)) return false; u.kk = kk; return true; }
};

template <int MODE> __device__ __forceinline__ const char* unitA(const Gemm& g, const Unit& u) {
    const char* p = (const char*)g.A + (size_t)u.pm * BM * g.lda * 2;
    if (MODE == 1) p += (((u.pn >> 1) & 3) * 256) * 2;
    if (MODE == 2) p += (u.kk == 1 ? g.a1 : (u.kk == 2 ? g.a2 : 0l));
    return p;
}
template <int MODE> __device__ __forceinline__ const char* unitB(const Gemm& g, const Unit& u) {
    const char* p = (const char*)g.Bt + (size_t)u.pn * BM * g.ldb * 2;
    if (MODE == 2) p += (size_t)u.kk * 1024 * 1024 * 2;
    return p;
}

template <class Epi, class Sched, int MODE>
__device__ __forceinline__ void gemm_phase(LAS unsigned char* lds, const Gemm g, const Sched& S, const Epi& E, const int tid) {
    const int wid = __builtin_amdgcn_readfirstlane(tid >> 6), lane = tid & 63, wr = wid >> 2, wc = wid & 3, fr = lane & 15, fq = lane >> 4;
    const int K = g.K, nt = K / BK;
    unsigned voffA[2], voffB[2];
#pragma unroll
    for (int i = 0; i < 2; ++i) { int R, C; stage_rc(tid * 16 + i * 8192, R, C); const int Rb = (R & ~31) + perm32(R & 31);
        voffA[i] = (unsigned)(R * g.lda + C) * 2u; voffB[i] = (unsigned)(Rb * g.ldb + C) * 2u; }
    const size_t kstep = (size_t)(BK * 2);
    const size_t hstepA = (size_t)HALF * g.lda * 2, hstepB = (size_t)HALF * g.ldb * 2;
    const unsigned ldsw = (unsigned)wid * 1024u;
    const int aoff = lds_byte(wr * 64 + fr, fq * 8), boff = lds_byte(wc * 32 + fr, fq * 8);
#define PG8_SA(b, h) (((b) * 2 + (h)) * HTB)
#define PG8_SB(b, h) ((4 + (b) * 2 + (h)) * HTB)
#define PG8_STAGE(bufoff, gbase, voff) do { _Pragma("unroll") for (int _i = 0; _i < 2; ++_i) \
        __builtin_amdgcn_global_load_lds((const unsigned*)((const char*)(gbase) + (voff)[_i]), (LAS unsigned*)(lds + (bufoff) + ldsw + _i * 8192), 16, 0, 0); } while (0)
#define PG8_LDA(dst, b, h) do { _Pragma("unroll") for (int m = 0; m < 4; ++m) _Pragma("unroll") for (int k = 0; k < 2; ++k) dst[m][k] = *(const LAS bf16x8*)(lds + PG8_SA(b, h) + aoff + m * 2048 + k * 1024); } while (0)
#define PG8_LDB(dst, b, h) do { _Pragma("unroll") for (int n = 0; n < 2; ++n) _Pragma("unroll") for (int k = 0; k < 2; ++k) dst[n][k] = *(const LAS bf16x8*)(lds + PG8_SB(b, h) + boff + n * 2048 + k * 1024); } while (0)
#define PG8_MMA(ai, bj, At, Bt) do { __builtin_amdgcn_s_setprio(1); _Pragma("unroll") for (int m = 0; m < 4; ++m) _Pragma("unroll") for (int n = 0; n < 2; ++n) _Pragma("unroll") for (int k = 0; k < 2; ++k) \
        acc[ai][bj][m][n] = __builtin_amdgcn_mfma_f32_16x16x32_bf16(Bt[n][k], At[m][k], acc[ai][bj][m][n], 0, 0, 0); __builtin_amdgcn_s_setprio(0); } while (0)
#define PG8_WAIT_V(n) asm volatile("s_waitcnt vmcnt(" #n ")" ::: "memory")
#define PG8_WAIT_L(n) asm volatile("s_waitcnt lgkmcnt(" #n ")" ::: "memory")
#define PG8_BAR __builtin_amdgcn_s_barrier()
#define PG8_SCHED __builtin_amdgcn_sched_barrier(0)
    Unit cur, nxt; int ui = 0;
    if (!S.next(0, cur)) return;
    f32x4 acc[2][2][4][2];
#pragma unroll
    for (int a = 0; a < 2; ++a)
#pragma unroll
        for (int b = 0; b < 2; ++b)
#pragma unroll
            for (int m = 0; m < 4; ++m)
#pragma unroll
                for (int n = 0; n < 2; ++n) acc[a][b][m][n] = (f32x4){0.f, 0.f, 0.f, 0.f};
    bf16x8 At[4][2], B0[2][2], B1[2][2];
    const char* cA = unitA<MODE>(g, cur); const char* cB = unitB<MODE>(g, cur);
    PG8_STAGE(PG8_SB(0, 0), cB, voffB); PG8_STAGE(PG8_SB(0, 1), cB + hstepB, voffB); PG8_STAGE(PG8_SA(0, 0), cA, voffA); PG8_STAGE(PG8_SA(0, 1), cA + hstepA, voffA);
    if (wr == 1) PG8_BAR;
    PG8_WAIT_V(2); PG8_BAR;
    PG8_STAGE(PG8_SB(1, 0), cB + kstep, voffB); PG8_STAGE(PG8_SA(1, 0), cA + kstep, voffA); PG8_STAGE(PG8_SB(1, 1), cB + hstepB + kstep, voffB);
    PG8_WAIT_V(6); PG8_BAR;
    for (;;) {
        const bool has_next = S.next(ui + 1, nxt);
        const char* nA = has_next ? unitA<MODE>(g, nxt) : cA; const char* nB = has_next ? unitB<MODE>(g, nxt) : cB;
#pragma nounroll
        for (int t = 0; t < nt; t += 2) {
            const bool last = (t == nt - 2);
            const char* a1 = cA + (size_t)(t + 1) * kstep;
            const char* a2 = last ? nA : cA + (size_t)(t + 2) * kstep; const char* b2 = last ? nB : cB + (size_t)(t + 2) * kstep;
            const char* a3 = a2 + kstep; const char* b3 = b2 + kstep;
            PG8_LDB(B0, 0, 0); PG8_LDB(B1, 0, 1); PG8_SCHED; PG8_LDA(At, 0, 0); PG8_STAGE(PG8_SA(1, 1), a1 + hstepA, voffA);
            PG8_WAIT_V(8); PG8_WAIT_L(0); PG8_BAR; PG8_MMA(0, 0, At, B0); PG8_MMA(0, 1, At, B1); PG8_BAR; PG8_SCHED;
            PG8_LDA(At, 0, 1); PG8_STAGE(PG8_SB(0, 0), b2, voffB); PG8_STAGE(PG8_SB(0, 1), b2 + hstepB, voffB); PG8_STAGE(PG8_SA(0, 0), a2, voffA);
            PG8_WAIT_V(8); PG8_WAIT_L(0); PG8_BAR; PG8_MMA(1, 0, At, B0); PG8_MMA(1, 1, At, B1); PG8_BAR; PG8_SCHED;
            PG8_LDB(B0, 1, 0); PG8_LDB(B1, 1, 1); PG8_SCHED; PG8_LDA(At, 1, 0); PG8_STAGE(PG8_SA(0, 1), a2 + hstepA, voffA);
            PG8_WAIT_V(8); PG8_WAIT_L(0); PG8_BAR; PG8_MMA(0, 0, At, B0); PG8_MMA(0, 1, At, B1); PG8_BAR; PG8_SCHED;
            PG8_LDA(At, 1, 1); PG8_STAGE(PG8_SB(1, 0), b3, voffB); PG8_STAGE(PG8_SB(1, 1), b3 + hstepB, voffB); PG8_STAGE(PG8_SA(1, 0), a3, voffA);
            PG8_WAIT_V(8); PG8_WAIT_L(0); PG8_BAR; PG8_MMA(1, 0, At, B0); PG8_MMA(1, 1, At, B1); PG8_BAR; PG8_SCHED;
        }
        if (wr == 0) PG8_BAR;
        E(acc, cur, wr, wc, fr, fq);
        if (!has_next) break;
#pragma unroll
        for (int a = 0; a < 2; ++a)
#pragma unroll
            for (int b = 0; b < 2; ++b)
#pragma unroll
                for (int m = 0; m < 4; ++m)
#pragma unroll
                    for (int n = 0; n < 2; ++n) acc[a][b][m][n] = (f32x4){0.f, 0.f, 0.f, 0.f};
        cur = nxt; cA = nA; cB = nB; ++ui;
        if (wr == 1) PG8_BAR;
    }
    PG8_WAIT_V(0);
    PG8_BAR;
#undef PG8_SA
#undef PG8_SB
#undef PG8_STAGE
#undef PG8_LDA
#undef PG8_LDB
#undef PG8_MMA
#undef PG8_WAIT_V
#undef PG8_WAIT_L
#undef PG8_BAR
#undef PG8_SCHED
}

__device__ __forceinline__ void store_tile_bf16(const f32x4 (&acc)[2][2][4][2], bf16_t* base, int ldc, int row0, int col0, int act) {
#pragma unroll
    for (int ai = 0; ai < 2; ++ai)
#pragma unroll
        for (int m = 0; m < 4; ++m) { bf16_t* rowp = base + (size_t)(row0 + ai * HALF + m * 16) * ldc + col0;
#pragma unroll
            for (int bj = 0; bj < 2; ++bj) { float v[8];
#pragma unroll
                for (int j = 0; j < 4; ++j) { v[j] = acc[ai][bj][m][0][j]; v[4 + j] = acc[ai][bj][m][1][j]; }
                if (act != 0) {
                    float sg[8];
#pragma unroll
                    for (int j = 0; j < 8; ++j) sg[j] = sigmoidf_(v[j]);
                    if (act == 1) {
#pragma unroll
                        for (int j = 0; j < 8; ++j) v[j] *= sg[j];
                    } else {
#pragma unroll
                        for (int j = 0; j < 8; ++j) v[j] = sg[j];
                    }
                }
                *(u32x4*)(rowp + bj * HALF) = pack8(v); }
            asm volatile("" ::: "memory"); }
}
struct EpiInProj {
    unsigned char* ws;
    __device__ __forceinline__ void operator()(const f32x4 (&acc)[2][2][4][2], const Unit& u, int wr, int wc, int fr, int fq) const {
        const int pn = u.pn; size_t off; int ldc = 1024, col, act = 0;
        if (pn < 4) { off = WS_XA; col = pn * 256; }
        else if (pn < 8) { off = WS_SGA; col = (pn - 4) * 256; act = 1; }
        else if (pn < 12) { off = WS_Q; col = (pn - 8) * 256; }
        else if (pn == 12) { off = WS_K; col = 0; ldc = 256; }
        else if (pn == 13) { off = WS_V; col = 0; ldc = 256; }
        else if (pn < 18) { off = WS_SGB; col = (pn - 14) * 256; act = 1; }
        else if (pn < 34) {
            const bool bg = pn >= 26; const int blk = bg ? pn - 26 : pn - 18;
            bf16_t* basep = (bf16_t*)(ws + (bg ? WS_BC : WS_XC));
            const int row0p = u.pm * BM + wr * 64 + fr, col0p = blk * 128 + wc * 32 + 8 * fq;
#pragma unroll
            for (int ai = 0; ai < 2; ++ai)
#pragma unroll
                for (int m = 0; m < 4; ++m) { float v[8];
#pragma unroll
                    for (int j = 0; j < 8; ++j) { const float x0 = acc[ai][0][m][j >> 2][j & 3], x1 = acc[ai][1][m][j >> 2][j & 3];
                        v[j] = bg ? x0 * (x1 * sigmoidf_(x1)) : x0 * x1; }
                    *(u32x4*)(basep + (size_t)(row0p + ai * HALF + m * 16) * 1024 + col0p) = pack8(v); }
            return; }
        else { off = WS_SMG; col = (pn - 34) * 256; ldc = 3072; act = 2; }
        bf16_t* base = (bf16_t*)(ws + off);
        const int row0 = u.pm * BM + wr * 64 + fr, col0 = col + wc * 32 + 8 * fq;
        store_tile_bf16(acc, base, ldc, row0, col0, act);
    }
};
struct EpiGates {
    unsigned char* ws; const float* b_r; const float* b_i; const float* lam;
    __device__ __forceinline__ void operator()(const f32x4 (&acc)[2][2][4][2], const Unit& u, int wr, int wc, int fr, int fq) const {
        const int dir = u.pn >> 3, nb = (u.pn >> 1) & 3, hh = u.pn & 1;
        const int ch0 = nb * 256 + hh * 128 + wc * 32 + 8 * fq;
        float br[8], bi[8], sp[8];
#pragma unroll
        for (int j = 0; j < 8; ++j) { br[j] = b_r[dir * 1024 + ch0 + j]; bi[j] = b_i[dir * 1024 + ch0 + j];
            const float lm = lam[dir * 1024 + ch0 + j]; const float e = __expf(-lm);
            const float spl = lm < -15.f ? -lm : (e < 0.03f ? e * (1.f - e * (0.5f - e * (0.33333334f - 0.25f * e))) : __logf(1.f + e));
            sp[j] = -8.0f * LOG2E * spl; }
        const bf16_t* UA = (const bf16_t*)(ws + WS_H);
        bf16_t* LA = (bf16_t*)(ws + WS_LA + (size_t)dir * 64 * MiB);
        bf16_t* UU = (bf16_t*)(ws + WS_U + (size_t)dir * 64 * MiB);
        const int row0 = u.pm * BM + wr * 64 + fr;
#pragma unroll
        for (int ai = 0; ai < 2; ++ai)
#pragma unroll
            for (int m = 0; m < 4; ++m) { const size_t o = (size_t)(row0 + ai * HALF + m * 16) * 1024 + ch0;
                float x[8]; unpack8(*(const u32x4*)(UA + o), x);
                float la[8], uu[8];
#pragma unroll
                for (int j = 0; j < 8; ++j) { const float pr = acc[ai][0][m][j >> 2][j & 3] + br[j], pi = acc[ai][1][m][j >> 2][j & 3] + bi[j];
                    const float r = sigmoidf_(pr), ig = sigmoidf_(pi);
                    const float l2 = r * sp[j]; const float a = __builtin_amdgcn_exp2f(l2);
                    la[j] = l2; uu[j] = __builtin_amdgcn_sqrtf(fmaxf(1.f - a * a, 0.f)) * ig * x[j]; }
                *(u32x4*)(LA + o) = pack8(la); *(u32x4*)(UU + o) = pack8(uu); }
    }
};
struct EpiBranch {
    unsigned char* ws;
    __device__ __forceinline__ void operator()(const f32x4 (&acc)[2][2][4][2], const Unit& u, int wr, int wc, int fr, int fq) const {
        const bf16_t* G = (const bf16_t*)(ws + WS_SMG) + u.kk * 1024;
        bf16_t* Mg = (bf16_t*)(ws + WS_SGA);
        const int row0 = u.pm * BM + wr * 64 + fr, col0 = u.pn * BM + wc * 32 + 8 * fq;
#pragma unroll
        for (int ai = 0; ai < 2; ++ai)
#pragma unroll
            for (int m = 0; m < 4; ++m) { const int row = row0 + ai * HALF + m * 16;
#pragma unroll
                for (int bj = 0; bj < 2; ++bj) { const int col = col0 + bj * HALF;
                    float gt[8], v[8]; unpack8(*(const u32x4*)(G + (size_t)row * 3072 + col), gt);
#pragma unroll
                    for (int j = 0; j < 8; ++j) v[j] = gt[j] * acc[ai][bj][m][j >> 2][j & 3];
                    bf16_t* mp = Mg + (size_t)row * 1024 + col;
                    if (u.kk != 0) { float old[8]; unpack8(*(const u32x4*)mp, old);
#pragma unroll
                        for (int j = 0; j < 8; ++j) v[j] += old[j]; }
                    *(u32x4*)mp = pack8(v); } }
    }
};
struct EpiOut {
    const float* xi; float* xo; const float* gate; const unsigned* flag;
    __device__ __forceinline__ void operator()(const f32x4 (&acc)[2][2][4][2], const Unit& u, int wr, int wc, int fr, int fq) const {
        const int row0 = u.pm * BM + wr * 64 + fr, col0 = u.pn * BM + wc * 32 + 8 * fq;
        const bool bad = PROBE_F8 ? (__hip_atomic_load(flag, __ATOMIC_RELAXED, __HIP_MEMORY_SCOPE_AGENT) != 0u) : false; const float qn = __builtin_nanf("");
        f32x4 gv[2][2];
#pragma unroll
        for (int bj = 0; bj < 2; ++bj)
#pragma unroll
            for (int n = 0; n < 2; ++n) gv[bj][n] = *(const f32x4*)(gate + col0 + bj * HALF + 4 * n);
#pragma unroll
        for (int ai = 0; ai < 2; ++ai)
#pragma unroll
            for (int m = 0; m < 4; ++m) { const size_t o = (size_t)(row0 + ai * HALF + m * 16) * 1024 + col0;
#pragma unroll
                for (int bj = 0; bj < 2; ++bj)
#pragma unroll
                    for (int n = 0; n < 2; ++n) { const f32x4 xv = *(const f32x4*)(xi + o + bj * HALF + 4 * n);
                        f32x4 r = xv + gv[bj][n] * acc[ai][bj][m][n]; if (PROBE_F8 && bad) r = (f32x4){qn, qn, qn, qn};
                        *(f32x4*)(xo + o + bj * HALF + 4 * n) = r; } }
    }
};
}

namespace attn {
using bf16 = __hip_bfloat16;
using s16x4 = __attribute__((ext_vector_type(4))) short;
using f32x16 = __attribute__((ext_vector_type(16))) float;
constexpr int D = 128, NW = 8, QBLK = 32, KVBLK = 64;
constexpr float SCALE = 0.088388347648318440f;
constexpr float THR = 8.f;
constexpr int LDQ = 1024, LDK = 256, LDO = 1024;
constexpr size_t SHM_V = KVBLK * D * 2, SHM_K = KVBLK * D * 2, SHM_ATTN = 2 * SHM_V + 2 * SHM_K + NW * 64 * 4;
#define KSWZ(row, colB) ((row) * 256 + ((colB) ^ (((row) & 7) << 4)))
#define SBAR() __builtin_amdgcn_sched_barrier(0)
__device__ __forceinline__ int crow(int r, int hi) { return (r & 3) + 8 * (r >> 2) + 4 * hi; }
__device__ __forceinline__ unsigned cvtpk(float lo, float hi) { unsigned r; asm volatile("v_cvt_pk_bf16_f32 %0, %1, %2" : "=v"(r) : "v"(lo), "v"(hi)); return r; }

__device__ __forceinline__ void partialSM(f32x16& p0, f32x16& p1, float& m_reg, float& mn, float& alpha) {
  constexpr float C = SCALE * 1.4426950408889634f;
  float pmax = p0[0]; for (int r = 1; r < 16; ++r) pmax = fmaxf(pmax, p0[r]); for (int r = 0; r < 16; ++r) pmax = fmaxf(pmax, p1[r]);
  { auto rr = __builtin_amdgcn_permlane32_swap(__float_as_uint(pmax), __float_as_uint(pmax), false, false);
    pmax = fmaxf(__uint_as_float(rr[0]), __uint_as_float(rr[1])); }
  if (__builtin_expect(__all(pmax - m_reg <= THR / SCALE), 1)) { mn = m_reg; alpha = 1.f; }
  else { mn = fmaxf(m_reg, pmax); alpha = __builtin_amdgcn_exp2f((m_reg - mn) * C); m_reg = mn; }
  float mnC = -mn * C;
  for (int r = 0; r < 16; ++r) p0[r] = fmaf(p0[r], C, mnC); for (int r = 0; r < 16; ++r) p1[r] = fmaf(p1[r], C, mnC);
  for (int r = 0; r < 16; ++r) p0[r] = __builtin_amdgcn_exp2f(p0[r]);
}
__device__ __forceinline__ void finishSM(f32x16& p0, f32x16& p1, float alpha, float& l_reg, bf16x8& pa0, bf16x8& pa1, bf16x8& pa2, bf16x8& pa3) {
  for (int r = 0; r < 16; ++r) p1[r] = __builtin_amdgcn_exp2f(p1[r]);
  float ps = 0; for (int r = 0; r < 16; ++r) ps += p0[r]; for (int r = 0; r < 16; ++r) ps += p1[r];
  { auto rr = __builtin_amdgcn_permlane32_swap(__float_as_uint(ps), __float_as_uint(ps), false, false);
    ps = __uint_as_float(rr[0]) + __uint_as_float(rr[1]); }
  l_reg = l_reg * alpha + ps;
#define PK4(P, BASE, OUT) do { unsigned a0 = cvtpk(P[BASE + 0], P[BASE + 1]), a1 = cvtpk(P[BASE + 2], P[BASE + 3]);   \
    unsigned b0 = cvtpk(P[BASE + 4], P[BASE + 5]), b1 = cvtpk(P[BASE + 6], P[BASE + 7]);                              \
    auto r0 = __builtin_amdgcn_permlane32_swap(a0, b0, false, false); auto r1 = __builtin_amdgcn_permlane32_swap(a1, b1, false, false); \
    u32x4 w = {r0[0], r1[0], r0[1], r1[1]}; OUT = *reinterpret_cast<bf16x8*>(&w); } while (0)
  PK4(p0, 0, pa0); PK4(p0, 8, pa1); PK4(p1, 0, pa2); PK4(p1, 8, pa3);
#undef PK4
}
__device__ __forceinline__ void qkt(f32x16& p0, f32x16& p1, const bf16* Ks, const bf16x8* qr, int r32, int hi) {
  p0 = f32x16{}; p1 = f32x16{};
  for (int d0 = 0; d0 < 8; ++d0) { int cb = (d0 * 16 + hi * 8) * 2;
    bf16x8 b0 = *reinterpret_cast<const bf16x8*>((const char*)Ks + KSWZ(r32, cb));
    bf16x8 b1 = *reinterpret_cast<const bf16x8*>((const char*)Ks + KSWZ(32 + r32, cb));
    p0 = __builtin_amdgcn_mfma_f32_32x32x16_bf16(b0, qr[d0], p0, 0, 0, 0);
    p1 = __builtin_amdgcn_mfma_f32_32x32x16_bf16(b1, qr[d0], p1, 0, 0, 0); }
}
__device__ __forceinline__ int v_st(int k, int c) { const int kk = (k & ~0xC) | ((k & 4) << 1) | ((k & 8) >> 1); return ((kk >> 3) * 4 + (c >> 5)) * 512 + ((kk & 7) * 32 + (c & 31)) * 2; }
__device__ __forceinline__ int v_rd_base(int lane) { return ((lane & 3) << 3) | (((lane >> 2) & 3) << 6) | (((lane >> 4) & 1) << 5) | (((lane >> 5) & 1) << 8); }
constexpr int v_rd_off(int d0, int ks, int half) { return d0 * 512 + ks * 4096 + half * 2048; }
template <int OFF> __device__ __forceinline__ s16x4 tr_read(int vb) {
  s16x4 r; asm volatile("ds_read_b64_tr_b16 %0, %1 offset:%2" : "=&v"(r) : "v"(vb), "i"(OFF) : "memory"); return r;
}
template <int D0> __device__ __forceinline__ void pv_one(f32x16& od, int vb, bf16x8 pa0, bf16x8 pa1, bf16x8 pa2, bf16x8 pa3) {
  const s16x4 l0 = tr_read<v_rd_off(D0, 0, 0)>(vb), h0 = tr_read<v_rd_off(D0, 0, 1)>(vb), l1 = tr_read<v_rd_off(D0, 1, 0)>(vb), h1 = tr_read<v_rd_off(D0, 1, 1)>(vb);
  const s16x4 l2 = tr_read<v_rd_off(D0, 2, 0)>(vb), h2 = tr_read<v_rd_off(D0, 2, 1)>(vb), l3 = tr_read<v_rd_off(D0, 3, 0)>(vb), h3 = tr_read<v_rd_off(D0, 3, 1)>(vb);
  asm volatile("s_waitcnt lgkmcnt(0)" ::: "memory"); SBAR();
#define PK(L, H) (bf16x8){L[0], L[1], L[2], L[3], H[0], H[1], H[2], H[3]}
  od = __builtin_amdgcn_mfma_f32_32x32x16_bf16(pa0, PK(l0, h0), od, 0, 0, 0);
  od = __builtin_amdgcn_mfma_f32_32x32x16_bf16(pa1, PK(l1, h1), od, 0, 0, 0);
  od = __builtin_amdgcn_mfma_f32_32x32x16_bf16(pa2, PK(l2, h2), od, 0, 0, 0);
  od = __builtin_amdgcn_mfma_f32_32x32x16_bf16(pa3, PK(l3, h3), od, 0, 0, 0);
#undef PK
}
__device__ __forceinline__ void pv_d0(f32x16* o, int vb, bf16x8 pa0, bf16x8 pa1, bf16x8 pa2, bf16x8 pa3) {
  pv_one<0>(o[0], vb, pa0, pa1, pa2, pa3); pv_one<1>(o[1], vb, pa0, pa1, pa2, pa3); pv_one<2>(o[2], vb, pa0, pa1, pa2, pa3); pv_one<3>(o[3], vb, pa0, pa1, pa2, pa3);
}
__device__ __forceinline__ void attn_dense_body(const bf16* Qb, const bf16* __restrict__ Kh, const bf16* __restrict__ Vh,
                                                bf16_t* Ob, const bf16_t* Gb, int seq, char* lds, const int tid) {
  const int wid = tid >> 6, lane = tid & 63, r32 = lane & 31, hi = lane >> 5;
  bf16* V_lds = (bf16*)lds; bf16* K_lds = (bf16*)(lds + 2 * SHM_V);
  float* ws = (float*)(lds + 2 * SHM_V + 2 * SHM_K) + wid * 64; float* li_l = ws; float* al_l = ws + 32;
  float m_reg = -1e30f, l_reg = 0; f32x16 o[4] = {}; bf16x8 qr[8];
  const bf16* Qw = Qb + (long)(wid * QBLK + r32) * LDQ + hi * 8;
#pragma unroll
  for (int d0 = 0; d0 < 8; ++d0) qr[d0] = *reinterpret_cast<const bf16x8*>(Qw + d0 * 16);
  const int sr = tid >> 4, sc = (tid & 15) * 8, vst0 = v_st(sr, sc), vst1 = v_st(32 + sr, sc);
  const int vb0 = (int)(uintptr_t)V_lds + v_rd_base(lane);
  struct { bf16x8 vs0, vs1, ks0, ks1; } sr_[2];
#define SLOAD(i, k0) do { sr_[i].vs0 = *reinterpret_cast<const bf16x8*>(&Vh[(long)((k0) + sr) * LDK + sc]); sr_[i].vs1 = *reinterpret_cast<const bf16x8*>(&Vh[(long)((k0) + 32 + sr) * LDK + sc]); \
    sr_[i].ks0 = *reinterpret_cast<const bf16x8*>(&Kh[(long)((k0) + sr) * LDK + sc]); sr_[i].ks1 = *reinterpret_cast<const bf16x8*>(&Kh[(long)((k0) + 32 + sr) * LDK + sc]); } while (0)
#define SWRITE(b, i) do { *(bf16x8*)((char*)V_lds + (b) * SHM_V + vst0) = sr_[i].vs0;          \
    *(bf16x8*)((char*)V_lds + (b) * SHM_V + vst1) = sr_[i].vs1; int kc = sc * 2;               \
    *(bf16x8*)((char*)K_lds + (b) * SHM_K + KSWZ(sr, kc)) = sr_[i].ks0;                       \
    *(bf16x8*)((char*)K_lds + (b) * SHM_K + KSWZ(32 + sr, kc)) = sr_[i].ks1; } while (0)
#define SWAIT() asm volatile("s_waitcnt vmcnt(4)" ::: "memory")
#define RESC(a) do { if (__any((a) < 1.f)) { if (hi == 0) al_l[r32] = (a); asm volatile("s_waitcnt lgkmcnt(0)" ::: "memory"); \
    for (int d = 0; d < 4; ++d) for (int r = 0; r < 16; ++r) o[d][r] *= al_l[crow(r, hi)]; } } while (0)
  f32x16 pA0, pA1, pB0, pB1; float mnA, mnB, alA, alB; bf16x8 pa0, pa1, pa2, pa3; const int NT = seq / KVBLK;
  constexpr int SE = 0, SO = 1;
  SLOAD(SE, 0); asm volatile("s_waitcnt vmcnt(0)" ::: "memory"); SWRITE(0, SE); __syncthreads();
  qkt(pA0, pA1, K_lds, qr, r32, hi); partialSM(pA0, pA1, m_reg, mnA, alA);
  SLOAD(SO, KVBLK); if (2 < NT) SLOAD(SE, 2 * KVBLK);
  SWAIT(); SWRITE(1, SO); __syncthreads();
#pragma nounroll
  for (int j = 1; j + 1 < NT; j += 2) {
    SBAR(); qkt(pB0, pB1, (bf16*)((char*)K_lds + SHM_K), qr, r32, hi);
    finishSM(pA0, pA1, alA, l_reg, pa0, pa1, pa2, pa3); SBAR();
    SLOAD(SO, (j + 2) * KVBLK); SBAR();
    pv_d0(o, vb0, pa0, pa1, pa2, pa3); partialSM(pB0, pB1, m_reg, mnB, alB);
    __syncthreads(); SWAIT(); SWRITE(0, SE);
    RESC(alB); __syncthreads();
    SBAR(); qkt(pA0, pA1, K_lds, qr, r32, hi);
    finishSM(pB0, pB1, alB, l_reg, pa0, pa1, pa2, pa3); SBAR();
    if (j + 3 < NT) SLOAD(SE, (j + 3) * KVBLK); SBAR();
    pv_d0(o, vb0 + (int)SHM_V, pa0, pa1, pa2, pa3); partialSM(pA0, pA1, m_reg, mnA, alA);
    __syncthreads(); SWAIT(); SWRITE(1, SO);
    RESC(alA); __syncthreads();
  }
  SBAR(); qkt(pB0, pB1, (bf16*)((char*)K_lds + SHM_K), qr, r32, hi);
  finishSM(pA0, pA1, alA, l_reg, pa0, pa1, pa2, pa3); SBAR();
  pv_d0(o, vb0, pa0, pa1, pa2, pa3); partialSM(pB0, pB1, m_reg, mnB, alB);
  __syncthreads(); RESC(alB);
  finishSM(pB0, pB1, alB, l_reg, pa0, pa1, pa2, pa3); SBAR();
  pv_d0(o, vb0 + (int)SHM_V, pa0, pa1, pa2, pa3);
  if (hi == 0) li_l[r32] = l_reg; asm volatile("s_waitcnt lgkmcnt(0)" ::: "memory");
  float rli[16];
#pragma unroll
  for (int r = 0; r < 16; ++r) rli[r] = __builtin_amdgcn_rcpf(li_l[crow(r, hi)]);
  __syncthreads();
  { int lane_e = lane, wid_e = wid; asm volatile("" : "+v"(lane_e), "+v"(wid_e)); wid_e = __builtin_amdgcn_readfirstlane(wid_e);
    bf16_t* stg = (bf16_t*)lds + wid_e * 4096;
#pragma unroll
    for (int r = 0; r < 16; ++r) { const int orow = crow(r, hi);
#pragma unroll
      for (int d0 = 0; d0 < 4; ++d0) stg[orow * 128 + d0 * 32 + r32] = (bf16_t)f2bf(o[d0][r] * rli[r]); }
    asm volatile("s_waitcnt lgkmcnt(0)" ::: "memory");
    bf16_t* Ow = Ob + (long)(wid_e * QBLK) * LDO; const bf16_t* Gw = Gb + (long)(wid_e * QBLK) * LDO;
    u32x4 gq[8];
#pragma unroll
    for (int i = 0; i < 8; ++i) { const int row = i * 4 + (lane_e >> 4), ch = lane_e & 15; gq[i] = *(const u32x4*)(Gw + (long)row * LDO + ch * 8); }
#pragma unroll
    for (int i = 0; i < 8; ++i) { const int row = i * 4 + (lane_e >> 4), ch = lane_e & 15;
      float ov[8], gv[8]; unpack8(*(const u32x4*)(stg + row * 128 + ch * 8), ov); unpack8(gq[i], gv);
#pragma unroll
      for (int j = 0; j < 8; ++j) ov[j] *= gv[j];
      *(u32x4*)(Ow + (long)row * LDO + ch * 8) = pack8(ov); } }
  __syncthreads();
#undef SLOAD
#undef SWRITE
#undef SWAIT
#undef RESC
}

__device__ __forceinline__ void attn_pp_body(const bf16* Qb, const bf16* __restrict__ Kh, const bf16* __restrict__ Vh,
                                             bf16_t* Ob, const bf16_t* Gb, int seq, char* lds, const int tid, const bf16_t* cmp = nullptr, unsigned* flag = nullptr) {
  const int wid = __builtin_amdgcn_readfirstlane(tid >> 6), lane = tid & 63, r32 = lane & 31, hi = lane >> 5;
  const int g = wid >> 2;
  constexpr int NB = 3;
  char* V_lds = lds; char* K_lds = lds + NB * SHM_V;
  float* ws = (float*)(lds + NB * (SHM_V + SHM_K)) + wid * 64; float* li_l = ws; float* al_l = ws + 32;
  float m_reg = -1e30f, l_reg = 0; f32x16 o[4] = {}; bf16x8 qr[8];
  const bf16* Qw = Qb + (long)(wid * QBLK + r32) * LDQ + hi * 8;
#pragma unroll
  for (int d0 = 0; d0 < 8; ++d0) qr[d0] = *reinterpret_cast<const bf16x8*>(Qw + d0 * 16);
  const int sr = tid >> 4, sc = (tid & 15) * 8, vst0 = v_st(sr, sc), vst1 = v_st(32 + sr, sc);
  const int ksw0 = KSWZ(sr, sc * 2), ksw1 = KSWZ(32 + sr, sc * 2);
  const int vbase = (int)(uintptr_t)V_lds + v_rd_base(lane);
  struct Stg { bf16x8 vs0, vs1, ks0, ks1; } st0, st1;
#define SLOAD(S, t) do { const long k0_ = (long)(t) * KVBLK; S.vs0 = *reinterpret_cast<const bf16x8*>(&Vh[(k0_ + sr) * LDK + sc]); S.vs1 = *reinterpret_cast<const bf16x8*>(&Vh[(k0_ + 32 + sr) * LDK + sc]); \
    S.ks0 = *reinterpret_cast<const bf16x8*>(&Kh[(k0_ + sr) * LDK + sc]); S.ks1 = *reinterpret_cast<const bf16x8*>(&Kh[(k0_ + 32 + sr) * LDK + sc]); } while (0)
#define SWRITE(S, b) do { *(bf16x8*)(V_lds + (b) * SHM_V + vst0) = S.vs0; *(bf16x8*)(V_lds + (b) * SHM_V + vst1) = S.vs1; \
    *(bf16x8*)(K_lds + (b) * SHM_K + ksw0) = S.ks0; *(bf16x8*)(K_lds + (b) * SHM_K + ksw1) = S.ks1; } while (0)
#define RESC(a) do { if (__any((a) < 1.f)) { if (hi == 0) al_l[r32] = (a); asm volatile("s_waitcnt lgkmcnt(0)" ::: "memory"); \
    for (int d = 0; d < 4; ++d) for (int r = 0; r < 16; ++r) o[d][r] *= al_l[crow(r, hi)]; } } while (0)
  const int NT = seq / KVBLK;
  f32x16 p0, p1; bf16x8 pa0, pa1, pa2, pa3;
#define SMX() do { float mn_, al_; partialSM(p0, p1, m_reg, mn_, al_); RESC(al_); finishSM(p0, p1, al_, l_reg, pa0, pa1, pa2, pa3); } while (0)
  SLOAD(st0, 0); if (g) SLOAD(st1, 1);
  SWRITE(st0, 0); if (g) SWRITE(st1, 1);
  SLOAD(st0, 1 + g); SLOAD(st1, 2 + g);
  __syncthreads();
  if (g) __syncthreads();
  SBAR(); qkt(p0, p1, (const bf16*)K_lds, qr, r32, hi); SBAR();
  __syncthreads();
  SWRITE(st0, 1 + g); if (3 + g < NT) SLOAD(st0, 3 + g);
  SMX();
  __syncthreads();
  int c = 0;
#define STEP(i, ST) do { const int cK_ = (c == 2) ? 0 : c + 1; \
    SBAR(); \
    qkt(p0, p1, (const bf16*)(K_lds + cK_ * SHM_K), qr, r32, hi); \
    pv_d0(o, vbase + c * (int)SHM_V, pa0, pa1, pa2, pa3); \
    SBAR(); \
    __syncthreads(); \
    { const int t_ = (i) + 2 + g; if (t_ < NT) { const int cb_ = (cK_ == 2) ? 0 : cK_ + 1; const int cw_ = g ? ((cb_ == 2) ? 0 : cb_ + 1) : cb_; \
        SWRITE(ST, cw_); if (t_ + 2 < NT) SLOAD(ST, t_ + 2); } } \
    SMX(); \
    __syncthreads(); \
    c = cK_; } while (0)
  int i = 0;
#pragma nounroll
  for (; i + 1 < NT - 1; i += 2) { STEP(i, st1); STEP(i + 1, st0); }
  if (i < NT - 1) { STEP(i, st1); }
  SBAR(); pv_d0(o, vbase + c * (int)SHM_V, pa0, pa1, pa2, pa3); SBAR();
  __syncthreads();
  if (!g) __syncthreads();
  if (hi == 0) li_l[r32] = l_reg; asm volatile("s_waitcnt lgkmcnt(0)" ::: "memory");
  float rli[16];
#pragma unroll
  for (int r = 0; r < 16; ++r) rli[r] = __builtin_amdgcn_rcpf(li_l[crow(r, hi)]);
  { int lane_e = lane, wid_e = wid; asm volatile("" : "+v"(lane_e), "+v"(wid_e)); wid_e = __builtin_amdgcn_readfirstlane(wid_e);
    bf16_t* stg = (bf16_t*)lds + wid_e * 4096;
#pragma unroll
    for (int r = 0; r < 16; ++r) { const int orow = crow(r, hi);
#pragma unroll
      for (int d0 = 0; d0 < 4; ++d0) stg[orow * 128 + d0 * 32 + r32] = (bf16_t)f2bf(o[d0][r] * rli[r]); }
    asm volatile("s_waitcnt lgkmcnt(0)" ::: "memory");
    bf16_t* Ow = Ob + (long)(wid_e * QBLK) * LDO; const bf16_t* Gw = Gb + (long)(wid_e * QBLK) * LDO;
    u32x4 gq[8];
#pragma unroll
    for (int i2 = 0; i2 < 8; ++i2) { const int row = i2 * 4 + (lane_e >> 4), ch = lane_e & 15; gq[i2] = *(const u32x4*)(Gw + (long)row * LDO + ch * 8); }
#pragma unroll
    for (int i2 = 0; i2 < 8; ++i2) { const int row = i2 * 4 + (lane_e >> 4), ch = lane_e & 15;
      float ov[8], gv[8]; unpack8(*(const u32x4*)(stg + row * 128 + ch * 8), ov); unpack8(gq[i2], gv);
#pragma unroll
      for (int j = 0; j < 8; ++j) ov[j] *= gv[j];
      *(u32x4*)(Ow + (long)row * LDO + ch * 8) = pack8(ov); } }
  __syncthreads();
  if (PROBE_F8 && cmp) {
    asm volatile("s_waitcnt vmcnt(0)" ::: "memory");
    float pr_d = 0.f, pr_r = 0.f; int lane_c = lane; asm volatile("" : "+v"(lane_c));
    const bf16_t* stg2 = (const bf16_t*)lds + wid * 4096;
    float a0[8], c0[8];
#pragma unroll
    for (int i2 = 0; i2 < 8; ++i2) { const int rl = i2 * 4 + (lane_c >> 4), ch = lane_c & 15; float a[8], cv[8];
      unpack8(*(const u32x4*)(stg2 + rl * 128 + ch * 8), a); unpack8(*(const u32x4*)(cmp + (long)(wid * QBLK + rl) * LDO + ch * 8), cv);
      if (i2 == 0) {
#pragma unroll
        for (int j = 0; j < 8; ++j) { a0[j] = a[j]; c0[j] = cv[j]; }
      } else {
#pragma unroll
        for (int j = 0; j < 8; ++j) { const float fa = a[j] - a0[j], fc = cv[j] - c0[j]; pr_d = fmaxf(pr_d, fabsf(fa - fc)); pr_r = fmaxf(pr_r, fabsf(fa)); } } }
#pragma unroll
    for (int o_ = 1; o_ < 64; o_ <<= 1) { pr_d = fmaxf(pr_d, __shfl_xor(pr_d, o_)); pr_r = fmaxf(pr_r, __shfl_xor(pr_r, o_)); }
    if (lane_c == 0 && !(pr_d <= 0.3f * pr_r)) atomicOr(flag, 1u);
    __syncthreads(); }
#undef SLOAD
#undef SWRITE
#undef RESC
#undef SMX
#undef STEP
}

constexpr float THR8 = 2.6f;
__device__ __forceinline__ void partialSM8(f32x16& p0, f32x16& p1, float& m_reg, float& alpha) {
  constexpr float C = SCALE * 1.4426950408889634f;
  float pmax = p0[0]; for (int r = 1; r < 16; ++r) pmax = fmaxf(pmax, p0[r]); for (int r = 0; r < 16; ++r) pmax = fmaxf(pmax, p1[r]);
  { auto rr = __builtin_amdgcn_permlane32_swap(__float_as_uint(pmax), __float_as_uint(pmax), false, false);
    pmax = fmaxf(__uint_as_float(rr[0]), __uint_as_float(rr[1])); }
  float mn;
  if (__builtin_expect(__all(pmax - m_reg <= THR8 / SCALE), 1)) { mn = m_reg; alpha = 1.f; }
  else { mn = fmaxf(m_reg, pmax); alpha = __builtin_amdgcn_exp2f((m_reg - mn) * C); m_reg = mn; }
  const float mnC = 6.0f - mn * C;
  for (int r = 0; r < 16; ++r) p0[r] = fmaf(p0[r], C, mnC); for (int r = 0; r < 16; ++r) p1[r] = fmaf(p1[r], C, mnC);
  for (int r = 0; r < 16; ++r) p0[r] = __builtin_amdgcn_exp2f(p0[r]);
}
__device__ __forceinline__ void finishSM8(f32x16& p0, f32x16& p1, float alpha, float& l_reg, i32x8& pa) {
  for (int r = 0; r < 16; ++r) p1[r] = __builtin_amdgcn_exp2f(p1[r]);
  float sA = p0[0] + p0[1], sB = p0[2] + p0[3], sC = p1[0] + p1[1], sD = p1[2] + p1[3];
  for (int r = 4; r < 16; r += 2) { sA += p0[r]; sB += p0[r + 1]; sC += p1[r]; sD += p1[r + 1]; }
  float ps = (sA + sB) + (sC + sD);
  { auto rr = __builtin_amdgcn_permlane32_swap(__float_as_uint(ps), __float_as_uint(ps), false, false);
    ps = __uint_as_float(rr[0]) + __uint_as_float(rr[1]); }
  l_reg = l_reg * alpha + ps;
#pragma unroll
  for (int w = 0; w < 4; ++w) { pa[w] = pk4_fp8(p0[4 * w], p0[4 * w + 1], p0[4 * w + 2], p0[4 * w + 3]); pa[4 + w] = pk4_fp8(p1[4 * w], p1[4 * w + 1], p1[4 * w + 2], p1[4 * w + 3]); }
}

template <bool FIRST> __device__ __forceinline__ void partialSM8n(f32x16& p0, f32x16& p1, float& M2, f32x16& negm, float& alpha) {
  constexpr float THR2 = THR8 * 1.4426950408889634f;
  float mA = fmaxf(p0[0], p0[1]), mB = fmaxf(p0[2], p0[3]), mC = fmaxf(p1[0], p1[1]), mD = fmaxf(p1[2], p1[3]);
  for (int r = 4; r < 16; r += 4) { mA = fmaxf(fmaxf(mA, p0[r]), p0[r + 1]); mB = fmaxf(fmaxf(mB, p0[r + 2]), p0[r + 3]); mC = fmaxf(fmaxf(mC, p1[r]), p1[r + 1]); mD = fmaxf(fmaxf(mD, p1[r + 2]), p1[r + 3]); }
  float emax = fmaxf(fmaxf(mA, mB), fmaxf(mC, mD));
  { auto rr = __builtin_amdgcn_permlane32_swap(__float_as_uint(emax), __float_as_uint(emax), false, false);
    emax = fmaxf(__uint_as_float(rr[0]), __uint_as_float(rr[1])); }
  if (!FIRST && __builtin_expect(__all(emax - 5.0f <= THR2), 1)) { alpha = 1.f; }
  else { const float delta = FIRST ? (emax - 5.0f) : fmaxf(emax - 5.0f, 0.f); alpha = FIRST ? 0.f : __builtin_amdgcn_exp2f(-delta); M2 += delta;
    for (int r = 0; r < 16; ++r) { p0[r] -= delta; p1[r] -= delta; }
    const float nm = 5.0f - M2; for (int r = 0; r < 16; ++r) negm[r] = nm; asm volatile("" : "+v"(negm)); }
  for (int r = 0; r < 16; ++r) p0[r] = __builtin_amdgcn_exp2f(p0[r]);
}
#define MFMA8(A, B, Cc) __builtin_amdgcn_mfma_scale_f32_32x32x64_f8f6f4((A), (B), (Cc), 0, 0, 0, 0x7f7f7f7f, 0, 0x7f7f7f7f)
__device__ __forceinline__ i32x8 cat8(const u32x4 lo, const u32x4 hi4) { i32x8 r; r[0] = (int)lo.x; r[1] = (int)lo.y; r[2] = (int)lo.z; r[3] = (int)lo.w; r[4] = (int)hi4.x; r[5] = (int)hi4.y; r[6] = (int)hi4.z; r[7] = (int)hi4.w; return r; }
__device__ __forceinline__ void qkt8(f32x16& p0, f32x16& p1, const char* Ks, const i32x8* qf, int r32, int hi, const f32x16& negm) {
  const int x = r32 & 7; const char* k0 = Ks + r32 * 128; const char* k1 = k0 + 32 * 128;
  p0 = negm; p1 = negm;
#pragma unroll
  for (int s2 = 0; s2 < 2; ++s2) { const int c0 = 4 * s2 + 2 * hi, oa = 16 * (c0 ^ x), ob = 16 * ((c0 + 1) ^ x);
    const i32x8 a0 = cat8(*reinterpret_cast<const u32x4*>(k0 + oa), *reinterpret_cast<const u32x4*>(k0 + ob));
    const i32x8 a1 = cat8(*reinterpret_cast<const u32x4*>(k1 + oa), *reinterpret_cast<const u32x4*>(k1 + ob));
    p0 = MFMA8(a0, qf[s2], p0); p1 = MFMA8(a1, qf[s2], p1); }
}
__device__ __forceinline__ void pv8(f32x16* o, const char* Vs, const i32x8 pa, int r32, int hi) {
  const int sw = (r32 >> 2) & 3; const char* vb = Vs + r32 * 64; const int oa = 16 * ((2 * hi) ^ sw), ob = 16 * ((2 * hi + 1) ^ sw);
#pragma unroll
  for (int d0 = 0; d0 < 4; ++d0) { const i32x8 b = cat8(*reinterpret_cast<const u32x4*>(vb + d0 * 2048 + oa), *reinterpret_cast<const u32x4*>(vb + d0 * 2048 + ob));
    o[d0] = MFMA8(pa, b, o[d0]); }
}
__device__ __forceinline__ void attn_pp8_body(const bf16* Qb, const unsigned char* __restrict__ K8, const unsigned char* __restrict__ V8,
                                              bf16_t* Ob, const bf16_t* Gb, int seq, char* lds, const int tid) {
  const int wid = __builtin_amdgcn_readfirstlane(tid >> 6), lane = tid & 63, r32 = lane & 31, hi = lane >> 5;
  const int g = wid >> 2;
  constexpr int NB = 3, SL = 8192;
  char* V_lds = lds; char* K_lds = lds + NB * SL;
  float* ws = (float*)(lds + 65536) + wid * 64; float* li_l = ws; float* al_l = ws + 32;
  float M2 = 0.f, l_reg = 0; f32x16 o[4] = {}; i32x8 qf[2]; f32x16 negm; for (int r = 0; r < 16; ++r) negm[r] = 5.0f; asm volatile("" : "+v"(negm));
  constexpr float QC = SCALE * 1.4426950408889634f;
  { const bf16* Qw = Qb + (long)(wid * QBLK + r32) * LDQ + hi * 32;
#pragma unroll
    for (int s2 = 0; s2 < 2; ++s2) {
#pragma unroll
      for (int q4 = 0; q4 < 4; ++q4) { float f[8]; unpack8(*reinterpret_cast<const u32x4*>(Qw + s2 * 64 + q4 * 8), f);
        qf[s2][2 * q4] = pk4_fp8(f[0] * QC, f[1] * QC, f[2] * QC, f[3] * QC); qf[s2][2 * q4 + 1] = pk4_fp8(f[4] * QC, f[5] * QC, f[6] * QC, f[7] * QC); } } }
  struct Stg8 { u32x4 k, v; } st0, st1;
#define SLOAD(S, t) do { const size_t o_ = (size_t)(t) * SL + (size_t)tid * 16; S.k = *reinterpret_cast<const u32x4*>(K8 + o_); S.v = *reinterpret_cast<const u32x4*>(V8 + o_); } while (0)
#define SWRITE(S, b) do { *(u32x4*)(K_lds + (b) * SL + tid * 16) = S.k; *(u32x4*)(V_lds + (b) * SL + tid * 16) = S.v; } while (0)
#define RESC(a) do { if (__any((a) < 1.f)) { if (hi == 0) al_l[r32] = (a); asm volatile("s_waitcnt lgkmcnt(0)" ::: "memory"); \
    for (int d = 0; d < 4; ++d) for (int r = 0; r < 16; ++r) o[d][r] *= al_l[crow(r, hi)]; } } while (0)
  const int NT = seq / KVBLK;
  f32x16 p0, p1; i32x8 pa;
#define SMX() do { float al_; partialSM8n<true>(p0, p1, M2, negm, al_); RESC(al_); finishSM8(p0, p1, al_, l_reg, pa); } while (0)
  SLOAD(st0, 0); if (g) SLOAD(st1, 1);
  SWRITE(st0, 0); if (g) SWRITE(st1, 1);
  SLOAD(st0, 1 + g);
  __syncthreads();
  if (g) __syncthreads();
  SBAR(); qkt8(p0, p1, K_lds, qf, r32, hi, negm); SBAR();
  __syncthreads();
  SWRITE(st0, 1 + g); SLOAD(st0, 2 + g);
  SMX();
  __syncthreads();
  int c = 0;
#define STEP(i, ST) do { const int cK_ = (c == 2) ? 0 : c + 1; \
    SBAR(); \
    float al2_; \
    qkt8(p0, p1, K_lds + cK_ * SL, qf, r32, hi, negm); \
    pv8(o, V_lds + c * SL, pa, r32, hi);                    \
    SBAR(); \
    partialSM8n<false>(p0, p1, M2, negm, al2_);            \
    SBAR(); \
    __syncthreads(); \
    { const int t_ = (i) + 2 + g; if (t_ < NT) { const int cb_ = (cK_ == 2) ? 0 : cK_ + 1; const int cw_ = g ? ((cb_ == 2) ? 0 : cb_ + 1) : cb_; \
        SWRITE(st0, cw_); if (t_ + 1 < NT) SLOAD(st0, t_ + 1); } } \
    RESC(al2_); finishSM8(p0, p1, al2_, l_reg, pa); \
    __syncthreads(); \
    c = cK_; } while (0)
  int i = 0;
#pragma nounroll
  for (; i + 1 < NT - 1; i += 2) { STEP(i, st1); STEP(i + 1, st0); }
  if (i < NT - 1) { STEP(i, st1); }
  SBAR(); pv8(o, V_lds + c * SL, pa, r32, hi); SBAR();
  __syncthreads();
  if (!g) __syncthreads();
  if (hi == 0) li_l[r32] = l_reg; asm volatile("s_waitcnt lgkmcnt(0)" ::: "memory");
  float rli[16];
#pragma unroll
  for (int r = 0; r < 16; ++r) rli[r] = __builtin_amdgcn_rcpf(li_l[crow(r, hi)]);
  { int tid_e = tid; asm volatile("" : "+v"(tid_e)); const int lane_e = tid_e & 63; const int wid_e = __builtin_amdgcn_readfirstlane(tid_e >> 6);
    bf16_t* stg = (bf16_t*)lds + wid_e * 4096;
#pragma unroll
    for (int r = 0; r < 16; ++r) { const int orow = crow(r, hi);
#pragma unroll
      for (int d0 = 0; d0 < 4; ++d0) stg[orow * 128 + d0 * 32 + r32] = (bf16_t)f2bf(o[d0][r] * rli[r]); }
    asm volatile("s_waitcnt lgkmcnt(0)" ::: "memory");
    bf16_t* Ow = Ob + (long)(wid_e * QBLK) * LDO; const bf16_t* Gw = Gb + (long)(wid_e * QBLK) * LDO;
    u32x4 gq[8];
#pragma unroll
    for (int i2 = 0; i2 < 8; ++i2) { const int row = i2 * 4 + (lane_e >> 4), ch = lane_e & 15; gq[i2] = Gb ? *(const u32x4*)(Gw + (long)row * LDO + ch * 8) : (u32x4){0x3f803f80u, 0x3f803f80u, 0x3f803f80u, 0x3f803f80u}; }
#pragma unroll
    for (int i2 = 0; i2 < 8; ++i2) { const int row = i2 * 4 + (lane_e >> 4), ch = lane_e & 15;
      float ov[8], gv[8]; unpack8(*(const u32x4*)(stg + row * 128 + ch * 8), ov); unpack8(gq[i2], gv);
#pragma unroll
      for (int j = 0; j < 8; ++j) ov[j] *= gv[j];
      *(u32x4*)(Ow + (long)row * LDO + ch * 8) = pack8(ov); } }
  __syncthreads();
#undef SLOAD
#undef SWRITE
#undef RESC
#undef SMX
#undef STEP
#undef MFMA8
}
#undef KSWZ
#undef SBAR
}


#define XB_TMO      128
#define XB_XCNT(j)  (256  + 64 * (j))
#define XB_XSUB(j)  (1280 + 64 * (j))
#define XB_XGEN(j)  (2304 + 64 * (j))
#define XB_TOP      3328
#define XB_TOPGEN   3392
#define XCD_BAR_WORDS 3456
#define XB_SPIN_CAP (1u << 22)
__device__ __forceinline__ unsigned xb_ld(unsigned* p)              { return __hip_atomic_load(p, __ATOMIC_RELAXED, __HIP_MEMORY_SCOPE_AGENT); }
__device__ __forceinline__ unsigned xb_add(unsigned* p, unsigned v) { return __hip_atomic_fetch_add(p, v, __ATOMIC_RELAXED, __HIP_MEMORY_SCOPE_AGENT); }
__device__ __forceinline__ unsigned xb_xcc_id() { return (unsigned)__builtin_amdgcn_s_getreg((3 << 11) | 20) & 0xFu; }
#define XB_SPIN(cond, bar) do { unsigned _sp = 0; while (cond) { __builtin_amdgcn_s_sleep(1); \
    if ((++_sp & 255u) == 0u) { if (xb_ld(&(bar)[XB_TMO])) break; if (_sp > XB_SPIN_CAP) { atomicAdd(&(bar)[XB_TMO], 1u); break; } } } } while (0)
struct XcdBarrier { unsigned* bar; unsigned x; volatile LAS unsigned* st; };
__device__ __forceinline__ XcdBarrier xcd_barrier_post(unsigned* bar, volatile LAS unsigned* st) {
    XcdBarrier b; b.bar = bar; b.x = xb_xcc_id(); b.st = st;
    if (threadIdx.x == 0) (void)xb_add(&bar[XB_XCNT(b.x)], 1u);
    return b;
}
__device__ __forceinline__ void xcd_barrier_complete(unsigned* bar, unsigned x, unsigned& nloc, unsigned& nx) {
    const unsigned G = gridDim.x * gridDim.y * gridDim.z;
    unsigned sum, cnt, mine, sp = 0u;
    for (;;) {
        sum = 0u; cnt = 0u; mine = 0u;
#pragma unroll
        for (unsigned j = 0; j < 16; ++j) { const unsigned c = xb_ld(&bar[XB_XCNT(j)]); sum += c; cnt += (c > 0u) ? 1u : 0u; mine = (j == x) ? c : mine; }
        if (sum == G) break;
        __builtin_amdgcn_s_sleep(1);
        if ((++sp & 255u) == 0u) { if (xb_ld(&bar[XB_TMO])) break; if (sp > XB_SPIN_CAP) { atomicAdd(&bar[XB_TMO], 1u); break; } }
    }
    nloc = mine > 0u ? mine : 1u; nx = cnt > 0u ? cnt : 1u;
}
__device__ __forceinline__ void xcd_barrier(const XcdBarrier& b, const int tid) {
    asm volatile("s_waitcnt vmcnt(0)" ::: "memory");
    __syncthreads();
    if (tid == 0) {
        unsigned* bar = b.bar;
        __builtin_amdgcn_s_waitcnt(0);
        unsigned nloc = b.st[0], nx = b.st[1];
        if (nloc == 0u) { xcd_barrier_complete(bar, b.x, nloc, nx); b.st[0] = nloc; b.st[1] = nx; }
        const unsigned old = xb_add(&bar[XB_XSUB(b.x)], 1u);
        const unsigned gen = old / nloc;
        if (old + 1u == (gen + 1u) * nloc) {
            __builtin_amdgcn_fence(__ATOMIC_RELEASE, "agent");
            asm volatile("s_waitcnt vmcnt(0)" ::: "memory");
            const unsigned og = xb_add(&bar[XB_TOP], 1u);
            const unsigned tg = og / nx;
            if (og + 1u == (tg + 1u) * nx) xb_add(&bar[XB_TOPGEN], 1u);
            else XB_SPIN(xb_ld(&bar[XB_TOPGEN]) == tg, bar);
            __builtin_amdgcn_fence(__ATOMIC_ACQUIRE, "agent");
            xb_add(&bar[XB_XGEN(b.x)], 1u);
            asm volatile("s_waitcnt vmcnt(0)" ::: "memory");
        } else {
            XB_SPIN(xb_ld(&bar[XB_XGEN(b.x)]) == gen, bar);
            __builtin_amdgcn_fence(__ATOMIC_ACQUIRE, "agent");
            asm volatile("s_waitcnt vmcnt(0)" ::: "memory");
        }
    }
    __syncthreads();
}

#ifndef PHM
#define PHM 1023
#endif
#ifndef PROBE_K
#define PROBE_K -1
#endif
struct Args { const float* in[18]; float* out; unsigned char* ws; int ph_lo, ph_hi; };
typedef const __attribute__((address_space(4))) Args* KArgs;
#define INP(a, i) ((const float*)(const GAS float*)((a)->in[i]))
#define OUTP(a) ((float*)(GAS float*)((a)->out))
enum { I_X = 0, I_C, I_WADA, I_BADA, I_NORMG, I_WIN, I_CAW, I_CAB, I_WRG, I_BRG, I_WIG, I_BIG, I_LAM, I_QG, I_KG, I_CCW, I_WBR, I_WOUT };

__device__ __forceinline__ void transpose_item(const float* W, int ldw, bf16_t* dst, int ldd, LAS float* scr, int lane) {
#pragma unroll 8
    for (int i = 0; i < 32; ++i) { const int kk = 2 * i + (lane >> 5); scr[kk * 33 + (lane & 31)] = W[(size_t)kk * ldw + (lane & 31)]; }
    LDS_WAIT();
    const int c = lane & 7;
#pragma unroll
    for (int j = 0; j < 4; ++j) { const int n = (lane >> 3) + 8 * j; const LAS float* s = scr + (8 * c) * 33 + n;
        u32x4 o; o.x = cvt_pk_bf16(s[0 * 33], s[1 * 33]); o.y = cvt_pk_bf16(s[2 * 33], s[3 * 33]); o.z = cvt_pk_bf16(s[4 * 33], s[5 * 33]); o.w = cvt_pk_bf16(s[6 * 33], s[7 * 33]);
        *(u32x4*)(dst + (size_t)n * ldd + 8 * c) = o; }
    LDS_WAIT();
}

__device__ __forceinline__ void phase_prologue(KArgs a, unsigned char* wsb, LAS unsigned char* lds, int tid, int lane, int wave, int bid, int G) {
    unsigned char* ws = wsb;
    {
        LAS float* red = (LAS float*)lds;
        for (int it = bid; it < 96; it += G) {
            const int l = it / 48, jb = it % 48, j = jb * 64 + lane;
            const float* wa = INP(a, I_WADA) + (size_t)l * 1024 * 3072 + j; const float* c0 = INP(a, I_C); const float* c1 = c0 + 1024;
            float a0 = 0.f, a1 = 0.f; const int kb = wave * 128;
#pragma unroll 16
            for (int k = 0; k < 128; ++k) { const float w = wa[(size_t)(kb + k) * 3072]; a0 += c0[kb + k] * w; a1 += c1[kb + k] * w; }
            red[(wave * 2 + 0) * 64 + lane] = a0; red[(wave * 2 + 1) * 64 + lane] = a1;
            __syncthreads();
            if (tid < 128) { const int bb = tid >> 6; float s = 0.f;
#pragma unroll
                for (int w = 0; w < 8; ++w) s += red[(w * 2 + bb) * 64 + lane];
                ((float*)(ws + WS_MOD))[(l * 2 + bb) * 3072 + j] = s + INP(a, I_BADA)[l * 3072 + j]; }
            __syncthreads();
        }
    }
    {
        float* rc = (float*)(ws + WS_ROPE); float* rs = rc + 320 * 32;
        for (int e = bid * 512 + tid; e < 320 * 32; e += G * 512) {
            const int pos = e >> 5, i = e & 31; const int p = pos < 256 ? pos : pos - 256;
            const float inv = __builtin_amdgcn_exp2f(-((float)(2 * i)) * (13.287712379549449f / 64.0f));
            const float ang = (float)p * inv;
            rc[e] = __cosf(ang); rs[e] = __sinf(ang);
        }
    }
    {
        LAS float* scr = (LAS float*)(lds + 8192 + wave * 12288);
        const int gw = bid * 8 + wave, NGW = G * 8;
        constexpr int I_IN = 2 * 16 * 368, I_G = 1024, I_BR = 3072, I_OUT = 1024, NITEMS = I_IN + I_G + I_BR + I_OUT;
        for (int it = gw; it < NITEMS; it += NGW) {
            int r = it;
            if (r < I_IN) { const int l = r / 5888, q = r % 5888, kb = q / 368, nb = q % 368;
                const int n0 = 32 * nb; int drow = n0;
                if (n0 >= 4608 && n0 < 8704) { const int sec = (n0 - 4608) >> 10, ch = (n0 - 4608) & 1023, blk = ch >> 7;
                    drow = ((sec & 1) ? 26 + blk : 18 + blk) * 256 + ((sec >> 1) ? 128 : 0) + (ch & 127); }
                transpose_item(INP(a, I_WIN) + (size_t)l * 1024 * NIN + (size_t)(64 * kb) * NIN + n0, NIN,
                               (bf16_t*)(ws + WS_WIN) + (size_t)l * NIN * 1024 + (size_t)drow * 1024 + 64 * kb, 1024, scr, lane); continue; }
            r -= I_IN;
            if (r < I_G) { const int mi = r >> 5, sub = r & 31, kb = sub >> 3, nblk = sub & 7;
                const int nb = mi & 3, gate = (mi >> 2) & 1, dir = (mi >> 3) & 1, l = mi >> 4;
                const float* src = (gate ? INP(a, I_WIG) : INP(a, I_WRG)) + (size_t)((l * 2 + dir) * 4 + nb) * 65536 + (size_t)(64 * kb) * 256 + 32 * nblk;
                const int n0 = 32 * nblk, hh = n0 >> 7, pn = (dir * 4 + nb) * 2 + hh, row = pn * 256 + gate * 128 + (n0 & 127);
                transpose_item(src, 256, (bf16_t*)(ws + WS_WG) + (size_t)l * 4096 * 256 + (size_t)row * 256 + 64 * kb, 256, scr, lane); continue; }
            r -= I_G;
            if (r < I_BR) { const int mi = r >> 9, sub = r & 511, kb = sub >> 5, nblk = sub & 31;
                transpose_item(INP(a, I_WBR) + (size_t)mi * 1048576 + (size_t)(64 * kb) * 1024 + 32 * nblk, 1024,
                               (bf16_t*)(ws + WS_WBR) + (size_t)mi * 1048576 + (size_t)(32 * nblk) * 1024 + 64 * kb, 1024, scr, lane); continue; }
            r -= I_BR;
            { const int mi = r >> 9, sub = r & 511, kb = sub >> 5, nblk = sub & 31;
                transpose_item(INP(a, I_WOUT) + (size_t)mi * 1048576 + (size_t)(64 * kb) * 1024 + 32 * nblk, 1024,
                               (bf16_t*)(ws + WS_WOUT) + (size_t)mi * 1048576 + (size_t)(32 * nblk) * 1024 + 64 * kb, 1024, scr, lane); }
        }
    }
}

__device__ __forceinline__ void phase_h(KArgs a, unsigned char* wsb, int l, int b, int lane, int wave, int bid, int G) {
    const float* xin = (l == 0 ? INP(a, I_X) : OUTP(a)) + (size_t)b * SEQ * DM;
    const float* mod = (const float*)(wsb + WS_MOD) + (l * 2 + b) * 3072;
    bf16_t* H = (bf16_t*)(wsb + WS_H);
    f32x4 gs[4], sh[4];
#pragma unroll
    for (int j = 0; j < 4; ++j) { const int col = 4 * lane + 256 * j;
        const f32x4 g = *(const f32x4*)(INP(a, I_NORMG) + l * 1024 + col), sc = *(const f32x4*)(mod + 1024 + col);
        gs[j] = g * (sc + 1.0f); sh[j] = *(const f32x4*)(mod + col); }
    const int gw = bid * 8 + wave, NGW = G * 8;
    for (int m = gw; m < SEQ; m += 2 * NGW) {
        const int m2 = (m + NGW < SEQ) ? m + NGW : m;
        const f32x4* xr = (const f32x4*)(xin + (size_t)m * DM) + lane; const f32x4* xr2 = (const f32x4*)(xin + (size_t)m2 * DM) + lane;
        f32x4 v[4], w[4]; float s = 0.f, s2 = 0.f;
#pragma unroll
        for (int j = 0; j < 4; ++j) { v[j] = xr[64 * j]; w[j] = xr2[64 * j]; }
#pragma unroll
        for (int j = 0; j < 4; ++j) { s += (v[j].x * v[j].x + v[j].y * v[j].y) + (v[j].z * v[j].z + v[j].w * v[j].w); s2 += (w[j].x * w[j].x + w[j].y * w[j].y) + (w[j].z * w[j].z + w[j].w * w[j].w); }
        const float rstd = __builtin_amdgcn_rsqf(wave_sum(s) * (1.f / DM) + EPS), rstd2 = __builtin_amdgcn_rsqf(wave_sum(s2) * (1.f / DM) + EPS);
        u32x2* o8 = (u32x2*)(H + (size_t)m * DM) + lane; u32x2* o82 = (u32x2*)(H + (size_t)m2 * DM) + lane;
#pragma unroll
        for (int j = 0; j < 4; ++j) { const f32x4 o = v[j] * rstd * gs[j] + sh[j]; u32x2 q; q.x = cvt_pk_bf16(o.x, o.y); q.y = cvt_pk_bf16(o.z, o.w); o8[64 * j] = q;
            const f32x4 o2 = w[j] * rstd2 * gs[j] + sh[j]; u32x2 q2; q2.x = cvt_pk_bf16(o2.x, o2.y); q2.y = cvt_pk_bf16(o2.z, o2.w); o82[64 * j] = q2; }
    }
}

__device__ __forceinline__ void ldrow8(const bf16_t* __restrict__ base, int t, int ch, float (&v)[8]) {
    if (t < 0 || t >= SEQ) {
#pragma unroll
        for (int j = 0; j < 8; ++j) v[j] = 0.f;
    } else unpack8(*(const u32x4*)(base + (size_t)t * 1024 + ch), v);
}
__device__ __forceinline__ void ld8f32(const float* p, float (&v)[8]) {
    const f32x4 a = *(const f32x4*)p, b = *(const f32x4*)(p + 4);
    v[0] = a.x; v[1] = a.y; v[2] = a.z; v[3] = a.w; v[4] = b.x; v[5] = b.y; v[6] = b.z; v[7] = b.w;
}

__device__ __forceinline__ void phase_elem(KArgs a, unsigned char* wsb, int l, int lane, int wave, int bid, int G) {
    unsigned char* ws = wsb;
    const int gw = bid * 8 + wave, NGW = G * 8;
    for (int it = gw; it < 2048; it += NGW) {
        const int run = it >> 1, hf = it & 1, ch = hf * 512 + lane * 8, t0 = run * 16;
        {
            const bf16_t* __restrict__ XA = (const bf16_t*)(ws + WS_XA); bf16_t* __restrict__ UA = (bf16_t*)(ws + WS_H);
            float w0[8], w1[8], w2[8], w3[8], bb[8];
            const float* cw = INP(a, I_CAW) + (size_t)l * 4 * 1024 + ch;
            ld8f32(cw, w0); ld8f32(cw + 1024, w1); ld8f32(cw + 2048, w2); ld8f32(cw + 3072, w3); ld8f32(INP(a, I_CAB) + l * 1024 + ch, bb);
            float xm2[8], xm1[8], x0[8], xp1[8];
            ldrow8(XA, t0 - 2, ch, xm2); ldrow8(XA, t0 - 1, ch, xm1); ldrow8(XA, t0, ch, x0);
#pragma unroll
            for (int s = 0; s < 16; ++s) { const int t = t0 + s;
                ldrow8(XA, t + 1, ch, xp1);
                float o[8];
#pragma unroll
                for (int j = 0; j < 8; ++j) o[j] = w0[j] * xm2[j] + w1[j] * xm1[j] + w2[j] * x0[j] + w3[j] * xp1[j] + bb[j];
                *(u32x4*)(UA + (size_t)t * 1024 + ch) = pack8(o);
#pragma unroll
                for (int j = 0; j < 8; ++j) { xm2[j] = xm1[j]; xm1[j] = x0[j]; x0[j] = xp1[j]; } }
        }
        {
            const bf16_t* __restrict__ PP = (const bf16_t*)(ws + WS_XC); const bf16_t* __restrict__ BG = (const bf16_t*)(ws + WS_BC); bf16_t* __restrict__ YC = (bf16_t*)(ws + WS_YC);
            float w0[8], w1[8], w2[8];
            const float* cw = INP(a, I_CCW) + (size_t)l * 3 * 1024 + ch;
            ld8f32(cw, w0); ld8f32(cw + 1024, w1); ld8f32(cw + 2048, w2);
            float pm1[8], p0[8], pp1[8], t1[8];
            ldrow8(PP, t0 - 1, ch, pm1); ldrow8(PP, t0, ch, p0);
#pragma unroll
            for (int s = 0; s < 16; ++s) { const int t = t0 + s;
                ldrow8(PP, t + 1, ch, pp1); ldrow8(BG, t, ch, t1);
                float o[8];
#pragma unroll
                for (int j = 0; j < 8; ++j) o[j] = t1[j] * (w0[j] * pm1[j] + w1[j] * p0[j] + w2[j] * pp1[j]);
                *(u32x4*)(YC + (size_t)t * 1024 + ch) = pack8(o);
#pragma unroll
                for (int j = 0; j < 8; ++j) { pm1[j] = p0[j]; p0[j] = pp1[j]; } }
        }
        {
            bf16_t* Q = (bf16_t*)(ws + WS_Q); bf16_t* Kb = (bf16_t*)(ws + WS_K);
            const float* rc = (const float*)(ws + WS_ROPE); const float* rs = rc + 320 * 32;
            const int d0 = (lane & 15) * 8, i0 = (lane & 3) * 8;
            float qg[8], kg[8];
            ld8f32(INP(a, I_QG) + l * 128 + d0, qg); ld8f32(INP(a, I_KG) + l * 128 + d0, kg);
            const bool second = (lane & 4) != 0;
            const int tokb = run * 16 + hf * 8;
            const int tsel = (d0 < 64) ? 0 : 1;
            u32x4 cur[3]; float cs[8], sn[8];
#define LD_TOK(tok, dst, dcs, dsn) do { const int tp_ = tsel ? 256 + ((tok) & 63) : ((tok) >> 6); ld8f32(rc + tp_ * 32 + i0, dcs); ld8f32(rs + tp_ * 32 + i0, dsn); \
                dst[0] = *(const u32x4*)(Q + (size_t)(tok) * 1024 + lane * 8); dst[1] = *(const u32x4*)(Q + (size_t)(tok) * 1024 + 512 + lane * 8); dst[2] = *(const u32x4*)(Kb + (size_t)(tok) * 256 + (lane & 31) * 8); } while (0)
            LD_TOK(tokb, cur, cs, sn);
#pragma unroll
            for (int i = 0; i < 8; ++i) {
                const int tok = tokb + i;
                u32x4 nx[3]; float ncs[8], nsn[8];
                if (i < 7) LD_TOK(tok + 1, nx, ncs, nsn);
#pragma unroll
                for (int part = 0; part < 3; ++part) {
                    bf16_t* p = (part < 2) ? (Q + (size_t)tok * 1024 + part * 512 + lane * 8) : (Kb + (size_t)tok * 256 + (lane & 31) * 8);
                    float v[8]; unpack8(cur[part], v);
                    float ss = 0.f;
#pragma unroll
                    for (int j = 0; j < 8; ++j) ss += v[j] * v[j];
                    ss += __shfl_xor(ss, 1); ss += __shfl_xor(ss, 2); ss += __shfl_xor(ss, 4); ss += __shfl_xor(ss, 8);
                    const float rstd = __builtin_amdgcn_rsqf(ss * (1.f / 128.f) + EPS);
                    float o[8];
#pragma unroll
                    for (int j = 0; j < 8; ++j) { const float y = v[j] * rstd * (part < 2 ? qg[j] : kg[j]); const float pr = __shfl_xor(y, 4);
                        o[j] = y * cs[j] + (second ? pr : -pr) * sn[j]; }
                    if (part < 2 || lane < 32) *(u32x4*)p = pack8(o);
                    if (part == 2 && lane < 32) {
                        const int kvh = lane >> 4, r = tok & 63, dch = (lane & 15) >> 1;
                        unsigned char* kp = ws + WS_K8 + (size_t)kvh * 2097152 + (size_t)(tok >> 6) * 8192 + r * 128 + 16 * (dch ^ (r & 7)) + (lane & 1) * 8;
                        u32x2 w8; w8.x = (unsigned)pk4_fp8(o[0], o[1], o[2], o[3]); w8.y = (unsigned)pk4_fp8(o[4], o[5], o[6], o[7]); *(u32x2*)kp = w8; }
                }
                if (i < 7) {
#pragma unroll
                    for (int part = 0; part < 3; ++part) cur[part] = nx[part];
#pragma unroll
                    for (int j = 0; j < 8; ++j) { cs[j] = ncs[j]; sn[j] = nsn[j]; } }
            }
#undef LD_TOK
        }
    }
    for (int it = gw; it < 4096; it += NGW) {
        const int jh = it & 1, h = (it >> 1) & 1, dh = (it >> 2) & 1, tile = (it >> 3) & 255, kvh = it >> 11;
        const int d = dh * 64 + lane;
        const bf16_t* __restrict__ V = (const bf16_t*)(ws + WS_V) + (size_t)tile * 64 * 256 + kvh * 128 + d;
        float f[16];
#pragma unroll
        for (int jj = 0; jj < 16; ++jj) { const int key = (jj & 3) + 8 * (jj >> 2) + 4 * h + 32 * jh; f[jj] = bf2f(V[(size_t)key * 256]); }
        u32x4 w; w.x = (unsigned)pk4_fp8(f[0], f[1], f[2], f[3]); w.y = (unsigned)pk4_fp8(f[4], f[5], f[6], f[7]); w.z = (unsigned)pk4_fp8(f[8], f[9], f[10], f[11]); w.w = (unsigned)pk4_fp8(f[12], f[13], f[14], f[15]);
        *(u32x4*)(ws + WS_V8 + (size_t)kvh * 2097152 + (size_t)tile * 8192 + d * 64 + 16 * ((2 * h + jh) ^ ((d >> 2) & 3))) = w;
    }
}

__device__ __forceinline__ void phase_scan_a(KArgs a, unsigned char* wsb, int lane, int wave, int bid, int G) {
    unsigned char* ws = wsb;
    const int gw = bid * 8 + wave, NGW = G * 8;
    for (int it = gw; it < 2048; it += NGW) {
        const int c = it >> 4, dir = (it >> 3) & 1, ch = (it & 7) * 128 + lane * 2;
        const bf16_t* LA = (const bf16_t*)(ws + WS_LA + (size_t)dir * 64 * MiB) + ch;
        const bf16_t* UU = (const bf16_t*)(ws + WS_U + (size_t)dir * 64 * MiB) + ch;
        float s0 = 0.f, s1 = 0.f, h0 = 0.f, h1 = 0.f;
#pragma unroll 16
        for (int st = 0; st < 128; ++st) { const int t = dir == 0 ? c * 128 + st : c * 128 + 127 - st;
            const unsigned wl = *(const unsigned*)(LA + (size_t)t * 1024), wu = *(const unsigned*)(UU + (size_t)t * 1024);
            const float l0 = __uint_as_float(wl << 16), l1 = __uint_as_float(wl & 0xffff0000u);
            const float u0 = __uint_as_float(wu << 16), u1 = __uint_as_float(wu & 0xffff0000u);
            h0 = __builtin_amdgcn_exp2f(l0) * h0 + u0; h1 = __builtin_amdgcn_exp2f(l1) * h1 + u1; s0 += l0; s1 += l1; }
        *(f32x2*)((float*)(ws + WS_SA) + (c * 2 + dir) * 1024 + ch) = (f32x2){s0, s1};
        *(f32x2*)((float*)(ws + WS_SH) + (c * 2 + dir) * 1024 + ch) = (f32x2){h0, h1};
    }
}
__device__ __forceinline__ void phase_scan_c(unsigned char* wsb, LAS unsigned char* lds, int lane, int wave, int bid, int G) {
    unsigned char* ws = wsb;
    const int gw = bid * 8 + wave, NGW = G * 8;
    const float* __restrict__ SA = (const float*)(ws + WS_SA); const float* __restrict__ SH = (const float*)(ws + WS_SH);
    for (int it = gw; it < 2048; it += NGW) {
        const int c = it >> 4, ch = (it & 15) * 64 + lane;
        float cf = 0.f, cb = 0.f;
#pragma unroll 8
        for (int sidx = 0; sidx < c; ++sidx) { const int idx = (sidx * 2) * 1024 + ch; cf = __builtin_amdgcn_exp2f(SA[idx]) * cf + SH[idx]; }
#pragma unroll 8
        for (int sidx = 127; sidx > c; --sidx) { const int idx = (sidx * 2 + 1) * 1024 + ch; cb = __builtin_amdgcn_exp2f(SA[idx]) * cb + SH[idx]; }
        const bf16_t* __restrict__ LAf = (const bf16_t*)(ws + WS_LA) + ch; const bf16_t* __restrict__ UUf = (const bf16_t*)(ws + WS_U) + ch;
        const bf16_t* __restrict__ LAb = (const bf16_t*)(ws + WS_LA + 64 * MiB) + ch; const bf16_t* __restrict__ UUb = (const bf16_t*)(ws + WS_U + 64 * MiB) + ch;
        const bf16_t* __restrict__ SGA = (const bf16_t*)(ws + WS_SGA) + ch; bf16_t* __restrict__ YA = (bf16_t*)(ws + WS_XA) + ch;
        LAS bf16_t* hfs = (LAS bf16_t*)(lds + wave * 16384) + lane;
        float h = cf;
        { const bf16_t* pl = LAf + (size_t)c * 128 * 1024; const bf16_t* pu = UUf + (size_t)c * 128 * 1024;
#pragma unroll 1
            for (int blk = 0; blk < 8; ++blk) {
                float l[16], u[16];
#pragma unroll
                for (int i = 0; i < 16; ++i) { l[i] = bf2f(pl[i * 1024]); u[i] = bf2f(pu[i * 1024]); }
#pragma unroll
                for (int i = 0; i < 16; ++i) { h = __builtin_amdgcn_exp2f(l[i]) * h + u[i]; hfs[(blk * 16 + i) * 64] = (bf16_t)f2bf(h); }
                pl += 16 * 1024; pu += 16 * 1024; } }
        h = cb;
        { const size_t e0 = (size_t)(c * 128 + 112) * 1024;
            const bf16_t* pl = LAb + e0; const bf16_t* pu = UUb + e0; const bf16_t* pg = SGA + e0; bf16_t* py = YA + e0;
#pragma unroll 1
            for (int blk = 7; blk >= 0; --blk) {
                float l[16], u[16], g[16];
#pragma unroll
                for (int i = 0; i < 16; ++i) { l[i] = bf2f(pl[i * 1024]); u[i] = bf2f(pu[i * 1024]); g[i] = bf2f(pg[i * 1024]); }
#pragma unroll
                for (int i = 15; i >= 0; --i) { h = __builtin_amdgcn_exp2f(l[i]) * h + u[i];
                    py[i * 1024] = (bf16_t)f2bf((bf2f(hfs[(blk * 16 + i) * 64]) + h) * g[i]); }
                pl -= 16 * 1024; pu -= 16 * 1024; pg -= 16 * 1024; py -= 16 * 1024; } }
    }
}

__global__ void __launch_bounds__(512, 2) mk_fwd(Args args) {
    extern __shared__ __attribute__((aligned(16))) unsigned char lds[];
    cg::grid_group grid = cg::this_grid();
    LAS unsigned char* L = (LAS unsigned char*)lds;
    if (threadIdx.x < 2) ((LAS unsigned*)(L + 131072))[threadIdx.x] = 0u;
    __syncthreads();
    (void)xcd_barrier_post((unsigned*)(args.ws + WS_BAR), (volatile LAS unsigned*)(L + 131072));
    const int wave_u = __builtin_amdgcn_readfirstlane(threadIdx.x >> 6);
    for (int ph = args.ph_lo; ph < args.ph_hi; ++ph) {
        int tid; { int ln_; asm volatile("v_mbcnt_lo_u32_b32 %0, -1, 0\n\tv_mbcnt_hi_u32_b32 %0, -1, %0" : "=v"(ln_)); tid = wave_u * 64 + ln_; }
        int G = gridDim.x, bid = blockIdx.x; asm volatile("" : "+s"(G), "+s"(bid));
        KArgs ap = (KArgs)__builtin_amdgcn_kernarg_segment_ptr(); asm volatile("" : "+s"(ap));
        GAS unsigned char* wsg = (GAS unsigned char*)ap->ws; asm volatile("" : "+s"(wsg));
        unsigned char* ws = (unsigned char*)wsg;
        const int lane = tid & 63, wave = __builtin_amdgcn_readfirstlane(tid >> 6);
        unsigned long long pt0 = 0; int pcls = -1; if (PROBE_K >= 0) pt0 = __builtin_amdgcn_s_memrealtime();
        if (ph == 0) { pcls = 8; if (PHM & 512) phase_prologue(ap, ws, L, tid, lane, wave, bid, G); }
        else {
            const int q = ph - 1, lb = q / NPH_PER, k = q - lb * NPH_PER, l = lb >> 1, b = lb & 1; pcls = k;
            if (k == 0) { if (PHM & 1) phase_h(ap, ws, l, b, lane, wave, bid, G); }
            else if (k == 1) { if (PHM & 2) {
                pg8::Gemm g{(const bf16_t*)(ws + WS_H), (const bf16_t*)(ws + WS_WIN) + (size_t)l * NIN * 1024, 1024, 1024, 1024, 0, 0};
                pg8::StaticOrder S; S.init(SEQ, NIN, G, bid);
                pg8::EpiInProj E{ws};
                pg8::gemm_phase<pg8::EpiInProj, pg8::StaticOrder, 0>(L, g, S, E, tid); }
            } else if (k == 2) { if (PHM & 4) phase_elem(ap, ws, l, lane, wave, bid, G); }
            else if (k == 3) {
                if (PHM & 8) {
                    pg8::Gemm g{(const bf16_t*)(ws + WS_H), (const bf16_t*)(ws + WS_WG) + (size_t)l * 4096 * 256, 1024, 256, 256, 0, 0};
                    pg8::StaticOrder S; S.init(SEQ, 4096, G, bid);
                    pg8::EpiGates E{ws, INP(ap, I_BRG) + l * 2048, INP(ap, I_BIG) + l * 2048, INP(ap, I_LAM) + l * 2048};
                    pg8::gemm_phase<pg8::EpiGates, pg8::StaticOrder, 1>(L, g, S, E, tid);
                }
                if (PROBE_K == 3) { const unsigned long long t1 = __builtin_amdgcn_s_memrealtime(), dt = t1 - pt0; while (__builtin_amdgcn_s_memrealtime() - t1 < dt) __builtin_amdgcn_s_sleep(8); }
                if (PROBE_K == 9) { pt0 = __builtin_amdgcn_s_memrealtime(); pcls = 9; }
                if (PHM & 256) {
                    const int v = (G % 8 == 0) ? (bid % 8) * (G / 8) + bid / 8 : bid;
                    const int per = (512 + G - 1) / G;
                    if (PROBE_F8 && l == 0 && b == 0) {
                        for (int i = 0; i < per; ++i) { const int idx = v * per + i; if (idx >= 4) break;
                            const int h = idx >> 6, qb = idx & 63, kvh = h >> 2;
                            const attn::bf16* Qb = (const attn::bf16*)(ws + WS_Q) + (size_t)qb * 256 * 1024 + h * 128;
                            const bf16_t* Gb = (const bf16_t*)(ws + WS_SGB) + (size_t)qb * 256 * 1024 + h * 128;
                            attn::attn_pp8_body(Qb, ws + WS_K8 + (size_t)kvh * 2097152, ws + WS_V8 + (size_t)kvh * 2097152, (bf16_t*)(ws + WS_SPARE) + (size_t)idx * 256 * 1024, nullptr, SEQ, (char*)lds, tid);
                        }
                    }
                    int tid2 = tid; asm volatile("" : "+v"(tid2));
                    for (int i = 0; i < per; ++i) { const int idx = v * per + i; if (idx >= 512) break;
                        const int h = idx >> 6, qb = idx & 63, kvh = h >> 2;
                        const attn::bf16* Qb = (const attn::bf16*)(ws + WS_Q) + (size_t)qb * 256 * 1024 + h * 128;
                        bf16_t* Ob = (bf16_t*)(ws + WS_SGB) + (size_t)qb * 256 * 1024 + h * 128;
                        const bf16_t* Gb = (const bf16_t*)(ws + WS_SGB) + (size_t)qb * 256 * 1024 + h * 128;
                        if (PROBE_F8) {
                            const attn::bf16* Kh = (const attn::bf16*)(ws + WS_K) + kvh * 128;
                            const attn::bf16* Vh = (const attn::bf16*)(ws + WS_V) + kvh * 128;
                            const bf16_t* cmp = (l == 0 && b == 0 && idx < 4) ? (const bf16_t*)(ws + WS_SPARE) + (size_t)idx * 256 * 1024 : nullptr;
                            attn::attn_pp_body(Qb, Kh, Vh, Ob, Gb, SEQ, (char*)lds, tid2, cmp, (unsigned*)(ws + WS_FLAG));
                        } else attn::attn_pp8_body(Qb, ws + WS_K8 + (size_t)kvh * 2097152, ws + WS_V8 + (size_t)kvh * 2097152, Ob, Gb, SEQ, (char*)lds, tid2);
                    }
                }
            } else if (k == 4) { if (PHM & 16) phase_scan_a(ap, ws, lane, wave, bid, G); }
            else if (k == 5) { if (PHM & 32) phase_scan_c(ws, L, lane, wave, bid, G); }
            else if (k == 6) { if (PHM & 64) {
                pg8::Gemm g{(const bf16_t*)(ws + WS_XA), (const bf16_t*)(ws + WS_WBR) + (size_t)l * 3 * 1048576, 1024, 1024, 1024,
                            (long)WS_SGB - (long)WS_XA, (long)WS_YC - (long)WS_XA};
                pg8::BranchOrder S; S.so.init(SEQ, 1024, G, bid);
                pg8::EpiBranch E{ws};
                pg8::gemm_phase<pg8::EpiBranch, pg8::BranchOrder, 2>(L, g, S, E, tid); }
            } else if (PHM & 128) {
                pg8::Gemm g{(const bf16_t*)(ws + WS_SGA), (const bf16_t*)(ws + WS_WOUT) + (size_t)l * 1048576, 1024, 1024, 1024, 0, 0};
                pg8::StaticOrder S; S.init(SEQ, 1024, G, bid);
                const float* xi = (l == 0 ? INP(ap, I_X) : OUTP(ap)) + (size_t)b * SEQ * DM;
                pg8::EpiOut E{xi, OUTP(ap) + (size_t)b * SEQ * DM, (const float*)(ws + WS_MOD) + (l * 2 + b) * 3072 + 2048, (const unsigned*)(ws + WS_FLAG)};
                pg8::gemm_phase<pg8::EpiOut, pg8::StaticOrder, 0>(L, g, S, E, tid);
            }
        }
        if (PROBE_K >= 0 && PROBE_K != 3 && ph + 1 == args.ph_hi && pcls == PROBE_K) { VM_WAIT(); __syncthreads(); const unsigned long long t1 = __builtin_amdgcn_s_memrealtime(), dt = t1 - pt0; while (__builtin_amdgcn_s_memrealtime() - t1 < dt) __builtin_amdgcn_s_sleep(8); }
        if (ph + 1 < args.ph_hi) { if (ph == args.ph_lo) grid.sync(); else { XcdBarrier xbar; xbar.bar = (unsigned*)(ws + WS_BAR); xbar.x = xb_xcc_id(); xbar.st = (volatile LAS unsigned*)(L + 131072); xcd_barrier(xbar, tid); }
            if (PROBE_K >= 0 && PROBE_K != 3 && pcls == PROBE_K) { const unsigned long long t1 = __builtin_amdgcn_s_memrealtime(), dt = t1 - pt0; while (__builtin_amdgcn_s_memrealtime() - t1 < dt) __builtin_amdgcn_s_sleep(8); } }
    }
}

extern "C" void kernel_launch(void* const* d_in, const int* in_sizes, int n_in, void* d_out, int out_size, void* d_ws, size_t ws_size, hipStream_t stream) {
    static int grid = 0;
    if (grid == 0) {
        if (n_in != 18 || ws_size < WS_END) { fprintf(stderr, "kernel_launch: need 18 inputs and >= %zu bytes of workspace (got %d, %zu)\n", (size_t)WS_END, n_in, ws_size); grid = -1; return; }
        int dev = 0, cus = 0, per_cu = 0;
        hipGetDevice(&dev);
        hipDeviceGetAttribute(&cus, hipDeviceAttributeMultiprocessorCount, dev);
        if (hipFuncSetAttribute((const void*)mk_fwd, hipFuncAttributeMaxDynamicSharedMemorySize, LDS_BYTES) != hipSuccess) { fprintf(stderr, "kernel_launch: hipFuncSetAttribute failed\n"); grid = -1; return; }
        if (hipOccupancyMaxActiveBlocksPerMultiprocessor(&per_cu, (const void*)mk_fwd, 512, LDS_BYTES) != hipSuccess || per_cu < 1) { fprintf(stderr, "kernel_launch: occupancy query gave %d\n", per_cu); per_cu = 1; }
        (void)hipGetLastError();
        grid = cus * 1;
    }
    if (grid < 0) return;
    if (hipMemsetAsync((char*)d_ws + WS_BAR, 0, 16384, stream) != hipSuccess) { fprintf(stderr, "kernel_launch: memset failed\n"); return; }
    Args a{};
    for (int i = 0; i < 18; ++i) a.in[i] = (const float*)d_in[i];
    a.out = (float*)d_out; a.ws = (unsigned char*)d_ws; a.ph_lo = 0; a.ph_hi = NPHASES;
    void* kargs[] = {&a};
    hipError_t e = hipLaunchCooperativeKernel((const void*)mk_fwd, dim3(grid), dim3(512), kargs, LDS_BYTES, stream);
    if (e != hipSuccess) fprintf(stderr, "kernel_launch: cooperative launch failed: %s (grid %d)\n", hipGetErrorString(e), grid);
}
```
